# Optimizing an MI355X kernel written in HIP

```python
import math
import jax, jax.numpy as jnp
from jax import lax
import numpy as np

D_MODEL = 1024
BATCH = 2
SEQ = 8192
DEPTH = 1

D_CONV = D_MODEL
CONV_WIDTH = 3
MLA_HEADS = 8
QK_NOPE = 128
QK_ROPE = 64
V_HEAD = 128
Q_LORA = 256
KV_LORA = 128
ROPE_THETA = 10000.0
Q_BLOCK = 128
MEM_LEN = 256
MEM_HEADS = 4
MEM_HEAD_DIM = D_MODEL // MEM_HEADS
N_EXPERTS = 16
EXPERT_FF = 1024
CAPACITY_FACTOR = 2
EPS = 1e-6
IN_COLS = 3 * D_CONV + Q_LORA + KV_LORA + QK_ROPE + 2 * D_MODEL

kernel_name = "hybrid_conv_mla_ec_moe_encoder"


def rmsnorm(x, g):
    xf = x.astype(jnp.float32)
    y = xf * lax.rsqrt(jnp.mean(xf * xf, axis=-1, keepdims=True) + EPS)
    return (y * g.astype(jnp.float32)).astype(x.dtype)


def rotary_tables(seq):
    inv = 1.0 / (ROPE_THETA ** (jnp.arange(0, QK_ROPE, 2, dtype=jnp.float32) / QK_ROPE))
    ang = jnp.arange(seq, dtype=jnp.float32)[:, None] * inv[None, :]
    return jnp.cos(ang), jnp.sin(ang)


def apply_rope(v, cos, sin):
    vf = v.astype(jnp.float32)
    v1, v2 = jnp.split(vf, 2, axis=-1)
    out = jnp.concatenate([v1 * cos - v2 * sin, v1 * sin + v2 * cos], axis=-1)
    return out.astype(v.dtype)


def short_conv(v, w, b):
    y = lax.conv_general_dilated(
        v, w[:, None, :].astype(v.dtype), window_strides=(1,), padding=((1, 1),),
        dimension_numbers=("NWC", "WIO", "NWC"), feature_group_count=v.shape[-1])
    return y + b.astype(v.dtype)


def mla_attention(q_nope, q_rope, k_nope, k_rope, v):
    b, s, h, _ = q_nope.shape
    nb = s // Q_BLOCK
    scale = (QK_NOPE + QK_ROPE) ** -0.5
    qn = q_nope.reshape(b, nb, Q_BLOCK, h, QK_NOPE).transpose(1, 0, 2, 3, 4)
    qr = q_rope.reshape(b, nb, Q_BLOCK, h, QK_ROPE).transpose(1, 0, 2, 3, 4)

    def block(args):
        qn_b, qr_b = args
        sc = (jnp.einsum("bqhd,bkhd->bhqk", qn_b, k_nope)
              + jnp.einsum("bqhr,bkr->bhqk", qr_b, k_rope))
        p = jax.nn.softmax(sc.astype(jnp.float32) * scale, axis=-1).astype(v.dtype)
        return jnp.einsum("bhqk,bkhd->bqhd", p, v)

    o = lax.map(block, (qn, qr))
    return o.transpose(1, 0, 2, 3, 4).reshape(b, s, h * V_HEAD)


def memory_cross_attention(h, m, w_q, w_kv, w_o):
    b, s, _ = h.shape
    ml = m.shape[1]
    q = (h @ w_q).reshape(b, s, MEM_HEADS, MEM_HEAD_DIM)
    kv = (m @ w_kv).reshape(b, ml, 2, MEM_HEADS, MEM_HEAD_DIM)
    k, v = kv[:, :, 0], kv[:, :, 1]
    sc = jnp.einsum("bqhd,bkhd->bhqk", q, k).astype(jnp.float32) * (MEM_HEAD_DIM ** -0.5)
    p = jax.nn.softmax(sc, axis=-1).astype(v.dtype)
    o = jnp.einsum("bhqk,bkhd->bqhd", p, v).reshape(b, s, MEM_HEADS * MEM_HEAD_DIM)
    return o @ w_o


def expert_choice_moe(h, w_router, w_gate, w_up, w_down):
    b, s, d = h.shape
    cap = max(1, CAPACITY_FACTOR * s // N_EXPERTS)
    aff = jax.nn.softmax((h @ w_router).astype(jnp.float32), axis=-1)
    gates, idx = lax.top_k(jnp.swapaxes(aff, 1, 2), cap)
    xg = jax.vmap(lambda hb, ib: hb[ib])(h, idx)
    a = jax.nn.silu(jnp.einsum("becd,edf->becf", xg, w_gate)) * jnp.einsum("becd,edf->becf", xg, w_up)
    yo = jnp.einsum("becf,efd->becd", a, w_down) * gates[..., None].astype(h.dtype)
    return jax.vmap(lambda ib, vb: jnp.zeros((s, d), vb.dtype).at[ib.reshape(-1)].add(vb.reshape(-1, d)))(idx, yo)


def setup_inputs(seed: int = 0) -> dict:
    key = jax.random.key(seed)
    ks = jax.random.split(key, 32)

    def w(k, shape, fan_in):
        return jax.random.normal(k, shape, jnp.float32) * fan_in ** -0.5

    def g(k, shape):
        return 1.0 + 0.02 * jax.random.normal(k, shape, jnp.float32)

    def bias(k, shape):
        return 0.02 * jax.random.normal(k, shape, jnp.float32)

    L = DEPTH
    return {
        "x": jax.random.normal(ks[0], (BATCH, SEQ, D_MODEL), jnp.float32),
        "mem": jax.random.normal(ks[1], (BATCH, MEM_LEN, D_MODEL), jnp.float32),
        "norm_mix_g": g(ks[2], (L, D_MODEL)),
        "w_in": w(ks[3], (L, D_MODEL, IN_COLS), D_MODEL),
        "conv_w": w(ks[4], (L, CONV_WIDTH, D_CONV), CONV_WIDTH),
        "conv_b": bias(ks[5], (L, D_CONV)),
        "w_conv_out": w(ks[6], (L, D_CONV, D_MODEL), D_CONV),
        "q_norm_g": g(ks[7], (L, Q_LORA)),
        "w_uq": w(ks[8], (L, Q_LORA, MLA_HEADS * (QK_NOPE + QK_ROPE)), Q_LORA),
        "kv_norm_g": g(ks[9], (L, KV_LORA)),
        "w_ukv": w(ks[10], (L, KV_LORA, MLA_HEADS * (QK_NOPE + V_HEAD)), KV_LORA),
        "w_mla_out": w(ks[11], (L, MLA_HEADS * V_HEAD, D_MODEL), MLA_HEADS * V_HEAD),
        "b_gate": bias(ks[12], (L, 2 * D_MODEL)),
        "w_mix_out": w(ks[13], (L, D_MODEL, D_MODEL), D_MODEL),
        "norm_mem_g": g(ks[14], (L, D_MODEL)),
        "norm_memkv_g": g(ks[15], (L, D_MODEL)),
        "w_mem_q": w(ks[16], (L, D_MODEL, MEM_HEADS * MEM_HEAD_DIM), D_MODEL),
        "w_mem_kv": w(ks[17], (L, D_MODEL, 2 * MEM_HEADS * MEM_HEAD_DIM), D_MODEL),
        "w_mem_out": w(ks[18], (L, MEM_HEADS * MEM_HEAD_DIM, D_MODEL), MEM_HEADS * MEM_HEAD_DIM),
        "norm_moe_g": g(ks[19], (L, D_MODEL)),
        "w_router": w(ks[20], (L, D_MODEL, N_EXPERTS), D_MODEL),
        "w_exp_gate": w(ks[21], (L, N_EXPERTS, D_MODEL, EXPERT_FF), D_MODEL),
        "w_exp_up": w(ks[22], (L, N_EXPERTS, D_MODEL, EXPERT_FF), D_MODEL),
        "w_exp_down": w(ks[23], (L, N_EXPERTS, EXPERT_FF, D_MODEL), EXPERT_FF),
        "norm_final_g": g(ks[24], (D_MODEL,)),
    }


def reference(x, mem, norm_mix_g, w_in, conv_w, conv_b, w_conv_out, q_norm_g, w_uq, kv_norm_g,
              w_ukv, w_mla_out, b_gate, w_mix_out, norm_mem_g, norm_memkv_g, w_mem_q, w_mem_kv,
              w_mem_out, norm_moe_g, w_router, w_exp_gate, w_exp_up, w_exp_down, norm_final_g):
    b, s, _ = x.shape
    cos, sin = rotary_tables(s)
    splits = list(np.cumsum([D_CONV, D_CONV, D_CONV, Q_LORA, KV_LORA, QK_ROPE]))
    for l in range(DEPTH):
        h = rmsnorm(x, norm_mix_g[l])
        u = h @ w_in[l]
        xc, gb, gc, cq, ckv, kr, glog = jnp.split(u, splits, axis=-1)
        y_conv = (gb * short_conv(gc * xc, conv_w[l], conv_b[l])) @ w_conv_out[l]
        q = (rmsnorm(cq, q_norm_g[l]) @ w_uq[l]).reshape(b, s, MLA_HEADS, QK_NOPE + QK_ROPE)
        q_nope, q_rope = q[..., :QK_NOPE], apply_rope(q[..., QK_NOPE:], cos[None, :, None, :], sin[None, :, None, :])
        kv = (rmsnorm(ckv, kv_norm_g[l]) @ w_ukv[l]).reshape(b, s, MLA_HEADS, QK_NOPE + V_HEAD)
        k_nope, v = kv[..., :QK_NOPE], kv[..., QK_NOPE:]
        k_rope = apply_rope(kr, cos[None], sin[None])
        y_mla = mla_attention(q_nope, q_rope, k_nope, k_rope, v) @ w_mla_out[l]
        gates = jax.nn.sigmoid((glog + b_gate[l]).astype(jnp.float32)).astype(x.dtype)
        g_conv, g_mla = gates[..., :D_MODEL], gates[..., D_MODEL:]
        x = x + (g_conv * y_conv + g_mla * y_mla) @ w_mix_out[l]
        x = x + memory_cross_attention(rmsnorm(x, norm_mem_g[l]), rmsnorm(mem, norm_memkv_g[l]),
                                       w_mem_q[l], w_mem_kv[l], w_mem_out[l])
        x = x + expert_choice_moe(rmsnorm(x, norm_moe_g[l]), w_router[l], w_exp_gate[l],
                                  w_exp_up[l], w_exp_down[l])
    return rmsnorm(x, norm_final_g)
```

```cpp
#include <hip/hip_runtime.h>
#include <cstdio>
#include <cstdint>

#ifndef MK_N_LAUNCHES
#define MK_N_LAUNCHES 1
#endif
#ifndef REP_PHASE
#define REP_PHASE -1
#endif
#ifndef RESID_BF16
#define RESID_BF16 1
#endif
#ifndef GEMM_SIMPLE
#define GEMM_SIMPLE 0
#endif

#define LAS __attribute__((address_space(3)))
#define GAS __attribute__((address_space(1)))
typedef unsigned short bf16_t;
typedef short bf16x8 __attribute__((ext_vector_type(8)));
typedef short s16x4 __attribute__((ext_vector_type(4)));
typedef float f32x2 __attribute__((ext_vector_type(2)));
typedef float f32x4 __attribute__((ext_vector_type(4)));
typedef float f32x16 __attribute__((ext_vector_type(16)));
typedef unsigned u32x2 __attribute__((ext_vector_type(2)));
typedef unsigned u32x4 __attribute__((ext_vector_type(4)));
typedef __bf16 bf16x2_t __attribute__((ext_vector_type(2)));

constexpr int DM = 1024, NB = 2, SEQ = 8192, MT = NB * SEQ;
constexpr int NU = 5632;
constexpr int NHEAD = 8, QK_NOPE = 128, QK_ROPE = 64, V_HEAD = 128, Q_LORA = 256, KV_LORA = 128;
constexpr int MEM_LEN = 256, MEM_HEADS = 4, MEM_HD = 256;
constexpr int NEXP = 16, EFF = 1024, CAP = 1024;
constexpr int MOE_ROWS = NB * NEXP * CAP;
constexpr float EPS = 1e-6f;
constexpr float ATT_SCALE = 0.07216878364870322f;

__device__ __forceinline__ unsigned cvtpk(float lo, float hi) { f32x2 v = {lo, hi}; bf16x2_t b = __builtin_convertvector(v, bf16x2_t); return __builtin_bit_cast(unsigned, b); }
__device__ __forceinline__ float bflo(unsigned w) { return __builtin_bit_cast(float, w << 16); }
__device__ __forceinline__ float bfhi(unsigned w) { return __builtin_bit_cast(float, w & 0xffff0000u); }
__device__ __forceinline__ float bf2f(bf16_t h) { return __builtin_bit_cast(float, (unsigned)h << 16); }
__device__ __forceinline__ bf16_t f2bf(float f) { return (bf16_t)(cvtpk(f, 0.f) & 0xffffu); }
__device__ __forceinline__ void unpack8(const u32x4 w, float (&v)[8]) { v[0] = bflo(w.x); v[1] = bfhi(w.x); v[2] = bflo(w.y); v[3] = bfhi(w.y); v[4] = bflo(w.z); v[5] = bfhi(w.z); v[6] = bflo(w.w); v[7] = bfhi(w.w); }
__device__ __forceinline__ u32x4 pack8(const float (&v)[8]) { u32x4 w; w.x = cvtpk(v[0], v[1]); w.y = cvtpk(v[2], v[3]); w.z = cvtpk(v[4], v[5]); w.w = cvtpk(v[6], v[7]); return w; }
__device__ __forceinline__ float wave_sum(float v) {
#pragma unroll
    for (int o = 1; o < 64; o <<= 1) v += __shfl_xor(v, o);
    return v;
}

namespace pg8 {
constexpr int BM = 256, BK = 64, HALF = 128, HTB = HALF * BK * 2, STAGE_BYTES = 8 * HTB, NXCD = 8, WGM = 8;
__host__ __device__ __forceinline__ int lds_byte(int r, int c) { const int st = (r >> 4) * 2 + (c >> 5), rr = r & 15, cc = c & 31, ob = rr * 64 + cc * 2; return st * 1024 + (ob ^ (((ob >> 9) & 1) << 5)); }
__host__ __device__ __forceinline__ void stage_rc(int b, int& R, int& C) { const int st = b / 1024, sb = b % 1024, swz = sb ^ (((sb >> 9) & 1) << 5); R = (st >> 1) * 16 + swz / 64; C = (st & 1) * 32 + (swz % 64) / 2; }
__host__ __device__ __forceinline__ int perm32(int rho) { const int n = rho >> 4, i = rho & 15; return 8 * (i >> 2) + 4 * n + (i & 3); }

struct Unit { int pm, pn; };
struct Gemm { const bf16_t* A; const bf16_t* Bt; int M, N, K, lda, ldb, bdiv, bmod; size_t bstride; const int* gidx; };
__device__ __forceinline__ Gemm mkgemm(const bf16_t* A, const bf16_t* Bt, int M, int N, int K, int lda, int ldb, int bdiv = 1, int bmod = 1, size_t bstride = 0) {
    Gemm g; g.A = A; g.Bt = Bt; g.M = M; g.N = N; g.K = K; g.lda = lda; g.ldb = ldb; g.bdiv = bdiv; g.bmod = bmod; g.bstride = bstride; g.gidx = nullptr; return g; }

struct StaticOrder {
    int nM, nN, nwg, G, c;
    __host__ __device__ void init(int M, int N, int G_, int c_) { nM = M / BM; nN = N / BM; nwg = nM * nN; G = G_; c = c_; }
    __host__ __device__ bool next(int i, Unit& u) const {
        const long L = (long)i * G + c; if (L >= nwg) return false;
        int wgid = (int)L; { const int q = nwg / NXCD, r = nwg % NXCD, xcd = wgid % NXCD, off = wgid / NXCD; wgid = (xcd < r ? xcd * (q + 1) : r * (q + 1) + (xcd - r) * q) + off; }
        const int nig = WGM * nN, gid = wgid / nig, fm = gid * WGM, gsz = (nM - fm) < WGM ? (nM - fm) : WGM;
        u.pm = fm + ((wgid % nig) % gsz); u.pn = (wgid % nig) / gsz; return true;
    }
};

typedef f32x4 Acc[2][2][4][2];

template <class Epi, class Sched>
__device__ __forceinline__ void gemm_simple(LAS unsigned char* lds, const Gemm g, const Sched& S, const Epi& E) {
    const int tid = threadIdx.x, wid = __builtin_amdgcn_readfirstlane(tid >> 6), lane = tid & 63, wr = wid >> 2, wc = wid & 3, fr = lane & 15, fq = lane >> 4;
    Unit u;
    for (int i = 0; S.next(i, u); ++i) {
        Acc acc;
#pragma unroll
        for (int a = 0; a < 2; ++a)
#pragma unroll
            for (int b = 0; b < 2; ++b)
#pragma unroll
                for (int m = 0; m < 4; ++m)
#pragma unroll
                    for (int n = 0; n < 2; ++n) acc[a][b][m][n] = (f32x4){0.f, 0.f, 0.f, 0.f};
        const bf16_t* Ab = g.A + (size_t)u.pm * BM * g.lda + (size_t)(wr * 64 + fr) * g.lda + fq * 8;
        const bf16_t* Bb = g.Bt + (size_t)((u.pm / g.bdiv) % g.bmod) * g.bstride + (size_t)u.pn * BM * g.ldb + fq * 8;
        int brow[2][2];
#pragma unroll
        for (int bj = 0; bj < 2; ++bj)
#pragma unroll
            for (int n = 0; n < 2; ++n) brow[bj][n] = bj * HALF + wc * 32 + perm32(n * 16 + fr);
#pragma unroll 1
        for (int k0 = 0; k0 < g.K; k0 += 32) {
            bf16x8 b[2][2];
#pragma unroll
            for (int bj = 0; bj < 2; ++bj)
#pragma unroll
                for (int n = 0; n < 2; ++n) b[bj][n] = *(const bf16x8*)(Bb + (size_t)brow[bj][n] * g.ldb + k0);
#pragma unroll
            for (int ai = 0; ai < 2; ++ai) { bf16x8 a[4];
#pragma unroll
                for (int m = 0; m < 4; ++m) a[m] = *(const bf16x8*)(Ab + (size_t)(ai * HALF + m * 16) * g.lda + k0);
#pragma unroll
                for (int bj = 0; bj < 2; ++bj)
#pragma unroll
                    for (int m = 0; m < 4; ++m)
#pragma unroll
                        for (int n = 0; n < 2; ++n) acc[ai][bj][m][n] = __builtin_amdgcn_mfma_f32_16x16x32_bf16(b[bj][n], a[m], acc[ai][bj][m][n], 0, 0, 0); }
        }
        E.run(acc, u, wr, wc, fr, fq, lds, wid, lane);
        if (Epi::USES_LDS) __syncthreads();
    }
}

template <class Epi, class Sched, bool GATHER>
__device__ __forceinline__ void gemm_fast(LAS unsigned char* lds, const Gemm g, const Sched& S, const Epi& E) {
    const int tid = threadIdx.x, wid = __builtin_amdgcn_readfirstlane(tid >> 6), lane = tid & 63, wr = wid >> 2, wc = wid & 3, fr = lane & 15, fq = lane >> 4;
    int Kop = g.K; asm volatile("" : "+s"(Kop));
    const int K = Kop, nt = K / BK;
    int Rr[2], Cc[2]; unsigned voffB[2];
    unsigned cvA0[2], cvA1[2], nvA0[2], nvA1[2];
    const size_t kstep = (size_t)(BK * 2);
    const size_t hstepA = (size_t)HALF * g.lda * 2, hstepB = (size_t)HALF * g.ldb * 2;
    const size_t tstepA = 2 * hstepA, tstepB = 2 * hstepB;
#pragma unroll
    for (int i = 0; i < 2; ++i) { stage_rc(tid * 16 + i * 8192, Rr[i], Cc[i]); const int Rb = (Rr[i] & ~31) + perm32(Rr[i] & 31);
        voffB[i] = (unsigned)(Rb * g.ldb + Cc[i]) * 2u;
        cvA0[i] = (unsigned)(Rr[i] * g.lda + Cc[i]) * 2u; cvA1[i] = cvA0[i] + (unsigned)hstepA; nvA0[i] = cvA0[i]; nvA1[i] = cvA1[i]; }
    const unsigned ldsw = (unsigned)wid * 1024u;
    const int aoff = lds_byte(wr * 64 + fr, fq * 8), boff = lds_byte(wc * 32 + fr, fq * 8);
#define PG8_SA(b, h) (((b) * 2 + (h)) * HTB)
#define PG8_SB(b, h) ((4 + (b) * 2 + (h)) * HTB)
#define PG8_STAGE(bufoff, gbase, voff) do { _Pragma("unroll") for (int _i = 0; _i < 2; ++_i) \
        __builtin_amdgcn_global_load_lds((const unsigned*)((const char*)(gbase) + (voff)[_i]), (LAS unsigned*)(lds + (bufoff) + ldsw + _i * 8192), 16, 0, 0); } while (0)
#define PG8_LDA(dst, b, h) do { _Pragma("unroll") for (int m = 0; m < 4; ++m) _Pragma("unroll") for (int k = 0; k < 2; ++k) dst[m][k] = *(const LAS bf16x8*)(lds + PG8_SA(b, h) + aoff + m * 2048 + k * 1024); } while (0)
#define PG8_LDB(dst, b, h) do { _Pragma("unroll") for (int n = 0; n < 2; ++n) _Pragma("unroll") for (int k = 0; k < 2; ++k) dst[n][k] = *(const LAS bf16x8*)(lds + PG8_SB(b, h) + boff + n * 2048 + k * 1024); } while (0)
#define PG8_MMA(ai, bj, At, Bt) do { __builtin_amdgcn_s_setprio(1); _Pragma("unroll") for (int m = 0; m < 4; ++m) _Pragma("unroll") for (int n = 0; n < 2; ++n) _Pragma("unroll") for (int k = 0; k < 2; ++k) \
        acc[ai][bj][m][n] = __builtin_amdgcn_mfma_f32_16x16x32_bf16(Bt[n][k], At[m][k], acc[ai][bj][m][n], 0, 0, 0); __builtin_amdgcn_s_setprio(0); } while (0)
#define PG8_WAIT_V(n) asm volatile("s_waitcnt vmcnt(" #n ")" ::: "memory")
#define PG8_WAIT_L(n) asm volatile("s_waitcnt lgkmcnt(" #n ")" ::: "memory")
#define PG8_BAR __builtin_amdgcn_s_barrier()
#define PG8_SCHED __builtin_amdgcn_sched_barrier(0)
#define PG8_GIDX(u, raw) do { const int* ip_ = g.gidx + (size_t)(u).pm * BM; raw[0] = ip_[Rr[0]]; raw[1] = ip_[Rr[1]]; raw[2] = ip_[HALF + Rr[0]]; raw[3] = ip_[HALF + Rr[1]]; } while (0)
#define PG8_GOFF(u, raw, v0, v1) do { const unsigned bb_ = (unsigned)((u).pm >> 6) * (unsigned)SEQ; _Pragma("unroll") for (int _i = 0; _i < 2; ++_i) { \
        v0[_i] = ((bb_ + (unsigned)raw[_i]) * (unsigned)g.lda + (unsigned)Cc[_i]) * 2u; v1[_i] = ((bb_ + (unsigned)raw[2 + _i]) * (unsigned)g.lda + (unsigned)Cc[_i]) * 2u; } } while (0)
    Unit cur, nxt; int ui = 0;
    if (!S.next(0, cur)) return;
    Acc acc;
#pragma unroll
    for (int a = 0; a < 2; ++a)
#pragma unroll
        for (int b = 0; b < 2; ++b)
#pragma unroll
            for (int m = 0; m < 4; ++m)
#pragma unroll
                for (int n = 0; n < 2; ++n) acc[a][b][m][n] = (f32x4){0.f, 0.f, 0.f, 0.f};
    bf16x8 At[4][2], B0[2][2], B1[2][2];
    int nraw[4] = {0, 0, 0, 0};
    const char* cA = GATHER ? (const char*)g.A : (const char*)g.A + (size_t)cur.pm * tstepA;
    const char* cB = (const char*)g.Bt + (size_t)((cur.pm / g.bdiv) % g.bmod) * g.bstride * 2 + (size_t)cur.pn * tstepB;
    if constexpr (GATHER) { int craw[4]; PG8_GIDX(cur, craw); PG8_GOFF(cur, craw, cvA0, cvA1); }
    PG8_STAGE(PG8_SB(0, 0), cB, voffB); PG8_STAGE(PG8_SB(0, 1), cB + hstepB, voffB); PG8_STAGE(PG8_SA(0, 0), cA, cvA0); PG8_STAGE(PG8_SA(0, 1), cA, cvA1);
    if (wr == 1) PG8_BAR;
    PG8_WAIT_V(2); PG8_BAR;
    PG8_STAGE(PG8_SB(1, 0), cB + kstep, voffB); PG8_STAGE(PG8_SA(1, 0), cA + kstep, cvA0); PG8_STAGE(PG8_SB(1, 1), cB + hstepB + kstep, voffB);
    PG8_WAIT_V(6); PG8_BAR;
    for (;;) {
        const bool has_next = S.next(ui + 1, nxt);
        const char* nA = GATHER ? (const char*)g.A : (has_next ? (const char*)g.A + (size_t)nxt.pm * tstepA : cA);
        const char* nB = has_next ? (const char*)g.Bt + (size_t)((nxt.pm / g.bdiv) % g.bmod) * g.bstride * 2 + (size_t)nxt.pn * tstepB : cB;
        if constexpr (GATHER) { if (has_next) PG8_GIDX(nxt, nraw); }
        for (int t = 0; t < nt; t += 2) {
            const bool last = (t == nt - 2);
            const char* a1 = cA + (size_t)(t + 1) * kstep;
            const char* a2 = last ? nA : cA + (size_t)(t + 2) * kstep; const char* b2 = last ? nB : cB + (size_t)(t + 2) * kstep;
            const char* a3 = a2 + kstep; const char* b3 = b2 + kstep;
            unsigned sA0[2] = {cvA0[0], cvA0[1]}, sA1[2] = {cvA1[0], cvA1[1]};
            if constexpr (GATHER) { if (last) { if (has_next) PG8_GOFF(nxt, nraw, nvA0, nvA1); else { nvA0[0] = cvA0[0]; nvA0[1] = cvA0[1]; nvA1[0] = cvA1[0]; nvA1[1] = cvA1[1]; }
                                                 sA0[0] = nvA0[0]; sA0[1] = nvA0[1]; sA1[0] = nvA1[0]; sA1[1] = nvA1[1]; } }
            PG8_LDB(B0, 0, 0); PG8_LDB(B1, 0, 1); PG8_SCHED; PG8_LDA(At, 0, 0); PG8_STAGE(PG8_SA(1, 1), a1, cvA1);
            PG8_WAIT_V(8); PG8_WAIT_L(0); PG8_BAR; PG8_MMA(0, 0, At, B0); PG8_MMA(0, 1, At, B1); PG8_BAR; PG8_SCHED;
            PG8_LDA(At, 0, 1); PG8_STAGE(PG8_SB(0, 0), b2, voffB); PG8_STAGE(PG8_SB(0, 1), b2 + hstepB, voffB); PG8_STAGE(PG8_SA(0, 0), a2, sA0);
            PG8_WAIT_V(8); PG8_WAIT_L(0); PG8_BAR; PG8_MMA(1, 0, At, B0); PG8_MMA(1, 1, At, B1); PG8_BAR; PG8_SCHED;
            PG8_LDB(B0, 1, 0); PG8_LDB(B1, 1, 1); PG8_SCHED; PG8_LDA(At, 1, 0); PG8_STAGE(PG8_SA(0, 1), a2, sA1);
            PG8_WAIT_V(8); PG8_WAIT_L(0); PG8_BAR; PG8_MMA(0, 0, At, B0); PG8_MMA(0, 1, At, B1); PG8_BAR; PG8_SCHED;
            PG8_LDA(At, 1, 1); PG8_STAGE(PG8_SB(1, 0), b3, voffB); PG8_STAGE(PG8_SB(1, 1), b3 + hstepB, voffB); PG8_STAGE(PG8_SA(1, 0), a3, sA0);
            PG8_WAIT_V(8); PG8_WAIT_L(0); PG8_BAR; PG8_MMA(1, 0, At, B0); PG8_MMA(1, 1, At, B1); PG8_BAR; PG8_SCHED;
        }
        if (wr == 0) PG8_BAR;
        E.run(acc, cur, wr, wc, fr, fq, lds + STAGE_BYTES, wid, lane);
        if (!has_next) break;
#pragma unroll
        for (int a = 0; a < 2; ++a)
#pragma unroll
            for (int b = 0; b < 2; ++b)
#pragma unroll
                for (int m = 0; m < 4; ++m)
#pragma unroll
                    for (int n = 0; n < 2; ++n) acc[a][b][m][n] = (f32x4){0.f, 0.f, 0.f, 0.f};
        cur = nxt; cA = nA; cB = nB; ++ui;
        if constexpr (GATHER) { cvA0[0] = nvA0[0]; cvA0[1] = nvA0[1]; cvA1[0] = nvA1[0]; cvA1[1] = nvA1[1]; }
        if (wr == 1) PG8_BAR;
    }
    PG8_WAIT_V(0);
    PG8_BAR;
#undef PG8_SA
#undef PG8_SB
#undef PG8_STAGE
#undef PG8_LDA
#undef PG8_LDB
#undef PG8_MMA
#undef PG8_WAIT_V
#undef PG8_WAIT_L
#undef PG8_BAR
#undef PG8_SCHED
#undef PG8_GIDX
#undef PG8_GOFF
}

template <class Epi, class Sched, bool GATHER = false>
__device__ __forceinline__ void gemm_phase(LAS unsigned char* lds, const Gemm g, const Sched& S, const Epi& E) {
#if GEMM_SIMPLE
    static_assert(!GATHER, "the simple body has no gather path");
    gemm_simple<Epi, Sched>(lds + STAGE_BYTES, g, S, E);
#else
    gemm_fast<Epi, Sched, GATHER>(lds, g, S, E);
#endif
}

template <class F> struct EpiChunk {
    static constexpr bool USES_LDS = false;
    F f;
    __device__ __forceinline__ void run(Acc& acc, const Unit& u, int wr, int wc, int fr, int fq, LAS unsigned char*, int, int) const {
        constexpr int NBT = F::NBATCH, GPB = 8 / NBT;
#pragma unroll
        for (int bt = 0; bt < NBT; ++bt) {
            typename F::Pre pre[GPB][2];
#pragma unroll
            for (int g = 0; g < GPB; ++g) { const int rg = bt * GPB + g, ai = rg >> 2, m = rg & 3; const int row = u.pm * BM + ai * HALF + wr * 64 + m * 16 + fr;
#pragma unroll
                for (int bj = 0; bj < 2; ++bj) { const int col = u.pn * BM + bj * HALF + wc * 32 + 8 * fq; pre[g][bj] = f.load(row, col); } }
            asm volatile("" ::: "memory");
#pragma unroll
            for (int g = 0; g < GPB; ++g) { const int rg = bt * GPB + g, ai = rg >> 2, m = rg & 3; const int row = u.pm * BM + ai * HALF + wr * 64 + m * 16 + fr;
#pragma unroll
                for (int bj = 0; bj < 2; ++bj) { const int col = u.pn * BM + bj * HALF + wc * 32 + 8 * fq;
                    const f32x4 a = acc[ai][bj][m][0], b = acc[ai][bj][m][1];
                    const float v[8] = {a[0], a[1], a[2], a[3], b[0], b[1], b[2], b[3]};
                    f.chunk(row, col, v, pre[g][bj]); } }
            asm volatile("" ::: "memory");
        }
    }
};
}
using pg8::Gemm; using pg8::Unit; using pg8::StaticOrder; using pg8::mkgemm;

struct PreNone {};
struct PreF { float r; };
struct FU { const float* rstd0; bf16_t *XGG, *CQ, *CKV, *KR, *SIGA, *SIGB; const float* bgate;
    static constexpr int NBATCH = 4;
    struct Pre { float rs; f32x4 b0, b1; };
    __device__ __forceinline__ Pre load(int row, int col) const { Pre p; p.rs = rstd0[row];
        if (col >= 3584) { p.b0 = *(const f32x4*)(bgate + (col - 3584)); p.b1 = *(const f32x4*)(bgate + (col - 3584) + 4); } else { p.b0 = (f32x4){0.f, 0.f, 0.f, 0.f}; p.b1 = p.b0; }
        return p; }
    __device__ __forceinline__ void chunk(int row, int col, const float (&v)[8], const Pre& p) const {
        const float rs = p.rs; float o[8];
#pragma unroll
        for (int i = 0; i < 8; ++i) o[i] = v[i] * rs;
        if (col < 3072) { *(u32x4*)(XGG + (size_t)row * 2048 + 1024 + (col - 2048)) = pack8(o); }
        else if (col < 3328) { *(u32x4*)(CQ + (size_t)row * 256 + (col - 3072)) = pack8(o); }
        else if (col < 3456) { *(u32x4*)(CKV + (size_t)row * 128 + (col - 3328)) = pack8(o); }
        else if (col < 3520) { *(u32x4*)(KR + (size_t)row * 64 + (col - 3456)) = pack8(o); }
        else if (col >= 3584) { const int c = col - 3584;
            const float bb[8] = {p.b0[0], p.b0[1], p.b0[2], p.b0[3], p.b1[0], p.b1[1], p.b1[2], p.b1[3]};
#pragma unroll
            for (int i = 0; i < 8; ++i) o[i] = 1.f / (1.f + __expf(-(o[i] + bb[i])));
            bf16_t* dst = c < 1024 ? SIGA + (size_t)row * 1024 + c : SIGB + (size_t)row * 1024 + (c - 1024);
            *(u32x4*)dst = pack8(o); }
    } };
struct EpiU {
    static constexpr bool USES_LDS = false;
    FU f;
    __device__ __forceinline__ void run(pg8::Acc& acc, const Unit& u, int wr, int wc, int fr, int fq, LAS unsigned char* scr, int wid, int lane) const {
        if (u.pn < 8) {
#pragma unroll
            for (int ai = 0; ai < 2; ++ai)
#pragma unroll
                for (int m = 0; m < 4; ++m) { const int row = u.pm * 256 + ai * 128 + wr * 64 + m * 16 + fr; const int col = u.pn * 128 + wc * 32 + 8 * fq; const float rs = f.rstd0[row]; const float r2 = rs * rs; float o[8];
#pragma unroll
                    for (int n = 0; n < 2; ++n)
#pragma unroll
                        for (int i = 0; i < 4; ++i) o[n * 4 + i] = acc[ai][0][m][n][i] * acc[ai][1][m][n][i] * r2;
                    *(u32x4*)(f.XGG + (size_t)row * 2048 + col) = pack8(o); }
        } else { pg8::EpiChunk<FU> E{f}; E.run(acc, u, wr, wc, fr, fq, scr, wid, lane); }
    }
};
struct FMemKV { const float* rstdm; bf16_t* MKV;
    static constexpr int NBATCH = 1; typedef PreF Pre;
    __device__ __forceinline__ Pre load(int row, int) const { Pre p; p.r = rstdm[row]; return p; }
    __device__ __forceinline__ void chunk(int row, int col, const float (&v)[8], const Pre& p) const {
        const float rs = p.r * (col < 1024 ? 0.0625f : 1.f); float o[8];
#pragma unroll
        for (int i = 0; i < 8; ++i) o[i] = v[i] * rs;
        const int kv = col >> 10, h = (col >> 8) & 3, j = col & 255, b = row >> 8, key = row & 255;
        *(u32x4*)(MKV + ((size_t)((kv * 2 + b) * 4 + h) * 256 + key) * 256 + j) = pack8(o);
    } };
struct FQ { const float* rstdq; const f32x2* rope; bf16_t* Q;
    static constexpr int NBATCH = 4;
    struct Pre { float rs; f32x2 cs[4]; };
    __device__ __forceinline__ Pre load(int row, int col) const { Pre p; p.rs = rstdq[row];
        if (col >= 1024) { const int pp = (col - 1024) & 63, j0 = (pp >> 3) * 4, s = row & (SEQ - 1);
#pragma unroll
            for (int i = 0; i < 4; ++i) p.cs[i] = rope[s * 32 + j0 + i]; }
        else {
#pragma unroll
            for (int i = 0; i < 4; ++i) p.cs[i] = (f32x2){1.f, 0.f}; }
        return p; }
    __device__ __forceinline__ void chunk(int row, int col, const float (&v)[8], const Pre& p) const {
        const float rs = p.rs; float o[8];
#pragma unroll
        for (int i = 0; i < 8; ++i) o[i] = v[i] * rs;
        if (col >= 1024) {
#pragma unroll
            for (int i = 0; i < 4; ++i) { const f32x2 cs = p.cs[i]; const float a = o[i], b = o[4 + i]; o[i] = a * cs.x - b * cs.y; o[4 + i] = a * cs.y + b * cs.x; } }
        *(u32x4*)(Q + (size_t)row * 1536 + col) = pack8(o);
    } };
struct FScaleRow { const float* rs; bf16_t* O; int ldo;
    static constexpr int NBATCH = 1; typedef PreF Pre;
    __device__ __forceinline__ Pre load(int row, int) const { Pre p; p.r = rs[row]; return p; }
    __device__ __forceinline__ void chunk(int row, int col, const float (&v)[8], const Pre& p) const {
        const float r = p.r; float o[8];
#pragma unroll
        for (int i = 0; i < 8; ++i) o[i] = v[i] * r;
        *(u32x4*)(O + (size_t)row * ldo + col) = pack8(o);
    } };
struct FPlain { bf16_t* O; int ldo;
    static constexpr int NBATCH = 1; typedef PreNone Pre;
    __device__ __forceinline__ Pre load(int, int) const { return Pre{}; }
    __device__ __forceinline__ void chunk(int row, int col, const float (&v)[8], const Pre&) const { *(u32x4*)(O + (size_t)row * ldo + col) = pack8(v); } };
struct FVW { bf16_t* O;
    static constexpr int NBATCH = 1; typedef PreNone Pre;
    __device__ __forceinline__ Pre load(int, int) const { return Pre{}; }
    __device__ __forceinline__ void chunk(int row, int col, const float (&v)[8], const Pre&) const { const int h = row >> 10, n = row & 1023; *(u32x4*)(O + (size_t)n * 1024 + h * 256 + col) = pack8(v); } };
struct FGateMul { const bf16_t* G; bf16_t* O;
    static constexpr int NBATCH = 2;
    struct Pre { u32x4 g; };
    __device__ __forceinline__ Pre load(int row, int col) const { Pre p; p.g = *(const u32x4*)(G + (size_t)row * 1024 + col); return p; }
    __device__ __forceinline__ void chunk(int row, int col, const float (&v)[8], const Pre& p) const {
        float g[8], o[8]; unpack8(p.g, g);
#pragma unroll
        for (int i = 0; i < 8; ++i) o[i] = g[i] * v[i];
        *(u32x4*)(O + (size_t)row * 1024 + col) = pack8(o);
    } };
struct FGateMulAdd { const bf16_t* G; const bf16_t* Pv; bf16_t* O;
    static constexpr int NBATCH = 2;
    struct Pre { u32x4 g, p; };
    __device__ __forceinline__ Pre load(int row, int col) const { Pre p; p.g = *(const u32x4*)(G + (size_t)row * 1024 + col); p.p = *(const u32x4*)(Pv + (size_t)row * 1024 + col); return p; }
    __device__ __forceinline__ void chunk(int row, int col, const float (&v)[8], const Pre& pr) const {
        float g[8], p[8], o[8]; unpack8(pr.g, g); unpack8(pr.p, p);
#pragma unroll
        for (int i = 0; i < 8; ++i) o[i] = p[i] + g[i] * v[i];
        *(u32x4*)(O + (size_t)row * 1024 + col) = pack8(o);
    } };
struct FResidF32 { const float* base; float* out;
    static constexpr int NBATCH = 2;
    struct Pre { f32x4 a, b; };
    __device__ __forceinline__ Pre load(int row, int col) const { const size_t off = (size_t)row * 1024 + col; Pre p; p.a = *(const f32x4*)(base + off); p.b = *(const f32x4*)(base + off + 4); return p; }
    __device__ __forceinline__ void chunk(int row, int col, const float (&v)[8], const Pre& p) const {
        const size_t off = (size_t)row * 1024 + col; const f32x4 a = p.a, b = p.b;
        *(f32x4*)(out + off) = (f32x4){a[0] + v[0], a[1] + v[1], a[2] + v[2], a[3] + v[3]}; *(f32x4*)(out + off + 4) = (f32x4){b[0] + v[4], b[1] + v[5], b[2] + v[6], b[3] + v[7]};
    } };
struct FResidBf16 { const bf16_t* base; bf16_t* out;
    static constexpr int NBATCH = 1;
    struct Pre { u32x4 a; };
    __device__ __forceinline__ Pre load(int row, int col) const { Pre p; p.a = *(const u32x4*)(base + (size_t)row * 1024 + col); return p; }
    __device__ __forceinline__ void chunk(int row, int col, const float (&v)[8], const Pre& p) const {
        float a[8], o[8]; unpack8(p.a, a);
#pragma unroll
        for (int i = 0; i < 8; ++i) o[i] = a[i] + v[i];
        *(u32x4*)(out + (size_t)row * 1024 + col) = pack8(o);
    } };
struct FGateRow { const float* gate; bf16_t* O;
    static constexpr int NBATCH = 1; typedef PreF Pre;
    __device__ __forceinline__ Pre load(int row, int) const { Pre p; p.r = gate[row]; return p; }
    __device__ __forceinline__ void chunk(int row, int col, const float (&v)[8], const Pre& p) const {
        const float r = p.r; float o[8];
#pragma unroll
        for (int i = 0; i < 8; ++i) o[i] = v[i] * r;
        *(u32x4*)(O + (size_t)row * 1024 + col) = pack8(o);
    } };

struct EpiX1 {
    static constexpr bool USES_LDS = false;
    const float* base; float* out; bf16_t* xb; float* ssq;
    __device__ __forceinline__ void run(pg8::Acc& acc, const Unit& u, int wr, int wc, int fr, int fq, LAS unsigned char*, int, int) const {
#pragma unroll
        for (int bt = 0; bt < 4; ++bt) { f32x4 pa[2][2], pb[2][2];
#pragma unroll
            for (int g = 0; g < 2; ++g) { const int rg = bt * 2 + g, ai = rg >> 2, m = rg & 3; const int row = u.pm * 256 + ai * 128 + wr * 64 + m * 16 + fr;
#pragma unroll
                for (int bj = 0; bj < 2; ++bj) { const size_t off = (size_t)row * 1024 + u.pn * 256 + bj * 128 + wc * 32 + 8 * fq; pa[g][bj] = *(const f32x4*)(base + off); pb[g][bj] = *(const f32x4*)(base + off + 4); } }
            asm volatile("" ::: "memory");
#pragma unroll
            for (int g = 0; g < 2; ++g) { const int rg = bt * 2 + g, ai = rg >> 2, m = rg & 3; const int row = u.pm * 256 + ai * 128 + wr * 64 + m * 16 + fr; float s = 0.f;
#pragma unroll
                for (int bj = 0; bj < 2; ++bj) { const int col = u.pn * 256 + bj * 128 + wc * 32 + 8 * fq; const size_t off = (size_t)row * 1024 + col;
                    const f32x4 a = pa[g][bj], b = pb[g][bj]; const f32x4 c0 = acc[ai][bj][m][0], c1 = acc[ai][bj][m][1];
                    const float o[8] = {a[0] + c0[0], a[1] + c0[1], a[2] + c0[2], a[3] + c0[3], b[0] + c1[0], b[1] + c1[1], b[2] + c1[2], b[3] + c1[3]};
                    if (out) { *(f32x4*)(out + off) = (f32x4){o[0], o[1], o[2], o[3]}; *(f32x4*)(out + off + 4) = (f32x4){o[4], o[5], o[6], o[7]}; }
                    *(u32x4*)(xb + off) = pack8(o);
#pragma unroll
                    for (int i = 0; i < 8; ++i) s += o[i] * o[i]; }
                s += __shfl_xor(s, 16); s += __shfl_xor(s, 32);
                if (fq == 0) ssq[(size_t)row * 16 + u.pn * 4 + wc] = s; }
            asm volatile("" ::: "memory"); }
    }
};
struct EpiSoftmax {
    static constexpr bool USES_LDS = true;
    const float* ssq; bf16_t* P;
    __device__ __forceinline__ void run(pg8::Acc& acc, const Unit& u, int wr, int wc, int fr, int fq, LAS unsigned char* scr, int, int) const {
        LAS float* PM = (LAS float*)scr;
        LAS float* PS = (LAS float*)(scr + 4096);
        LAS float* RS = (LAS float*)(scr + 4096);
        { const int t = threadIdx.x; if (t < 256) { const f32x4* sp = (const f32x4*)((const char*)ssq + (unsigned)(u.pm * 256 + t) * 64u); const f32x4 q0 = sp[0], q1 = sp[1], q2 = sp[2], q3 = sp[3];
            float tt = ((q0[0] + q0[1]) + (q0[2] + q0[3])) + ((q1[0] + q1[1]) + (q1[2] + q1[3])); tt += ((q2[0] + q2[1]) + (q2[2] + q2[3])) + ((q3[0] + q3[1]) + (q3[2] + q3[3]));
            RS[t] = 1.f / sqrtf(tt * (1.f / 1024.f) + EPS); } }
        __syncthreads();
#pragma unroll
        for (int ai = 0; ai < 2; ++ai)
#pragma unroll
            for (int m = 0; m < 4; ++m) { const int rl = ai * 128 + wr * 64 + m * 16 + fr;
                const float rs = RS[rl];
                float mx = -3.0e38f;
#pragma unroll
                for (int bj = 0; bj < 2; ++bj)
#pragma unroll
                    for (int n = 0; n < 2; ++n)
#pragma unroll
                        for (int i = 0; i < 4; ++i) { const float s = acc[ai][bj][m][n][i] * rs; acc[ai][bj][m][n][i] = s; mx = fmaxf(mx, s); }
                mx = fmaxf(mx, __shfl_xor(mx, 16)); mx = fmaxf(mx, __shfl_xor(mx, 32));
                if (fq == 0) PM[rl * 4 + wc] = mx;
                asm volatile("" ::: "memory"); }
        __syncthreads();
#pragma unroll
        for (int ai = 0; ai < 2; ++ai)
#pragma unroll
            for (int m = 0; m < 4; ++m) { const int rl = ai * 128 + wr * 64 + m * 16 + fr;
                const f32x4 pm4 = *(const LAS f32x4*)(PM + rl * 4); const float mx = fmaxf(fmaxf(pm4[0], pm4[1]), fmaxf(pm4[2], pm4[3]));
                float s = 0.f;
#pragma unroll
                for (int bj = 0; bj < 2; ++bj)
#pragma unroll
                    for (int n = 0; n < 2; ++n)
#pragma unroll
                        for (int i = 0; i < 4; ++i) { const float e = __expf(acc[ai][bj][m][n][i] - mx); acc[ai][bj][m][n][i] = e; s += e; }
                s += __shfl_xor(s, 16); s += __shfl_xor(s, 32);
                if (fq == 0) PS[rl * 4 + wc] = s;
                asm volatile("" ::: "memory"); }
        __syncthreads();
#pragma unroll
        for (int ai = 0; ai < 2; ++ai)
#pragma unroll
            for (int m = 0; m < 4; ++m) { const int rl = ai * 128 + wr * 64 + m * 16 + fr; const int row = u.pm * 256 + rl;
                const f32x4 ps4 = *(const LAS f32x4*)(PS + rl * 4); const float inv = 1.f / ((ps4[0] + ps4[1]) + (ps4[2] + ps4[3]));
#pragma unroll
                for (int bj = 0; bj < 2; ++bj) { const int col = u.pn * 256 + bj * 128 + wc * 32 + 8 * fq; float o[8];
#pragma unroll
                    for (int n = 0; n < 2; ++n)
#pragma unroll
                        for (int i = 0; i < 4; ++i) o[n * 4 + i] = acc[ai][bj][m][n][i] * inv;
                    *(u32x4*)((char*)P + ((unsigned)row * 1024u + (unsigned)col) * 2u) = pack8(o); }
                asm volatile("" ::: "memory"); }
    }
};
struct EpiSwiglu {
    static constexpr bool USES_LDS = false;
    bf16_t* H;
    __device__ __forceinline__ void run(pg8::Acc& acc, const Unit& u, int wr, int wc, int fr, int fq, LAS unsigned char*, int, int) const {
#pragma unroll
        for (int ai = 0; ai < 2; ++ai)
#pragma unroll
            for (int m = 0; m < 4; ++m) { const int row = u.pm * 256 + ai * 128 + wr * 64 + m * 16 + fr; const int col = u.pn * 128 + wc * 32 + 8 * fq; float o[8];
#pragma unroll
                for (int n = 0; n < 2; ++n)
#pragma unroll
                    for (int i = 0; i < 4; ++i) { const float g = acc[ai][0][m][n][i], up = acc[ai][1][m][n][i]; o[n * 4 + i] = g / (1.f + __expf(-g)) * up; }
                *(u32x4*)(H + (size_t)row * 1024 + col) = pack8(o); }
    }
};

namespace att {
constexpr int QBLK = 32, KVBLK = 64, NW = 8;
constexpr int LDQ = 1536, LDKV = 2048, LDKR = 64, LDO = 1024;
constexpr int KPITCH = 272, KRPITCH = 144;
constexpr int SHM_V = KVBLK * 128 * 2, SHM_K = KVBLK * KPITCH, SHM_KR = KVBLK * KRPITCH;
constexpr int OFF_V = 0, OFF_K = 2 * SHM_V, OFF_KR = OFF_K + 2 * SHM_K, OFF_WS = OFF_KR + 2 * SHM_KR, OFF_QR = OFF_WS + NW * 64 * 4, SHM_ATTN = OFF_QR + NW * 4096;
constexpr float THR = 8.f;
#define KSWZ(row, colB) ((row) * KPITCH + (colB))
#define KRSWZ(row, colB) ((row) * KRPITCH + (colB))
#define SBAR() __builtin_amdgcn_sched_barrier(0)
__device__ __forceinline__ int crow(int r, int hi) { return (r & 3) + 8 * (r >> 2) + 4 * hi; }
__device__ __forceinline__ unsigned cvtpk_a(float lo, float hi) { unsigned r; asm volatile("v_cvt_pk_bf16_f32 %0, %1, %2" : "=v"(r) : "v"(lo), "v"(hi)); return r; }

__device__ __forceinline__ void partialSM(f32x16& p0, f32x16& p1, float& m_reg, float& mn, float& alpha) {
  constexpr float C = ATT_SCALE * 1.4426950408889634f;
  float pmax = p0[0];
#pragma unroll
  for (int r = 1; r < 16; ++r) pmax = fmaxf(pmax, p0[r]);
#pragma unroll
  for (int r = 0; r < 16; ++r) pmax = fmaxf(pmax, p1[r]);
  { auto rr = __builtin_amdgcn_permlane32_swap(__float_as_uint(pmax), __float_as_uint(pmax), false, false);
    pmax = fmaxf(__uint_as_float(rr[0]), __uint_as_float(rr[1])); }
  if (__builtin_expect(__all(pmax - m_reg <= THR / ATT_SCALE), 1)) { mn = m_reg; alpha = 1.f; }
  else { mn = fmaxf(m_reg, pmax); alpha = __builtin_amdgcn_exp2f((m_reg - mn) * C); m_reg = mn; }
  float mnC = -mn * C;
#pragma unroll
  for (int r = 0; r < 16; ++r) p0[r] = fmaf(p0[r], C, mnC);
#pragma unroll
  for (int r = 0; r < 16; ++r) p1[r] = fmaf(p1[r], C, mnC);
#pragma unroll
  for (int r = 0; r < 16; ++r) p0[r] = __builtin_amdgcn_exp2f(p0[r]);
}
__device__ __forceinline__ void finishSM(f32x16& p0, f32x16& p1, float alpha, float& l_reg, bf16x8& pa0, bf16x8& pa1, bf16x8& pa2, bf16x8& pa3) {
#pragma unroll
  for (int r = 0; r < 16; ++r) p1[r] = __builtin_amdgcn_exp2f(p1[r]);
  float ps = 0;
#pragma unroll
  for (int r = 0; r < 16; ++r) ps += p0[r];
#pragma unroll
  for (int r = 0; r < 16; ++r) ps += p1[r];
  { auto rr = __builtin_amdgcn_permlane32_swap(__float_as_uint(ps), __float_as_uint(ps), false, false);
    ps = __uint_as_float(rr[0]) + __uint_as_float(rr[1]); }
  l_reg = l_reg * alpha + ps;
#define PK4(P, BASE, OUT) do { unsigned a0 = cvtpk_a(P[BASE + 0], P[BASE + 1]), a1 = cvtpk_a(P[BASE + 2], P[BASE + 3]);   \
    unsigned b0 = cvtpk_a(P[BASE + 4], P[BASE + 5]), b1 = cvtpk_a(P[BASE + 6], P[BASE + 7]);                              \
    auto r0 = __builtin_amdgcn_permlane32_swap(a0, b0, false, false); auto r1 = __builtin_amdgcn_permlane32_swap(a1, b1, false, false); \
    u32x4 w = {r0[0], r1[0], r0[1], r1[1]}; OUT = *reinterpret_cast<bf16x8*>(&w); } while (0)
  PK4(p0, 0, pa0); PK4(p0, 8, pa1); PK4(p1, 0, pa2); PK4(p1, 8, pa3);
#undef PK4
}
__device__ __forceinline__ void qkt(f32x16& p0, f32x16& p1, const char* Ks, const char* Krs, const bf16x8* qr, const char* qpark, int r32, int hi) {
  p0 = f32x16{}; p1 = f32x16{};
  const char* kb = Ks + r32 * KPITCH + hi * 16; const char* rb = Krs + r32 * KRPITCH + hi * 16;
#pragma unroll
  for (int d0 = 0; d0 < 8; ++d0) {
    bf16x8 b0 = *reinterpret_cast<const bf16x8*>(kb + d0 * 32);
    bf16x8 b1 = *reinterpret_cast<const bf16x8*>(kb + 32 * KPITCH + d0 * 32);
    p0 = __builtin_amdgcn_mfma_f32_32x32x16_bf16(b0, qr[d0], p0, 0, 0, 0);
    p1 = __builtin_amdgcn_mfma_f32_32x32x16_bf16(b1, qr[d0], p1, 0, 0, 0); }
#pragma unroll
  for (int d0 = 0; d0 < 4; ++d0) {
    bf16x8 b0 = *reinterpret_cast<const bf16x8*>(rb + d0 * 32);
    bf16x8 b1 = *reinterpret_cast<const bf16x8*>(rb + 32 * KRPITCH + d0 * 32);
    const bf16x8 qf = qr[8 + d0];
    p0 = __builtin_amdgcn_mfma_f32_32x32x16_bf16(b0, qf, p0, 0, 0, 0);
    p1 = __builtin_amdgcn_mfma_f32_32x32x16_bf16(b1, qf, p1, 0, 0, 0); }
}
__device__ __forceinline__ int v_st(int k, int c) { const int kk = (k & ~0xC) | ((k & 4) << 1) | ((k & 8) >> 1); return ((kk >> 3) * 4 + (c >> 5)) * 512 + ((kk & 7) * 32 + (c & 31)) * 2; }
__device__ __forceinline__ int v_rd_base(int lane) { return ((lane & 3) << 3) | (((lane >> 2) & 3) << 6) | (((lane >> 4) & 1) << 5) | (((lane >> 5) & 1) << 8); }
constexpr int v_rd_off(int d0, int ks, int half) { return d0 * 512 + ks * 4096 + half * 2048; }
template <int OFF> __device__ __forceinline__ s16x4 tr_read(int vb) {
  s16x4 r; asm volatile("ds_read_b64_tr_b16 %0, %1 offset:%2" : "=&v"(r) : "v"(vb), "i"(OFF) : "memory"); return r;
}
template <int D0> __device__ __forceinline__ void pv_one(f32x16& od, int vb, bf16x8 pa0, bf16x8 pa1, bf16x8 pa2, bf16x8 pa3) {
  const s16x4 l0 = tr_read<v_rd_off(D0, 0, 0)>(vb), h0 = tr_read<v_rd_off(D0, 0, 1)>(vb), l1 = tr_read<v_rd_off(D0, 1, 0)>(vb), h1 = tr_read<v_rd_off(D0, 1, 1)>(vb);
  const s16x4 l2 = tr_read<v_rd_off(D0, 2, 0)>(vb), h2 = tr_read<v_rd_off(D0, 2, 1)>(vb), l3 = tr_read<v_rd_off(D0, 3, 0)>(vb), h3 = tr_read<v_rd_off(D0, 3, 1)>(vb);
  asm volatile("s_waitcnt lgkmcnt(0)" ::: "memory"); SBAR();
#define PK(L, H) (bf16x8){L[0], L[1], L[2], L[3], H[0], H[1], H[2], H[3]}
  od = __builtin_amdgcn_mfma_f32_32x32x16_bf16(pa0, PK(l0, h0), od, 0, 0, 0);
  od = __builtin_amdgcn_mfma_f32_32x32x16_bf16(pa1, PK(l1, h1), od, 0, 0, 0);
  od = __builtin_amdgcn_mfma_f32_32x32x16_bf16(pa2, PK(l2, h2), od, 0, 0, 0);
  od = __builtin_amdgcn_mfma_f32_32x32x16_bf16(pa3, PK(l3, h3), od, 0, 0, 0);
#undef PK
}
__device__ __forceinline__ void pv_d0(f32x16* o, int vb, bf16x8 pa0, bf16x8 pa1, bf16x8 pa2, bf16x8 pa3) {
  pv_one<0>(o[0], vb, pa0, pa1, pa2, pa3); pv_one<1>(o[1], vb, pa0, pa1, pa2, pa3); pv_one<2>(o[2], vb, pa0, pa1, pa2, pa3); pv_one<3>(o[3], vb, pa0, pa1, pa2, pa3);
}

__device__ __forceinline__ void attn_unit(const bf16_t* __restrict__ Qn, const bf16_t* __restrict__ Qr, const bf16_t* __restrict__ Kh,
                                          const bf16_t* __restrict__ Krh, bf16_t* __restrict__ Ob, int seq, char* lds) {
  const int tid = threadIdx.x, wid = tid >> 6, lane = tid & 63, r32 = lane & 31, hi = lane >> 5;
  char* V_lds = lds + OFF_V; char* K_lds = lds + OFF_K; char* Kr_lds = lds + OFF_KR;
  float* ws = (float*)(lds + OFF_WS) + wid * 64; float* li_l = ws; float* al_l = ws + 32;
  float m_reg = -1e30f, l_reg = 0; f32x16 o[4] = {}; bf16x8 qr[12];
  char* qpark = nullptr;
  { const bf16_t* qn = Qn + (long)(wid * QBLK + r32) * LDQ + hi * 8; const bf16_t* qq = Qr + (long)(wid * QBLK + r32) * LDQ + hi * 8;
#pragma unroll
    for (int d0 = 0; d0 < 8; ++d0) qr[d0] = *reinterpret_cast<const bf16x8*>(qn + d0 * 16);
#pragma unroll
    for (int d0 = 0; d0 < 4; ++d0) qr[8 + d0] = *reinterpret_cast<const bf16x8*>(qq + d0 * 16); }
  const int sr = tid >> 4, sc = (tid & 15) * 8, vst0 = v_st(sr, sc), vst1 = v_st(32 + sr, sc);
  const int krr = tid >> 3, krc = (tid & 7) * 8;
  const int vb0 = (int)(uintptr_t)V_lds + v_rd_base(lane);
  bf16x8 vs0, vs1, ks0, ks1, kr0;
  const unsigned offkv = (unsigned)(sr * LDKV + sc) * 2u, offkr = (unsigned)(krr * LDKR + krc) * 2u;
#define SLOAD(k0) do { const char* kb_ = (const char*)Kh + (size_t)(k0) * (LDKV * 2); const char* kb2_ = kb_ + 32 * LDKV * 2; const char* rb_ = (const char*)Krh + (size_t)(k0) * (LDKR * 2); \
    ks0 = *reinterpret_cast<const bf16x8*>(kb_ + offkv); vs0 = *reinterpret_cast<const bf16x8*>(kb_ + offkv + 2048); \
    ks1 = *reinterpret_cast<const bf16x8*>(kb2_ + offkv); vs1 = *reinterpret_cast<const bf16x8*>(kb2_ + offkv + 2048); \
    kr0 = *reinterpret_cast<const bf16x8*>(rb_ + offkr); } while (0)
#define SWRITE(b) do { *(bf16x8*)(V_lds + (b) * SHM_V + vst0) = vs0; *(bf16x8*)(V_lds + (b) * SHM_V + vst1) = vs1; const int kc = sc * 2; \
    *(bf16x8*)(K_lds + (b) * SHM_K + KSWZ(sr, kc)) = ks0; *(bf16x8*)(K_lds + (b) * SHM_K + KSWZ(32 + sr, kc)) = ks1; \
    *(bf16x8*)(Kr_lds + (b) * SHM_KR + KRSWZ(krr, krc * 2)) = kr0; } while (0)
#define SWAIT() asm volatile("s_waitcnt vmcnt(0)" ::: "memory")
#define RESC(a) do { if (__any((a) < 1.f)) { if (hi == 0) al_l[r32] = (a); asm volatile("s_waitcnt lgkmcnt(0)" ::: "memory"); \
    _Pragma("unroll") for (int d = 0; d < 4; ++d) _Pragma("unroll") for (int r = 0; r < 16; ++r) o[d][r] *= al_l[crow(r, hi)]; } } while (0)
  f32x16 pA0, pA1, pB0, pB1; float mnA, mnB, alA, alB; bf16x8 pa0, pa1, pa2, pa3; const int NT = seq / KVBLK;
  SLOAD(0); SWAIT(); SWRITE(0); __syncthreads();
  qkt(pA0, pA1, K_lds, Kr_lds, qr, qpark, r32, hi); partialSM(pA0, pA1, m_reg, mnA, alA);
  SLOAD(KVBLK);
  SWAIT(); SWRITE(1); __syncthreads();
  for (int j = 1; j + 1 < NT; j += 2) {
    SBAR(); qkt(pB0, pB1, K_lds + SHM_K, Kr_lds + SHM_KR, qr, qpark, r32, hi);
    finishSM(pA0, pA1, alA, l_reg, pa0, pa1, pa2, pa3); SBAR();
    SLOAD((j + 1) * KVBLK); SBAR();
    pv_d0(o, vb0, pa0, pa1, pa2, pa3); partialSM(pB0, pB1, m_reg, mnB, alB);
    __syncthreads(); SWAIT(); SWRITE(0);
    RESC(alB); __syncthreads();
    SBAR(); qkt(pA0, pA1, K_lds, Kr_lds, qr, qpark, r32, hi);
    finishSM(pB0, pB1, alB, l_reg, pa0, pa1, pa2, pa3); SBAR();
    SLOAD((j + 2) * KVBLK); SBAR();
    pv_d0(o, vb0 + SHM_V, pa0, pa1, pa2, pa3); partialSM(pA0, pA1, m_reg, mnA, alA);
    __syncthreads(); SWAIT(); SWRITE(1);
    RESC(alA); __syncthreads();
  }
  SBAR(); qkt(pB0, pB1, K_lds + SHM_K, Kr_lds + SHM_KR, qr, qpark, r32, hi);
  finishSM(pA0, pA1, alA, l_reg, pa0, pa1, pa2, pa3); SBAR();
  pv_d0(o, vb0, pa0, pa1, pa2, pa3); partialSM(pB0, pB1, m_reg, mnB, alB);
  __syncthreads(); RESC(alB);
  finishSM(pB0, pB1, alB, l_reg, pa0, pa1, pa2, pa3); SBAR();
  pv_d0(o, vb0 + SHM_V, pa0, pa1, pa2, pa3);
  if (hi == 0) li_l[r32] = l_reg; asm volatile("s_waitcnt lgkmcnt(0)" ::: "memory");
  float rli[16];
#pragma unroll
  for (int r = 0; r < 16; ++r) rli[r] = __builtin_amdgcn_rcpf(li_l[crow(r, hi)]);
  bf16_t* Ow = Ob + (long)(wid * QBLK) * LDO;
#pragma unroll
  for (int r = 0; r < 16; ++r) { const int orow = crow(r, hi);
#pragma unroll
    for (int d0 = 0; d0 < 4; ++d0) Ow[(long)orow * LDO + d0 * 32 + r32] = f2bf(o[d0][r] * rli[r]); }
  __syncthreads();
#undef SLOAD
#undef SWRITE
#undef SWAIT
#undef RESC
}
#undef SBAR
}

constexpr int NWAVES = 8;
constexpr int N_LAUNCHES = MK_N_LAUNCHES;
constexpr int N_PHASES = 15;
static_assert(N_LAUNCHES == 1 || N_LAUNCHES == N_PHASES, "MK_N_LAUNCHES is 1 or 15");

constexpr size_t MiB = 1u << 20;
constexpr size_t WS_CTL = 0, CTL_ZERO_BYTES = 32768;
constexpr size_t WS_ROPE = 1 * MiB;
constexpr size_t WS_RSTD0 = 3 * MiB, WS_RSTDQ = WS_RSTD0 + 65536, WS_RSTDKV = WS_RSTDQ + 65536, WS_RSTDM = WS_RSTDKV + 65536;
constexpr size_t WS_SSQ = 4 * MiB;
constexpr size_t WS_AFF = 5 * MiB;
constexpr size_t WS_INV = 6 * MiB;
constexpr size_t WS_IDX = 7 * MiB, WS_GATE = WS_IDX + 131072;
constexpr size_t WS_MEMB = 8 * MiB;
constexpr size_t WS_MKV = 9 * MiB;
constexpr size_t WS_QKT = 11 * MiB, WS_VWT = 15 * MiB;
constexpr size_t WS_WIN = 19 * MiB;
constexpr size_t WS_WCO = 30 * MiB, WS_WMO = 32 * MiB, WS_WMIX = 34 * MiB, WS_WUQ = 36 * MiB, WS_WUKV = 37 * MiB, WS_WMQH = 38 * MiB, WS_WOHT = 40 * MiB, WS_WMKV = 42 * MiB;
constexpr size_t WS_XGG = 48 * MiB, WS_QB = 48 * MiB, WS_MIXA = 96 * MiB, WS_WGU = 48 * MiB, WS_WD = 112 * MiB, WS_Y = 48 * MiB;
constexpr size_t WS_XB = 144 * MiB, WS_ACONV = 144 * MiB, WS_OB = 144 * MiB, WS_X1B = 144 * MiB, WS_XG = 144 * MiB;
constexpr size_t WS_SIGA = 176 * MiB, WS_MIXED = 176 * MiB, WS_PM = 176 * MiB;
constexpr size_t WS_SIGB = 208 * MiB, WS_H3 = 208 * MiB, WS_H = 144 * MiB;
constexpr size_t WS_CQ = 240 * MiB, WS_CKV = 248 * MiB, WS_KR = 252 * MiB, WS_KROPE = 254 * MiB;
constexpr size_t WS_X2B = 256 * MiB;
constexpr size_t WS_END = RESID_BF16 ? 288 * MiB : 256 * MiB;
constexpr int CW_TMO = 0, CW_BAR = 4096;

constexpr int RING_BYTES = 131072, EPI_OFF = 131072, EPI_BYTES = 8192, LDSCTL_OFF = 140288, MISC_OFF = LDSCTL_OFF + 320;
constexpr int LDS_BYTES = 148480;
static_assert(2 * 16 * 1028 * 4 + 8192 <= LDSCTL_OFF && EPI_OFF + EPI_BYTES <= LDSCTL_OFF, "LDS map (router, epilogue scratch)");
static_assert(MISC_OFF + 128 <= LDS_BYTES && att::SHM_ATTN <= RING_BYTES, "LDS map");

typedef GAS unsigned gu32;
#define RLX_AGENT __ATOMIC_RELAXED, __HIP_MEMORY_SCOPE_AGENT

#define XB_TMO      128
#define XB_XCNT(j)  (256  + 64 * (j))
#define XB_XSUB(j)  (1280 + 64 * (j))
#define XB_XGEN(j)  (2304 + 64 * (j))
#define XB_TOP      3328
#define XB_TOPGEN   3392
#define XCD_BAR_WORDS 3456
#define XB_SPIN_CAP (1u << 18)
__device__ __forceinline__ unsigned xb_ld(unsigned* p)              { return __hip_atomic_load(p, __ATOMIC_RELAXED, __HIP_MEMORY_SCOPE_AGENT); }
__device__ __forceinline__ unsigned xb_add(unsigned* p, unsigned v) { return __hip_atomic_fetch_add(p, v, __ATOMIC_RELAXED, __HIP_MEMORY_SCOPE_AGENT); }
__device__ __forceinline__ unsigned xb_xcc_id() { return (unsigned)__builtin_amdgcn_s_getreg((3 << 11) | 20) & 0xFu; }
#define XB_SPIN(cond, bar) do { unsigned _sp = 0; while (cond) { __builtin_amdgcn_s_sleep(1); \
    if ((++_sp & 255u) == 0u) { if (xb_ld(&(bar)[XB_TMO])) break; if (_sp > XB_SPIN_CAP) { atomicAdd(&(bar)[XB_TMO], 1u); break; } } } } while (0)
struct XcdBarrier { unsigned* bar; unsigned x; volatile LAS unsigned* st; };
__device__ __forceinline__ XcdBarrier xcd_barrier_post(unsigned* bar, volatile LAS unsigned* st) {
    XcdBarrier b; b.bar = bar; b.x = xb_xcc_id(); b.st = st;
    if (threadIdx.x == 0) (void)xb_add(&bar[XB_XCNT(b.x)], 1u);
    return b;
}
__device__ __forceinline__ void xcd_barrier_complete(unsigned* bar, unsigned x, unsigned& nloc, unsigned& nx) {
    const unsigned G = gridDim.x * gridDim.y * gridDim.z;
    unsigned sum, cnt, mine, sp = 0u;
    for (;;) {
        sum = 0u; cnt = 0u; mine = 0u;
#pragma unroll
        for (unsigned j = 0; j < 16; ++j) { const unsigned c = xb_ld(&bar[XB_XCNT(j)]); sum += c; cnt += (c > 0u) ? 1u : 0u; mine = (j == x) ? c : mine; }
        if (sum == G) break;
        __builtin_amdgcn_s_sleep(1);
        if ((++sp & 255u) == 0u) { if (xb_ld(&bar[XB_TMO])) break; if (sp > XB_SPIN_CAP) { atomicAdd(&bar[XB_TMO], 1u); break; } }
    }
    nloc = mine > 0u ? mine : 1u; nx = cnt > 0u ? cnt : 1u;
}
__device__ __forceinline__ void xcd_barrier(const XcdBarrier& b) {
    asm volatile("s_waitcnt vmcnt(0)" ::: "memory");
    __syncthreads();
    if (threadIdx.x == 0) {
        unsigned* bar = b.bar;
        __builtin_amdgcn_s_waitcnt(0);
        unsigned nloc = b.st[0], nx = b.st[1];
        if (nloc == 0u) { xcd_barrier_complete(bar, b.x, nloc, nx); b.st[0] = nloc; b.st[1] = nx; }
        const unsigned old = xb_add(&bar[XB_XSUB(b.x)], 1u);
        const unsigned gen = old / nloc;
        if (old + 1u == (gen + 1u) * nloc) {
            __builtin_amdgcn_fence(__ATOMIC_RELEASE, "agent");
            asm volatile("s_waitcnt vmcnt(0)" ::: "memory");
            const unsigned og = xb_add(&bar[XB_TOP], 1u);
            const unsigned tg = og / nx;
            __builtin_amdgcn_fence(__ATOMIC_ACQUIRE, "agent");
            if (og + 1u == (tg + 1u) * nx) (void)__hip_atomic_fetch_add(&bar[XB_TOPGEN], 1u, __ATOMIC_RELAXED, __HIP_MEMORY_SCOPE_AGENT);
            else XB_SPIN(xb_ld(&bar[XB_TOPGEN]) == tg, bar);
            (void)__hip_atomic_fetch_add(&bar[XB_XGEN(b.x)], 1u, __ATOMIC_RELAXED, __HIP_MEMORY_SCOPE_AGENT);
            asm volatile("s_waitcnt vmcnt(0)" ::: "memory");
        } else {
            __builtin_amdgcn_fence(__ATOMIC_ACQUIRE, "agent");
            XB_SPIN(xb_ld(&bar[XB_XGEN(b.x)]) == gen, bar);
            asm volatile("s_waitcnt vmcnt(0)" ::: "memory");
        }
    }
    __syncthreads();
}

struct Args {
    const float* in[25];
    float* out; unsigned char* ws;
    int ph_lo, ph_hi;
};
enum { I_X = 0, I_MEM, I_NORM_MIX_G, I_W_IN, I_CONV_W, I_CONV_B, I_W_CONV_OUT, I_Q_NORM_G, I_W_UQ, I_KV_NORM_G, I_W_UKV, I_W_MLA_OUT, I_B_GATE, I_W_MIX_OUT,
       I_NORM_MEM_G, I_NORM_MEMKV_G, I_W_MEM_Q, I_W_MEM_KV, I_W_MEM_OUT, I_NORM_MOE_G, I_W_ROUTER, I_W_EXP_GATE, I_W_EXP_UP, I_W_EXP_DOWN, I_NORM_FINAL_G };

constexpr int TP_PITCH = 65, TP_BYTES = 64 * TP_PITCH * 4;
template <class SrcF, class DstF>
__device__ __forceinline__ void transpose_item(SrcF srcp, DstF dstp, int ld, const float* gain, int k0, LAS float* scr, int lane) {
    const int n4 = (lane & 15) * 4, kr = lane >> 4;
    const float* sp = srcp(n4);
    f32x4 v[16];
#pragma unroll
    for (int i = 0; i < 16; ++i) v[i] = sp ? *(const f32x4*)(sp + (size_t)(k0 + 4 * i + kr) * ld) : (f32x4){0.f, 0.f, 0.f, 0.f};
    if (gain) {
#pragma unroll
        for (int i = 0; i < 16; ++i) v[i] = v[i] * gain[k0 + 4 * i + kr]; }
#pragma unroll
    for (int i = 0; i < 16; ++i)
#pragma unroll
        for (int e = 0; e < 4; ++e) scr[(n4 + e) * TP_PITCH + 4 * i + kr] = v[i][e];
    asm volatile("s_waitcnt lgkmcnt(0)" ::: "memory");
    const int c = lane & 7;
#pragma unroll
    for (int j = 0; j < 8; ++j) { const int n = (lane >> 3) + 8 * j; const LAS float* s = scr + n * TP_PITCH + 8 * c;
        u32x4 o; o.x = cvtpk(s[0], s[1]); o.y = cvtpk(s[2], s[3]); o.z = cvtpk(s[4], s[5]); o.w = cvtpk(s[6], s[7]);
        *(u32x4*)(dstp(n) + k0 + 8 * c) = o; }
    asm volatile("s_waitcnt lgkmcnt(0)" ::: "memory");
}
template <class MapF>
__device__ __forceinline__ void transpose_matrix(MapF map, bf16_t* dst, int NDST, int K, int ld, const float* gain, LAS float* scr, int lane, int gw, int NGW, int& itbase) {
    const int nkb = K / 64, nitems = (NDST / 64) * nkb;
    int first = (gw - (itbase % NGW) + NGW) % NGW;
    for (int it = first; it < nitems; it += NGW) { const int nb = it / nkb, kb = it % nkb, n0 = nb * 64;
        transpose_item([&](int n) { return map(n0 + n); }, [&](int n) { return dst + (size_t)(n0 + n) * K; }, ld, gain, kb * 64, scr, lane); }
    itbase += nitems;
}

__device__ __forceinline__ int rope_dim(int p) { return (p >> 3) * 4 + (p & 3) + 32 * ((p >> 2) & 1); }

template <int PHM> __global__ void __launch_bounds__(NWAVES * 64, 2) fwd_kernel(Args args) {
    extern __shared__ __attribute__((aligned(16))) unsigned char lds_raw[];
    LAS unsigned char* lds = (LAS unsigned char*)lds_raw;
    volatile LAS unsigned* MISC = (volatile LAS unsigned*)(lds + MISC_OFF);
    const int tid = threadIdx.x, lane = tid & 63, wave = __builtin_amdgcn_readfirstlane(tid >> 6);
    const int G = gridDim.x; const int bx = blockIdx.x; const int vcu = (G % 8 == 0) ? (bx % 8) * (G / 8) + bx / 8 : bx;
    const int gw = vcu * NWAVES + wave, NGW = G * NWAVES;
    unsigned char* ws = args.ws;
    gu32* ctl = (gu32*)(ws + WS_CTL);
    for (int u = tid; u < (LDS_BYTES - LDSCTL_OFF) / 4; u += NWAVES * 64) ((LAS unsigned*)(lds + LDSCTL_OFF))[u] = 0u;
    __syncthreads();
    XcdBarrier bar; bar.bar = (unsigned*)(ctl + CW_BAR); bar.x = 0; bar.st = nullptr;
    if (N_LAUNCHES == 1) bar = xcd_barrier_post((unsigned*)(ctl + CW_BAR), MISC + 8);
#define GRID_BAR() do { if (N_LAUNCHES == 1) xcd_barrier(bar); } while (0)
    const int lo = args.ph_lo, hi = args.ph_hi;
#define IN(k) (((PHM >> (k)) & 1) && lo <= (k) && (k) < hi)
#define SEAM(k) do { if (IN(k) && IN((k) + 1)) GRID_BAR(); } while (0)

    const float* x = args.in[I_X]; float* out = args.out;
#define rope ((f32x2*)(ws + WS_ROPE))
#define rstd0 ((float*)(ws + WS_RSTD0))
#define rstdq ((float*)(ws + WS_RSTDQ))
#define rstdkv ((float*)(ws + WS_RSTDKV))
#define rstdm ((float*)(ws + WS_RSTDM))
#define ssq ((float*)(ws + WS_SSQ))
#define aff ((float*)(ws + WS_AFF))
#define inv ((int*)(ws + WS_INV))
#define idx ((int*)(ws + WS_IDX))
#define gate ((float*)(ws + WS_GATE))
#define memb ((bf16_t*)(ws + WS_MEMB))
#define MKV ((bf16_t*)(ws + WS_MKV))
#define QKT ((bf16_t*)(ws + WS_QKT))
#define VWT ((bf16_t*)(ws + WS_VWT))
#define Win_t ((bf16_t*)(ws + WS_WIN))
#define Wco_t ((bf16_t*)(ws + WS_WCO))
#define Wmo_t ((bf16_t*)(ws + WS_WMO))
#define Wmix_t ((bf16_t*)(ws + WS_WMIX))
#define Wuq_t ((bf16_t*)(ws + WS_WUQ))
#define Wukv_t ((bf16_t*)(ws + WS_WUKV))
#define Wmqh ((bf16_t*)(ws + WS_WMQH))
#define Woht ((bf16_t*)(ws + WS_WOHT))
#define Wmkv_t ((bf16_t*)(ws + WS_WMKV))
#define XGG ((bf16_t*)(ws + WS_XGG))
#define QB ((bf16_t*)(ws + WS_QB))
#define MIXA ((bf16_t*)(ws + WS_MIXA))
#define Wgu_t ((bf16_t*)(ws + WS_WGU))
#define Wd_t ((bf16_t*)(ws + WS_WD))
#define Y ((bf16_t*)(ws + WS_Y))
#define XB ((bf16_t*)(ws + WS_XB))
#define X2B ((bf16_t*)(ws + WS_X2B))
#define ACONV ((bf16_t*)(ws + WS_ACONV))
#define OB ((bf16_t*)(ws + WS_OB))
#define X1B ((bf16_t*)(ws + WS_X1B))
#define XG ((bf16_t*)(ws + WS_XG))
#define SIGA ((bf16_t*)(ws + WS_SIGA))
#define MIXED ((bf16_t*)(ws + WS_MIXED))
#define PM ((bf16_t*)(ws + WS_PM))
#define SIGB ((bf16_t*)(ws + WS_SIGB))
#define H3 ((bf16_t*)(ws + WS_H3))
#define HB ((bf16_t*)(ws + WS_H))
#define CQ ((bf16_t*)(ws + WS_CQ))
#define CKV ((bf16_t*)(ws + WS_CKV))
#define KR ((bf16_t*)(ws + WS_KR))
#define KROPE ((bf16_t*)(ws + WS_KROPE))
#define KVB ((bf16_t*)out)
    LAS float* scr = (LAS float*)(lds + wave * TP_BYTES);

    if (IN(0)) {
        int itb = 0;
        { const float* W = args.in[I_W_IN]; const float* gn = args.in[I_NORM_MIX_G];
          transpose_matrix([&](int n) -> const float* { if (n < 2048) { const int t = n >> 8, half = (n >> 7) & 1, c = n & 127; return W + (half ? 2048 : 0) + 128 * t + c; }
                                                         if (n < 3072) return W + 1024 + (n - 2048); if (n < 3520) return W + n; if (n < 3584) return nullptr; return W + (n - 64); },
                           Win_t, NU, 1024, 5568, gn, scr, lane, gw, NGW, itb); }
        { const float* W = args.in[I_W_CONV_OUT]; transpose_matrix([&](int n) -> const float* { return W + n; }, Wco_t, 1024, 1024, 1024, nullptr, scr, lane, gw, NGW, itb); }
        { const float* W = args.in[I_W_MLA_OUT]; transpose_matrix([&](int n) -> const float* { return W + n; }, Wmo_t, 1024, 1024, 1024, nullptr, scr, lane, gw, NGW, itb); }
        { const float* W = args.in[I_W_MIX_OUT]; transpose_matrix([&](int n) -> const float* { return W + n; }, Wmix_t, 1024, 1024, 1024, nullptr, scr, lane, gw, NGW, itb); }
        { const float* W = args.in[I_W_UQ]; const float* gn = args.in[I_Q_NORM_G];
          transpose_matrix([&](int n) -> const float* { if (n < 1024) return W + (n >> 7) * 192 + (n & 127); const int r = n - 1024; return W + (r >> 6) * 192 + 128 + rope_dim(r & 63); },
                           Wuq_t, 1536, 256, 1536, gn, scr, lane, gw, NGW, itb); }
        { const float* W = args.in[I_W_UKV]; const float* gn = args.in[I_KV_NORM_G];
          transpose_matrix([&](int n) -> const float* { if (n < 1024) return W + (n >> 7) * 256 + (n & 127); const int r = n - 1024; return W + (r >> 7) * 256 + 128 + (r & 127); },
                           Wukv_t, 2048, 128, 2048, gn, scr, lane, gw, NGW, itb); }
        { const float* W = args.in[I_W_MEM_KV]; const float* gn = args.in[I_NORM_MEMKV_G];
          transpose_matrix([&](int n) -> const float* { return W + n; }, Wmkv_t, 2048, 1024, 2048, gn, scr, lane, gw, NGW, itb); }
        for (int h = 0; h < 4; ++h) { const float* W = args.in[I_W_MEM_OUT] + (size_t)h * 256 * 1024;
          transpose_matrix([&](int n) -> const float* { return W + n; }, Woht + (size_t)h * 1024 * 256, 1024, 256, 1024, nullptr, scr, lane, gw, NGW, itb); }
        { const float* W = args.in[I_W_MEM_Q]; const float* gn = args.in[I_NORM_MEM_G];
          for (int c = gw * 64 + lane; c < 1024 * 1024 / 8; c += NGW * 64) { const int e0 = c * 8, h = e0 >> 18, d = (e0 >> 8) & 1023, j = e0 & 255; const float g = gn[d];
              const float* s = W + (size_t)d * 1024 + h * 256 + j; const f32x4 a = *(const f32x4*)s, b = *(const f32x4*)(s + 4);
              const float o[8] = {a[0] * g, a[1] * g, a[2] * g, a[3] * g, b[0] * g, b[1] * g, b[2] * g, b[3] * g}; *(u32x4*)(Wmqh + e0) = pack8(o); } }
        for (int r = gw; r < MT + NB * MEM_LEN; r += NGW) { const bool isx = r < MT; const int rr = isx ? r : r - MT;
            const float* src = (isx ? x : args.in[I_MEM]) + (size_t)rr * 1024; bf16_t* dst = (isx ? XB : memb) + (size_t)rr * 1024; float s = 0.f;
#pragma unroll
            for (int j = 0; j < 4; ++j) { const f32x4 v = *(const f32x4*)(src + (lane + 64 * j) * 4); s += (v[0] * v[0] + v[1] * v[1]) + (v[2] * v[2] + v[3] * v[3]);
                u32x2 w; w.x = cvtpk(v[0], v[1]); w.y = cvtpk(v[2], v[3]); *(u32x2*)(dst + (lane + 64 * j) * 4) = w; }
            s = wave_sum(s); if (lane == 0) (isx ? rstd0 : rstdm)[rr] = 1.f / sqrtf(s * (1.f / 1024.f) + EPS); }
        for (int i = gw * 64 + lane; i < SEQ * 32; i += NGW * 64) { const int s = i >> 5, j = i & 31; const float invf = 1.0f / powf(10000.0f, (float)(2 * j) / 64.0f); const float ang = (float)s * invf;
            rope[i] = (f32x2){cosf(ang), sinf(ang)}; }
    }
    SEAM(0);

    if (IN(1)) {
        { Gemm g = mkgemm(XB, Win_t, MT, NU, 1024, 1024, 1024); StaticOrder S; S.init(MT, NU, G, bx);
          EpiU E{{rstd0, XGG, CQ, CKV, KR, SIGA, SIGB, args.in[I_B_GATE]}}; pg8::gemm_phase(lds, g, S, E); }
        { Gemm g = mkgemm(memb, Wmkv_t, NB * MEM_LEN, 2048, 1024, 1024, 1024); StaticOrder S; S.init(NB * MEM_LEN, 2048, G, (bx + G / 2) % G);
          pg8::EpiChunk<FMemKV> E{{rstdm, MKV}}; pg8::gemm_phase(lds, g, S, E); }
    }
    SEAM(1);

    if (IN(2)) {
        const float* cw = args.in[I_CONV_W]; const float* cb = args.in[I_CONV_B];
        for (int blk = gw; blk < MT / 4; blk += NGW) { const int r0 = blk * 4, s0 = r0 & (SEQ - 1);
            u32x4 pxr[6][2], gbr[4][2]; u32x2 cqr[4]; unsigned ckr[4]; bf16_t k1[4], k2[4];
            const u32x4 z = {0u, 0u, 0u, 0u};
#pragma unroll
            for (int i = 0; i < 6; ++i) { const int rr = r0 - 1 + i; const bool ok = (i > 0 || s0 > 0) && (i < 5 || s0 + 4 < SEQ);
#pragma unroll
                for (int j = 0; j < 2; ++j) pxr[i][j] = ok ? *(const u32x4*)(XGG + (size_t)rr * 2048 + lane * 8 + 512 * j) : z; }
#pragma unroll
            for (int i = 0; i < 4; ++i) { const int rr = r0 + i;
#pragma unroll
                for (int j = 0; j < 2; ++j) gbr[i][j] = *(const u32x4*)(XGG + (size_t)rr * 2048 + 1024 + lane * 8 + 512 * j);
                cqr[i] = *(const u32x2*)(CQ + (size_t)rr * 256 + lane * 4); ckr[i] = *(const unsigned*)(CKV + (size_t)rr * 128 + lane * 2);
                { const int j_ = (lane >> 3) * 4 + (lane & 3); k1[i] = KR[(size_t)rr * 64 + j_]; k2[i] = KR[(size_t)rr * 64 + j_ + 32]; } }
#pragma unroll
            for (int j = 0; j < 2; ++j) { const int c0 = lane * 8 + 512 * j;
                float w0[8], w1[8], w2[8], bb[8];
                { const f32x4 a = *(const f32x4*)(cw + c0), b = *(const f32x4*)(cw + c0 + 4); w0[0] = a[0]; w0[1] = a[1]; w0[2] = a[2]; w0[3] = a[3]; w0[4] = b[0]; w0[5] = b[1]; w0[6] = b[2]; w0[7] = b[3]; }
                { const f32x4 a = *(const f32x4*)(cw + 1024 + c0), b = *(const f32x4*)(cw + 1024 + c0 + 4); w1[0] = a[0]; w1[1] = a[1]; w1[2] = a[2]; w1[3] = a[3]; w1[4] = b[0]; w1[5] = b[1]; w1[6] = b[2]; w1[7] = b[3]; }
                { const f32x4 a = *(const f32x4*)(cw + 2048 + c0), b = *(const f32x4*)(cw + 2048 + c0 + 4); w2[0] = a[0]; w2[1] = a[1]; w2[2] = a[2]; w2[3] = a[3]; w2[4] = b[0]; w2[5] = b[1]; w2[6] = b[2]; w2[7] = b[3]; }
                { const f32x4 a = *(const f32x4*)(cb + c0), b = *(const f32x4*)(cb + c0 + 4); bb[0] = a[0]; bb[1] = a[1]; bb[2] = a[2]; bb[3] = a[3]; bb[4] = b[0]; bb[5] = b[1]; bb[6] = b[2]; bb[7] = b[3]; }
                float p[6][8];
#pragma unroll
                for (int i = 0; i < 6; ++i) unpack8(pxr[i][j], p[i]);
#pragma unroll
                for (int i = 0; i < 4; ++i) { float gb[8], o[8]; unpack8(gbr[i][j], gb);
#pragma unroll
                    for (int e = 0; e < 8; ++e) o[e] = gb[e] * (w0[e] * p[i][e] + w1[e] * p[i + 1][e] + w2[e] * p[i + 2][e] + bb[e]);
                    *(u32x4*)(ACONV + (size_t)(r0 + i) * 1024 + c0) = pack8(o); } }
#pragma unroll
            for (int i = 0; i < 4; ++i) { const int r = r0 + i, s = r & (SEQ - 1);
                { const u32x2 w = cqr[i]; const float a = bflo(w.x), b = bfhi(w.x), c = bflo(w.y), d = bfhi(w.y);
                  const float sq = wave_sum((a * a + b * b) + (c * c + d * d)); if (lane == 0) rstdq[r] = 1.f / sqrtf(sq * (1.f / 256.f) + EPS); }
                { const unsigned w = ckr[i]; const float a = bflo(w), b = bfhi(w);
                  const float sq = wave_sum(a * a + b * b); if (lane == 0) rstdkv[r] = 1.f / sqrtf(sq * (1.f / 128.f) + EPS); }
                { const int pp = lane, j = (pp >> 3) * 4 + (pp & 3), half = (pp >> 2) & 1; const float v1 = bf2f(k1[i]), v2 = bf2f(k2[i]); const f32x2 cs = rope[s * 32 + j];
                  KROPE[(size_t)r * 64 + pp] = f2bf(half ? v1 * cs.y + v2 * cs.x : v1 * cs.x - v2 * cs.y); } }
        }
    }
    SEAM(2);

    if (IN(3)) {
        { Gemm g = mkgemm(ACONV, Wco_t, MT, 1024, 1024, 1024, 1024); StaticOrder S; S.init(MT, 1024, G, bx);
          pg8::EpiChunk<FGateMul> E{{SIGA, MIXA}}; pg8::gemm_phase(lds, g, S, E); }
        { Gemm g = mkgemm(CQ, Wuq_t, MT, 1536, 256, 256, 256); StaticOrder S; S.init(MT, 1536, G, (bx + G / 2) % G);
          pg8::EpiChunk<FQ> E{{rstdq, rope, QB}}; pg8::gemm_phase(lds, g, S, E); }
        { Gemm g = mkgemm(CKV, Wukv_t, MT, 2048, 128, 128, 128); StaticOrder S; S.init(MT, 2048, G, bx);
          pg8::EpiChunk<FScaleRow> E{{rstdkv, KVB, 2048}}; pg8::gemm_phase(lds, g, S, E); }
        { Gemm g = mkgemm(MKV, Wmqh, 2048, 1024, 256, 256, 256, 1, 4, (size_t)1024 * 256); StaticOrder S; S.init(2048, 1024, G, bx);
          pg8::EpiChunk<FPlain> E{{QKT, 1024}}; pg8::gemm_phase(lds, g, S, E); }
        for (int b = 0; b < NB; ++b) { Gemm g = mkgemm(Woht, MKV + (size_t)(8 + b * 4) * 65536, 4096, 256, 256, 256, 256, 4, 4, (size_t)65536); StaticOrder S; S.init(4096, 256, G, (bx + G - 64 - 16 * b) % G);
          pg8::EpiChunk<FVW> E{{VWT + (size_t)b * 1024 * 1024}}; pg8::gemm_phase(lds, g, S, E); }
    }
    SEAM(3);

    if (IN(4)) {
        for (int u = vcu; u < NB * NHEAD * (SEQ / 256); u += G) { const int bh = u >> 5, qb = u & 31, b = bh >> 3, h = bh & 7; const size_t row0 = (size_t)b * SEQ + qb * 256;
            att::attn_unit(QB + row0 * 1536 + h * 128, QB + row0 * 1536 + 1024 + h * 64, KVB + (size_t)b * SEQ * 2048 + h * 128,
                           KROPE + (size_t)b * SEQ * 64, OB + row0 * 1024 + h * 128, SEQ, (char*)lds_raw); }
    }
    SEAM(4);

    if (IN(5)) { Gemm g = mkgemm(OB, Wmo_t, MT, 1024, 1024, 1024, 1024); StaticOrder S; S.init(MT, 1024, G, bx);
        pg8::EpiChunk<FGateMulAdd> E{{SIGB, MIXA, MIXED}}; pg8::gemm_phase(lds, g, S, E); }
    SEAM(5);

    if (IN(6)) { Gemm g = mkgemm(MIXED, Wmix_t, MT, 1024, 1024, 1024, 1024); StaticOrder S; S.init(MT, 1024, G, bx);
        EpiX1 E{x, RESID_BF16 ? nullptr : out, X1B, ssq}; pg8::gemm_phase(lds, g, S, E); }
    SEAM(6);

    if (IN(7)) { Gemm g = mkgemm(X1B, QKT, MT, 1024, 1024, 1024, 1024, 32, 2, (size_t)1024 * 1024); StaticOrder S; S.init(MT, 1024, G, bx);
        EpiSoftmax E{ssq, PM}; pg8::gemm_phase(lds, g, S, E); }
    SEAM(7);

    if (IN(8)) { Gemm g = mkgemm(PM, VWT, MT, 1024, 1024, 1024, 1024, 32, 2, (size_t)1024 * 1024); StaticOrder S; S.init(MT, 1024, G, bx);
#if RESID_BF16
        pg8::EpiChunk<FResidBf16> E{{X1B, X2B}}; pg8::gemm_phase(lds, g, S, E); }
#else
        pg8::EpiChunk<FResidF32> E{{out, out}}; pg8::gemm_phase(lds, g, S, E); }
#endif
    SEAM(8);

#if RESID_BF16
#define LDROW4(r_, j_) ([&]() -> f32x4 { const u32x2 w_ = *(const u32x2*)(X2B + (size_t)(r_) * 1024 + (lane + 64 * (j_)) * 4); return (f32x4){bflo(w_.x), bfhi(w_.x), bflo(w_.y), bfhi(w_.y)}; }())
#else
#define LDROW4(r_, j_) (*(const f32x4*)(out + (size_t)(r_) * 1024 + (lane + 64 * (j_)) * 4))
#endif
    if (IN(9)) {
        constexpr int RP = 1028;
        LAS float* wt = (LAS float*)lds;
        LAS float* hb = (LAS float*)(lds + 16 * RP * 4);
        LAS float* part = (LAS float*)(lds + 2 * 16 * RP * 4);
        const float* wr_ = args.in[I_W_ROUTER]; const float* gn = args.in[I_NORM_MOE_G];
        for (int i = tid; i < 1024 * 16; i += NWAVES * 64) wt[(i & 15) * RP + (i >> 4)] = wr_[i];
        f32x4 gv[4];
#pragma unroll
        for (int j = 0; j < 4; ++j) gv[j] = *(const f32x4*)(gn + (lane + 64 * j) * 4);
        f32x4 v[2][4], vn[2][4];
        const int ngroups = MT / 16;
        if (vcu < ngroups) {
#pragma unroll
            for (int t = 0; t < 2; ++t)
#pragma unroll
                for (int j = 0; j < 4; ++j) v[t][j] = LDROW4(vcu * 16 + wave * 2 + t, j); }
        __syncthreads();
        for (int g = vcu; g < ngroups; g += G) { const int r0 = g * 16;
            if (g + G < ngroups) {
#pragma unroll
                for (int t = 0; t < 2; ++t)
#pragma unroll
                    for (int j = 0; j < 4; ++j) vn[t][j] = LDROW4((g + G) * 16 + wave * 2 + t, j); }
#pragma unroll
            for (int t = 0; t < 2; ++t) { const int tk = wave * 2 + t, r = r0 + tk; float s = 0.f;
#pragma unroll
                for (int j = 0; j < 4; ++j) s += (v[t][j][0] * v[t][j][0] + v[t][j][1] * v[t][j][1]) + (v[t][j][2] * v[t][j][2] + v[t][j][3] * v[t][j][3]);
                const float rs = 1.f / sqrtf(wave_sum(s) * (1.f / 1024.f) + EPS);
#pragma unroll
                for (int j = 0; j < 4; ++j) { const f32x4 hh = v[t][j] * rs * gv[j]; *(LAS f32x4*)(hb + tk * RP + (lane + 64 * j) * 4) = hh;
                    u32x2 w; w.x = cvtpk(hh[0], hh[1]); w.y = cvtpk(hh[2], hh[3]); *(u32x2*)(H3 + (size_t)r * 1024 + (lane + 64 * j) * 4) = w; } }
            __syncthreads();
            { f32x4 acc = {0.f, 0.f, 0.f, 0.f}; const LAS float* ap = wt + (lane & 15) * RP + wave * 128 + (lane >> 4); const LAS float* bp = hb + (lane & 15) * RP + wave * 128 + (lane >> 4);
#pragma unroll 8
                for (int st = 0; st < 32; ++st) acc = __builtin_amdgcn_mfma_f32_16x16x4f32(ap[4 * st], bp[4 * st], acc, 0, 0, 0);
                *(LAS f32x4*)(part + (wave * 16 + (lane & 15)) * 16 + 4 * (lane >> 4)) = acc; }
            __syncthreads();
            if (tid < 256) { const int tk = tid >> 4, e = tid & 15; float lg = 0.f;
#pragma unroll
                for (int w = 0; w < 8; ++w) lg += part[(w * 16 + tk) * 16 + e];
                float mx = lg;
#pragma unroll
                for (int o = 1; o < 16; o <<= 1) mx = fmaxf(mx, __shfl_xor(mx, o));
                const float p = __expf(lg - mx); float sm = p;
#pragma unroll
                for (int o = 1; o < 16; o <<= 1) sm += __shfl_xor(sm, o);
                const int r = r0 + tk, b = r >> 13, sidx = r & (SEQ - 1); aff[((size_t)b * NEXP + e) * SEQ + sidx] = p / sm; inv[(size_t)r * 16 + e] = -1; }
            __syncthreads();
#pragma unroll
            for (int t = 0; t < 2; ++t)
#pragma unroll
                for (int j = 0; j < 4; ++j) v[t][j] = vn[t][j];
        }
    }
    SEAM(9);

    if (IN(10)) {
        if (vcu < NB * NEXP) {
            LAS unsigned* keys = (LAS unsigned*)lds; LAS unsigned* hist = (LAS unsigned*)(lds + 32768); LAS unsigned* misc = (LAS unsigned*)(lds + 32768 + 1024);
            for (int be = vcu; be < NB * NEXP; be += G) { const int b = be >> 4, e = be & 15; const float* a = aff + (size_t)be * SEQ;
#pragma unroll 1
                for (int i = tid; i < SEQ; i += NWAVES * 64) keys[i] = __float_as_uint(a[i]);
                unsigned prefix = 0u, kth = CAP;
#pragma unroll 1
                for (int pass = 0; pass < 4; ++pass) { const int shift = 24 - 8 * pass;
                    if (tid < 256) hist[tid] = 0u;
                    __syncthreads();
#pragma unroll 1
                    for (int i = tid; i < SEQ; i += NWAVES * 64) { const unsigned k = keys[i]; const bool match = (pass == 0) || ((k >> (shift + 8)) == (prefix >> (shift + 8)));
                        if (match) atomicAdd((unsigned*)(hist + ((k >> shift) & 255u)), 1u); }
                    __syncthreads();
                    if (wave == 0) { unsigned c[4]; unsigned tot = 0u;
#pragma unroll
                        for (int i = 0; i < 4; ++i) { c[i] = hist[255 - (4 * lane + i)]; tot += c[i]; }
                        unsigned incl = tot;
#pragma unroll
                        for (int o = 1; o < 64; o <<= 1) { const unsigned t = __shfl_up(incl, o); if (lane >= o) incl += t; }
                        unsigned run = incl - tot;
#pragma unroll
                        for (int i = 0; i < 4; ++i) { if (run < kth && run + c[i] >= kth) { misc[0] = 255u - (unsigned)(4 * lane + i); misc[1] = kth - run; } run += c[i]; } }
                    __syncthreads();
                    prefix |= misc[0] << shift; kth = misc[1];
                    __syncthreads();
                }
                const unsigned T = prefix; unsigned base_g = 0u, base_e = 0u;
#pragma unroll 1
                for (int it = 0; it < SEQ / (NWAVES * 64); ++it) { const int t = it * (NWAVES * 64) + tid; const unsigned k = keys[t]; const bool gt = k > T, eq = k == T;
                    const unsigned long long bg = __ballot(gt), bq = __ballot(eq); const unsigned long long lt = (1ull << lane) - 1ull;
                    if (lane == 0) { misc[8 + wave] = (unsigned)__popcll(bg); misc[16 + wave] = (unsigned)__popcll(bq); }
                    __syncthreads();
                    unsigned pg = base_g, pq = base_e, tg = 0u, tq = 0u;
#pragma unroll
                    for (int w = 0; w < NWAVES; ++w) { const unsigned cg = misc[8 + w], cq = misc[16 + w]; if (w < wave) { pg += cg; pq += cq; } tg += cg; tq += cq; }
                    pg += (unsigned)__popcll(bg & lt); pq += (unsigned)__popcll(bq & lt);
                    const bool sel = gt || (eq && pq < kth);
                    if (sel) { const unsigned pos = pg + (pq < kth ? pq : kth); idx[(size_t)be * CAP + pos] = t; gate[(size_t)be * CAP + pos] = __uint_as_float(k); inv[((size_t)b * SEQ + t) * 16 + e] = (int)pos; }
                    base_g += tg; base_e += tq;
                    __syncthreads();
                }
            }
        } else {
            const int cw_ = vcu - NB * NEXP, ncw = G - NB * NEXP; const int gw2 = cw_ * NWAVES + wave, NGW2 = ncw * NWAVES;
#pragma unroll 1
            for (int it = gw2; it < NEXP * 768; it += NGW2) { const int e = it / 768, r = it % 768;
                if (r < 512) { const int nb = r >> 4, kb = r & 15, n0 = nb * 64; const int f0 = (n0 >> 8) * 128 + (n0 & 127);
                    const float* W = (((n0 >> 7) & 1) ? args.in[I_W_EXP_UP] : args.in[I_W_EXP_GATE]) + (size_t)e * 1024 * 1024 + f0; bf16_t* D = Wgu_t + (size_t)e * 2048 * 1024 + (size_t)n0 * 1024;
                    transpose_item([&](int n) { return W + n; }, [&](int n) { return D + (size_t)n * 1024; }, 1024, nullptr, kb * 64, scr, lane); }
                else { const int r2 = r - 512, nb = r2 >> 4, kb = r2 & 15, n0 = nb * 64;
                    const float* W = args.in[I_W_EXP_DOWN] + (size_t)e * 1024 * 1024 + n0; bf16_t* D = Wd_t + (size_t)e * 1024 * 1024 + (size_t)n0 * 1024;
                    transpose_item([&](int n) { return W + n; }, [&](int n) { return D + (size_t)n * 1024; }, 1024, nullptr, kb * 64, scr, lane); } }
        }
    }
    if (IN(10) && IN(12)) GRID_BAR();

    if (IN(12)) { Gemm g = mkgemm(H3, Wgu_t, MOE_ROWS, 2048, 1024, 1024, 1024, 4, 16, (size_t)2048 * 1024); g.gidx = idx; StaticOrder S; S.init(MOE_ROWS, 2048, G, bx);
        EpiSwiglu E{HB}; pg8::gemm_phase<EpiSwiglu, StaticOrder, true>(lds, g, S, E); }
    SEAM(12);

    if (IN(13)) { Gemm g = mkgemm(HB, Wd_t, MOE_ROWS, 1024, 1024, 1024, 1024, 4, 16, (size_t)1024 * 1024); StaticOrder S; S.init(MOE_ROWS, 1024, G, bx);
        pg8::EpiChunk<FGateRow> E{{gate, Y}}; pg8::gemm_phase(lds, g, S, E); }
    SEAM(13);

    if (IN(14)) {
        const float* gn = args.in[I_NORM_FINAL_G]; f32x4 gv[4];
#pragma unroll
        for (int j = 0; j < 4; ++j) gv[j] = *(const f32x4*)(gn + (lane + 64 * j) * 4);
        f32x4 v[4], vn[4]; int myslot = -1, nslot = -1;
        if (gw < MT) { myslot = inv[(size_t)gw * 16 + (lane & 15)];
#pragma unroll
            for (int j = 0; j < 4; ++j) v[j] = LDROW4(gw, j); }
        for (int r = gw; r < MT; r += NGW) { float* row = out + (size_t)r * 1024; const int b = r >> 13;
            if (r + NGW < MT) { nslot = inv[(size_t)(r + NGW) * 16 + (lane & 15)];
#pragma unroll
                for (int j = 0; j < 4; ++j) vn[j] = LDROW4(r + NGW, j); }
            unsigned long long em = __ballot(lane < 16 && myslot >= 0) & 0xffffull;
            while (em) { u32x2 w[4][4]; int ne = 0;
#pragma unroll
                for (int q = 0; q < 4; ++q) { if (em) { const int e = __builtin_ctzll(em); em &= em - 1; const int slot = __builtin_amdgcn_readlane(myslot, e);
                        const bf16_t* yr = Y + ((size_t)(b * NEXP + e) * CAP + slot) * 1024;
#pragma unroll
                        for (int j = 0; j < 4; ++j) w[q][j] = *(const u32x2*)(yr + (lane + 64 * j) * 4);
                        ne = q + 1; } }
#pragma unroll
                for (int q = 0; q < 4; ++q) { if (q < ne) {
#pragma unroll
                        for (int j = 0; j < 4; ++j) { v[j][0] += bflo(w[q][j].x); v[j][1] += bfhi(w[q][j].x); v[j][2] += bflo(w[q][j].y); v[j][3] += bfhi(w[q][j].y); } } } }
            float s = 0.f;
#pragma unroll
            for (int j = 0; j < 4; ++j) s += (v[j][0] * v[j][0] + v[j][1] * v[j][1]) + (v[j][2] * v[j][2] + v[j][3] * v[j][3]);
            const float rs = 1.f / sqrtf(wave_sum(s) * (1.f / 1024.f) + EPS);
#pragma unroll
            for (int j = 0; j < 4; ++j) *(f32x4*)(row + (lane + 64 * j) * 4) = v[j] * rs * gv[j];
#pragma unroll
            for (int j = 0; j < 4; ++j) v[j] = vn[j];
            myslot = nslot;
        }
    }
#undef IN
#undef SEAM
#undef GRID_BAR
}

#ifndef PH_MASK
#define PH_MASK 0x7fff
#endif
static const void* phase_fn(int k) {
#if MK_N_LAUNCHES == 1
    (void)k; return (const void*)fwd_kernel<PH_MASK>;
#else
    switch (k) {
    case 0: return (const void*)fwd_kernel<1 << 0>;   case 1: return (const void*)fwd_kernel<1 << 1>;   case 2: return (const void*)fwd_kernel<1 << 2>;   case 3: return (const void*)fwd_kernel<1 << 3>;
    case 4: return (const void*)fwd_kernel<1 << 4>;   case 5: return (const void*)fwd_kernel<1 << 5>;   case 6: return (const void*)fwd_kernel<1 << 6>;   case 7: return (const void*)fwd_kernel<1 << 7>;
    case 8: return (const void*)fwd_kernel<1 << 8>;   case 9: return (const void*)fwd_kernel<1 << 9>;   case 10: return (const void*)fwd_kernel<1 << 10>; case 11: return (const void*)fwd_kernel<1 << 11>;
    case 12: return (const void*)fwd_kernel<1 << 12>; case 13: return (const void*)fwd_kernel<1 << 13>; default: return (const void*)fwd_kernel<1 << 14>;
    }
#endif
}
extern "C" void kernel_launch(void* const* d_in, const int* in_sizes, int n_in, void* d_out, int out_size, void* d_ws, size_t ws_size, hipStream_t stream) {
    static int grid = 0;
    if (grid == 0) {
        if (n_in != 25 || in_sizes[0] != MT * DM || out_size != MT * DM || ws_size < WS_END) {
            fprintf(stderr, "kernel_launch: built for 25 inputs, x/out of %d floats, >= %zu bytes of workspace; got n_in %d, in0 %d, out %d, ws %zu; nothing launched\n", MT * DM, (size_t)WS_END, n_in, n_in > 0 ? in_sizes[0] : -1, out_size, ws_size);
            grid = -1; return; }
        int dev = 0, cus = 0;
        if (hipGetDevice(&dev) != hipSuccess || hipDeviceGetAttribute(&cus, hipDeviceAttributeMultiprocessorCount, dev) != hipSuccess) { fprintf(stderr, "kernel_launch: device query failed\n"); grid = -1; return; }
        for (int k = 0; k < (N_LAUNCHES == 1 ? 1 : N_PHASES); ++k)
            if (hipFuncSetAttribute(phase_fn(N_LAUNCHES == 1 ? -1 : k), hipFuncAttributeMaxDynamicSharedMemorySize, LDS_BYTES) != hipSuccess) { fprintf(stderr, "kernel_launch: hipFuncSetAttribute failed\n"); grid = -1; return; }
        (void)hipGetLastError();
        grid = cus;
    }
    if (grid < 0) return;
    if (hipMemsetAsync((char*)d_ws + WS_CTL, 0, CTL_ZERO_BYTES, stream) != hipSuccess) { fprintf(stderr, "kernel_launch: memset failed\n"); return; }
    Args a{};
    for (int i = 0; i < 25; ++i) a.in[i] = (const float*)d_in[i];
    a.out = (float*)d_out; a.ws = (unsigned char*)d_ws;
    for (int li = 0; li < N_LAUNCHES; ++li) {
        a.ph_lo = (N_LAUNCHES == 1) ? 0 : li; a.ph_hi = (N_LAUNCHES == 1) ? N_PHASES : li + 1;
        void* kargs[] = {&a};
        for (int rep = 0; rep < ((N_LAUNCHES != 1 && li == REP_PHASE) ? 2 : 1); ++rep)
            (void)hipLaunchKernel(phase_fn(N_LAUNCHES == 1 ? -1 : li), dim3(grid), dim3(NWAVES * 64), kargs, LDS_BYTES, stream);
        const hipError_t le = hipPeekAtLastError();
        if (le != hipSuccess) { fprintf(stderr, "kernel_launch: launch %d failed: %s\n", li, hipGetErrorName(le)); break; }
    }
}
```

```cpp
#include <hip/hip_runtime.h>
#include <cstdio>
#include <cstdint>

#ifndef MK_N_LAUNCHES
#define MK_N_LAUNCHES 1
#endif
#ifndef REP_PHASE
#define REP_PHASE -1
#endif
#ifndef RESID_BF16
#define RESID_BF16 1
#endif
#ifndef ATT_FP8
#define ATT_FP8 1
#endif
#ifndef GEMM_SIMPLE
#define GEMM_SIMPLE 0
#endif

#define LAS __attribute__((address_space(3)))
#define GAS __attribute__((address_space(1)))
typedef unsigned short bf16_t;
typedef short bf16x8 __attribute__((ext_vector_type(8)));
typedef short s16x4 __attribute__((ext_vector_type(4)));
typedef float f32x2 __attribute__((ext_vector_type(2)));
typedef float f32x4 __attribute__((ext_vector_type(4)));
typedef float f32x16 __attribute__((ext_vector_type(16)));
typedef unsigned u32x2 __attribute__((ext_vector_type(2)));
typedef unsigned u32x4 __attribute__((ext_vector_type(4)));
typedef __bf16 bf16x2_t __attribute__((ext_vector_type(2)));

constexpr int DM = 1024, NB = 2, SEQ = 8192, MT = NB * SEQ;
constexpr int NU = 5632;
constexpr int NHEAD = 8, QK_NOPE = 128, QK_ROPE = 64, V_HEAD = 128, Q_LORA = 256, KV_LORA = 128;
constexpr int MEM_LEN = 256, MEM_HEADS = 4, MEM_HD = 256;
constexpr int NEXP = 16, EFF = 1024, CAP = 1024;
constexpr int MOE_ROWS = NB * NEXP * CAP;
constexpr float EPS = 1e-6f;
constexpr float ATT_SCALE = 0.07216878364870322f;

__device__ __forceinline__ unsigned cvtpk(float lo, float hi) { f32x2 v = {lo, hi}; bf16x2_t b = __builtin_convertvector(v, bf16x2_t); return __builtin_bit_cast(unsigned, b); }
__device__ __forceinline__ float bflo(unsigned w) { return __builtin_bit_cast(float, w << 16); }
__device__ __forceinline__ float bfhi(unsigned w) { return __builtin_bit_cast(float, w & 0xffff0000u); }
__device__ __forceinline__ float bf2f(bf16_t h) { return __builtin_bit_cast(float, (unsigned)h << 16); }
__device__ __forceinline__ bf16_t f2bf(float f) { return (bf16_t)(cvtpk(f, 0.f) & 0xffffu); }
__device__ __forceinline__ void unpack8(const u32x4 w, float (&v)[8]) { v[0] = bflo(w.x); v[1] = bfhi(w.x); v[2] = bflo(w.y); v[3] = bfhi(w.y); v[4] = bflo(w.z); v[5] = bfhi(w.z); v[6] = bflo(w.w); v[7] = bfhi(w.w); }
__device__ __forceinline__ u32x4 pack8(const float (&v)[8]) { u32x4 w; w.x = cvtpk(v[0], v[1]); w.y = cvtpk(v[2], v[3]); w.z = cvtpk(v[4], v[5]); w.w = cvtpk(v[6], v[7]); return w; }
typedef int v8i __attribute__((ext_vector_type(8)));
__device__ __forceinline__ unsigned pk4_fp8(float a, float b, float c, float d) { unsigned w = 0; w = __builtin_amdgcn_cvt_pk_fp8_f32(a, b, w, false); w = __builtin_amdgcn_cvt_pk_fp8_f32(c, d, w, true); return w; }
__device__ __forceinline__ u32x2 pack8_fp8(const float (&v)[8]) { u32x2 w; w.x = pk4_fp8(v[0], v[1], v[2], v[3]); w.y = pk4_fp8(v[4], v[5], v[6], v[7]); return w; }
__device__ __forceinline__ float wave_sum(float v) {
#pragma unroll
    for (int o = 1; o < 64; o <<= 1) v += __shfl_xor(v, o);
    return v;
}

namespace pg8 {
constexpr int BM = 256, BK = 64, HALF = 128, HTB = HALF * BK * 2, STAGE_BYTES = 8 * HTB, NXCD = 8, WGM = 8;
__host__ __device__ __forceinline__ int lds_byte(int r, int c) { const int st = (r >> 4) * 2 + (c >> 5), rr = r & 15, cc = c & 31, ob = rr * 64 + cc * 2; return st * 1024 + (ob ^ (((ob >> 9) & 1) << 5)); }
__host__ __device__ __forceinline__ void stage_rc(int b, int& R, int& C) { const int st = b / 1024, sb = b % 1024, swz = sb ^ (((sb >> 9) & 1) << 5); R = (st >> 1) * 16 + swz / 64; C = (st & 1) * 32 + (swz % 64) / 2; }
__host__ __device__ __forceinline__ int perm32(int rho) { const int n = rho >> 4, i = rho & 15; return 8 * (i >> 2) + 4 * n + (i & 3); }

struct Unit { int pm, pn; };
struct Gemm { const bf16_t* A; const bf16_t* Bt; int M, N, K, lda, ldb, bdiv, bmod; size_t bstride; const int* gidx; };
__device__ __forceinline__ Gemm mkgemm(const bf16_t* A, const bf16_t* Bt, int M, int N, int K, int lda, int ldb, int bdiv = 1, int bmod = 1, size_t bstride = 0) {
    Gemm g; g.A = A; g.Bt = Bt; g.M = M; g.N = N; g.K = K; g.lda = lda; g.ldb = ldb; g.bdiv = bdiv; g.bmod = bmod; g.bstride = bstride; g.gidx = nullptr; return g; }

struct StaticOrder {
    int nM, nN, nwg, G, c;
    __host__ __device__ void init(int M, int N, int G_, int c_) { nM = M / BM; nN = N / BM; nwg = nM * nN; G = G_; c = c_; }
    __host__ __device__ bool next(int i, Unit& u) const {
        const long L = (long)i * G + c; if (L >= nwg) return false;
        int wgid = (int)L; { const int q = nwg / NXCD, r = nwg % NXCD, xcd = wgid % NXCD, off = wgid / NXCD; wgid = (xcd < r ? xcd * (q + 1) : r * (q + 1) + (xcd - r) * q) + off; }
        const int nig = WGM * nN, gid = wgid / nig, fm = gid * WGM, gsz = (nM - fm) < WGM ? (nM - fm) : WGM;
        u.pm = fm + ((wgid % nig) % gsz); u.pn = (wgid % nig) / gsz; return true;
    }
};

typedef f32x4 Acc[2][2][4][2];

template <class Epi, class Sched>
__device__ __forceinline__ void gemm_simple(LAS unsigned char* lds, const Gemm g, const Sched& S, const Epi& E, const int tid) {
    const int wid = __builtin_amdgcn_readfirstlane(tid >> 6), lane = tid & 63, wr = wid >> 2, wc = wid & 3, fr = lane & 15, fq = lane >> 4;
    Unit u;
    for (int i = 0; S.next(i, u); ++i) {
        Acc acc;
#pragma unroll
        for (int a = 0; a < 2; ++a)
#pragma unroll
            for (int b = 0; b < 2; ++b)
#pragma unroll
                for (int m = 0; m < 4; ++m)
#pragma unroll
                    for (int n = 0; n < 2; ++n) acc[a][b][m][n] = (f32x4){0.f, 0.f, 0.f, 0.f};
        const bf16_t* Ab = g.A + (size_t)u.pm * BM * g.lda + (size_t)(wr * 64 + fr) * g.lda + fq * 8;
        const bf16_t* Bb = g.Bt + (size_t)((u.pm / g.bdiv) % g.bmod) * g.bstride + (size_t)u.pn * BM * g.ldb + fq * 8;
        int brow[2][2];
#pragma unroll
        for (int bj = 0; bj < 2; ++bj)
#pragma unroll
            for (int n = 0; n < 2; ++n) brow[bj][n] = bj * HALF + wc * 32 + perm32(n * 16 + fr);
#pragma unroll 1
        for (int k0 = 0; k0 < g.K; k0 += 32) {
            bf16x8 b[2][2];
#pragma unroll
            for (int bj = 0; bj < 2; ++bj)
#pragma unroll
                for (int n = 0; n < 2; ++n) b[bj][n] = *(const bf16x8*)(Bb + (size_t)brow[bj][n] * g.ldb + k0);
#pragma unroll
            for (int ai = 0; ai < 2; ++ai) { bf16x8 a[4];
#pragma unroll
                for (int m = 0; m < 4; ++m) a[m] = *(const bf16x8*)(Ab + (size_t)(ai * HALF + m * 16) * g.lda + k0);
#pragma unroll
                for (int bj = 0; bj < 2; ++bj)
#pragma unroll
                    for (int m = 0; m < 4; ++m)
#pragma unroll
                        for (int n = 0; n < 2; ++n) acc[ai][bj][m][n] = __builtin_amdgcn_mfma_f32_16x16x32_bf16(b[bj][n], a[m], acc[ai][bj][m][n], 0, 0, 0); }
        }
        E.run(acc, u, wr, wc, fr, fq, lds, wid, lane);
        if (Epi::USES_LDS) __syncthreads();
    }
}

template <class Epi, class Sched, bool GATHER>
__device__ __forceinline__ void gemm_fast(LAS unsigned char* lds, const Gemm g, const Sched& S, const Epi& E, const int tid) {
    const int wid = __builtin_amdgcn_readfirstlane(tid >> 6), lane = tid & 63, wr = wid >> 2, wc = wid & 3, fr = lane & 15, fq = lane >> 4;
    int Kop = g.K; asm volatile("" : "+s"(Kop));
    const int K = Kop, nt = K / BK;
    int Rr[2], Cc[2]; unsigned voffB[2];
    unsigned cvA0[2], cvA1[2], nvA0[2], nvA1[2];
    const size_t kstep = (size_t)(BK * 2);
    const size_t hstepA = (size_t)HALF * g.lda * 2, hstepB = (size_t)HALF * g.ldb * 2;
    const size_t tstepA = 2 * hstepA, tstepB = 2 * hstepB;
#pragma unroll
    for (int i = 0; i < 2; ++i) { stage_rc(tid * 16 + i * 8192, Rr[i], Cc[i]); const int Rb = (Rr[i] & ~31) + perm32(Rr[i] & 31);
        voffB[i] = (unsigned)(Rb * g.ldb + Cc[i]) * 2u;
        cvA0[i] = (unsigned)(Rr[i] * g.lda + Cc[i]) * 2u; cvA1[i] = cvA0[i] + (unsigned)hstepA; nvA0[i] = cvA0[i]; nvA1[i] = cvA1[i]; }
    const unsigned ldsw = (unsigned)wid * 1024u;
    const int aoff = lds_byte(wr * 64 + fr, fq * 8), boff = lds_byte(wc * 32 + fr, fq * 8);
#define PG8_SA(b, h) (((b) * 2 + (h)) * HTB)
#define PG8_SB(b, h) ((4 + (b) * 2 + (h)) * HTB)
#define PG8_STAGE(bufoff, gbase, voff) do { _Pragma("unroll") for (int _i = 0; _i < 2; ++_i) \
        __builtin_amdgcn_global_load_lds((const unsigned*)((const char*)(gbase) + (voff)[_i]), (LAS unsigned*)(lds + (bufoff) + ldsw + _i * 8192), 16, 0, 0); } while (0)
#define PG8_LDA(dst, b, h) do { _Pragma("unroll") for (int m = 0; m < 4; ++m) _Pragma("unroll") for (int k = 0; k < 2; ++k) dst[m][k] = *(const LAS bf16x8*)(lds + PG8_SA(b, h) + aoff + m * 2048 + k * 1024); } while (0)
#define PG8_LDB(dst, b, h) do { _Pragma("unroll") for (int n = 0; n < 2; ++n) _Pragma("unroll") for (int k = 0; k < 2; ++k) dst[n][k] = *(const LAS bf16x8*)(lds + PG8_SB(b, h) + boff + n * 2048 + k * 1024); } while (0)
#define PG8_MMA(ai, bj, At, Bt) do { __builtin_amdgcn_s_setprio(1); _Pragma("unroll") for (int m = 0; m < 4; ++m) _Pragma("unroll") for (int n = 0; n < 2; ++n) _Pragma("unroll") for (int k = 0; k < 2; ++k) \
        acc[ai][bj][m][n] = __builtin_amdgcn_mfma_f32_16x16x32_bf16(Bt[n][k], At[m][k], acc[ai][bj][m][n], 0, 0, 0); __builtin_amdgcn_s_setprio(0); } while (0)
#define PG8_WAIT_V(n) asm volatile("s_waitcnt vmcnt(" #n ")" ::: "memory")
#define PG8_WAIT_L(n) asm volatile("s_waitcnt lgkmcnt(" #n ")" ::: "memory")
#define PG8_BAR __builtin_amdgcn_s_barrier()
#define PG8_SCHED __builtin_amdgcn_sched_barrier(0)
#define PG8_GIDX(u, raw) do { const int* ip_ = g.gidx + (size_t)(u).pm * BM; raw[0] = ip_[Rr[0]]; raw[1] = ip_[Rr[1]]; raw[2] = ip_[HALF + Rr[0]]; raw[3] = ip_[HALF + Rr[1]]; } while (0)
#define PG8_GOFF(u, raw, v0, v1) do { const unsigned bb_ = (unsigned)((u).pm >> 6) * (unsigned)SEQ; _Pragma("unroll") for (int _i = 0; _i < 2; ++_i) { \
        v0[_i] = ((bb_ + (unsigned)raw[_i]) * (unsigned)g.lda + (unsigned)Cc[_i]) * 2u; v1[_i] = ((bb_ + (unsigned)raw[2 + _i]) * (unsigned)g.lda + (unsigned)Cc[_i]) * 2u; } } while (0)
    Unit cur, nxt; int ui = 0;
    if (!S.next(0, cur)) return;
    Acc acc;
#pragma unroll
    for (int a = 0; a < 2; ++a)
#pragma unroll
        for (int b = 0; b < 2; ++b)
#pragma unroll
            for (int m = 0; m < 4; ++m)
#pragma unroll
                for (int n = 0; n < 2; ++n) acc[a][b][m][n] = (f32x4){0.f, 0.f, 0.f, 0.f};
    bf16x8 At[4][2], B0[2][2], B1[2][2];
    int nraw[4] = {0, 0, 0, 0};
    const char* cA = GATHER ? (const char*)g.A : (const char*)g.A + (size_t)cur.pm * tstepA;
    const char* cB = (const char*)g.Bt + (size_t)((cur.pm / g.bdiv) % g.bmod) * g.bstride * 2 + (size_t)cur.pn * tstepB;
    if constexpr (GATHER) { int craw[4]; PG8_GIDX(cur, craw); PG8_GOFF(cur, craw, cvA0, cvA1); }
    PG8_STAGE(PG8_SB(0, 0), cB, voffB); PG8_STAGE(PG8_SB(0, 1), cB + hstepB, voffB); PG8_STAGE(PG8_SA(0, 0), cA, cvA0); PG8_STAGE(PG8_SA(0, 1), cA, cvA1);
    if (wr == 1) PG8_BAR;
    PG8_WAIT_V(2); PG8_BAR;
    PG8_STAGE(PG8_SB(1, 0), cB + kstep, voffB); PG8_STAGE(PG8_SA(1, 0), cA + kstep, cvA0); PG8_STAGE(PG8_SB(1, 1), cB + hstepB + kstep, voffB);
    PG8_WAIT_V(6); PG8_BAR;
    for (;;) {
        const bool has_next = S.next(ui + 1, nxt);
        const char* nA = GATHER ? (const char*)g.A : (has_next ? (const char*)g.A + (size_t)nxt.pm * tstepA : cA);
        const char* nB = has_next ? (const char*)g.Bt + (size_t)((nxt.pm / g.bdiv) % g.bmod) * g.bstride * 2 + (size_t)nxt.pn * tstepB : cB;
        if constexpr (GATHER) { if (has_next) PG8_GIDX(nxt, nraw); }
        for (int t = 0; t < nt; t += 2) {
            const bool last = (t == nt - 2);
            const char* a1 = cA + (size_t)(t + 1) * kstep;
            const char* a2 = last ? nA : cA + (size_t)(t + 2) * kstep; const char* b2 = last ? nB : cB + (size_t)(t + 2) * kstep;
            const char* a3 = a2 + kstep; const char* b3 = b2 + kstep;
            unsigned sA0[2] = {cvA0[0], cvA0[1]}, sA1[2] = {cvA1[0], cvA1[1]};
            if constexpr (GATHER) { if (last) { if (has_next) PG8_GOFF(nxt, nraw, nvA0, nvA1); else { nvA0[0] = cvA0[0]; nvA0[1] = cvA0[1]; nvA1[0] = cvA1[0]; nvA1[1] = cvA1[1]; }
                                                 sA0[0] = nvA0[0]; sA0[1] = nvA0[1]; sA1[0] = nvA1[0]; sA1[1] = nvA1[1]; } }
            PG8_LDB(B0, 0, 0); PG8_LDB(B1, 0, 1); PG8_SCHED; PG8_LDA(At, 0, 0); PG8_STAGE(PG8_SA(1, 1), a1, cvA1);
            PG8_WAIT_V(8); PG8_WAIT_L(0); PG8_BAR; PG8_MMA(0, 0, At, B0); PG8_MMA(0, 1, At, B1); PG8_BAR; PG8_SCHED;
            PG8_LDA(At, 0, 1); PG8_STAGE(PG8_SB(0, 0), b2, voffB); PG8_STAGE(PG8_SB(0, 1), b2 + hstepB, voffB); PG8_STAGE(PG8_SA(0, 0), a2, sA0);
            PG8_WAIT_V(8); PG8_WAIT_L(0); PG8_BAR; PG8_MMA(1, 0, At, B0); PG8_MMA(1, 1, At, B1); PG8_BAR; PG8_SCHED;
            PG8_LDB(B0, 1, 0); PG8_LDB(B1, 1, 1); PG8_SCHED; PG8_LDA(At, 1, 0); PG8_STAGE(PG8_SA(0, 1), a2, sA1);
            PG8_WAIT_V(8); PG8_WAIT_L(0); PG8_BAR; PG8_MMA(0, 0, At, B0); PG8_MMA(0, 1, At, B1); PG8_BAR; PG8_SCHED;
            PG8_LDA(At, 1, 1); PG8_STAGE(PG8_SB(1, 0), b3, voffB); PG8_STAGE(PG8_SB(1, 1), b3 + hstepB, voffB); PG8_STAGE(PG8_SA(1, 0), a3, sA0);
            PG8_WAIT_V(8); PG8_WAIT_L(0); PG8_BAR; PG8_MMA(1, 0, At, B0); PG8_MMA(1, 1, At, B1); PG8_BAR; PG8_SCHED;
        }
        if (wr == 0) PG8_BAR;
        E.run(acc, cur, wr, wc, fr, fq, lds + STAGE_BYTES, wid, lane);
        if (!has_next) break;
#pragma unroll
        for (int a = 0; a < 2; ++a)
#pragma unroll
            for (int b = 0; b < 2; ++b)
#pragma unroll
                for (int m = 0; m < 4; ++m)
#pragma unroll
                    for (int n = 0; n < 2; ++n) acc[a][b][m][n] = (f32x4){0.f, 0.f, 0.f, 0.f};
        cur = nxt; cA = nA; cB = nB; ++ui;
        if constexpr (GATHER) { cvA0[0] = nvA0[0]; cvA0[1] = nvA0[1]; cvA1[0] = nvA1[0]; cvA1[1] = nvA1[1]; }
        if (wr == 1) PG8_BAR;
    }
    PG8_WAIT_V(0);
    PG8_BAR;
#undef PG8_SA
#undef PG8_SB
#undef PG8_STAGE
#undef PG8_LDA
#undef PG8_LDB
#undef PG8_MMA
#undef PG8_WAIT_V
#undef PG8_WAIT_L
#undef PG8_BAR
#undef PG8_SCHED
#undef PG8_GIDX
#undef PG8_GOFF
}

template <class Epi, class Sched, bool GATHER = false>
__device__ __forceinline__ void gemm_phase(LAS unsigned char* lds, const Gemm g, const Sched& S, const Epi& E, const int tid) {
#if GEMM_SIMPLE
    static_assert(!GATHER, "the simple body has no gather path");
    gemm_simple<Epi, Sched>(lds + STAGE_BYTES, g, S, E, tid);
#else
    gemm_fast<Epi, Sched, GATHER>(lds, g, S, E, tid);
#endif
}

template <class F> struct EpiChunk {
    static constexpr bool USES_LDS = false;
    F f;
    __device__ __forceinline__ void run(Acc& acc, const Unit& u, int wr, int wc, int fr, int fq, LAS unsigned char*, int, int) const {
        constexpr int NBT = F::NBATCH, GPB = 8 / NBT;
#pragma unroll
        for (int bt = 0; bt < NBT; ++bt) {
            typename F::Pre pre[GPB][2];
#pragma unroll
            for (int g = 0; g < GPB; ++g) { const int rg = bt * GPB + g, ai = rg >> 2, m = rg & 3; const int row = u.pm * BM + ai * HALF + wr * 64 + m * 16 + fr;
#pragma unroll
                for (int bj = 0; bj < 2; ++bj) { const int col = u.pn * BM + bj * HALF + wc * 32 + 8 * fq; pre[g][bj] = f.load(row, col); } }
            asm volatile("" ::: "memory");
#pragma unroll
            for (int g = 0; g < GPB; ++g) { const int rg = bt * GPB + g, ai = rg >> 2, m = rg & 3; const int row = u.pm * BM + ai * HALF + wr * 64 + m * 16 + fr;
#pragma unroll
                for (int bj = 0; bj < 2; ++bj) { const int col = u.pn * BM + bj * HALF + wc * 32 + 8 * fq;
                    const f32x4 a = acc[ai][bj][m][0], b = acc[ai][bj][m][1];
                    const float v[8] = {a[0], a[1], a[2], a[3], b[0], b[1], b[2], b[3]};
                    f.chunk(row, col, v, pre[g][bj]); } }
            asm volatile("" ::: "memory");
        }
    }
};
}
using pg8::Gemm; using pg8::Unit; using pg8::StaticOrder; using pg8::mkgemm;

struct PreNone {};
struct PreF { float r; };
struct FU { const float* rstd0; bf16_t *XGG, *CQ, *CKV, *KR, *SIGA, *SIGB; const float* bgate;
    static constexpr int NBATCH = 4;
    struct Pre { float rs; f32x4 b0, b1; };
    __device__ __forceinline__ Pre load(int row, int col) const { Pre p; p.rs = rstd0[row];
        if (col >= 3584) { p.b0 = *(const f32x4*)(bgate + (col - 3584)); p.b1 = *(const f32x4*)(bgate + (col - 3584) + 4); } else { p.b0 = (f32x4){0.f, 0.f, 0.f, 0.f}; p.b1 = p.b0; }
        return p; }
    __device__ __forceinline__ void chunk(int row, int col, const float (&v)[8], const Pre& p) const {
        const float rs = p.rs; float o[8];
#pragma unroll
        for (int i = 0; i < 8; ++i) o[i] = v[i] * rs;
        if (col < 3072) { *(u32x4*)(XGG + (size_t)row * 2048 + 1024 + (col - 2048)) = pack8(o); }
        else if (col < 3328) { *(u32x4*)(CQ + (size_t)row * 256 + (col - 3072)) = pack8(o); }
        else if (col < 3456) { *(u32x4*)(CKV + (size_t)row * 128 + (col - 3328)) = pack8(o); }
        else if (col < 3520) { *(u32x4*)(KR + (size_t)row * 64 + (col - 3456)) = pack8(o); }
        else if (col >= 3584) { const int c = col - 3584;
            const float bb[8] = {p.b0[0], p.b0[1], p.b0[2], p.b0[3], p.b1[0], p.b1[1], p.b1[2], p.b1[3]};
#pragma unroll
            for (int i = 0; i < 8; ++i) o[i] = 1.f / (1.f + __expf(-(o[i] + bb[i])));
            bf16_t* dst = c < 1024 ? SIGA + (size_t)row * 1024 + c : SIGB + (size_t)row * 1024 + (c - 1024);
            *(u32x4*)dst = pack8(o); }
    } };
struct EpiU {
    static constexpr bool USES_LDS = false;
    FU f;
    __device__ __forceinline__ void run(pg8::Acc& acc, const Unit& u, int wr, int wc, int fr, int fq, LAS unsigned char* scr, int wid, int lane) const {
        if (u.pn < 8) {
#pragma unroll
            for (int ai = 0; ai < 2; ++ai)
#pragma unroll
                for (int m = 0; m < 4; ++m) { const int row = u.pm * 256 + ai * 128 + wr * 64 + m * 16 + fr; const int col = u.pn * 128 + wc * 32 + 8 * fq; const float rs = f.rstd0[row]; const float r2 = rs * rs; float o[8];
#pragma unroll
                    for (int n = 0; n < 2; ++n)
#pragma unroll
                        for (int i = 0; i < 4; ++i) o[n * 4 + i] = acc[ai][0][m][n][i] * acc[ai][1][m][n][i] * r2;
                    *(u32x4*)(f.XGG + (size_t)row * 2048 + col) = pack8(o); }
        } else { pg8::EpiChunk<FU> E{f}; E.run(acc, u, wr, wc, fr, fq, scr, wid, lane); }
    }
};
struct FMemKV { const float* rstdm; bf16_t* MKV;
    static constexpr int NBATCH = 1; typedef PreF Pre;
    __device__ __forceinline__ Pre load(int row, int) const { Pre p; p.r = rstdm[row]; return p; }
    __device__ __forceinline__ void chunk(int row, int col, const float (&v)[8], const Pre& p) const {
        const float rs = p.r * (col < 1024 ? 0.0625f : 1.f); float o[8];
#pragma unroll
        for (int i = 0; i < 8; ++i) o[i] = v[i] * rs;
        const int kv = col >> 10, h = (col >> 8) & 3, j = col & 255, b = row >> 8, key = row & 255;
        *(u32x4*)(MKV + ((size_t)((kv * 2 + b) * 4 + h) * 256 + key) * 256 + j) = pack8(o);
    } };
struct FQ { const float* rstdq; const f32x2* rope; bf16_t* Q; unsigned char* Q8;
    static constexpr int NBATCH = 4;
    struct Pre { float rs; f32x2 cs[4]; };
    __device__ __forceinline__ Pre load(int row, int col) const { Pre p; p.rs = rstdq[row];
        if (col >= 1024) { const int pp = (col - 1024) & 63, j0 = (pp >> 3) * 4, s = row & (SEQ - 1);
#pragma unroll
            for (int i = 0; i < 4; ++i) p.cs[i] = rope[s * 32 + j0 + i]; }
        else {
#pragma unroll
            for (int i = 0; i < 4; ++i) p.cs[i] = (f32x2){1.f, 0.f}; }
        return p; }
    __device__ __forceinline__ void chunk(int row, int col, const float (&v)[8], const Pre& p) const {
        const float rs = p.rs; float o[8];
#pragma unroll
        for (int i = 0; i < 8; ++i) o[i] = v[i] * rs;
        if (col >= 1024) {
#pragma unroll
            for (int i = 0; i < 4; ++i) { const f32x2 cs = p.cs[i]; const float a = o[i], b = o[4 + i]; o[i] = a * cs.x - b * cs.y; o[4 + i] = a * cs.y + b * cs.x; } }
        if (Q8) *(u32x2*)(Q8 + (size_t)row * 1536 + col) = pack8_fp8(o); else *(u32x4*)(Q + (size_t)row * 1536 + col) = pack8(o);
    } };
struct FScaleRow { const float* rs; bf16_t* O; int ldo;
    static constexpr int NBATCH = 1; typedef PreF Pre;
    __device__ __forceinline__ Pre load(int row, int) const { Pre p; p.r = rs[row]; return p; }
    __device__ __forceinline__ void chunk(int row, int col, const float (&v)[8], const Pre& p) const {
        const float r = p.r; float o[8];
#pragma unroll
        for (int i = 0; i < 8; ++i) o[i] = v[i] * r;
        *(u32x4*)(O + (size_t)row * ldo + col) = pack8(o);
    } };
struct FKV8 { const float* rs; bf16_t* KV; unsigned char* K8;
    static constexpr int NBATCH = 1; typedef PreF Pre;
    __device__ __forceinline__ Pre load(int row, int) const { Pre p; p.r = rs[row]; return p; }
    __device__ __forceinline__ void chunk(int row, int col, const float (&v)[8], const Pre& p) const {
        const float r = p.r; float o[8];
#pragma unroll
        for (int i = 0; i < 8; ++i) o[i] = v[i] * r;
        if (col < 1024) *(u32x2*)(K8 + (size_t)row * 1024 + col) = pack8_fp8(o); else *(u32x4*)(KV + (size_t)row * 2048 + col) = pack8(o);
    } };
struct FPlain { bf16_t* O; int ldo;
    static constexpr int NBATCH = 1; typedef PreNone Pre;
    __device__ __forceinline__ Pre load(int, int) const { return Pre{}; }
    __device__ __forceinline__ void chunk(int row, int col, const float (&v)[8], const Pre&) const { *(u32x4*)(O + (size_t)row * ldo + col) = pack8(v); } };
struct FVW { bf16_t* O;
    static constexpr int NBATCH = 1; typedef PreNone Pre;
    __device__ __forceinline__ Pre load(int, int) const { return Pre{}; }
    __device__ __forceinline__ void chunk(int row, int col, const float (&v)[8], const Pre&) const { const int h = row >> 10, n = row & 1023; *(u32x4*)(O + (size_t)n * 1024 + h * 256 + col) = pack8(v); } };
struct FGateMul { const bf16_t* G; bf16_t* O;
    static constexpr int NBATCH = 2;
    struct Pre { u32x4 g; };
    __device__ __forceinline__ Pre load(int row, int col) const { Pre p; p.g = *(const u32x4*)(G + (size_t)row * 1024 + col); return p; }
    __device__ __forceinline__ void chunk(int row, int col, const float (&v)[8], const Pre& p) const {
        float g[8], o[8]; unpack8(p.g, g);
#pragma unroll
        for (int i = 0; i < 8; ++i) o[i] = g[i] * v[i];
        *(u32x4*)(O + (size_t)row * 1024 + col) = pack8(o);
    } };
struct FGateMulAdd { const bf16_t* G; const bf16_t* Pv; bf16_t* O;
    static constexpr int NBATCH = 2;
    struct Pre { u32x4 g, p; };
    __device__ __forceinline__ Pre load(int row, int col) const { Pre p; p.g = *(const u32x4*)(G + (size_t)row * 1024 + col); p.p = *(const u32x4*)(Pv + (size_t)row * 1024 + col); return p; }
    __device__ __forceinline__ void chunk(int row, int col, const float (&v)[8], const Pre& pr) const {
        float g[8], p[8], o[8]; unpack8(pr.g, g); unpack8(pr.p, p);
#pragma unroll
        for (int i = 0; i < 8; ++i) o[i] = p[i] + g[i] * v[i];
        *(u32x4*)(O + (size_t)row * 1024 + col) = pack8(o);
    } };
struct FResidF32 { const float* base; float* out;
    static constexpr int NBATCH = 2;
    struct Pre { f32x4 a, b; };
    __device__ __forceinline__ Pre load(int row, int col) const { const size_t off = (size_t)row * 1024 + col; Pre p; p.a = *(const f32x4*)(base + off); p.b = *(const f32x4*)(base + off + 4); return p; }
    __device__ __forceinline__ void chunk(int row, int col, const float (&v)[8], const Pre& p) const {
        const size_t off = (size_t)row * 1024 + col; const f32x4 a = p.a, b = p.b;
        *(f32x4*)(out + off) = (f32x4){a[0] + v[0], a[1] + v[1], a[2] + v[2], a[3] + v[3]}; *(f32x4*)(out + off + 4) = (f32x4){b[0] + v[4], b[1] + v[5], b[2] + v[6], b[3] + v[7]};
    } };
struct FResidBf16 { const bf16_t* base; bf16_t* out;
    static constexpr int NBATCH = 1;
    struct Pre { u32x4 a; };
    __device__ __forceinline__ Pre load(int row, int col) const { Pre p; p.a = *(const u32x4*)(base + (size_t)row * 1024 + col); return p; }
    __device__ __forceinline__ void chunk(int row, int col, const float (&v)[8], const Pre& p) const {
        float a[8], o[8]; unpack8(p.a, a);
#pragma unroll
        for (int i = 0; i < 8; ++i) o[i] = a[i] + v[i];
        *(u32x4*)(out + (size_t)row * 1024 + col) = pack8(o);
    } };
struct FGateRow { const float* gate; bf16_t* O;
    static constexpr int NBATCH = 1; typedef PreF Pre;
    __device__ __forceinline__ Pre load(int row, int) const { Pre p; p.r = gate[row]; return p; }
    __device__ __forceinline__ void chunk(int row, int col, const float (&v)[8], const Pre& p) const {
        const float r = p.r; float o[8];
#pragma unroll
        for (int i = 0; i < 8; ++i) o[i] = v[i] * r;
        *(u32x4*)(O + (size_t)row * 1024 + col) = pack8(o);
    } };

struct EpiX1 {
    static constexpr bool USES_LDS = false;
    const float* base; float* out; bf16_t* xb; float* ssq;
    __device__ __forceinline__ void run(pg8::Acc& acc, const Unit& u, int wr, int wc, int fr, int fq, LAS unsigned char*, int, int) const {
#pragma unroll
        for (int bt = 0; bt < 4; ++bt) { f32x4 pa[2][2], pb[2][2];
#pragma unroll
            for (int g = 0; g < 2; ++g) { const int rg = bt * 2 + g, ai = rg >> 2, m = rg & 3; const int row = u.pm * 256 + ai * 128 + wr * 64 + m * 16 + fr;
#pragma unroll
                for (int bj = 0; bj < 2; ++bj) { const size_t off = (size_t)row * 1024 + u.pn * 256 + bj * 128 + wc * 32 + 8 * fq; pa[g][bj] = *(const f32x4*)(base + off); pb[g][bj] = *(const f32x4*)(base + off + 4); } }
            asm volatile("" ::: "memory");
#pragma unroll
            for (int g = 0; g < 2; ++g) { const int rg = bt * 2 + g, ai = rg >> 2, m = rg & 3; const int row = u.pm * 256 + ai * 128 + wr * 64 + m * 16 + fr; float s = 0.f;
#pragma unroll
                for (int bj = 0; bj < 2; ++bj) { const int col = u.pn * 256 + bj * 128 + wc * 32 + 8 * fq; const size_t off = (size_t)row * 1024 + col;
                    const f32x4 a = pa[g][bj], b = pb[g][bj]; const f32x4 c0 = acc[ai][bj][m][0], c1 = acc[ai][bj][m][1];
                    const float o[8] = {a[0] + c0[0], a[1] + c0[1], a[2] + c0[2], a[3] + c0[3], b[0] + c1[0], b[1] + c1[1], b[2] + c1[2], b[3] + c1[3]};
                    if (out) { *(f32x4*)(out + off) = (f32x4){o[0], o[1], o[2], o[3]}; *(f32x4*)(out + off + 4) = (f32x4){o[4], o[5], o[6], o[7]}; }
                    *(u32x4*)(xb + off) = pack8(o);
#pragma unroll
                    for (int i = 0; i < 8; ++i) s += o[i] * o[i]; }
                s += __shfl_xor(s, 16); s += __shfl_xor(s, 32);
                if (fq == 0) ssq[(size_t)row * 16 + u.pn * 4 + wc] = s; }
            asm volatile("" ::: "memory"); }
    }
};
struct EpiSoftmax {
    static constexpr bool USES_LDS = true;
    const float* ssq; bf16_t* P;
    __device__ __forceinline__ void run(pg8::Acc& acc, const Unit& u, int wr, int wc, int fr, int fq, LAS unsigned char* scr, int wid_, int lane_) const {
        LAS float* PM = (LAS float*)scr;
        LAS float* PS = (LAS float*)(scr + 4096);
        LAS float* RS = (LAS float*)(scr + 4096);
        { const int t = wid_ * 64 + lane_; if (t < 256) { const f32x4* sp = (const f32x4*)((const char*)ssq + (unsigned)(u.pm * 256 + t) * 64u); const f32x4 q0 = sp[0], q1 = sp[1], q2 = sp[2], q3 = sp[3];
            float tt = ((q0[0] + q0[1]) + (q0[2] + q0[3])) + ((q1[0] + q1[1]) + (q1[2] + q1[3])); tt += ((q2[0] + q2[1]) + (q2[2] + q2[3])) + ((q3[0] + q3[1]) + (q3[2] + q3[3]));
            RS[t] = 1.f / sqrtf(tt * (1.f / 1024.f) + EPS); } }
        __syncthreads();
#pragma unroll
        for (int ai = 0; ai < 2; ++ai)
#pragma unroll
            for (int m = 0; m < 4; ++m) { const int rl = ai * 128 + wr * 64 + m * 16 + fr;
                const float rs = RS[rl];
                float mx = -3.0e38f;
#pragma unroll
                for (int bj = 0; bj < 2; ++bj)
#pragma unroll
                    for (int n = 0; n < 2; ++n)
#pragma unroll
                        for (int i = 0; i < 4; ++i) { const float s = acc[ai][bj][m][n][i] * rs; acc[ai][bj][m][n][i] = s; mx = fmaxf(mx, s); }
                mx = fmaxf(mx, __shfl_xor(mx, 16)); mx = fmaxf(mx, __shfl_xor(mx, 32));
                if (fq == 0) PM[rl * 4 + wc] = mx;
                asm volatile("" ::: "memory"); }
        __syncthreads();
#pragma unroll
        for (int ai = 0; ai < 2; ++ai)
#pragma unroll
            for (int m = 0; m < 4; ++m) { const int rl = ai * 128 + wr * 64 + m * 16 + fr;
                const f32x4 pm4 = *(const LAS f32x4*)(PM + rl * 4); const float mx = fmaxf(fmaxf(pm4[0], pm4[1]), fmaxf(pm4[2], pm4[3]));
                float s = 0.f;
#pragma unroll
                for (int bj = 0; bj < 2; ++bj)
#pragma unroll
                    for (int n = 0; n < 2; ++n)
#pragma unroll
                        for (int i = 0; i < 4; ++i) { const float e = __expf(acc[ai][bj][m][n][i] - mx); acc[ai][bj][m][n][i] = e; s += e; }
                s += __shfl_xor(s, 16); s += __shfl_xor(s, 32);
                if (fq == 0) PS[rl * 4 + wc] = s;
                asm volatile("" ::: "memory"); }
        __syncthreads();
#pragma unroll
        for (int ai = 0; ai < 2; ++ai)
#pragma unroll
            for (int m = 0; m < 4; ++m) { const int rl = ai * 128 + wr * 64 + m * 16 + fr; const int row = u.pm * 256 + rl;
                const f32x4 ps4 = *(const LAS f32x4*)(PS + rl * 4); const float inv = 1.f / ((ps4[0] + ps4[1]) + (ps4[2] + ps4[3]));
#pragma unroll
                for (int bj = 0; bj < 2; ++bj) { const int col = u.pn * 256 + bj * 128 + wc * 32 + 8 * fq; float o[8];
#pragma unroll
                    for (int n = 0; n < 2; ++n)
#pragma unroll
                        for (int i = 0; i < 4; ++i) o[n * 4 + i] = acc[ai][bj][m][n][i] * inv;
                    *(u32x4*)((char*)P + ((unsigned)row * 1024u + (unsigned)col) * 2u) = pack8(o); }
                asm volatile("" ::: "memory"); }
    }
};
struct EpiSwiglu {
    static constexpr bool USES_LDS = false;
    bf16_t* H;
    __device__ __forceinline__ void run(pg8::Acc& acc, const Unit& u, int wr, int wc, int fr, int fq, LAS unsigned char*, int, int) const {
#pragma unroll
        for (int ai = 0; ai < 2; ++ai)
#pragma unroll
            for (int m = 0; m < 4; ++m) { const int row = u.pm * 256 + ai * 128 + wr * 64 + m * 16 + fr; const int col = u.pn * 128 + wc * 32 + 8 * fq; float o[8];
#pragma unroll
                for (int n = 0; n < 2; ++n)
#pragma unroll
                    for (int i = 0; i < 4; ++i) { const float g = acc[ai][0][m][n][i], up = acc[ai][1][m][n][i]; o[n * 4 + i] = g / (1.f + __expf(-g)) * up; }
                *(u32x4*)(H + (size_t)row * 1024 + col) = pack8(o); }
    }
};

namespace att {
constexpr int QBLK = 32, KVBLK = 64, NW = 8;
constexpr int LDQ = 1536, LDKV = 2048, LDKR = 64, LDO = 1024;
constexpr int KPITCH = 272, KRPITCH = 144;
constexpr int SHM_V = KVBLK * 128 * 2, SHM_K = KVBLK * KPITCH, SHM_KR = KVBLK * KRPITCH;
constexpr int OFF_V = 0, OFF_K = 2 * SHM_V, OFF_KR = OFF_K + 2 * SHM_K, OFF_WS = OFF_KR + 2 * SHM_KR, OFF_QR = OFF_WS + NW * 64 * 4, SHM_ATTN = OFF_QR + NW * 4096;
constexpr float THR = 8.f;
#define KSWZ(row, colB) ((row) * KPITCH + (colB))
#define KRSWZ(row, colB) ((row) * KRPITCH + (colB))
#define SBAR() __builtin_amdgcn_sched_barrier(0)
__device__ __forceinline__ int crow(int r, int hi) { return (r & 3) + 8 * (r >> 2) + 4 * hi; }
__device__ __forceinline__ unsigned cvtpk_a(float lo, float hi) { unsigned r; asm volatile("v_cvt_pk_bf16_f32 %0, %1, %2" : "=v"(r) : "v"(lo), "v"(hi)); return r; }

__device__ __forceinline__ void partialSM(f32x16& p0, f32x16& p1, float& m_reg, float& mn, float& alpha) {
  constexpr float C = ATT_SCALE * 1.4426950408889634f;
  float pmax = p0[0];
#pragma unroll
  for (int r = 1; r < 16; ++r) pmax = fmaxf(pmax, p0[r]);
#pragma unroll
  for (int r = 0; r < 16; ++r) pmax = fmaxf(pmax, p1[r]);
  { auto rr = __builtin_amdgcn_permlane32_swap(__float_as_uint(pmax), __float_as_uint(pmax), false, false);
    pmax = fmaxf(__uint_as_float(rr[0]), __uint_as_float(rr[1])); }
  if (__builtin_expect(__all(pmax - m_reg <= THR / ATT_SCALE), 1)) { mn = m_reg; alpha = 1.f; }
  else { mn = fmaxf(m_reg, pmax); alpha = __builtin_amdgcn_exp2f((m_reg - mn) * C); m_reg = mn; }
  float mnC = -mn * C;
#pragma unroll
  for (int r = 0; r < 16; ++r) p0[r] = fmaf(p0[r], C, mnC);
#pragma unroll
  for (int r = 0; r < 16; ++r) p1[r] = fmaf(p1[r], C, mnC);
#pragma unroll
  for (int r = 0; r < 16; ++r) p0[r] = __builtin_amdgcn_exp2f(p0[r]);
}
__device__ __forceinline__ void finishSM(f32x16& p0, f32x16& p1, float alpha, float& l_reg, bf16x8& pa0, bf16x8& pa1, bf16x8& pa2, bf16x8& pa3) {
#pragma unroll
  for (int r = 0; r < 16; ++r) p1[r] = __builtin_amdgcn_exp2f(p1[r]);
  float ps = 0;
#pragma unroll
  for (int r = 0; r < 16; ++r) ps += p0[r];
#pragma unroll
  for (int r = 0; r < 16; ++r) ps += p1[r];
  { auto rr = __builtin_amdgcn_permlane32_swap(__float_as_uint(ps), __float_as_uint(ps), false, false);
    ps = __uint_as_float(rr[0]) + __uint_as_float(rr[1]); }
  l_reg = l_reg * alpha + ps;
#define PK4(P, BASE, OUT) do { unsigned a0 = cvtpk_a(P[BASE + 0], P[BASE + 1]), a1 = cvtpk_a(P[BASE + 2], P[BASE + 3]);   \
    unsigned b0 = cvtpk_a(P[BASE + 4], P[BASE + 5]), b1 = cvtpk_a(P[BASE + 6], P[BASE + 7]);                              \
    auto r0 = __builtin_amdgcn_permlane32_swap(a0, b0, false, false); auto r1 = __builtin_amdgcn_permlane32_swap(a1, b1, false, false); \
    u32x4 w = {r0[0], r1[0], r0[1], r1[1]}; OUT = *reinterpret_cast<bf16x8*>(&w); } while (0)
  PK4(p0, 0, pa0); PK4(p0, 8, pa1); PK4(p1, 0, pa2); PK4(p1, 8, pa3);
#undef PK4
}
__device__ __forceinline__ void qkt(f32x16& p0, f32x16& p1, const char* Ks, const char* Krs, const bf16x8* qr, const char* qpark, int r32, int hi) {
  p0 = f32x16{}; p1 = f32x16{};
  const char* kb = Ks + r32 * KPITCH + hi * 16; const char* rb = Krs + r32 * KRPITCH + hi * 16;
#pragma unroll
  for (int d0 = 0; d0 < 8; ++d0) {
    bf16x8 b0 = *reinterpret_cast<const bf16x8*>(kb + d0 * 32);
    bf16x8 b1 = *reinterpret_cast<const bf16x8*>(kb + 32 * KPITCH + d0 * 32);
    p0 = __builtin_amdgcn_mfma_f32_32x32x16_bf16(b0, qr[d0], p0, 0, 0, 0);
    p1 = __builtin_amdgcn_mfma_f32_32x32x16_bf16(b1, qr[d0], p1, 0, 0, 0); }
#pragma unroll
  for (int d0 = 0; d0 < 4; ++d0) {
    bf16x8 b0 = *reinterpret_cast<const bf16x8*>(rb + d0 * 32);
    bf16x8 b1 = *reinterpret_cast<const bf16x8*>(rb + 32 * KRPITCH + d0 * 32);
    const bf16x8 qf = qr[8 + d0];
    p0 = __builtin_amdgcn_mfma_f32_32x32x16_bf16(b0, qf, p0, 0, 0, 0);
    p1 = __builtin_amdgcn_mfma_f32_32x32x16_bf16(b1, qf, p1, 0, 0, 0); }
}
__device__ __forceinline__ int v_st(int k, int c) { const int kk = (k & ~0xC) | ((k & 4) << 1) | ((k & 8) >> 1); return ((kk >> 3) * 4 + (c >> 5)) * 512 + ((kk & 7) * 32 + (c & 31)) * 2; }
__device__ __forceinline__ int v_rd_base(int lane) { return ((lane & 3) << 3) | (((lane >> 2) & 3) << 6) | (((lane >> 4) & 1) << 5) | (((lane >> 5) & 1) << 8); }
constexpr int v_rd_off(int d0, int ks, int half) { return d0 * 512 + ks * 4096 + half * 2048; }
template <int OFF> __device__ __forceinline__ s16x4 tr_read(int vb) {
  s16x4 r; asm volatile("ds_read_b64_tr_b16 %0, %1 offset:%2" : "=&v"(r) : "v"(vb), "i"(OFF) : "memory"); return r;
}
template <int D0> __device__ __forceinline__ void pv_one(f32x16& od, int vb, bf16x8 pa0, bf16x8 pa1, bf16x8 pa2, bf16x8 pa3) {
  const s16x4 l0 = tr_read<v_rd_off(D0, 0, 0)>(vb), h0 = tr_read<v_rd_off(D0, 0, 1)>(vb), l1 = tr_read<v_rd_off(D0, 1, 0)>(vb), h1 = tr_read<v_rd_off(D0, 1, 1)>(vb);
  const s16x4 l2 = tr_read<v_rd_off(D0, 2, 0)>(vb), h2 = tr_read<v_rd_off(D0, 2, 1)>(vb), l3 = tr_read<v_rd_off(D0, 3, 0)>(vb), h3 = tr_read<v_rd_off(D0, 3, 1)>(vb);
  asm volatile("s_waitcnt lgkmcnt(0)" ::: "memory"); SBAR();
#define PK(L, H) (bf16x8){L[0], L[1], L[2], L[3], H[0], H[1], H[2], H[3]}
  od = __builtin_amdgcn_mfma_f32_32x32x16_bf16(pa0, PK(l0, h0), od, 0, 0, 0);
  od = __builtin_amdgcn_mfma_f32_32x32x16_bf16(pa1, PK(l1, h1), od, 0, 0, 0);
  od = __builtin_amdgcn_mfma_f32_32x32x16_bf16(pa2, PK(l2, h2), od, 0, 0, 0);
  od = __builtin_amdgcn_mfma_f32_32x32x16_bf16(pa3, PK(l3, h3), od, 0, 0, 0);
#undef PK
}
__device__ __forceinline__ void pv_d0(f32x16* o, int vb, bf16x8 pa0, bf16x8 pa1, bf16x8 pa2, bf16x8 pa3) {
  pv_one<0>(o[0], vb, pa0, pa1, pa2, pa3); pv_one<1>(o[1], vb, pa0, pa1, pa2, pa3); pv_one<2>(o[2], vb, pa0, pa1, pa2, pa3); pv_one<3>(o[3], vb, pa0, pa1, pa2, pa3);
}

__device__ __forceinline__ void attn_unit(const bf16_t* __restrict__ Qn, const bf16_t* __restrict__ Qr, const bf16_t* __restrict__ Kh,
                                          const bf16_t* __restrict__ Krh, bf16_t* __restrict__ Ob, int seq, char* lds, const int tid) {
  const int wid = tid >> 6, lane = tid & 63, r32 = lane & 31, hi = lane >> 5;
  char* V_lds = lds + OFF_V; char* K_lds = lds + OFF_K; char* Kr_lds = lds + OFF_KR;
  float* ws = (float*)(lds + OFF_WS) + wid * 64; float* li_l = ws; float* al_l = ws + 32;
  float m_reg = -1e30f, l_reg = 0; f32x16 o[4] = {}; bf16x8 qr[12];
  char* qpark = nullptr;
  { const bf16_t* qn = Qn + (long)(wid * QBLK + r32) * LDQ + hi * 8; const bf16_t* qq = Qr + (long)(wid * QBLK + r32) * LDQ + hi * 8;
#pragma unroll
    for (int d0 = 0; d0 < 8; ++d0) qr[d0] = *reinterpret_cast<const bf16x8*>(qn + d0 * 16);
#pragma unroll
    for (int d0 = 0; d0 < 4; ++d0) qr[8 + d0] = *reinterpret_cast<const bf16x8*>(qq + d0 * 16); }
  const int sr = tid >> 4, sc = (tid & 15) * 8, vst0 = v_st(sr, sc), vst1 = v_st(32 + sr, sc);
  const int krr = tid >> 3, krc = (tid & 7) * 8;
  const int vb0 = (int)(uintptr_t)V_lds + v_rd_base(lane);
  bf16x8 vs0, vs1, ks0, ks1, kr0;
  const unsigned offkv = (unsigned)(sr * LDKV + sc) * 2u, offkr = (unsigned)(krr * LDKR + krc) * 2u;
#define SLOAD(k0) do { const char* kb_ = (const char*)Kh + (size_t)(k0) * (LDKV * 2); const char* kb2_ = kb_ + 32 * LDKV * 2; const char* rb_ = (const char*)Krh + (size_t)(k0) * (LDKR * 2); \
    ks0 = *reinterpret_cast<const bf16x8*>(kb_ + offkv); vs0 = *reinterpret_cast<const bf16x8*>(kb_ + offkv + 2048); \
    ks1 = *reinterpret_cast<const bf16x8*>(kb2_ + offkv); vs1 = *reinterpret_cast<const bf16x8*>(kb2_ + offkv + 2048); \
    kr0 = *reinterpret_cast<const bf16x8*>(rb_ + offkr); } while (0)
#define SWRITE(b) do { *(bf16x8*)(V_lds + (b) * SHM_V + vst0) = vs0; *(bf16x8*)(V_lds + (b) * SHM_V + vst1) = vs1; const int kc = sc * 2; \
    *(bf16x8*)(K_lds + (b) * SHM_K + KSWZ(sr, kc)) = ks0; *(bf16x8*)(K_lds + (b) * SHM_K + KSWZ(32 + sr, kc)) = ks1; \
    *(bf16x8*)(Kr_lds + (b) * SHM_KR + KRSWZ(krr, krc * 2)) = kr0; } while (0)
#define SWAIT() asm volatile("s_waitcnt vmcnt(0)" ::: "memory")
#define RESC(a) do { if (__any((a) < 1.f)) { if (hi == 0) al_l[r32] = (a); asm volatile("s_waitcnt lgkmcnt(0)" ::: "memory"); \
    _Pragma("unroll") for (int d = 0; d < 4; ++d) _Pragma("unroll") for (int r = 0; r < 16; ++r) o[d][r] *= al_l[crow(r, hi)]; } } while (0)
  f32x16 pA0, pA1, pB0, pB1; float mnA, mnB, alA, alB; bf16x8 pa0, pa1, pa2, pa3; const int NT = seq / KVBLK;
  SLOAD(0); SWAIT(); SWRITE(0); __syncthreads();
  qkt(pA0, pA1, K_lds, Kr_lds, qr, qpark, r32, hi); partialSM(pA0, pA1, m_reg, mnA, alA);
  SLOAD(KVBLK);
  SWAIT(); SWRITE(1); __syncthreads();
  for (int j = 1; j + 1 < NT; j += 2) {
    SBAR(); qkt(pB0, pB1, K_lds + SHM_K, Kr_lds + SHM_KR, qr, qpark, r32, hi);
    finishSM(pA0, pA1, alA, l_reg, pa0, pa1, pa2, pa3); SBAR();
    SLOAD((j + 1) * KVBLK); SBAR();
    pv_d0(o, vb0, pa0, pa1, pa2, pa3); partialSM(pB0, pB1, m_reg, mnB, alB);
    __syncthreads(); SWAIT(); SWRITE(0);
    RESC(alB); __syncthreads();
    SBAR(); qkt(pA0, pA1, K_lds, Kr_lds, qr, qpark, r32, hi);
    finishSM(pB0, pB1, alB, l_reg, pa0, pa1, pa2, pa3); SBAR();
    SLOAD((j + 2) * KVBLK); SBAR();
    pv_d0(o, vb0 + SHM_V, pa0, pa1, pa2, pa3); partialSM(pA0, pA1, m_reg, mnA, alA);
    __syncthreads(); SWAIT(); SWRITE(1);
    RESC(alA); __syncthreads();
  }
  SBAR(); qkt(pB0, pB1, K_lds + SHM_K, Kr_lds + SHM_KR, qr, qpark, r32, hi);
  finishSM(pA0, pA1, alA, l_reg, pa0, pa1, pa2, pa3); SBAR();
  pv_d0(o, vb0, pa0, pa1, pa2, pa3); partialSM(pB0, pB1, m_reg, mnB, alB);
  __syncthreads(); RESC(alB);
  finishSM(pB0, pB1, alB, l_reg, pa0, pa1, pa2, pa3); SBAR();
  pv_d0(o, vb0 + SHM_V, pa0, pa1, pa2, pa3);
  if (hi == 0) li_l[r32] = l_reg; asm volatile("s_waitcnt lgkmcnt(0)" ::: "memory");
  float rli[16];
#pragma unroll
  for (int r = 0; r < 16; ++r) rli[r] = __builtin_amdgcn_rcpf(li_l[crow(r, hi)]);
  bf16_t* Ow = Ob + (long)(wid * QBLK) * LDO;
#pragma unroll
  for (int r = 0; r < 16; ++r) { const int orow = crow(r, hi);
#pragma unroll
    for (int d0 = 0; d0 < 4; ++d0) Ow[(long)orow * LDO + d0 * 32 + r32] = f2bf(o[d0][r] * rli[r]); }
  __syncthreads();
#undef SLOAD
#undef SWRITE
#undef SWAIT
#undef RESC
}

constexpr int K8P = 144, KR8P = 80, SHM_K8 = KVBLK * K8P, SHM_KR8 = KVBLK * KR8P;
constexpr int O8_V = 0, O8_K = 2 * SHM_V, O8_KR = O8_K + 2 * SHM_K8, O8_WS = O8_KR + 2 * SHM_KR8, SHM_ATTN8 = O8_WS + NW * 64 * 4;
__device__ __forceinline__ v8i ld32(const char* p) { const u32x4 a = *reinterpret_cast<const u32x4*>(p), b = *reinterpret_cast<const u32x4*>(p + 16); return (v8i){(int)a.x, (int)a.y, (int)a.z, (int)a.w, (int)b.x, (int)b.y, (int)b.z, (int)b.w}; }
__device__ __forceinline__ void qkt8(f32x16& p0, f32x16& p1, const char* Ks, const char* Krs, const v8i* qf, int r32, int hi) {
  p0 = f32x16{}; p1 = f32x16{};
  const char* kb = Ks + r32 * K8P + hi * 32; const char* rb = Krs + r32 * KR8P + hi * 32;
#pragma unroll
  for (int st = 0; st < 2; ++st) { const v8i a0 = ld32(kb + st * 64), a1 = ld32(kb + 32 * K8P + st * 64);
    p0 = __builtin_amdgcn_mfma_scale_f32_32x32x64_f8f6f4(a0, qf[st], p0, 0, 0, 0, 0x7f7f7f7f, 0, 0x7f7f7f7f);
    p1 = __builtin_amdgcn_mfma_scale_f32_32x32x64_f8f6f4(a1, qf[st], p1, 0, 0, 0, 0x7f7f7f7f, 0, 0x7f7f7f7f); }
  { const v8i a0 = ld32(rb), a1 = ld32(rb + 32 * KR8P);
    p0 = __builtin_amdgcn_mfma_scale_f32_32x32x64_f8f6f4(a0, qf[2], p0, 0, 0, 0, 0x7f7f7f7f, 0, 0x7f7f7f7f);
    p1 = __builtin_amdgcn_mfma_scale_f32_32x32x64_f8f6f4(a1, qf[2], p1, 0, 0, 0, 0x7f7f7f7f, 0, 0x7f7f7f7f); }
}
__device__ __forceinline__ void attn_unit8(const unsigned char* __restrict__ Q8n, const unsigned char* __restrict__ Q8r, const unsigned char* __restrict__ K8h,
                                           const unsigned char* __restrict__ Kr8, const bf16_t* __restrict__ Vh, bf16_t* __restrict__ Ob, int seq, char* lds, const int tid) {
  const int wid = tid >> 6, lane = tid & 63, r32 = lane & 31, hi = lane >> 5;
  char* V_lds = lds + O8_V; char* K_lds = lds + O8_K; char* Kr_lds = lds + O8_KR;
  float* ws = (float*)(lds + O8_WS) + wid * 64; float* li_l = ws; float* al_l = ws + 32;
  float m_reg = -1e30f, l_reg = 0; f32x16 o[4] = {}; v8i qf[3];
  { const unsigned char* qn = Q8n + (long)(wid * QBLK + r32) * LDQ + hi * 32; const unsigned char* qq = Q8r + (long)(wid * QBLK + r32) * LDQ + hi * 32;
    qf[0] = ld32((const char*)qn); qf[1] = ld32((const char*)qn + 64); qf[2] = ld32((const char*)qq); }
  const int sr = tid >> 4, sc = (tid & 15) * 8, vst0 = v_st(sr, sc), vst1 = v_st(32 + sr, sc);
  const int k8r = tid >> 3, k8c = (tid & 7) * 16;
  const int r8r = (tid & 255) >> 2, r8c = (tid & 3) * 16;
  const int vb0 = (int)(uintptr_t)V_lds + v_rd_base(lane);
  bf16x8 vs0, vs1; u32x4 k8v, r8v;
  const unsigned offv = (unsigned)(sr * LDKV + sc) * 2u, offk8 = (unsigned)(k8r * 1024 + k8c), offr8 = (unsigned)(r8r * 64 + r8c);
#define SLOAD(k0) do { const char* vb_ = (const char*)Vh + (size_t)(k0) * (LDKV * 2); const char* vb2_ = vb_ + 32 * LDKV * 2; \
    vs0 = *reinterpret_cast<const bf16x8*>(vb_ + offv); vs1 = *reinterpret_cast<const bf16x8*>(vb2_ + offv); \
    k8v = *reinterpret_cast<const u32x4*>((const char*)K8h + (size_t)(k0) * 1024 + offk8); \
    if (tid < 256) r8v = *reinterpret_cast<const u32x4*>((const char*)Kr8 + (size_t)(k0) * 64 + offr8); } while (0)
#define SWRITE(b) do { *(bf16x8*)(V_lds + (b) * SHM_V + vst0) = vs0; *(bf16x8*)(V_lds + (b) * SHM_V + vst1) = vs1; \
    *(u32x4*)(K_lds + (b) * SHM_K8 + k8r * K8P + k8c) = k8v; if (tid < 256) *(u32x4*)(Kr_lds + (b) * SHM_KR8 + r8r * KR8P + r8c) = r8v; } while (0)
#define SWAIT() asm volatile("s_waitcnt vmcnt(0)" ::: "memory")
#define RESC(a) do { if (__any((a) < 1.f)) { if (hi == 0) al_l[r32] = (a); asm volatile("s_waitcnt lgkmcnt(0)" ::: "memory"); \
    _Pragma("unroll") for (int d = 0; d < 4; ++d) _Pragma("unroll") for (int r = 0; r < 16; ++r) o[d][r] *= al_l[crow(r, hi)]; } } while (0)
  f32x16 pA0, pA1, pB0, pB1; float mnA, mnB, alA, alB; bf16x8 pa0, pa1, pa2, pa3; const int NT = seq / KVBLK;
  SLOAD(0); SWAIT(); SWRITE(0); __syncthreads();
  qkt8(pA0, pA1, K_lds, Kr_lds, qf, r32, hi); partialSM(pA0, pA1, m_reg, mnA, alA);
  SLOAD(KVBLK);
  SWAIT(); SWRITE(1); __syncthreads();
  for (int j = 1; j + 1 < NT; j += 2) {
    SBAR(); qkt8(pB0, pB1, K_lds + SHM_K8, Kr_lds + SHM_KR8, qf, r32, hi);
    finishSM(pA0, pA1, alA, l_reg, pa0, pa1, pa2, pa3); SBAR();
    SLOAD((j + 1) * KVBLK); SBAR();
    pv_d0(o, vb0, pa0, pa1, pa2, pa3); partialSM(pB0, pB1, m_reg, mnB, alB);
    __syncthreads(); SWAIT(); SWRITE(0);
    RESC(alB); __syncthreads();
    SBAR(); qkt8(pA0, pA1, K_lds, Kr_lds, qf, r32, hi);
    finishSM(pB0, pB1, alB, l_reg, pa0, pa1, pa2, pa3); SBAR();
    SLOAD((j + 2) * KVBLK); SBAR();
    pv_d0(o, vb0 + SHM_V, pa0, pa1, pa2, pa3); partialSM(pA0, pA1, m_reg, mnA, alA);
    __syncthreads(); SWAIT(); SWRITE(1);
    RESC(alA); __syncthreads();
  }
  SBAR(); qkt8(pB0, pB1, K_lds + SHM_K8, Kr_lds + SHM_KR8, qf, r32, hi);
  finishSM(pA0, pA1, alA, l_reg, pa0, pa1, pa2, pa3); SBAR();
  pv_d0(o, vb0, pa0, pa1, pa2, pa3); partialSM(pB0, pB1, m_reg, mnB, alB);
  __syncthreads(); RESC(alB);
  finishSM(pB0, pB1, alB, l_reg, pa0, pa1, pa2, pa3); SBAR();
  pv_d0(o, vb0 + SHM_V, pa0, pa1, pa2, pa3);
  if (hi == 0) li_l[r32] = l_reg; asm volatile("s_waitcnt lgkmcnt(0)" ::: "memory");
  float rli[16];
#pragma unroll
  for (int r = 0; r < 16; ++r) rli[r] = __builtin_amdgcn_rcpf(li_l[crow(r, hi)]);
  bf16_t* Ow = Ob + (long)(wid * QBLK) * LDO;
#pragma unroll
  for (int r = 0; r < 16; ++r) { const int orow = crow(r, hi);
#pragma unroll
    for (int d0 = 0; d0 < 4; ++d0) Ow[(long)orow * LDO + d0 * 32 + r32] = f2bf(o[d0][r] * rli[r]); }
  __syncthreads();
#undef SLOAD
#undef SWRITE
#undef SWAIT
#undef RESC
}
#undef SBAR
}

constexpr int NWAVES = 8;
constexpr int N_LAUNCHES = MK_N_LAUNCHES;
constexpr int N_PHASES = 15;
static_assert(N_LAUNCHES == 1 || N_LAUNCHES == N_PHASES, "MK_N_LAUNCHES is 1 or 15");

constexpr size_t MiB = 1u << 20;
constexpr size_t WS_CTL = 0, CTL_ZERO_BYTES = 32768;
constexpr size_t WS_ROPE = 1 * MiB;
constexpr size_t WS_RSTD0 = 3 * MiB, WS_RSTDQ = WS_RSTD0 + 65536, WS_RSTDKV = WS_RSTDQ + 65536, WS_RSTDM = WS_RSTDKV + 65536;
constexpr size_t WS_SSQ = 4 * MiB;
constexpr size_t WS_AFF = 5 * MiB;
constexpr size_t WS_INV = 6 * MiB;
constexpr size_t WS_IDX = 7 * MiB, WS_GATE = WS_IDX + 131072;
constexpr size_t WS_MEMB = 8 * MiB;
constexpr size_t WS_MKV = 9 * MiB;
constexpr size_t WS_QKT = 11 * MiB, WS_VWT = 15 * MiB;
constexpr size_t WS_WIN = 19 * MiB;
constexpr size_t WS_WCO = 30 * MiB, WS_WMO = 32 * MiB, WS_WMIX = 34 * MiB, WS_WUQ = 36 * MiB, WS_WUKV = 37 * MiB, WS_WMQH = 38 * MiB, WS_WOHT = 40 * MiB, WS_WMKV = 42 * MiB;
constexpr size_t WS_XGG = 48 * MiB, WS_QB = 48 * MiB, WS_MIXA = 96 * MiB, WS_WGU = 48 * MiB, WS_WD = 112 * MiB, WS_Y = 48 * MiB;
constexpr size_t WS_XB = 144 * MiB, WS_ACONV = 144 * MiB, WS_OB = 144 * MiB, WS_X1B = 144 * MiB, WS_XG = 144 * MiB;
constexpr size_t WS_SIGA = 176 * MiB, WS_MIXED = 176 * MiB, WS_PM = 176 * MiB;
constexpr size_t WS_SIGB = 208 * MiB, WS_H3 = 208 * MiB, WS_H = 144 * MiB;
constexpr size_t WS_CQ = 240 * MiB, WS_CKV = 248 * MiB, WS_KR = 252 * MiB, WS_KROPE = 254 * MiB;
constexpr size_t WS_KN8 = 128 * MiB;
constexpr size_t WS_X2B = 256 * MiB;
constexpr size_t WS_END = RESID_BF16 ? 288 * MiB : 256 * MiB;
constexpr int CW_TMO = 0, CW_BAR = 4096;

constexpr int RING_BYTES = 131072, EPI_OFF = 131072, EPI_BYTES = 8192, LDSCTL_OFF = 140288, MISC_OFF = LDSCTL_OFF + 320;
constexpr int LDS_BYTES = 148480;
static_assert(2 * 16 * 1028 * 4 + 8192 <= LDSCTL_OFF && EPI_OFF + EPI_BYTES <= LDSCTL_OFF, "LDS map (router, epilogue scratch)");
static_assert(MISC_OFF + 128 <= LDS_BYTES && att::SHM_ATTN <= RING_BYTES && att::SHM_ATTN8 <= RING_BYTES, "LDS map");

typedef GAS unsigned gu32;
#define RLX_AGENT __ATOMIC_RELAXED, __HIP_MEMORY_SCOPE_AGENT

#define XB_TMO      128
#define XB_XCNT(j)  (256  + 64 * (j))
#define XB_XSUB(j)  (1280 + 64 * (j))
#define XB_XGEN(j)  (2304 + 64 * (j))
#define XB_TOP      3328
#define XB_TOPGEN   3392
#define XCD_BAR_WORDS 3456
#define XB_SPIN_CAP (1u << 18)
__device__ __forceinline__ unsigned xb_ld(unsigned* p)              { return __hip_atomic_load(p, __ATOMIC_RELAXED, __HIP_MEMORY_SCOPE_AGENT); }
__device__ __forceinline__ unsigned xb_add(unsigned* p, unsigned v) { return __hip_atomic_fetch_add(p, v, __ATOMIC_RELAXED, __HIP_MEMORY_SCOPE_AGENT); }
__device__ __forceinline__ unsigned xb_xcc_id() { return (unsigned)__builtin_amdgcn_s_getreg((3 << 11) | 20) & 0xFu; }
#define XB_SPIN(cond, bar) do { unsigned _sp = 0; while (cond) { __builtin_amdgcn_s_sleep(1); \
    if ((++_sp & 255u) == 0u) { if (xb_ld(&(bar)[XB_TMO])) break; if (_sp > XB_SPIN_CAP) { atomicAdd(&(bar)[XB_TMO], 1u); break; } } } } while (0)
struct XcdBarrier { unsigned* bar; unsigned x; volatile LAS unsigned* st; };
__device__ __forceinline__ XcdBarrier xcd_barrier_post(unsigned* bar, volatile LAS unsigned* st, const bool t0) {
    XcdBarrier b; b.bar = bar; b.x = xb_xcc_id(); b.st = st;
    if (t0) (void)xb_add(&bar[XB_XCNT(b.x)], 1u);
    return b;
}
__device__ __forceinline__ void xcd_barrier_complete(unsigned* bar, unsigned x, unsigned& nloc, unsigned& nx) {
    const unsigned G = gridDim.x * gridDim.y * gridDim.z;
    unsigned sum, cnt, mine, sp = 0u;
    for (;;) {
        sum = 0u; cnt = 0u; mine = 0u;
#pragma unroll
        for (unsigned j = 0; j < 16; ++j) { const unsigned c = xb_ld(&bar[XB_XCNT(j)]); sum += c; cnt += (c > 0u) ? 1u : 0u; mine = (j == x) ? c : mine; }
        if (sum == G) break;
        __builtin_amdgcn_s_sleep(1);
        if ((++sp & 255u) == 0u) { if (xb_ld(&bar[XB_TMO])) break; if (sp > XB_SPIN_CAP) { atomicAdd(&bar[XB_TMO], 1u); break; } }
    }
    nloc = mine > 0u ? mine : 1u; nx = cnt > 0u ? cnt : 1u;
}
__device__ __forceinline__ void xcd_barrier(const XcdBarrier& b, const bool t0) {
    asm volatile("s_waitcnt vmcnt(0)" ::: "memory");
    __syncthreads();
    if (t0) {
        unsigned* bar = b.bar;
        __builtin_amdgcn_s_waitcnt(0);
        unsigned nloc = b.st[0], nx = b.st[1];
        if (nloc == 0u) { xcd_barrier_complete(bar, b.x, nloc, nx); b.st[0] = nloc; b.st[1] = nx; }
        const unsigned old = xb_add(&bar[XB_XSUB(b.x)], 1u);
        const unsigned gen = old / nloc;
        if (old + 1u == (gen + 1u) * nloc) {
            __builtin_amdgcn_fence(__ATOMIC_RELEASE, "agent");
            asm volatile("s_waitcnt vmcnt(0)" ::: "memory");
            const unsigned og = xb_add(&bar[XB_TOP], 1u);
            const unsigned tg = og / nx;
            __builtin_amdgcn_fence(__ATOMIC_ACQUIRE, "agent");
            if (og + 1u == (tg + 1u) * nx) (void)__hip_atomic_fetch_add(&bar[XB_TOPGEN], 1u, __ATOMIC_RELAXED, __HIP_MEMORY_SCOPE_AGENT);
            else XB_SPIN(xb_ld(&bar[XB_TOPGEN]) == tg, bar);
            (void)__hip_atomic_fetch_add(&bar[XB_XGEN(b.x)], 1u, __ATOMIC_RELAXED, __HIP_MEMORY_SCOPE_AGENT);
            asm volatile("s_waitcnt vmcnt(0)" ::: "memory");
        } else {
            __builtin_amdgcn_fence(__ATOMIC_ACQUIRE, "agent");
            XB_SPIN(xb_ld(&bar[XB_XGEN(b.x)]) == gen, bar);
            asm volatile("s_waitcnt vmcnt(0)" ::: "memory");
        }
    }
    __syncthreads();
}

struct Args {
    const float* in[25];
    float* out; unsigned char* ws;
    int ph_lo, ph_hi;
};
enum { I_X = 0, I_MEM, I_NORM_MIX_G, I_W_IN, I_CONV_W, I_CONV_B, I_W_CONV_OUT, I_Q_NORM_G, I_W_UQ, I_KV_NORM_G, I_W_UKV, I_W_MLA_OUT, I_B_GATE, I_W_MIX_OUT,
       I_NORM_MEM_G, I_NORM_MEMKV_G, I_W_MEM_Q, I_W_MEM_KV, I_W_MEM_OUT, I_NORM_MOE_G, I_W_ROUTER, I_W_EXP_GATE, I_W_EXP_UP, I_W_EXP_DOWN, I_NORM_FINAL_G };

constexpr int TP_PITCH = 65, TP_BYTES = 64 * TP_PITCH * 4;
template <class SrcF, class DstF>
__device__ __forceinline__ void transpose_item(SrcF srcp, DstF dstp, int ld, const float* gain, int k0, LAS float* scr, int lane) {
    const int n4 = (lane & 15) * 4, kr = lane >> 4;
    const float* sp = srcp(n4);
    f32x4 v[16];
#pragma unroll
    for (int i = 0; i < 16; ++i) v[i] = sp ? *(const f32x4*)(sp + (size_t)(k0 + 4 * i + kr) * ld) : (f32x4){0.f, 0.f, 0.f, 0.f};
    if (gain) {
#pragma unroll
        for (int i = 0; i < 16; ++i) v[i] = v[i] * gain[k0 + 4 * i + kr]; }
#pragma unroll
    for (int i = 0; i < 16; ++i)
#pragma unroll
        for (int e = 0; e < 4; ++e) scr[(n4 + e) * TP_PITCH + 4 * i + kr] = v[i][e];
    asm volatile("s_waitcnt lgkmcnt(0)" ::: "memory");
    const int c = lane & 7;
#pragma unroll
    for (int j = 0; j < 8; ++j) { const int n = (lane >> 3) + 8 * j; const LAS float* s = scr + n * TP_PITCH + 8 * c;
        u32x4 o; o.x = cvtpk(s[0], s[1]); o.y = cvtpk(s[2], s[3]); o.z = cvtpk(s[4], s[5]); o.w = cvtpk(s[6], s[7]);
        *(u32x4*)(dstp(n) + k0 + 8 * c) = o; }
    asm volatile("s_waitcnt lgkmcnt(0)" ::: "memory");
}
template <class MapF>
__device__ __forceinline__ void transpose_matrix(MapF map, bf16_t* dst, int NDST, int K, int ld, const float* gain, LAS float* scr, int lane, int gw, int NGW, int& itbase) {
    const int nkb = K / 64, nitems = (NDST / 64) * nkb;
    int first = (gw - (itbase % NGW) + NGW) % NGW;
    for (int it = first; it < nitems; it += NGW) { const int nb = it / nkb, kb = it % nkb, n0 = nb * 64;
        transpose_item([&](int n) { return map(n0 + n); }, [&](int n) { return dst + (size_t)(n0 + n) * K; }, ld, gain, kb * 64, scr, lane); }
    itbase += nitems;
}

__device__ __forceinline__ int rope_dim(int p) { return (p >> 3) * 4 + (p & 3) + 32 * ((p >> 2) & 1); }

template <int PHM> __global__ void __launch_bounds__(NWAVES * 64, 2) fwd_kernel(Args args) {
    extern __shared__ __attribute__((aligned(16))) unsigned char lds_raw[];
    LAS unsigned char* lds = (LAS unsigned char*)lds_raw;
    volatile LAS unsigned* MISC = (volatile LAS unsigned*)(lds + MISC_OFF);
    int tid = threadIdx.x, lane = tid & 63; const int wave = __builtin_amdgcn_readfirstlane(tid >> 6);
#define PHASE_BEGIN() do { lane = (int)__builtin_amdgcn_mbcnt_hi(~0u, __builtin_amdgcn_mbcnt_lo(~0u, 0u)); asm volatile("" : "+v"(lane)); tid = wave * 64 + lane; } while (0)
    const int G = gridDim.x; const int bx = blockIdx.x; const int vcu = (G % 8 == 0) ? (bx % 8) * (G / 8) + bx / 8 : bx;
    const int gw = vcu * NWAVES + wave, NGW = G * NWAVES;
    unsigned char* ws = args.ws;
    gu32* ctl = (gu32*)(ws + WS_CTL);
    for (int u = tid; u < (LDS_BYTES - LDSCTL_OFF) / 4; u += NWAVES * 64) ((LAS unsigned*)(lds + LDSCTL_OFF))[u] = 0u;
    __syncthreads();
    XcdBarrier bar; bar.bar = (unsigned*)(ctl + CW_BAR); bar.x = 0; bar.st = nullptr;
    if (N_LAUNCHES == 1) bar = xcd_barrier_post((unsigned*)(ctl + CW_BAR), MISC + 8, tid == 0);
#define GRID_BAR() do { if (N_LAUNCHES == 1) xcd_barrier(bar, wave == 0 && __builtin_amdgcn_mbcnt_hi(~0u, __builtin_amdgcn_mbcnt_lo(~0u, 0u)) == 0u); } while (0)
    const int lo = args.ph_lo, hi = args.ph_hi;
#define IN(k) (((PHM >> (k)) & 1) && lo <= (k) && (k) < hi)
#define SEAM(k) do { if (IN(k) && IN((k) + 1)) GRID_BAR(); } while (0)

    const float* x = args.in[I_X]; float* out = args.out;
#define rope ((f32x2*)(ws + WS_ROPE))
#define rstd0 ((float*)(ws + WS_RSTD0))
#define rstdq ((float*)(ws + WS_RSTDQ))
#define rstdkv ((float*)(ws + WS_RSTDKV))
#define rstdm ((float*)(ws + WS_RSTDM))
#define ssq ((float*)(ws + WS_SSQ))
#define aff ((float*)(ws + WS_AFF))
#define inv ((int*)(ws + WS_INV))
#define idx ((int*)(ws + WS_IDX))
#define gate ((float*)(ws + WS_GATE))
#define memb ((bf16_t*)(ws + WS_MEMB))
#define MKV ((bf16_t*)(ws + WS_MKV))
#define QKT ((bf16_t*)(ws + WS_QKT))
#define VWT ((bf16_t*)(ws + WS_VWT))
#define Win_t ((bf16_t*)(ws + WS_WIN))
#define Wco_t ((bf16_t*)(ws + WS_WCO))
#define Wmo_t ((bf16_t*)(ws + WS_WMO))
#define Wmix_t ((bf16_t*)(ws + WS_WMIX))
#define Wuq_t ((bf16_t*)(ws + WS_WUQ))
#define Wukv_t ((bf16_t*)(ws + WS_WUKV))
#define Wmqh ((bf16_t*)(ws + WS_WMQH))
#define Woht ((bf16_t*)(ws + WS_WOHT))
#define Wmkv_t ((bf16_t*)(ws + WS_WMKV))
#define XGG ((bf16_t*)(ws + WS_XGG))
#define QB ((bf16_t*)(ws + WS_QB))
#define MIXA ((bf16_t*)(ws + WS_MIXA))
#define Wgu_t ((bf16_t*)(ws + WS_WGU))
#define Wd_t ((bf16_t*)(ws + WS_WD))
#define Y ((bf16_t*)(ws + WS_Y))
#define XB ((bf16_t*)(ws + WS_XB))
#define KN8 ((unsigned char*)(ws + WS_KN8))
#define Q8 ((unsigned char*)(ws + WS_QB))
#define KR8 ((unsigned char*)(ws + WS_KROPE))
#define X2B ((bf16_t*)(ws + WS_X2B))
#define ACONV ((bf16_t*)(ws + WS_ACONV))
#define OB ((bf16_t*)(ws + WS_OB))
#define X1B ((bf16_t*)(ws + WS_X1B))
#define XG ((bf16_t*)(ws + WS_XG))
#define SIGA ((bf16_t*)(ws + WS_SIGA))
#define MIXED ((bf16_t*)(ws + WS_MIXED))
#define PM ((bf16_t*)(ws + WS_PM))
#define SIGB ((bf16_t*)(ws + WS_SIGB))
#define H3 ((bf16_t*)(ws + WS_H3))
#define HB ((bf16_t*)(ws + WS_H))
#define CQ ((bf16_t*)(ws + WS_CQ))
#define CKV ((bf16_t*)(ws + WS_CKV))
#define KR ((bf16_t*)(ws + WS_KR))
#define KROPE ((bf16_t*)(ws + WS_KROPE))
#define KVB ((bf16_t*)out)
    LAS float* scr = (LAS float*)(lds + wave * TP_BYTES);

    if (IN(0)) { PHASE_BEGIN();
        int itb = 0;
        { const float* W = args.in[I_W_IN]; const float* gn = args.in[I_NORM_MIX_G];
          transpose_matrix([&](int n) -> const float* { if (n < 2048) { const int t = n >> 8, half = (n >> 7) & 1, c = n & 127; return W + (half ? 2048 : 0) + 128 * t + c; }
                                                         if (n < 3072) return W + 1024 + (n - 2048); if (n < 3520) return W + n; if (n < 3584) return nullptr; return W + (n - 64); },
                           Win_t, NU, 1024, 5568, gn, scr, lane, gw, NGW, itb); }
        { const float* W = args.in[I_W_CONV_OUT]; transpose_matrix([&](int n) -> const float* { return W + n; }, Wco_t, 1024, 1024, 1024, nullptr, scr, lane, gw, NGW, itb); }
        { const float* W = args.in[I_W_MLA_OUT]; transpose_matrix([&](int n) -> const float* { return W + n; }, Wmo_t, 1024, 1024, 1024, nullptr, scr, lane, gw, NGW, itb); }
        { const float* W = args.in[I_W_MIX_OUT]; transpose_matrix([&](int n) -> const float* { return W + n; }, Wmix_t, 1024, 1024, 1024, nullptr, scr, lane, gw, NGW, itb); }
        { const float* W = args.in[I_W_UQ]; const float* gn = args.in[I_Q_NORM_G];
          transpose_matrix([&](int n) -> const float* { if (n < 1024) return W + (n >> 7) * 192 + (n & 127); const int r = n - 1024; return W + (r >> 6) * 192 + 128 + rope_dim(r & 63); },
                           Wuq_t, 1536, 256, 1536, gn, scr, lane, gw, NGW, itb); }
        { const float* W = args.in[I_W_UKV]; const float* gn = args.in[I_KV_NORM_G];
          transpose_matrix([&](int n) -> const float* { if (n < 1024) return W + (n >> 7) * 256 + (n & 127); const int r = n - 1024; return W + (r >> 7) * 256 + 128 + (r & 127); },
                           Wukv_t, 2048, 128, 2048, gn, scr, lane, gw, NGW, itb); }
        { const float* W = args.in[I_W_MEM_KV]; const float* gn = args.in[I_NORM_MEMKV_G];
          transpose_matrix([&](int n) -> const float* { return W + n; }, Wmkv_t, 2048, 1024, 2048, gn, scr, lane, gw, NGW, itb); }
        for (int h = 0; h < 4; ++h) { const float* W = args.in[I_W_MEM_OUT] + (size_t)h * 256 * 1024;
          transpose_matrix([&](int n) -> const float* { return W + n; }, Woht + (size_t)h * 1024 * 256, 1024, 256, 1024, nullptr, scr, lane, gw, NGW, itb); }
        { const float* W = args.in[I_W_MEM_Q]; const float* gn = args.in[I_NORM_MEM_G];
          for (int c = gw * 64 + lane; c < 1024 * 1024 / 8; c += NGW * 64) { const int e0 = c * 8, h = e0 >> 18, d = (e0 >> 8) & 1023, j = e0 & 255; const float g = gn[d];
              const float* s = W + (size_t)d * 1024 + h * 256 + j; const f32x4 a = *(const f32x4*)s, b = *(const f32x4*)(s + 4);
              const float o[8] = {a[0] * g, a[1] * g, a[2] * g, a[3] * g, b[0] * g, b[1] * g, b[2] * g, b[3] * g}; *(u32x4*)(Wmqh + e0) = pack8(o); } }
        for (int r = gw; r < MT + NB * MEM_LEN; r += NGW) { const bool isx = r < MT; const int rr = isx ? r : r - MT;
            const float* src = (isx ? x : args.in[I_MEM]) + (size_t)rr * 1024; bf16_t* dst = (isx ? XB : memb) + (size_t)rr * 1024; float s = 0.f;
#pragma unroll
            for (int j = 0; j < 4; ++j) { const f32x4 v = *(const f32x4*)(src + (lane + 64 * j) * 4); s += (v[0] * v[0] + v[1] * v[1]) + (v[2] * v[2] + v[3] * v[3]);
                u32x2 w; w.x = cvtpk(v[0], v[1]); w.y = cvtpk(v[2], v[3]); *(u32x2*)(dst + (lane + 64 * j) * 4) = w; }
            s = wave_sum(s); if (lane == 0) (isx ? rstd0 : rstdm)[rr] = 1.f / sqrtf(s * (1.f / 1024.f) + EPS); }
        for (int i = gw * 64 + lane; i < SEQ * 32; i += NGW * 64) { const int s = i >> 5, j = i & 31; const float invf = 1.0f / powf(10000.0f, (float)(2 * j) / 64.0f); const float ang = (float)s * invf;
            rope[i] = (f32x2){cosf(ang), sinf(ang)}; }
    }
    SEAM(0);

    if (IN(1)) { PHASE_BEGIN();
        { Gemm g = mkgemm(XB, Win_t, MT, NU, 1024, 1024, 1024); StaticOrder S; S.init(MT, NU, G, bx);
          EpiU E{{rstd0, XGG, CQ, CKV, KR, SIGA, SIGB, args.in[I_B_GATE]}}; pg8::gemm_phase(lds, g, S, E, tid); }
        { Gemm g = mkgemm(memb, Wmkv_t, NB * MEM_LEN, 2048, 1024, 1024, 1024); StaticOrder S; S.init(NB * MEM_LEN, 2048, G, (bx + G / 2) % G);
          pg8::EpiChunk<FMemKV> E{{rstdm, MKV}}; pg8::gemm_phase(lds, g, S, E, tid); }
    }
    SEAM(1);

    if (IN(2)) { PHASE_BEGIN();
        const float* cw = args.in[I_CONV_W]; const float* cb = args.in[I_CONV_B];
        for (int blk = gw; blk < MT / 4; blk += NGW) { const int r0 = blk * 4, s0 = r0 & (SEQ - 1);
            u32x4 pxr[6][2], gbr[4][2]; u32x2 cqr[4]; unsigned ckr[4]; bf16_t k1[4], k2[4];
            const u32x4 z = {0u, 0u, 0u, 0u};
#pragma unroll
            for (int i = 0; i < 6; ++i) { const int rr = r0 - 1 + i; const bool ok = (i > 0 || s0 > 0) && (i < 5 || s0 + 4 < SEQ);
#pragma unroll
                for (int j = 0; j < 2; ++j) pxr[i][j] = ok ? *(const u32x4*)(XGG + (size_t)rr * 2048 + lane * 8 + 512 * j) : z; }
#pragma unroll
            for (int i = 0; i < 4; ++i) { const int rr = r0 + i;
#pragma unroll
                for (int j = 0; j < 2; ++j) gbr[i][j] = *(const u32x4*)(XGG + (size_t)rr * 2048 + 1024 + lane * 8 + 512 * j);
                cqr[i] = *(const u32x2*)(CQ + (size_t)rr * 256 + lane * 4); ckr[i] = *(const unsigned*)(CKV + (size_t)rr * 128 + lane * 2);
                { const int j_ = (lane >> 3) * 4 + (lane & 3); k1[i] = KR[(size_t)rr * 64 + j_]; k2[i] = KR[(size_t)rr * 64 + j_ + 32]; } }
#pragma unroll
            for (int j = 0; j < 2; ++j) { const int c0 = lane * 8 + 512 * j;
                float w0[8], w1[8], w2[8], bb[8];
                { const f32x4 a = *(const f32x4*)(cw + c0), b = *(const f32x4*)(cw + c0 + 4); w0[0] = a[0]; w0[1] = a[1]; w0[2] = a[2]; w0[3] = a[3]; w0[4] = b[0]; w0[5] = b[1]; w0[6] = b[2]; w0[7] = b[3]; }
                { const f32x4 a = *(const f32x4*)(cw + 1024 + c0), b = *(const f32x4*)(cw + 1024 + c0 + 4); w1[0] = a[0]; w1[1] = a[1]; w1[2] = a[2]; w1[3] = a[3]; w1[4] = b[0]; w1[5] = b[1]; w1[6] = b[2]; w1[7] = b[3]; }
                { const f32x4 a = *(const f32x4*)(cw + 2048 + c0), b = *(const f32x4*)(cw + 2048 + c0 + 4); w2[0] = a[0]; w2[1] = a[1]; w2[2] = a[2]; w2[3] = a[3]; w2[4] = b[0]; w2[5] = b[1]; w2[6] = b[2]; w2[7] = b[3]; }
                { const f32x4 a = *(const f32x4*)(cb + c0), b = *(const f32x4*)(cb + c0 + 4); bb[0] = a[0]; bb[1] = a[1]; bb[2] = a[2]; bb[3] = a[3]; bb[4] = b[0]; bb[5] = b[1]; bb[6] = b[2]; bb[7] = b[3]; }
                float p[6][8];
#pragma unroll
                for (int i = 0; i < 6; ++i) unpack8(pxr[i][j], p[i]);
#pragma unroll
                for (int i = 0; i < 4; ++i) { float gb[8], o[8]; unpack8(gbr[i][j], gb);
#pragma unroll
                    for (int e = 0; e < 8; ++e) o[e] = gb[e] * (w0[e] * p[i][e] + w1[e] * p[i + 1][e] + w2[e] * p[i + 2][e] + bb[e]);
                    *(u32x4*)(ACONV + (size_t)(r0 + i) * 1024 + c0) = pack8(o); } }
#pragma unroll
            for (int i = 0; i < 4; ++i) { const int r = r0 + i, s = r & (SEQ - 1);
                { const u32x2 w = cqr[i]; const float a = bflo(w.x), b = bfhi(w.x), c = bflo(w.y), d = bfhi(w.y);
                  const float sq = wave_sum((a * a + b * b) + (c * c + d * d)); if (lane == 0) rstdq[r] = 1.f / sqrtf(sq * (1.f / 256.f) + EPS); }
                { const unsigned w = ckr[i]; const float a = bflo(w), b = bfhi(w);
                  const float sq = wave_sum(a * a + b * b); if (lane == 0) rstdkv[r] = 1.f / sqrtf(sq * (1.f / 128.f) + EPS); }
                { const int pp = lane, j = (pp >> 3) * 4 + (pp & 3), half = (pp >> 2) & 1; const float v1 = bf2f(k1[i]), v2 = bf2f(k2[i]); const f32x2 cs = rope[s * 32 + j];
                  const float kv_ = half ? v1 * cs.y + v2 * cs.x : v1 * cs.x - v2 * cs.y;
#if ATT_FP8
                  KR8[(size_t)r * 64 + pp] = (unsigned char)(__builtin_amdgcn_cvt_pk_fp8_f32(kv_, kv_, 0u, false) & 0xffu);
#else
                  KROPE[(size_t)r * 64 + pp] = f2bf(kv_);
#endif
                } }
        }
    }
    SEAM(2);

    if (IN(3)) { PHASE_BEGIN();
        { Gemm g = mkgemm(ACONV, Wco_t, MT, 1024, 1024, 1024, 1024); StaticOrder S; S.init(MT, 1024, G, bx);
          pg8::EpiChunk<FGateMul> E{{SIGA, MIXA}}; pg8::gemm_phase(lds, g, S, E, tid); }
        { Gemm g = mkgemm(CQ, Wuq_t, MT, 1536, 256, 256, 256); StaticOrder S; S.init(MT, 1536, G, (bx + G / 2) % G);
          pg8::EpiChunk<FQ> E{{rstdq, rope, QB, ATT_FP8 ? Q8 : nullptr}}; pg8::gemm_phase(lds, g, S, E, tid); }
        { Gemm g = mkgemm(CKV, Wukv_t, MT, 2048, 128, 128, 128); StaticOrder S; S.init(MT, 2048, G, bx);
#if ATT_FP8
          pg8::EpiChunk<FKV8> E{{rstdkv, KVB, KN8}}; pg8::gemm_phase(lds, g, S, E, tid); }
#else
          pg8::EpiChunk<FScaleRow> E{{rstdkv, KVB, 2048}}; pg8::gemm_phase(lds, g, S, E, tid); }
#endif
        { Gemm g = mkgemm(MKV, Wmqh, 2048, 1024, 256, 256, 256, 1, 4, (size_t)1024 * 256); StaticOrder S; S.init(2048, 1024, G, bx);
          pg8::EpiChunk<FPlain> E{{QKT, 1024}}; pg8::gemm_phase(lds, g, S, E, tid); }
        for (int b = 0; b < NB; ++b) { Gemm g = mkgemm(Woht, MKV + (size_t)(8 + b * 4) * 65536, 4096, 256, 256, 256, 256, 4, 4, (size_t)65536); StaticOrder S; S.init(4096, 256, G, (bx + G - 64 - 16 * b) % G);
          pg8::EpiChunk<FVW> E{{VWT + (size_t)b * 1024 * 1024}}; pg8::gemm_phase(lds, g, S, E, tid); }
    }
    SEAM(3);

    if (IN(4)) { PHASE_BEGIN();
        for (int u = vcu; u < NB * NHEAD * (SEQ / 256); u += G) { const int bh = u >> 5, qb = u & 31, b = bh >> 3, h = bh & 7; const size_t row0 = (size_t)b * SEQ + qb * 256;
#if ATT_FP8
            att::attn_unit8(Q8 + row0 * 1536 + h * 128, Q8 + row0 * 1536 + 1024 + h * 64, KN8 + (size_t)b * SEQ * 1024 + h * 128, KR8 + (size_t)b * SEQ * 64,
                            KVB + (size_t)b * SEQ * 2048 + 1024 + h * 128, OB + row0 * 1024 + h * 128, SEQ, (char*)lds_raw, tid);
#else
            att::attn_unit(QB + row0 * 1536 + h * 128, QB + row0 * 1536 + 1024 + h * 64, KVB + (size_t)b * SEQ * 2048 + h * 128,
                           KROPE + (size_t)b * SEQ * 64, OB + row0 * 1024 + h * 128, SEQ, (char*)lds_raw, tid);
#endif
        }
    }
    SEAM(4);

    if (IN(5)) { PHASE_BEGIN(); Gemm g = mkgemm(OB, Wmo_t, MT, 1024, 1024, 1024, 1024); StaticOrder S; S.init(MT, 1024, G, bx);
        pg8::EpiChunk<FGateMulAdd> E{{SIGB, MIXA, MIXED}}; pg8::gemm_phase(lds, g, S, E, tid); }
    SEAM(5);

    if (IN(6)) { PHASE_BEGIN(); Gemm g = mkgemm(MIXED, Wmix_t, MT, 1024, 1024, 1024, 1024); StaticOrder S; S.init(MT, 1024, G, bx);
        EpiX1 E{x, RESID_BF16 ? nullptr : out, X1B, ssq}; pg8::gemm_phase(lds, g, S, E, tid); }
    SEAM(6);

    if (IN(7)) { PHASE_BEGIN(); Gemm g = mkgemm(X1B, QKT, MT, 1024, 1024, 1024, 1024, 32, 2, (size_t)1024 * 1024); StaticOrder S; S.init(MT, 1024, G, bx);
        EpiSoftmax E{ssq, PM}; pg8::gemm_phase(lds, g, S, E, tid); }
    SEAM(7);

    if (IN(8)) { PHASE_BEGIN(); Gemm g = mkgemm(PM, VWT, MT, 1024, 1024, 1024, 1024, 32, 2, (size_t)1024 * 1024); StaticOrder S; S.init(MT, 1024, G, bx);
#if RESID_BF16
        pg8::EpiChunk<FResidBf16> E{{X1B, X2B}}; pg8::gemm_phase(lds, g, S, E, tid); }
#else
        pg8::EpiChunk<FResidF32> E{{out, out}}; pg8::gemm_phase(lds, g, S, E, tid); }
#endif
    SEAM(8);

#if RESID_BF16
#define LDROW4(r_, j_) ([&]() -> f32x4 { const u32x2 w_ = *(const u32x2*)(X2B + (size_t)(r_) * 1024 + (lane + 64 * (j_)) * 4); return (f32x4){bflo(w_.x), bfhi(w_.x), bflo(w_.y), bfhi(w_.y)}; }())
#else
#define LDROW4(r_, j_) (*(const f32x4*)(out + (size_t)(r_) * 1024 + (lane + 64 * (j_)) * 4))
#endif
    if (IN(9)) { PHASE_BEGIN();
        constexpr int RP = 1028;
        LAS float* wt = (LAS float*)lds;
        LAS float* hb = (LAS float*)(lds + 16 * RP * 4);
        LAS float* part = (LAS float*)(lds + 2 * 16 * RP * 4);
        const float* wr_ = args.in[I_W_ROUTER]; const float* gn = args.in[I_NORM_MOE_G];
        for (int i = tid; i < 1024 * 16; i += NWAVES * 64) wt[(i & 15) * RP + (i >> 4)] = wr_[i];
        f32x4 gv[4];
#pragma unroll
        for (int j = 0; j < 4; ++j) gv[j] = *(const f32x4*)(gn + (lane + 64 * j) * 4);
        f32x4 v[2][4], vn[2][4];
        const int ngroups = MT / 16;
        if (vcu < ngroups) {
#pragma unroll
            for (int t = 0; t < 2; ++t)
#pragma unroll
                for (int j = 0; j < 4; ++j) v[t][j] = LDROW4(vcu * 16 + wave * 2 + t, j); }
        __syncthreads();
        for (int g = vcu; g < ngroups; g += G) { const int r0 = g * 16;
            if (g + G < ngroups) {
#pragma unroll
                for (int t = 0; t < 2; ++t)
#pragma unroll
                    for (int j = 0; j < 4; ++j) vn[t][j] = LDROW4((g + G) * 16 + wave * 2 + t, j); }
#pragma unroll
            for (int t = 0; t < 2; ++t) { const int tk = wave * 2 + t, r = r0 + tk; float s = 0.f;
#pragma unroll
                for (int j = 0; j < 4; ++j) s += (v[t][j][0] * v[t][j][0] + v[t][j][1] * v[t][j][1]) + (v[t][j][2] * v[t][j][2] + v[t][j][3] * v[t][j][3]);
                const float rs = 1.f / sqrtf(wave_sum(s) * (1.f / 1024.f) + EPS);
#pragma unroll
                for (int j = 0; j < 4; ++j) { const f32x4 hh = v[t][j] * rs * gv[j]; *(LAS f32x4*)(hb + tk * RP + (lane + 64 * j) * 4) = hh;
                    u32x2 w; w.x = cvtpk(hh[0], hh[1]); w.y = cvtpk(hh[2], hh[3]); *(u32x2*)(H3 + (size_t)r * 1024 + (lane + 64 * j) * 4) = w; } }
            __syncthreads();
            { f32x4 acc = {0.f, 0.f, 0.f, 0.f}; const LAS float* ap = wt + (lane & 15) * RP + wave * 128 + (lane >> 4); const LAS float* bp = hb + (lane & 15) * RP + wave * 128 + (lane >> 4);
#pragma unroll 8
                for (int st = 0; st < 32; ++st) acc = __builtin_amdgcn_mfma_f32_16x16x4f32(ap[4 * st], bp[4 * st], acc, 0, 0, 0);
                *(LAS f32x4*)(part + (wave * 16 + (lane & 15)) * 16 + 4 * (lane >> 4)) = acc; }
            __syncthreads();
            if (tid < 256) { const int tk = tid >> 4, e = tid & 15; float lg = 0.f;
#pragma unroll
                for (int w = 0; w < 8; ++w) lg += part[(w * 16 + tk) * 16 + e];
                float mx = lg;
#pragma unroll
                for (int o = 1; o < 16; o <<= 1) mx = fmaxf(mx, __shfl_xor(mx, o));
                const float p = __expf(lg - mx); float sm = p;
#pragma unroll
                for (int o = 1; o < 16; o <<= 1) sm += __shfl_xor(sm, o);
                const int r = r0 + tk, b = r >> 13, sidx = r & (SEQ - 1); aff[((size_t)b * NEXP + e) * SEQ + sidx] = p / sm; inv[(size_t)r * 16 + e] = -1; }
            __syncthreads();
#pragma unroll
            for (int t = 0; t < 2; ++t)
#pragma unroll
                for (int j = 0; j < 4; ++j) v[t][j] = vn[t][j];
        }
    }
    SEAM(9);

    if (IN(10)) { PHASE_BEGIN();
        if (vcu < NB * NEXP) {
            LAS unsigned* keys = (LAS unsigned*)lds; LAS unsigned* hist = (LAS unsigned*)(lds + 32768); LAS unsigned* misc = (LAS unsigned*)(lds + 32768 + 1024);
            for (int be = vcu; be < NB * NEXP; be += G) { const int b = be >> 4, e = be & 15; const float* a = aff + (size_t)be * SEQ;
#pragma unroll 1
                for (int i = tid; i < SEQ; i += NWAVES * 64) keys[i] = __float_as_uint(a[i]);
                unsigned prefix = 0u, kth = CAP;
#pragma unroll 1
                for (int pass = 0; pass < 4; ++pass) { const int shift = 24 - 8 * pass;
                    if (tid < 256) hist[tid] = 0u;
                    __syncthreads();
#pragma unroll 1
                    for (int i = tid; i < SEQ; i += NWAVES * 64) { const unsigned k = keys[i]; const bool match = (pass == 0) || ((k >> (shift + 8)) == (prefix >> (shift + 8)));
                        if (match) atomicAdd((unsigned*)(hist + ((k >> shift) & 255u)), 1u); }
                    __syncthreads();
                    if (wave == 0) { unsigned c[4]; unsigned tot = 0u;
#pragma unroll
                        for (int i = 0; i < 4; ++i) { c[i] = hist[255 - (4 * lane + i)]; tot += c[i]; }
                        unsigned incl = tot;
#pragma unroll
                        for (int o = 1; o < 64; o <<= 1) { const unsigned t = __shfl_up(incl, o); if (lane >= o) incl += t; }
                        unsigned run = incl - tot;
#pragma unroll
                        for (int i = 0; i < 4; ++i) { if (run < kth && run + c[i] >= kth) { misc[0] = 255u - (unsigned)(4 * lane + i); misc[1] = kth - run; } run += c[i]; } }
                    __syncthreads();
                    prefix |= misc[0] << shift; kth = misc[1];
                    __syncthreads();
                }
                const unsigned T = prefix; unsigned base_g = 0u, base_e = 0u;
#pragma unroll 1
                for (int it = 0; it < SEQ / (NWAVES * 64); ++it) { const int t = it * (NWAVES * 64) + tid; const unsigned k = keys[t]; const bool gt = k > T, eq = k == T;
                    const unsigned long long bg = __ballot(gt), bq = __ballot(eq); const unsigned long long lt = (1ull << lane) - 1ull;
                    if (lane == 0) { misc[8 + wave] = (unsigned)__popcll(bg); misc[16 + wave] = (unsigned)__popcll(bq); }
                    __syncthreads();
                    unsigned pg = base_g, pq = base_e, tg = 0u, tq = 0u;
#pragma unroll
                    for (int w = 0; w < NWAVES; ++w) { const unsigned cg = misc[8 + w], cq = misc[16 + w]; if (w < wave) { pg += cg; pq += cq; } tg += cg; tq += cq; }
                    pg += (unsigned)__popcll(bg & lt); pq += (unsigned)__popcll(bq & lt);
                    const bool sel = gt || (eq && pq < kth);
                    if (sel) { const unsigned pos = pg + (pq < kth ? pq : kth); idx[(size_t)be * CAP + pos] = t; gate[(size_t)be * CAP + pos] = __uint_as_float(k); inv[((size_t)b * SEQ + t) * 16 + e] = (int)pos; }
                    base_g += tg; base_e += tq;
                    __syncthreads();
                }
            }
        } else {
            const int cw_ = vcu - NB * NEXP, ncw = G - NB * NEXP; const int gw2 = cw_ * NWAVES + wave, NGW2 = ncw * NWAVES;
#pragma unroll 1
            for (int it = gw2; it < NEXP * 768; it += NGW2) { const int e = it / 768, r = it % 768;
                if (r < 512) { const int nb = r >> 4, kb = r & 15, n0 = nb * 64; const int f0 = (n0 >> 8) * 128 + (n0 & 127);
                    const float* W = (((n0 >> 7) & 1) ? args.in[I_W_EXP_UP] : args.in[I_W_EXP_GATE]) + (size_t)e * 1024 * 1024 + f0; bf16_t* D = Wgu_t + (size_t)e * 2048 * 1024 + (size_t)n0 * 1024;
                    transpose_item([&](int n) { return W + n; }, [&](int n) { return D + (size_t)n * 1024; }, 1024, nullptr, kb * 64, scr, lane); }
                else { const int r2 = r - 512, nb = r2 >> 4, kb = r2 & 15, n0 = nb * 64;
                    const float* W = args.in[I_W_EXP_DOWN] + (size_t)e * 1024 * 1024 + n0; bf16_t* D = Wd_t + (size_t)e * 1024 * 1024 + (size_t)n0 * 1024;
                    transpose_item([&](int n) { return W + n; }, [&](int n) { return D + (size_t)n * 1024; }, 1024, nullptr, kb * 64, scr, lane); } }
        }
    }
    if (IN(10) && IN(12)) GRID_BAR();

    if (IN(12)) { PHASE_BEGIN(); Gemm g = mkgemm(H3, Wgu_t, MOE_ROWS, 2048, 1024, 1024, 1024, 4, 16, (size_t)2048 * 1024); g.gidx = idx; StaticOrder S; S.init(MOE_ROWS, 2048, G, bx);
        EpiSwiglu E{HB}; pg8::gemm_phase<EpiSwiglu, StaticOrder, true>(lds, g, S, E, tid); }
    SEAM(12);

    if (IN(13)) { PHASE_BEGIN(); Gemm g = mkgemm(HB, Wd_t, MOE_ROWS, 1024, 1024, 1024, 1024, 4, 16, (size_t)1024 * 1024); StaticOrder S; S.init(MOE_ROWS, 1024, G, bx);
        pg8::EpiChunk<FGateRow> E{{gate, Y}}; pg8::gemm_phase(lds, g, S, E, tid); }
    SEAM(13);

    if (IN(14)) { PHASE_BEGIN();
        const float* gn = args.in[I_NORM_FINAL_G]; f32x4 gv[4];
#pragma unroll
        for (int j = 0; j < 4; ++j) gv[j] = *(const f32x4*)(gn + (lane + 64 * j) * 4);
        f32x4 v[4], vn[4]; int myslot = -1, nslot = -1;
        if (gw < MT) { myslot = inv[(size_t)gw * 16 + (lane & 15)];
#pragma unroll
            for (int j = 0; j < 4; ++j) v[j] = LDROW4(gw, j); }
        for (int r = gw; r < MT; r += NGW) { float* row = out + (size_t)r * 1024; const int b = r >> 13;
            if (r + NGW < MT) { nslot = inv[(size_t)(r + NGW) * 16 + (lane & 15)];
#pragma unroll
                for (int j = 0; j < 4; ++j) vn[j] = LDROW4(r + NGW, j); }
            unsigned long long em = __ballot(lane < 16 && myslot >= 0) & 0xffffull;
            while (em) { u32x2 w[4][4]; int ne = 0;
#pragma unroll
                for (int q = 0; q < 4; ++q) { if (em) { const int e = __builtin_ctzll(em); em &= em - 1; const int slot = __builtin_amdgcn_readlane(myslot, e);
                        const bf16_t* yr = Y + ((size_t)(b * NEXP + e) * CAP + slot) * 1024;
#pragma unroll
                        for (int j = 0; j < 4; ++j) w[q][j] = *(const u32x2*)(yr + (lane + 64 * j) * 4);
                        ne = q + 1; } }
#pragma unroll
                for (int q = 0; q < 4; ++q) { if (q < ne) {
#pragma unroll
                        for (int j = 0; j < 4; ++j) { v[j][0] += bflo(w[q][j].x); v[j][1] += bfhi(w[q][j].x); v[j][2] += bflo(w[q][j].y); v[j][3] += bfhi(w[q][j].y); } } } }
            float s = 0.f;
#pragma unroll
            for (int j = 0; j < 4; ++j) s += (v[j][0] * v[j][0] + v[j][1] * v[j][1]) + (v[j][2] * v[j][2] + v[j][3] * v[j][3]);
            const float rs = 1.f / sqrtf(wave_sum(s) * (1.f / 1024.f) + EPS);
#pragma unroll
            for (int j = 0; j < 4; ++j) *(f32x4*)(row + (lane + 64 * j) * 4) = v[j] * rs * gv[j];
#pragma unroll
            for (int j = 0; j < 4; ++j) v[j] = vn[j];
            myslot = nslot;
        }
    }
#undef IN
#undef SEAM
#undef GRID_BAR
}

#ifndef PH_MASK
#define PH_MASK 0x7fff
#endif
static const void* phase_fn(int k) {
#if MK_N_LAUNCHES == 1
    (void)k; return (const void*)fwd_kernel<PH_MASK>;
#else
    switch (k) {
    case 0: return (const void*)fwd_kernel<1 << 0>;   case 1: return (const void*)fwd_kernel<1 << 1>;   case 2: return (const void*)fwd_kernel<1 << 2>;   case 3: return (const void*)fwd_kernel<1 << 3>;
    case 4: return (const void*)fwd_kernel<1 << 4>;   case 5: return (const void*)fwd_kernel<1 << 5>;   case 6: return (const void*)fwd_kernel<1 << 6>;   case 7: return (const void*)fwd_kernel<1 << 7>;
    case 8: return (const void*)fwd_kernel<1 << 8>;   case 9: return (const void*)fwd_kernel<1 << 9>;   case 10: return (const void*)fwd_kernel<1 << 10>; case 11: return (const void*)fwd_kernel<1 << 11>;
    case 12: return (const void*)fwd_kernel<1 << 12>; case 13: return (const void*)fwd_kernel<1 << 13>; default: return (const void*)fwd_kernel<1 << 14>;
    }
#endif
}
extern "C" void kernel_launch(void* const* d_in, const int* in_sizes, int n_in, void* d_out, int out_size, void* d_ws, size_t ws_size, hipStream_t stream) {
    static int grid = 0;
    if (grid == 0) {
        if (n_in != 25 || in_sizes[0] != MT * DM || out_size != MT * DM || ws_size < WS_END) {
            fprintf(stderr, "kernel_launch: built for 25 inputs, x/out of %d floats, >= %zu bytes of workspace; got n_in %d, in0 %d, out %d, ws %zu; nothing launched\n", MT * DM, (size_t)WS_END, n_in, n_in > 0 ? in_sizes[0] : -1, out_size, ws_size);
            grid = -1; return; }
        int dev = 0, cus = 0;
        if (hipGetDevice(&dev) != hipSuccess || hipDeviceGetAttribute(&cus, hipDeviceAttributeMultiprocessorCount, dev) != hipSuccess) { fprintf(stderr, "kernel_launch: device query failed\n"); grid = -1; return; }
        for (int k = 0; k < (N_LAUNCHES == 1 ? 1 : N_PHASES); ++k)
            if (hipFuncSetAttribute(phase_fn(N_LAUNCHES == 1 ? -1 : k), hipFuncAttributeMaxDynamicSharedMemorySize, LDS_BYTES) != hipSuccess) { fprintf(stderr, "kernel_launch: hipFuncSetAttribute failed\n"); grid = -1; return; }
        (void)hipGetLastError();
        grid = cus;
    }
    if (grid < 0) return;
    if (hipMemsetAsync((char*)d_ws + WS_CTL, 0, CTL_ZERO_BYTES, stream) != hipSuccess) { fprintf(stderr, "kernel_launch: memset failed\n"); return; }
    Args a{};
    for (int i = 0; i < 25; ++i) a.in[i] = (const float*)d_in[i];
    a.out = (float*)d_out; a.ws = (unsigned char*)d_ws;
    for (int li = 0; li < N_LAUNCHES; ++li) {
        a.ph_lo = (N_LAUNCHES == 1) ? 0 : li; a.ph_hi = (N_LAUNCHES == 1) ? N_PHASES : li + 1;
        void* kargs[] = {&a};
        for (int rep = 0; rep < ((N_LAUNCHES != 1 && li == REP_PHASE) ? 2 : 1); ++rep)
            (void)hipLaunchKernel(phase_fn(N_LAUNCHES == 1 ? -1 : li), dim3(grid), dim3(NWAVES * 64), kargs, LDS_BYTES, stream);
        const hipError_t le = hipPeekAtLastError();
        if (le != hipSuccess) { fprintf(stderr, "kernel_launch: launch %d failed: %s\n", li, hipGetErrorName(le)); break; }
    }
}
```

```cpp
#include <hip/hip_runtime.h>
#include <cstdio>
#include <cstdint>

#ifndef MK_N_LAUNCHES
#define MK_N_LAUNCHES 1
#endif
#ifndef REP_PHASE
#define REP_PHASE -1
#endif
#ifndef RESID_BF16
#define RESID_BF16 1
#endif
#ifndef ATT_FP8
#define ATT_FP8 1
#endif
#ifndef GEMM_SIMPLE
#define GEMM_SIMPLE 0
#endif

#define LAS __attribute__((address_space(3)))
#define GAS __attribute__((address_space(1)))
typedef unsigned short bf16_t;
typedef short bf16x8 __attribute__((ext_vector_type(8)));
typedef short s16x4 __attribute__((ext_vector_type(4)));
typedef float f32x2 __attribute__((ext_vector_type(2)));
typedef float f32x4 __attribute__((ext_vector_type(4)));
typedef float f32x16 __attribute__((ext_vector_type(16)));
typedef unsigned u32x2 __attribute__((ext_vector_type(2)));
typedef unsigned u32x4 __attribute__((ext_vector_type(4)));
typedef __bf16 bf16x2_t __attribute__((ext_vector_type(2)));

constexpr int DM = 1024, NB = 2, SEQ = 8192, MT = NB * SEQ;
constexpr int NU = 5632;
constexpr int NHEAD = 8, QK_NOPE = 128, QK_ROPE = 64, V_HEAD = 128, Q_LORA = 256, KV_LORA = 128;
constexpr int MEM_LEN = 256, MEM_HEADS = 4, MEM_HD = 256;
constexpr int NEXP = 16, EFF = 1024, CAP = 1024;
constexpr int MOE_ROWS = NB * NEXP * CAP;
constexpr float EPS = 1e-6f;
constexpr float ATT_SCALE = 0.07216878364870322f;

__device__ __forceinline__ unsigned cvtpk(float lo, float hi) { f32x2 v = {lo, hi}; bf16x2_t b = __builtin_convertvector(v, bf16x2_t); return __builtin_bit_cast(unsigned, b); }
__device__ __forceinline__ float bflo(unsigned w) { return __builtin_bit_cast(float, w << 16); }
__device__ __forceinline__ float bfhi(unsigned w) { return __builtin_bit_cast(float, w & 0xffff0000u); }
__device__ __forceinline__ float bf2f(bf16_t h) { return __builtin_bit_cast(float, (unsigned)h << 16); }
__device__ __forceinline__ bf16_t f2bf(float f) { return (bf16_t)(cvtpk(f, 0.f) & 0xffffu); }
__device__ __forceinline__ void unpack8(const u32x4 w, float (&v)[8]) { v[0] = bflo(w.x); v[1] = bfhi(w.x); v[2] = bflo(w.y); v[3] = bfhi(w.y); v[4] = bflo(w.z); v[5] = bfhi(w.z); v[6] = bflo(w.w); v[7] = bfhi(w.w); }
__device__ __forceinline__ u32x4 pack8(const float (&v)[8]) { u32x4 w; w.x = cvtpk(v[0], v[1]); w.y = cvtpk(v[2], v[3]); w.z = cvtpk(v[4], v[5]); w.w = cvtpk(v[6], v[7]); return w; }
typedef int v8i __attribute__((ext_vector_type(8)));
__device__ __forceinline__ unsigned pk4_fp8(float a, float b, float c, float d) { unsigned w = 0; w = __builtin_amdgcn_cvt_pk_fp8_f32(a, b, w, false); w = __builtin_amdgcn_cvt_pk_fp8_f32(c, d, w, true); return w; }
__device__ __forceinline__ u32x2 pack8_fp8(const float (&v)[8]) { u32x2 w; w.x = pk4_fp8(v[0], v[1], v[2], v[3]); w.y = pk4_fp8(v[4], v[5], v[6], v[7]); return w; }
__device__ __forceinline__ float wave_sum(float v) {
#pragma unroll
    for (int o = 1; o < 64; o <<= 1) v += __shfl_xor(v, o);
    return v;
}

namespace pg8 {
constexpr int BM = 256, BK = 64, HALF = 128, HTB = HALF * BK * 2, STAGE_BYTES = 8 * HTB, NXCD = 8, WGM = 8;
__host__ __device__ __forceinline__ int lds_byte(int r, int c) { const int st = (r >> 4) * 2 + (c >> 5), rr = r & 15, cc = c & 31, ob = rr * 64 + cc * 2; return st * 1024 + (ob ^ (((ob >> 9) & 1) << 5)); }
__host__ __device__ __forceinline__ void stage_rc(int b, int& R, int& C) { const int st = b / 1024, sb = b % 1024, swz = sb ^ (((sb >> 9) & 1) << 5); R = (st >> 1) * 16 + swz / 64; C = (st & 1) * 32 + (swz % 64) / 2; }
__host__ __device__ __forceinline__ int perm32(int rho) { const int n = rho >> 4, i = rho & 15; return 8 * (i >> 2) + 4 * n + (i & 3); }

struct Unit { int pm, pn; };
struct Gemm { const bf16_t* A; const bf16_t* Bt; int M, N, K, lda, ldb, bdiv, bmod; size_t bstride; const int* gidx; };
__device__ __forceinline__ Gemm mkgemm(const bf16_t* A, const bf16_t* Bt, int M, int N, int K, int lda, int ldb, int bdiv = 1, int bmod = 1, size_t bstride = 0) {
    Gemm g; g.A = A; g.Bt = Bt; g.M = M; g.N = N; g.K = K; g.lda = lda; g.ldb = ldb; g.bdiv = bdiv; g.bmod = bmod; g.bstride = bstride; g.gidx = nullptr; return g; }

struct StaticOrder {
    int nM, nN, nwg, G, c;
    __host__ __device__ void init(int M, int N, int G_, int c_) { nM = M / BM; nN = N / BM; nwg = nM * nN; G = G_; c = c_; }
    __host__ __device__ bool next(int i, Unit& u) const {
        const long L = (long)i * G + c; if (L >= nwg) return false;
        int wgid = (int)L; { const int q = nwg / NXCD, r = nwg % NXCD, xcd = wgid % NXCD, off = wgid / NXCD; wgid = (xcd < r ? xcd * (q + 1) : r * (q + 1) + (xcd - r) * q) + off; }
        const int nig = WGM * nN, gid = wgid / nig, fm = gid * WGM, gsz = (nM - fm) < WGM ? (nM - fm) : WGM;
        u.pm = fm + ((wgid % nig) % gsz); u.pn = (wgid % nig) / gsz; return true;
    }
};

typedef f32x4 Acc[2][2][4][2];

template <class Epi, class Sched>
__device__ __forceinline__ void gemm_simple(LAS unsigned char* lds, const Gemm g, const Sched& S, const Epi& E, const int tid) {
    const int wid = __builtin_amdgcn_readfirstlane(tid >> 6), lane = tid & 63, wr = wid >> 2, wc = wid & 3, fr = lane & 15, fq = lane >> 4;
    Unit u;
    for (int i = 0; S.next(i, u); ++i) {
        Acc acc;
#pragma unroll
        for (int a = 0; a < 2; ++a)
#pragma unroll
            for (int b = 0; b < 2; ++b)
#pragma unroll
                for (int m = 0; m < 4; ++m)
#pragma unroll
                    for (int n = 0; n < 2; ++n) acc[a][b][m][n] = (f32x4){0.f, 0.f, 0.f, 0.f};
        const bf16_t* Ab = g.A + (size_t)u.pm * BM * g.lda + (size_t)(wr * 64 + fr) * g.lda + fq * 8;
        const bf16_t* Bb = g.Bt + (size_t)((u.pm / g.bdiv) % g.bmod) * g.bstride + (size_t)u.pn * BM * g.ldb + fq * 8;
        int brow[2][2];
#pragma unroll
        for (int bj = 0; bj < 2; ++bj)
#pragma unroll
            for (int n = 0; n < 2; ++n) brow[bj][n] = bj * HALF + wc * 32 + perm32(n * 16 + fr);
#pragma unroll 1
        for (int k0 = 0; k0 < g.K; k0 += 32) {
            bf16x8 b[2][2];
#pragma unroll
            for (int bj = 0; bj < 2; ++bj)
#pragma unroll
                for (int n = 0; n < 2; ++n) b[bj][n] = *(const bf16x8*)(Bb + (size_t)brow[bj][n] * g.ldb + k0);
#pragma unroll
            for (int ai = 0; ai < 2; ++ai) { bf16x8 a[4];
#pragma unroll
                for (int m = 0; m < 4; ++m) a[m] = *(const bf16x8*)(Ab + (size_t)(ai * HALF + m * 16) * g.lda + k0);
#pragma unroll
                for (int bj = 0; bj < 2; ++bj)
#pragma unroll
                    for (int m = 0; m < 4; ++m)
#pragma unroll
                        for (int n = 0; n < 2; ++n) acc[ai][bj][m][n] = __builtin_amdgcn_mfma_f32_16x16x32_bf16(b[bj][n], a[m], acc[ai][bj][m][n], 0, 0, 0); }
        }
        E.run(acc, u, wr, wc, fr, fq, lds, wid, lane);
        if (Epi::USES_LDS) __syncthreads();
    }
}

template <class Epi, class Sched, bool GATHER>
__device__ __forceinline__ void gemm_fast(LAS unsigned char* lds, const Gemm g, const Sched& S, const Epi& E, const int tid) {
    const int wid = __builtin_amdgcn_readfirstlane(tid >> 6), lane = tid & 63, wr = wid >> 2, wc = wid & 3, fr = lane & 15, fq = lane >> 4;
    int Kop = g.K; asm volatile("" : "+s"(Kop));
    const int K = Kop, nt = K / BK;
    int Rr[2], Cc[2]; unsigned voffB[2];
    unsigned cvA0[2], cvA1[2], nvA0[2], nvA1[2];
    const size_t kstep = (size_t)(BK * 2);
    const size_t hstepA = (size_t)HALF * g.lda * 2, hstepB = (size_t)HALF * g.ldb * 2;
    const size_t tstepA = 2 * hstepA, tstepB = 2 * hstepB;
#pragma unroll
    for (int i = 0; i < 2; ++i) { stage_rc(tid * 16 + i * 8192, Rr[i], Cc[i]); const int Rb = (Rr[i] & ~31) + perm32(Rr[i] & 31);
        voffB[i] = (unsigned)(Rb * g.ldb + Cc[i]) * 2u;
        cvA0[i] = (unsigned)(Rr[i] * g.lda + Cc[i]) * 2u; cvA1[i] = cvA0[i] + (unsigned)hstepA; nvA0[i] = cvA0[i]; nvA1[i] = cvA1[i]; }
    const unsigned ldsw = (unsigned)wid * 1024u;
    const int aoff = lds_byte(wr * 64 + fr, fq * 8), boff = lds_byte(wc * 32 + fr, fq * 8);
#define PG8_SA(b, h) (((b) * 2 + (h)) * HTB)
#define PG8_SB(b, h) ((4 + (b) * 2 + (h)) * HTB)
#define PG8_STAGE(bufoff, gbase, voff) do { _Pragma("unroll") for (int _i = 0; _i < 2; ++_i) \
        __builtin_amdgcn_global_load_lds((const unsigned*)((const char*)(gbase) + (voff)[_i]), (LAS unsigned*)(lds + (bufoff) + ldsw + _i * 8192), 16, 0, 0); } while (0)
#define PG8_LDA(dst, b, h) do { _Pragma("unroll") for (int m = 0; m < 4; ++m) _Pragma("unroll") for (int k = 0; k < 2; ++k) dst[m][k] = *(const LAS bf16x8*)(lds + PG8_SA(b, h) + aoff + m * 2048 + k * 1024); } while (0)
#define PG8_LDB(dst, b, h) do { _Pragma("unroll") for (int n = 0; n < 2; ++n) _Pragma("unroll") for (int k = 0; k < 2; ++k) dst[n][k] = *(const LAS bf16x8*)(lds + PG8_SB(b, h) + boff + n * 2048 + k * 1024); } while (0)
#define PG8_MMA(ai, bj, At, Bt) do { __builtin_amdgcn_s_setprio(1); _Pragma("unroll") for (int m = 0; m < 4; ++m) _Pragma("unroll") for (int n = 0; n < 2; ++n) _Pragma("unroll") for (int k = 0; k < 2; ++k) \
        acc[ai][bj][m][n] = __builtin_amdgcn_mfma_f32_16x16x32_bf16(Bt[n][k], At[m][k], acc[ai][bj][m][n], 0, 0, 0); __builtin_amdgcn_s_setprio(0); } while (0)
#define PG8_WAIT_V(n) asm volatile("s_waitcnt vmcnt(" #n ")" ::: "memory")
#define PG8_WAIT_L(n) asm volatile("s_waitcnt lgkmcnt(" #n ")" ::: "memory")
#define PG8_BAR __builtin_amdgcn_s_barrier()
#define PG8_SCHED __builtin_amdgcn_sched_barrier(0)
#define PG8_GIDX(u, raw) do { const int* ip_ = g.gidx + (size_t)(u).pm * BM; raw[0] = ip_[Rr[0]]; raw[1] = ip_[Rr[1]]; raw[2] = ip_[HALF + Rr[0]]; raw[3] = ip_[HALF + Rr[1]]; } while (0)
#define PG8_GOFF(u, raw, v0, v1) do { const unsigned bb_ = (unsigned)((u).pm >> 6) * (unsigned)SEQ; _Pragma("unroll") for (int _i = 0; _i < 2; ++_i) { \
        v0[_i] = ((bb_ + (unsigned)raw[_i]) * (unsigned)g.lda + (unsigned)Cc[_i]) * 2u; v1[_i] = ((bb_ + (unsigned)raw[2 + _i]) * (unsigned)g.lda + (unsigned)Cc[_i]) * 2u; } } while (0)
    Unit cur, nxt; int ui = 0;
    if (!S.next(0, cur)) return;
    Acc acc;
#pragma unroll
    for (int a = 0; a < 2; ++a)
#pragma unroll
        for (int b = 0; b < 2; ++b)
#pragma unroll
            for (int m = 0; m < 4; ++m)
#pragma unroll
                for (int n = 0; n < 2; ++n) acc[a][b][m][n] = (f32x4){0.f, 0.f, 0.f, 0.f};
    bf16x8 At[4][2], B0[2][2], B1[2][2];
    int nraw[4] = {0, 0, 0, 0};
    const char* cA = GATHER ? (const char*)g.A : (const char*)g.A + (size_t)cur.pm * tstepA;
    const char* cB = (const char*)g.Bt + (size_t)((cur.pm / g.bdiv) % g.bmod) * g.bstride * 2 + (size_t)cur.pn * tstepB;
    if constexpr (GATHER) { int craw[4]; PG8_GIDX(cur, craw); PG8_GOFF(cur, craw, cvA0, cvA1); }
    PG8_STAGE(PG8_SB(0, 0), cB, voffB); PG8_STAGE(PG8_SB(0, 1), cB + hstepB, voffB); PG8_STAGE(PG8_SA(0, 0), cA, cvA0); PG8_STAGE(PG8_SA(0, 1), cA, cvA1);
    if (wr == 1) PG8_BAR;
    PG8_WAIT_V(2); PG8_BAR;
    PG8_STAGE(PG8_SB(1, 0), cB + kstep, voffB); PG8_STAGE(PG8_SA(1, 0), cA + kstep, cvA0); PG8_STAGE(PG8_SB(1, 1), cB + hstepB + kstep, voffB);
    PG8_WAIT_V(6); PG8_BAR;
    for (;;) {
        const bool has_next = S.next(ui + 1, nxt);
        const char* nA = GATHER ? (const char*)g.A : (has_next ? (const char*)g.A + (size_t)nxt.pm * tstepA : cA);
        const char* nB = has_next ? (const char*)g.Bt + (size_t)((nxt.pm / g.bdiv) % g.bmod) * g.bstride * 2 + (size_t)nxt.pn * tstepB : cB;
        if constexpr (GATHER) { if (has_next) PG8_GIDX(nxt, nraw); }
        for (int t = 0; t < nt; t += 2) {
            const bool last = (t == nt - 2);
            const char* a1 = cA + (size_t)(t + 1) * kstep;
            const char* a2 = last ? nA : cA + (size_t)(t + 2) * kstep; const char* b2 = last ? nB : cB + (size_t)(t + 2) * kstep;
            const char* a3 = a2 + kstep; const char* b3 = b2 + kstep;
            unsigned sA0[2] = {cvA0[0], cvA0[1]}, sA1[2] = {cvA1[0], cvA1[1]};
            if constexpr (GATHER) { if (last) { if (has_next) PG8_GOFF(nxt, nraw, nvA0, nvA1); else { nvA0[0] = cvA0[0]; nvA0[1] = cvA0[1]; nvA1[0] = cvA1[0]; nvA1[1] = cvA1[1]; }
                                                 sA0[0] = nvA0[0]; sA0[1] = nvA0[1]; sA1[0] = nvA1[0]; sA1[1] = nvA1[1]; } }
            PG8_LDB(B0, 0, 0); PG8_LDB(B1, 0, 1); PG8_SCHED; PG8_LDA(At, 0, 0); PG8_STAGE(PG8_SA(1, 1), a1, cvA1);
            PG8_WAIT_V(8); PG8_WAIT_L(0); PG8_BAR; PG8_MMA(0, 0, At, B0); PG8_MMA(0, 1, At, B1); PG8_BAR; PG8_SCHED;
            PG8_LDA(At, 0, 1); PG8_STAGE(PG8_SB(0, 0), b2, voffB); PG8_STAGE(PG8_SB(0, 1), b2 + hstepB, voffB); PG8_STAGE(PG8_SA(0, 0), a2, sA0);
            PG8_WAIT_V(8); PG8_WAIT_L(0); PG8_BAR; PG8_MMA(1, 0, At, B0); PG8_MMA(1, 1, At, B1); PG8_BAR; PG8_SCHED;
            PG8_LDB(B0, 1, 0); PG8_LDB(B1, 1, 1); PG8_SCHED; PG8_LDA(At, 1, 0); PG8_STAGE(PG8_SA(0, 1), a2, sA1);
            PG8_WAIT_V(8); PG8_WAIT_L(0); PG8_BAR; PG8_MMA(0, 0, At, B0); PG8_MMA(0, 1, At, B1); PG8_BAR; PG8_SCHED;
            PG8_LDA(At, 1, 1); PG8_STAGE(PG8_SB(1, 0), b3, voffB); PG8_STAGE(PG8_SB(1, 1), b3 + hstepB, voffB); PG8_STAGE(PG8_SA(1, 0), a3, sA0);
            PG8_WAIT_V(8); PG8_WAIT_L(0); PG8_BAR; PG8_MMA(1, 0, At, B0); PG8_MMA(1, 1, At, B1); PG8_BAR; PG8_SCHED;
        }
        if (wr == 0) PG8_BAR;
        E.run(acc, cur, wr, wc, fr, fq, lds + STAGE_BYTES, wid, lane);
        if (!has_next) break;
#pragma unroll
        for (int a = 0; a < 2; ++a)
#pragma unroll
            for (int b = 0; b < 2; ++b)
#pragma unroll
                for (int m = 0; m < 4; ++m)
#pragma unroll
                    for (int n = 0; n < 2; ++n) acc[a][b][m][n] = (f32x4){0.f, 0.f, 0.f, 0.f};
        cur = nxt; cA = nA; cB = nB; ++ui;
        if constexpr (GATHER) { cvA0[0] = nvA0[0]; cvA0[1] = nvA0[1]; cvA1[0] = nvA1[0]; cvA1[1] = nvA1[1]; }
        if (wr == 1) PG8_BAR;
    }
    PG8_WAIT_V(0);
    PG8_BAR;
#undef PG8_SA
#undef PG8_SB
#undef PG8_STAGE
#undef PG8_LDA
#undef PG8_LDB
#undef PG8_MMA
#undef PG8_WAIT_V
#undef PG8_WAIT_L
#undef PG8_BAR
#undef PG8_SCHED
#undef PG8_GIDX
#undef PG8_GOFF
}

template <class Epi, class Sched, bool GATHER = false>
__device__ __forceinline__ void gemm_phase(LAS unsigned char* lds, const Gemm g, const Sched& S, const Epi& E, const int tid) {
#if GEMM_SIMPLE
    static_assert(!GATHER, "the simple body has no gather path");
    gemm_simple<Epi, Sched>(lds + STAGE_BYTES, g, S, E, tid);
#else
    gemm_fast<Epi, Sched, GATHER>(lds, g, S, E, tid);
#endif
}

template <class F> struct EpiChunk {
    static constexpr bool USES_LDS = false;
    F f;
    __device__ __forceinline__ void run(Acc& acc, const Unit& u, int wr, int wc, int fr, int fq, LAS unsigned char*, int, int) const {
        constexpr int NBT = F::NBATCH, GPB = 8 / NBT;
#pragma unroll
        for (int bt = 0; bt < NBT; ++bt) {
            typename F::Pre pre[GPB][2];
#pragma unroll
            for (int g = 0; g < GPB; ++g) { const int rg = bt * GPB + g, ai = rg >> 2, m = rg & 3; const int row = u.pm * BM + ai * HALF + wr * 64 + m * 16 + fr;
#pragma unroll
                for (int bj = 0; bj < 2; ++bj) { const int col = u.pn * BM + bj * HALF + wc * 32 + 8 * fq; pre[g][bj] = f.load(row, col); } }
            asm volatile("" ::: "memory");
#pragma unroll
            for (int g = 0; g < GPB; ++g) { const int rg = bt * GPB + g, ai = rg >> 2, m = rg & 3; const int row = u.pm * BM + ai * HALF + wr * 64 + m * 16 + fr;
#pragma unroll
                for (int bj = 0; bj < 2; ++bj) { const int col = u.pn * BM + bj * HALF + wc * 32 + 8 * fq;
                    const f32x4 a = acc[ai][bj][m][0], b = acc[ai][bj][m][1];
                    const float v[8] = {a[0], a[1], a[2], a[3], b[0], b[1], b[2], b[3]};
                    f.chunk(row, col, v, pre[g][bj]); } }
            asm volatile("" ::: "memory");
        }
    }
};
}
using pg8::Gemm; using pg8::Unit; using pg8::StaticOrder; using pg8::mkgemm;

struct PreNone {};
struct PreF { float r; };
struct FU { const float* rstd0; bf16_t *XGG, *CQ, *CKV, *KR, *SIGA, *SIGB; const float* bgate;
    static constexpr int NBATCH = 4;
    struct Pre { float rs; f32x4 b0, b1; };
    __device__ __forceinline__ Pre load(int row, int col) const { Pre p; p.rs = rstd0[row];
        if (col >= 3584) { p.b0 = *(const f32x4*)(bgate + (col - 3584)); p.b1 = *(const f32x4*)(bgate + (col - 3584) + 4); } else { p.b0 = (f32x4){0.f, 0.f, 0.f, 0.f}; p.b1 = p.b0; }
        return p; }
    __device__ __forceinline__ void chunk(int row, int col, const float (&v)[8], const Pre& p) const {
        const float rs = p.rs; float o[8];
#pragma unroll
        for (int i = 0; i < 8; ++i) o[i] = v[i] * rs;
        if (col < 3072) { *(u32x4*)(XGG + (size_t)row * 2048 + 1024 + (col - 2048)) = pack8(o); }
        else if (col < 3328) { *(u32x4*)(CQ + (size_t)row * 256 + (col - 3072)) = pack8(o); }
        else if (col < 3456) { *(u32x4*)(CKV + (size_t)row * 128 + (col - 3328)) = pack8(o); }
        else if (col < 3520) { *(u32x4*)(KR + (size_t)row * 64 + (col - 3456)) = pack8(o); }
        else if (col >= 3584) { const int c = col - 3584;
            const float bb[8] = {p.b0[0], p.b0[1], p.b0[2], p.b0[3], p.b1[0], p.b1[1], p.b1[2], p.b1[3]};
#pragma unroll
            for (int i = 0; i < 8; ++i) o[i] = 1.f / (1.f + __expf(-(o[i] + bb[i])));
            bf16_t* dst = c < 1024 ? SIGA + (size_t)row * 1024 + c : SIGB + (size_t)row * 1024 + (c - 1024);
            *(u32x4*)dst = pack8(o); }
    } };
struct EpiU {
    static constexpr bool USES_LDS = false;
    FU f;
    __device__ __forceinline__ void run(pg8::Acc& acc, const Unit& u, int wr, int wc, int fr, int fq, LAS unsigned char* scr, int wid, int lane) const {
        if (u.pn < 8) {
#pragma unroll
            for (int ai = 0; ai < 2; ++ai)
#pragma unroll
                for (int m = 0; m < 4; ++m) { const int row = u.pm * 256 + ai * 128 + wr * 64 + m * 16 + fr; const int col = u.pn * 128 + wc * 32 + 8 * fq; const float rs = f.rstd0[row]; const float r2 = rs * rs; float o[8];
#pragma unroll
                    for (int n = 0; n < 2; ++n)
#pragma unroll
                        for (int i = 0; i < 4; ++i) o[n * 4 + i] = acc[ai][0][m][n][i] * acc[ai][1][m][n][i] * r2;
                    *(u32x4*)(f.XGG + (size_t)row * 2048 + col) = pack8(o); }
        } else { pg8::EpiChunk<FU> E{f}; E.run(acc, u, wr, wc, fr, fq, scr, wid, lane); }
    }
};
struct FMemKV { const float* rstdm; bf16_t* MKV;
    static constexpr int NBATCH = 1; typedef PreF Pre;
    __device__ __forceinline__ Pre load(int row, int) const { Pre p; p.r = rstdm[row]; return p; }
    __device__ __forceinline__ void chunk(int row, int col, const float (&v)[8], const Pre& p) const {
        const float rs = p.r * (col < 1024 ? 0.0625f : 1.f); float o[8];
#pragma unroll
        for (int i = 0; i < 8; ++i) o[i] = v[i] * rs;
        const int kv = col >> 10, h = (col >> 8) & 3, j = col & 255, b = row >> 8, key = row & 255;
        *(u32x4*)(MKV + ((size_t)((kv * 2 + b) * 4 + h) * 256 + key) * 256 + j) = pack8(o);
    } };
struct FQ { const float* rstdq; const f32x2* rope; bf16_t* Q; unsigned char* Q8;
    static constexpr int NBATCH = 4;
    struct Pre { float rs; f32x2 cs[4]; };
    __device__ __forceinline__ Pre load(int row, int col) const { Pre p; p.rs = rstdq[row];
        if (col >= 1024) { const int pp = (col - 1024) & 63, j0 = (pp >> 3) * 4, s = row & (SEQ - 1);
#pragma unroll
            for (int i = 0; i < 4; ++i) p.cs[i] = rope[s * 32 + j0 + i]; }
        else {
#pragma unroll
            for (int i = 0; i < 4; ++i) p.cs[i] = (f32x2){1.f, 0.f}; }
        return p; }
    __device__ __forceinline__ void chunk(int row, int col, const float (&v)[8], const Pre& p) const {
        const float rs = p.rs; float o[8];
#pragma unroll
        for (int i = 0; i < 8; ++i) o[i] = v[i] * rs;
        if (col >= 1024) {
#pragma unroll
            for (int i = 0; i < 4; ++i) { const f32x2 cs = p.cs[i]; const float a = o[i], b = o[4 + i]; o[i] = a * cs.x - b * cs.y; o[4 + i] = a * cs.y + b * cs.x; } }
        if (Q8) *(u32x2*)(Q8 + (size_t)row * 1536 + col) = pack8_fp8(o); else *(u32x4*)(Q + (size_t)row * 1536 + col) = pack8(o);
    } };
struct FScaleRow { const float* rs; bf16_t* O; int ldo;
    static constexpr int NBATCH = 1; typedef PreF Pre;
    __device__ __forceinline__ Pre load(int row, int) const { Pre p; p.r = rs[row]; return p; }
    __device__ __forceinline__ void chunk(int row, int col, const float (&v)[8], const Pre& p) const {
        const float r = p.r; float o[8];
#pragma unroll
        for (int i = 0; i < 8; ++i) o[i] = v[i] * r;
        *(u32x4*)(O + (size_t)row * ldo + col) = pack8(o);
    } };
struct FKV8 { const float* rs; bf16_t* KV; unsigned char* K8;
    static constexpr int NBATCH = 1; typedef PreF Pre;
    __device__ __forceinline__ Pre load(int row, int) const { Pre p; p.r = rs[row]; return p; }
    __device__ __forceinline__ void chunk(int row, int col, const float (&v)[8], const Pre& p) const {
        const float r = p.r; float o[8];
#pragma unroll
        for (int i = 0; i < 8; ++i) o[i] = v[i] * r;
        if (col < 1024) *(u32x2*)(K8 + (size_t)row * 1024 + col) = pack8_fp8(o); else *(u32x4*)(KV + (size_t)row * 2048 + col) = pack8(o);
    } };
struct FK8 { const float* rs; unsigned char* K8;
    static constexpr int NBATCH = 1; typedef PreF Pre;
    __device__ __forceinline__ Pre load(int row, int) const { Pre p; p.r = rs[row]; return p; }
    __device__ __forceinline__ void chunk(int row, int col, const float (&v)[8], const Pre& p) const {
        const float r = p.r; float o[8];
#pragma unroll
        for (int i = 0; i < 8; ++i) o[i] = v[i] * r;
        *(u32x2*)(K8 + (size_t)row * 1024 + col) = pack8_fp8(o);
    } };
struct FVT8 { const float* rs; unsigned char* VT;
    static constexpr int NBATCH = 2;
    struct Pre { f32x4 a, b; };
    __device__ __forceinline__ Pre load(int, int col) const { Pre p; p.a = *(const f32x4*)(rs + col); p.b = *(const f32x4*)(rs + col + 4); return p; }
    __device__ __forceinline__ void chunk(int row, int col, const float (&v)[8], const Pre& p) const {
        const float o[8] = {v[0] * p.a[0], v[1] * p.a[1], v[2] * p.a[2], v[3] * p.a[3], v[4] * p.b[0], v[5] * p.b[1], v[6] * p.b[2], v[7] * p.b[3]};
        *(u32x2*)(VT + (size_t)(col >> 13) * ((size_t)1024 * SEQ) + (size_t)row * SEQ + (col & (SEQ - 1))) = pack8_fp8(o);
    } };
struct FPlain { bf16_t* O; int ldo;
    static constexpr int NBATCH = 1; typedef PreNone Pre;
    __device__ __forceinline__ Pre load(int, int) const { return Pre{}; }
    __device__ __forceinline__ void chunk(int row, int col, const float (&v)[8], const Pre&) const { *(u32x4*)(O + (size_t)row * ldo + col) = pack8(v); } };
struct FVW { bf16_t* O;
    static constexpr int NBATCH = 1; typedef PreNone Pre;
    __device__ __forceinline__ Pre load(int, int) const { return Pre{}; }
    __device__ __forceinline__ void chunk(int row, int col, const float (&v)[8], const Pre&) const { const int h = row >> 10, n = row & 1023; *(u32x4*)(O + (size_t)n * 1024 + h * 256 + col) = pack8(v); } };
struct FGateMul { const bf16_t* G; bf16_t* O;
    static constexpr int NBATCH = 2;
    struct Pre { u32x4 g; };
    __device__ __forceinline__ Pre load(int row, int col) const { Pre p; p.g = *(const u32x4*)(G + (size_t)row * 1024 + col); return p; }
    __device__ __forceinline__ void chunk(int row, int col, const float (&v)[8], const Pre& p) const {
        float g[8], o[8]; unpack8(p.g, g);
#pragma unroll
        for (int i = 0; i < 8; ++i) o[i] = g[i] * v[i];
        *(u32x4*)(O + (size_t)row * 1024 + col) = pack8(o);
    } };
struct FGateMulAdd { const bf16_t* G; const bf16_t* Pv; bf16_t* O;
    static constexpr int NBATCH = 2;
    struct Pre { u32x4 g, p; };
    __device__ __forceinline__ Pre load(int row, int col) const { Pre p; p.g = *(const u32x4*)(G + (size_t)row * 1024 + col); p.p = *(const u32x4*)(Pv + (size_t)row * 1024 + col); return p; }
    __device__ __forceinline__ void chunk(int row, int col, const float (&v)[8], const Pre& pr) const {
        float g[8], p[8], o[8]; unpack8(pr.g, g); unpack8(pr.p, p);
#pragma unroll
        for (int i = 0; i < 8; ++i) o[i] = p[i] + g[i] * v[i];
        *(u32x4*)(O + (size_t)row * 1024 + col) = pack8(o);
    } };
struct FResidF32 { const float* base; float* out;
    static constexpr int NBATCH = 2;
    struct Pre { f32x4 a, b; };
    __device__ __forceinline__ Pre load(int row, int col) const { const size_t off = (size_t)row * 1024 + col; Pre p; p.a = *(const f32x4*)(base + off); p.b = *(const f32x4*)(base + off + 4); return p; }
    __device__ __forceinline__ void chunk(int row, int col, const float (&v)[8], const Pre& p) const {
        const size_t off = (size_t)row * 1024 + col; const f32x4 a = p.a, b = p.b;
        *(f32x4*)(out + off) = (f32x4){a[0] + v[0], a[1] + v[1], a[2] + v[2], a[3] + v[3]}; *(f32x4*)(out + off + 4) = (f32x4){b[0] + v[4], b[1] + v[5], b[2] + v[6], b[3] + v[7]};
    } };
struct FResidBf16 { const bf16_t* base; bf16_t* out;
    static constexpr int NBATCH = 1;
    struct Pre { u32x4 a; };
    __device__ __forceinline__ Pre load(int row, int col) const { Pre p; p.a = *(const u32x4*)(base + (size_t)row * 1024 + col); return p; }
    __device__ __forceinline__ void chunk(int row, int col, const float (&v)[8], const Pre& p) const {
        float a[8], o[8]; unpack8(p.a, a);
#pragma unroll
        for (int i = 0; i < 8; ++i) o[i] = a[i] + v[i];
        *(u32x4*)(out + (size_t)row * 1024 + col) = pack8(o);
    } };
struct FGateRow { const float* gate; bf16_t* O;
    static constexpr int NBATCH = 1; typedef PreF Pre;
    __device__ __forceinline__ Pre load(int row, int) const { Pre p; p.r = gate[row]; return p; }
    __device__ __forceinline__ void chunk(int row, int col, const float (&v)[8], const Pre& p) const {
        const float r = p.r; float o[8];
#pragma unroll
        for (int i = 0; i < 8; ++i) o[i] = v[i] * r;
        *(u32x4*)(O + (size_t)row * 1024 + col) = pack8(o);
    } };

struct EpiX1 {
    static constexpr bool USES_LDS = false;
    const float* base; float* out; bf16_t* xb; float* ssq;
    __device__ __forceinline__ void run(pg8::Acc& acc, const Unit& u, int wr, int wc, int fr, int fq, LAS unsigned char*, int, int) const {
#pragma unroll
        for (int bt = 0; bt < 4; ++bt) { f32x4 pa[2][2], pb[2][2];
#pragma unroll
            for (int g = 0; g < 2; ++g) { const int rg = bt * 2 + g, ai = rg >> 2, m = rg & 3; const int row = u.pm * 256 + ai * 128 + wr * 64 + m * 16 + fr;
#pragma unroll
                for (int bj = 0; bj < 2; ++bj) { const size_t off = (size_t)row * 1024 + u.pn * 256 + bj * 128 + wc * 32 + 8 * fq; pa[g][bj] = *(const f32x4*)(base + off); pb[g][bj] = *(const f32x4*)(base + off + 4); } }
            asm volatile("" ::: "memory");
#pragma unroll
            for (int g = 0; g < 2; ++g) { const int rg = bt * 2 + g, ai = rg >> 2, m = rg & 3; const int row = u.pm * 256 + ai * 128 + wr * 64 + m * 16 + fr; float s = 0.f;
#pragma unroll
                for (int bj = 0; bj < 2; ++bj) { const int col = u.pn * 256 + bj * 128 + wc * 32 + 8 * fq; const size_t off = (size_t)row * 1024 + col;
                    const f32x4 a = pa[g][bj], b = pb[g][bj]; const f32x4 c0 = acc[ai][bj][m][0], c1 = acc[ai][bj][m][1];
                    const float o[8] = {a[0] + c0[0], a[1] + c0[1], a[2] + c0[2], a[3] + c0[3], b[0] + c1[0], b[1] + c1[1], b[2] + c1[2], b[3] + c1[3]};
                    if (out) { *(f32x4*)(out + off) = (f32x4){o[0], o[1], o[2], o[3]}; *(f32x4*)(out + off + 4) = (f32x4){o[4], o[5], o[6], o[7]}; }
                    *(u32x4*)(xb + off) = pack8(o);
#pragma unroll
                    for (int i = 0; i < 8; ++i) s += o[i] * o[i]; }
                s += __shfl_xor(s, 16); s += __shfl_xor(s, 32);
                if (fq == 0) ssq[(size_t)row * 16 + u.pn * 4 + wc] = s; }
            asm volatile("" ::: "memory"); }
    }
};
struct EpiSoftmax {
    static constexpr bool USES_LDS = true;
    const float* ssq; bf16_t* P;
    __device__ __forceinline__ void run(pg8::Acc& acc, const Unit& u, int wr, int wc, int fr, int fq, LAS unsigned char* scr, int wid_, int lane_) const {
        LAS float* PM = (LAS float*)scr;
        LAS float* PS = (LAS float*)(scr + 4096);
        LAS float* RS = (LAS float*)(scr + 4096);
        { const int t = wid_ * 64 + lane_; if (t < 256) { const f32x4* sp = (const f32x4*)((const char*)ssq + (unsigned)(u.pm * 256 + t) * 64u); const f32x4 q0 = sp[0], q1 = sp[1], q2 = sp[2], q3 = sp[3];
            float tt = ((q0[0] + q0[1]) + (q0[2] + q0[3])) + ((q1[0] + q1[1]) + (q1[2] + q1[3])); tt += ((q2[0] + q2[1]) + (q2[2] + q2[3])) + ((q3[0] + q3[1]) + (q3[2] + q3[3]));
            RS[t] = 1.f / sqrtf(tt * (1.f / 1024.f) + EPS); } }
        __syncthreads();
#pragma unroll
        for (int ai = 0; ai < 2; ++ai)
#pragma unroll
            for (int m = 0; m < 4; ++m) { const int rl = ai * 128 + wr * 64 + m * 16 + fr;
                const float rs = RS[rl];
                float mx = -3.0e38f;
#pragma unroll
                for (int bj = 0; bj < 2; ++bj)
#pragma unroll
                    for (int n = 0; n < 2; ++n)
#pragma unroll
                        for (int i = 0; i < 4; ++i) { const float s = acc[ai][bj][m][n][i] * rs; acc[ai][bj][m][n][i] = s; mx = fmaxf(mx, s); }
                mx = fmaxf(mx, __shfl_xor(mx, 16)); mx = fmaxf(mx, __shfl_xor(mx, 32));
                if (fq == 0) PM[rl * 4 + wc] = mx;
                asm volatile("" ::: "memory"); }
        __syncthreads();
#pragma unroll
        for (int ai = 0; ai < 2; ++ai)
#pragma unroll
            for (int m = 0; m < 4; ++m) { const int rl = ai * 128 + wr * 64 + m * 16 + fr;
                const f32x4 pm4 = *(const LAS f32x4*)(PM + rl * 4); const float mx = fmaxf(fmaxf(pm4[0], pm4[1]), fmaxf(pm4[2], pm4[3]));
                float s = 0.f;
#pragma unroll
                for (int bj = 0; bj < 2; ++bj)
#pragma unroll
                    for (int n = 0; n < 2; ++n)
#pragma unroll
                        for (int i = 0; i < 4; ++i) { const float e = __expf(acc[ai][bj][m][n][i] - mx); acc[ai][bj][m][n][i] = e; s += e; }
                s += __shfl_xor(s, 16); s += __shfl_xor(s, 32);
                if (fq == 0) PS[rl * 4 + wc] = s;
                asm volatile("" ::: "memory"); }
        __syncthreads();
#pragma unroll
        for (int ai = 0; ai < 2; ++ai)
#pragma unroll
            for (int m = 0; m < 4; ++m) { const int rl = ai * 128 + wr * 64 + m * 16 + fr; const int row = u.pm * 256 + rl;
                const f32x4 ps4 = *(const LAS f32x4*)(PS + rl * 4); const float inv = 1.f / ((ps4[0] + ps4[1]) + (ps4[2] + ps4[3]));
#pragma unroll
                for (int bj = 0; bj < 2; ++bj) { const int col = u.pn * 256 + bj * 128 + wc * 32 + 8 * fq; float o[8];
#pragma unroll
                    for (int n = 0; n < 2; ++n)
#pragma unroll
                        for (int i = 0; i < 4; ++i) o[n * 4 + i] = acc[ai][bj][m][n][i] * inv;
                    *(u32x4*)((char*)P + ((unsigned)row * 1024u + (unsigned)col) * 2u) = pack8(o); }
                asm volatile("" ::: "memory"); }
    }
};
struct EpiSwiglu {
    static constexpr bool USES_LDS = false;
    bf16_t* H;
    __device__ __forceinline__ void run(pg8::Acc& acc, const Unit& u, int wr, int wc, int fr, int fq, LAS unsigned char*, int, int) const {
#pragma unroll
        for (int ai = 0; ai < 2; ++ai)
#pragma unroll
            for (int m = 0; m < 4; ++m) { const int row = u.pm * 256 + ai * 128 + wr * 64 + m * 16 + fr; const int col = u.pn * 128 + wc * 32 + 8 * fq; float o[8];
#pragma unroll
                for (int n = 0; n < 2; ++n)
#pragma unroll
                    for (int i = 0; i < 4; ++i) { const float g = acc[ai][0][m][n][i], up = acc[ai][1][m][n][i]; o[n * 4 + i] = g / (1.f + __expf(-g)) * up; }
                *(u32x4*)(H + (size_t)row * 1024 + col) = pack8(o); }
    }
};

namespace att {
constexpr int QBLK = 32, KVBLK = 64, NW = 8;
constexpr int LDQ = 1536, LDKV = 2048, LDKR = 64, LDO = 1024;
constexpr int KPITCH = 272, KRPITCH = 144;
constexpr int SHM_V = KVBLK * 128 * 2, SHM_K = KVBLK * KPITCH, SHM_KR = KVBLK * KRPITCH;
constexpr int OFF_V = 0, OFF_K = 2 * SHM_V, OFF_KR = OFF_K + 2 * SHM_K, OFF_WS = OFF_KR + 2 * SHM_KR, OFF_QR = OFF_WS + NW * 64 * 4, SHM_ATTN = OFF_QR + NW * 4096;
constexpr float THR = 8.f;
#define KSWZ(row, colB) ((row) * KPITCH + (colB))
#define KRSWZ(row, colB) ((row) * KRPITCH + (colB))
#define SBAR() __builtin_amdgcn_sched_barrier(0)
__device__ __forceinline__ int crow(int r, int hi) { return (r & 3) + 8 * (r >> 2) + 4 * hi; }
__device__ __forceinline__ unsigned cvtpk_a(float lo, float hi) { unsigned r; asm volatile("v_cvt_pk_bf16_f32 %0, %1, %2" : "=v"(r) : "v"(lo), "v"(hi)); return r; }

__device__ __forceinline__ void partialSM(f32x16& p0, f32x16& p1, float& m_reg, float& mn, float& alpha) {
  constexpr float C = ATT_SCALE * 1.4426950408889634f;
  float pmax = p0[0];
#pragma unroll
  for (int r = 1; r < 16; ++r) pmax = fmaxf(pmax, p0[r]);
#pragma unroll
  for (int r = 0; r < 16; ++r) pmax = fmaxf(pmax, p1[r]);
  { auto rr = __builtin_amdgcn_permlane32_swap(__float_as_uint(pmax), __float_as_uint(pmax), false, false);
    pmax = fmaxf(__uint_as_float(rr[0]), __uint_as_float(rr[1])); }
  if (__builtin_expect(__all(pmax - m_reg <= THR / ATT_SCALE), 1)) { mn = m_reg; alpha = 1.f; }
  else { mn = fmaxf(m_reg, pmax); alpha = __builtin_amdgcn_exp2f((m_reg - mn) * C); m_reg = mn; }
  float mnC = -mn * C;
#pragma unroll
  for (int r = 0; r < 16; ++r) p0[r] = fmaf(p0[r], C, mnC);
#pragma unroll
  for (int r = 0; r < 16; ++r) p1[r] = fmaf(p1[r], C, mnC);
#pragma unroll
  for (int r = 0; r < 16; ++r) p0[r] = __builtin_amdgcn_exp2f(p0[r]);
}
__device__ __forceinline__ void finishSM(f32x16& p0, f32x16& p1, float alpha, float& l_reg, bf16x8& pa0, bf16x8& pa1, bf16x8& pa2, bf16x8& pa3) {
#pragma unroll
  for (int r = 0; r < 16; ++r) p1[r] = __builtin_amdgcn_exp2f(p1[r]);
  float ps = 0;
#pragma unroll
  for (int r = 0; r < 16; ++r) ps += p0[r];
#pragma unroll
  for (int r = 0; r < 16; ++r) ps += p1[r];
  { auto rr = __builtin_amdgcn_permlane32_swap(__float_as_uint(ps), __float_as_uint(ps), false, false);
    ps = __uint_as_float(rr[0]) + __uint_as_float(rr[1]); }
  l_reg = l_reg * alpha + ps;
#define PK4(P, BASE, OUT) do { unsigned a0 = cvtpk_a(P[BASE + 0], P[BASE + 1]), a1 = cvtpk_a(P[BASE + 2], P[BASE + 3]);   \
    unsigned b0 = cvtpk_a(P[BASE + 4], P[BASE + 5]), b1 = cvtpk_a(P[BASE + 6], P[BASE + 7]);                              \
    auto r0 = __builtin_amdgcn_permlane32_swap(a0, b0, false, false); auto r1 = __builtin_amdgcn_permlane32_swap(a1, b1, false, false); \
    u32x4 w = {r0[0], r1[0], r0[1], r1[1]}; OUT = *reinterpret_cast<bf16x8*>(&w); } while (0)
  PK4(p0, 0, pa0); PK4(p0, 8, pa1); PK4(p1, 0, pa2); PK4(p1, 8, pa3);
#undef PK4
}
__device__ __forceinline__ void qkt(f32x16& p0, f32x16& p1, const char* Ks, const char* Krs, const bf16x8* qr, const char* qpark, int r32, int hi) {
  p0 = f32x16{}; p1 = f32x16{};
  const char* kb = Ks + r32 * KPITCH + hi * 16; const char* rb = Krs + r32 * KRPITCH + hi * 16;
#pragma unroll
  for (int d0 = 0; d0 < 8; ++d0) {
    bf16x8 b0 = *reinterpret_cast<const bf16x8*>(kb + d0 * 32);
    bf16x8 b1 = *reinterpret_cast<const bf16x8*>(kb + 32 * KPITCH + d0 * 32);
    p0 = __builtin_amdgcn_mfma_f32_32x32x16_bf16(b0, qr[d0], p0, 0, 0, 0);
    p1 = __builtin_amdgcn_mfma_f32_32x32x16_bf16(b1, qr[d0], p1, 0, 0, 0); }
#pragma unroll
  for (int d0 = 0; d0 < 4; ++d0) {
    bf16x8 b0 = *reinterpret_cast<const bf16x8*>(rb + d0 * 32);
    bf16x8 b1 = *reinterpret_cast<const bf16x8*>(rb + 32 * KRPITCH + d0 * 32);
    const bf16x8 qf = qr[8 + d0];
    p0 = __builtin_amdgcn_mfma_f32_32x32x16_bf16(b0, qf, p0, 0, 0, 0);
    p1 = __builtin_amdgcn_mfma_f32_32x32x16_bf16(b1, qf, p1, 0, 0, 0); }
}
__device__ __forceinline__ int v_st(int k, int c) { const int kk = (k & ~0xC) | ((k & 4) << 1) | ((k & 8) >> 1); return ((kk >> 3) * 4 + (c >> 5)) * 512 + ((kk & 7) * 32 + (c & 31)) * 2; }
__device__ __forceinline__ int v_rd_base(int lane) { return ((lane & 3) << 3) | (((lane >> 2) & 3) << 6) | (((lane >> 4) & 1) << 5) | (((lane >> 5) & 1) << 8); }
constexpr int v_rd_off(int d0, int ks, int half) { return d0 * 512 + ks * 4096 + half * 2048; }
template <int OFF> __device__ __forceinline__ s16x4 tr_read(int vb) {
  s16x4 r; asm volatile("ds_read_b64_tr_b16 %0, %1 offset:%2" : "=&v"(r) : "v"(vb), "i"(OFF) : "memory"); return r;
}
template <int D0> __device__ __forceinline__ void pv_one(f32x16& od, int vb, bf16x8 pa0, bf16x8 pa1, bf16x8 pa2, bf16x8 pa3) {
  const s16x4 l0 = tr_read<v_rd_off(D0, 0, 0)>(vb), h0 = tr_read<v_rd_off(D0, 0, 1)>(vb), l1 = tr_read<v_rd_off(D0, 1, 0)>(vb), h1 = tr_read<v_rd_off(D0, 1, 1)>(vb);
  const s16x4 l2 = tr_read<v_rd_off(D0, 2, 0)>(vb), h2 = tr_read<v_rd_off(D0, 2, 1)>(vb), l3 = tr_read<v_rd_off(D0, 3, 0)>(vb), h3 = tr_read<v_rd_off(D0, 3, 1)>(vb);
  asm volatile("s_waitcnt lgkmcnt(0)" ::: "memory"); SBAR();
#define PK(L, H) (bf16x8){L[0], L[1], L[2], L[3], H[0], H[1], H[2], H[3]}
  od = __builtin_amdgcn_mfma_f32_32x32x16_bf16(pa0, PK(l0, h0), od, 0, 0, 0);
  od = __builtin_amdgcn_mfma_f32_32x32x16_bf16(pa1, PK(l1, h1), od, 0, 0, 0);
  od = __builtin_amdgcn_mfma_f32_32x32x16_bf16(pa2, PK(l2, h2), od, 0, 0, 0);
  od = __builtin_amdgcn_mfma_f32_32x32x16_bf16(pa3, PK(l3, h3), od, 0, 0, 0);
#undef PK
}
__device__ __forceinline__ void pv_d0(f32x16* o, int vb, bf16x8 pa0, bf16x8 pa1, bf16x8 pa2, bf16x8 pa3) {
  pv_one<0>(o[0], vb, pa0, pa1, pa2, pa3); pv_one<1>(o[1], vb, pa0, pa1, pa2, pa3); pv_one<2>(o[2], vb, pa0, pa1, pa2, pa3); pv_one<3>(o[3], vb, pa0, pa1, pa2, pa3);
}

__device__ __forceinline__ void attn_unit(const bf16_t* __restrict__ Qn, const bf16_t* __restrict__ Qr, const bf16_t* __restrict__ Kh,
                                          const bf16_t* __restrict__ Krh, bf16_t* __restrict__ Ob, int seq, char* lds, const int tid) {
  const int wid = tid >> 6, lane = tid & 63, r32 = lane & 31, hi = lane >> 5;
  char* V_lds = lds + OFF_V; char* K_lds = lds + OFF_K; char* Kr_lds = lds + OFF_KR;
  float* ws = (float*)(lds + OFF_WS) + wid * 64; float* li_l = ws; float* al_l = ws + 32;
  float m_reg = -1e30f, l_reg = 0; f32x16 o[4] = {}; bf16x8 qr[12];
  char* qpark = nullptr;
  { const bf16_t* qn = Qn + (long)(wid * QBLK + r32) * LDQ + hi * 8; const bf16_t* qq = Qr + (long)(wid * QBLK + r32) * LDQ + hi * 8;
#pragma unroll
    for (int d0 = 0; d0 < 8; ++d0) qr[d0] = *reinterpret_cast<const bf16x8*>(qn + d0 * 16);
#pragma unroll
    for (int d0 = 0; d0 < 4; ++d0) qr[8 + d0] = *reinterpret_cast<const bf16x8*>(qq + d0 * 16); }
  const int sr = tid >> 4, sc = (tid & 15) * 8, vst0 = v_st(sr, sc), vst1 = v_st(32 + sr, sc);
  const int krr = tid >> 3, krc = (tid & 7) * 8;
  const int vb0 = (int)(uintptr_t)V_lds + v_rd_base(lane);
  bf16x8 vs0, vs1, ks0, ks1, kr0;
  const unsigned offkv = (unsigned)(sr * LDKV + sc) * 2u, offkr = (unsigned)(krr * LDKR + krc) * 2u;
#define SLOAD(k0) do { const char* kb_ = (const char*)Kh + (size_t)(k0) * (LDKV * 2); const char* kb2_ = kb_ + 32 * LDKV * 2; const char* rb_ = (const char*)Krh + (size_t)(k0) * (LDKR * 2); \
    ks0 = *reinterpret_cast<const bf16x8*>(kb_ + offkv); vs0 = *reinterpret_cast<const bf16x8*>(kb_ + offkv + 2048); \
    ks1 = *reinterpret_cast<const bf16x8*>(kb2_ + offkv); vs1 = *reinterpret_cast<const bf16x8*>(kb2_ + offkv + 2048); \
    kr0 = *reinterpret_cast<const bf16x8*>(rb_ + offkr); } while (0)
#define SWRITE(b) do { *(bf16x8*)(V_lds + (b) * SHM_V + vst0) = vs0; *(bf16x8*)(V_lds + (b) * SHM_V + vst1) = vs1; const int kc = sc * 2; \
    *(bf16x8*)(K_lds + (b) * SHM_K + KSWZ(sr, kc)) = ks0; *(bf16x8*)(K_lds + (b) * SHM_K + KSWZ(32 + sr, kc)) = ks1; \
    *(bf16x8*)(Kr_lds + (b) * SHM_KR + KRSWZ(krr, krc * 2)) = kr0; } while (0)
#define SWAIT() asm volatile("s_waitcnt vmcnt(0)" ::: "memory")
#define RESC(a) do { if (__any((a) < 1.f)) { if (hi == 0) al_l[r32] = (a); asm volatile("s_waitcnt lgkmcnt(0)" ::: "memory"); \
    _Pragma("unroll") for (int d = 0; d < 4; ++d) _Pragma("unroll") for (int r = 0; r < 16; ++r) o[d][r] *= al_l[crow(r, hi)]; } } while (0)
  f32x16 pA0, pA1, pB0, pB1; float mnA, mnB, alA, alB; bf16x8 pa0, pa1, pa2, pa3; const int NT = seq / KVBLK;
  SLOAD(0); SWAIT(); SWRITE(0); __syncthreads();
  qkt(pA0, pA1, K_lds, Kr_lds, qr, qpark, r32, hi); partialSM(pA0, pA1, m_reg, mnA, alA);
  SLOAD(KVBLK);
  SWAIT(); SWRITE(1); __syncthreads();
  for (int j = 1; j + 1 < NT; j += 2) {
    SBAR(); qkt(pB0, pB1, K_lds + SHM_K, Kr_lds + SHM_KR, qr, qpark, r32, hi);
    finishSM(pA0, pA1, alA, l_reg, pa0, pa1, pa2, pa3); SBAR();
    SLOAD((j + 1) * KVBLK); SBAR();
    pv_d0(o, vb0, pa0, pa1, pa2, pa3); partialSM(pB0, pB1, m_reg, mnB, alB);
    __syncthreads(); SWAIT(); SWRITE(0);
    RESC(alB); __syncthreads();
    SBAR(); qkt(pA0, pA1, K_lds, Kr_lds, qr, qpark, r32, hi);
    finishSM(pB0, pB1, alB, l_reg, pa0, pa1, pa2, pa3); SBAR();
    SLOAD((j + 2) * KVBLK); SBAR();
    pv_d0(o, vb0 + SHM_V, pa0, pa1, pa2, pa3); partialSM(pA0, pA1, m_reg, mnA, alA);
    __syncthreads(); SWAIT(); SWRITE(1);
    RESC(alA); __syncthreads();
  }
  SBAR(); qkt(pB0, pB1, K_lds + SHM_K, Kr_lds + SHM_KR, qr, qpark, r32, hi);
  finishSM(pA0, pA1, alA, l_reg, pa0, pa1, pa2, pa3); SBAR();
  pv_d0(o, vb0, pa0, pa1, pa2, pa3); partialSM(pB0, pB1, m_reg, mnB, alB);
  __syncthreads(); RESC(alB);
  finishSM(pB0, pB1, alB, l_reg, pa0, pa1, pa2, pa3); SBAR();
  pv_d0(o, vb0 + SHM_V, pa0, pa1, pa2, pa3);
  if (hi == 0) li_l[r32] = l_reg; asm volatile("s_waitcnt lgkmcnt(0)" ::: "memory");
  float rli[16];
#pragma unroll
  for (int r = 0; r < 16; ++r) rli[r] = __builtin_amdgcn_rcpf(li_l[crow(r, hi)]);
  bf16_t* Ow = Ob + (long)(wid * QBLK) * LDO;
#pragma unroll
  for (int r = 0; r < 16; ++r) { const int orow = crow(r, hi);
#pragma unroll
    for (int d0 = 0; d0 < 4; ++d0) Ow[(long)orow * LDO + d0 * 32 + r32] = f2bf(o[d0][r] * rli[r]); }
  __syncthreads();
#undef SLOAD
#undef SWRITE
#undef SWAIT
#undef RESC
}

constexpr int K8P = 144, KR8P = 80, SHM_K8 = KVBLK * K8P, SHM_KR8 = KVBLK * KR8P;
constexpr int O8_V = 0, O8_K = 2 * SHM_V, O8_KR = O8_K + 2 * SHM_K8, O8_WS = O8_KR + 2 * SHM_KR8, SHM_ATTN8 = O8_WS + NW * 64 * 4;
__device__ __forceinline__ v8i ld32(const char* p) { const u32x4 a = *reinterpret_cast<const u32x4*>(p), b = *reinterpret_cast<const u32x4*>(p + 16); return (v8i){(int)a.x, (int)a.y, (int)a.z, (int)a.w, (int)b.x, (int)b.y, (int)b.z, (int)b.w}; }
__device__ __forceinline__ void qkt8(f32x16& p0, f32x16& p1, const char* Ks, const char* Krs, const v8i* qf, int r32, int hi) {
  p0 = f32x16{}; p1 = f32x16{};
  const char* kb = Ks + r32 * K8P + hi * 32; const char* rb = Krs + r32 * KR8P + hi * 32;
#pragma unroll
  for (int st = 0; st < 2; ++st) { const v8i a0 = ld32(kb + st * 64), a1 = ld32(kb + 32 * K8P + st * 64);
    p0 = __builtin_amdgcn_mfma_scale_f32_32x32x64_f8f6f4(a0, qf[st], p0, 0, 0, 0, 0x7f7f7f7f, 0, 0x7f7f7f7f);
    p1 = __builtin_amdgcn_mfma_scale_f32_32x32x64_f8f6f4(a1, qf[st], p1, 0, 0, 0, 0x7f7f7f7f, 0, 0x7f7f7f7f); }
  { const v8i a0 = ld32(rb), a1 = ld32(rb + 32 * KR8P);
    p0 = __builtin_amdgcn_mfma_scale_f32_32x32x64_f8f6f4(a0, qf[2], p0, 0, 0, 0, 0x7f7f7f7f, 0, 0x7f7f7f7f);
    p1 = __builtin_amdgcn_mfma_scale_f32_32x32x64_f8f6f4(a1, qf[2], p1, 0, 0, 0, 0x7f7f7f7f, 0, 0x7f7f7f7f); }
}
__device__ __forceinline__ void attn_unit8(const unsigned char* __restrict__ Q8n, const unsigned char* __restrict__ Q8r, const unsigned char* __restrict__ K8h,
                                           const unsigned char* __restrict__ Kr8, const bf16_t* __restrict__ Vh, bf16_t* __restrict__ Ob, int seq, char* lds, const int tid) {
  const int wid = tid >> 6, lane = tid & 63, r32 = lane & 31, hi = lane >> 5;
  char* V_lds = lds + O8_V; char* K_lds = lds + O8_K; char* Kr_lds = lds + O8_KR;
  float* ws = (float*)(lds + O8_WS) + wid * 64; float* li_l = ws; float* al_l = ws + 32;
  float m_reg = -1e30f, l_reg = 0; f32x16 o[4] = {}; v8i qf[3];
  { const unsigned char* qn = Q8n + (long)(wid * QBLK + r32) * LDQ + hi * 32; const unsigned char* qq = Q8r + (long)(wid * QBLK + r32) * LDQ + hi * 32;
    qf[0] = ld32((const char*)qn); qf[1] = ld32((const char*)qn + 64); qf[2] = ld32((const char*)qq); }
  const int sr = tid >> 4, sc = (tid & 15) * 8, vst0 = v_st(sr, sc), vst1 = v_st(32 + sr, sc);
  const int k8r = tid >> 3, k8c = (tid & 7) * 16;
  const int r8r = (tid & 255) >> 2, r8c = (tid & 3) * 16;
  const int vb0 = (int)(uintptr_t)V_lds + v_rd_base(lane);
  bf16x8 vs0, vs1; u32x4 k8v, r8v;
  const unsigned offv = (unsigned)(sr * LDKV + sc) * 2u, offk8 = (unsigned)(k8r * 1024 + k8c), offr8 = (unsigned)(r8r * 64 + r8c);
#define SLOAD(k0) do { const char* vb_ = (const char*)Vh + (size_t)(k0) * (LDKV * 2); const char* vb2_ = vb_ + 32 * LDKV * 2; \
    vs0 = *reinterpret_cast<const bf16x8*>(vb_ + offv); vs1 = *reinterpret_cast<const bf16x8*>(vb2_ + offv); \
    k8v = *reinterpret_cast<const u32x4*>((const char*)K8h + (size_t)(k0) * 1024 + offk8); \
    if (tid < 256) r8v = *reinterpret_cast<const u32x4*>((const char*)Kr8 + (size_t)(k0) * 64 + offr8); } while (0)
#define SWRITE(b) do { *(bf16x8*)(V_lds + (b) * SHM_V + vst0) = vs0; *(bf16x8*)(V_lds + (b) * SHM_V + vst1) = vs1; \
    *(u32x4*)(K_lds + (b) * SHM_K8 + k8r * K8P + k8c) = k8v; if (tid < 256) *(u32x4*)(Kr_lds + (b) * SHM_KR8 + r8r * KR8P + r8c) = r8v; } while (0)
#define SWAIT() asm volatile("s_waitcnt vmcnt(0)" ::: "memory")
#define RESC(a) do { if (__any((a) < 1.f)) { if (hi == 0) al_l[r32] = (a); asm volatile("s_waitcnt lgkmcnt(0)" ::: "memory"); \
    _Pragma("unroll") for (int d = 0; d < 4; ++d) _Pragma("unroll") for (int r = 0; r < 16; ++r) o[d][r] *= al_l[crow(r, hi)]; } } while (0)
  f32x16 pA0, pA1, pB0, pB1; float mnA, mnB, alA, alB; bf16x8 pa0, pa1, pa2, pa3; const int NT = seq / KVBLK;
  SLOAD(0); SWAIT(); SWRITE(0); __syncthreads();
  qkt8(pA0, pA1, K_lds, Kr_lds, qf, r32, hi); partialSM(pA0, pA1, m_reg, mnA, alA);
  SLOAD(KVBLK);
  SWAIT(); SWRITE(1); __syncthreads();
  for (int j = 1; j + 1 < NT; j += 2) {
    SBAR(); qkt8(pB0, pB1, K_lds + SHM_K8, Kr_lds + SHM_KR8, qf, r32, hi);
    finishSM(pA0, pA1, alA, l_reg, pa0, pa1, pa2, pa3); SBAR();
    SLOAD((j + 1) * KVBLK); SBAR();
    pv_d0(o, vb0, pa0, pa1, pa2, pa3); partialSM(pB0, pB1, m_reg, mnB, alB);
    __syncthreads(); SWAIT(); SWRITE(0);
    RESC(alB); __syncthreads();
    SBAR(); qkt8(pA0, pA1, K_lds, Kr_lds, qf, r32, hi);
    finishSM(pB0, pB1, alB, l_reg, pa0, pa1, pa2, pa3); SBAR();
    SLOAD((j + 2) * KVBLK); SBAR();
    pv_d0(o, vb0 + SHM_V, pa0, pa1, pa2, pa3); partialSM(pA0, pA1, m_reg, mnA, alA);
    __syncthreads(); SWAIT(); SWRITE(1);
    RESC(alA); __syncthreads();
  }
  SBAR(); qkt8(pB0, pB1, K_lds + SHM_K8, Kr_lds + SHM_KR8, qf, r32, hi);
  finishSM(pA0, pA1, alA, l_reg, pa0, pa1, pa2, pa3); SBAR();
  pv_d0(o, vb0, pa0, pa1, pa2, pa3); partialSM(pB0, pB1, m_reg, mnB, alB);
  __syncthreads(); RESC(alB);
  finishSM(pB0, pB1, alB, l_reg, pa0, pa1, pa2, pa3); SBAR();
  pv_d0(o, vb0 + SHM_V, pa0, pa1, pa2, pa3);
  if (hi == 0) li_l[r32] = l_reg; asm volatile("s_waitcnt lgkmcnt(0)" ::: "memory");
  float rli[16];
#pragma unroll
  for (int r = 0; r < 16; ++r) rli[r] = __builtin_amdgcn_rcpf(li_l[crow(r, hi)]);
  bf16_t* Ow = Ob + (long)(wid * QBLK) * LDO;
#pragma unroll
  for (int r = 0; r < 16; ++r) { const int orow = crow(r, hi);
#pragma unroll
    for (int d0 = 0; d0 < 4; ++d0) Ow[(long)orow * LDO + d0 * 32 + r32] = f2bf(o[d0][r] * rli[r]); }
  __syncthreads();
#undef SLOAD
#undef SWRITE
#undef SWAIT
#undef RESC
}

constexpr int V8P = 80, SHM_V8 = 128 * V8P;
constexpr int O9_V = 0, O9_K = 2 * SHM_V8, O9_KR = O9_K + 2 * SHM_K8, O9_WS = O9_KR + 2 * SHM_KR8, SHM_ATTN9 = O9_WS + NW * 64 * 4;
constexpr float THR9 = 2.f;
__device__ __forceinline__ void partialSM9(f32x16& p0, f32x16& p1, float& m_reg, float& mn, float& alpha) {
  constexpr float C = ATT_SCALE * 1.4426950408889634f;
  float pmax = p0[0];
#pragma unroll
  for (int r = 1; r < 16; ++r) pmax = fmaxf(pmax, p0[r]);
#pragma unroll
  for (int r = 0; r < 16; ++r) pmax = fmaxf(pmax, p1[r]);
  { auto rr = __builtin_amdgcn_permlane32_swap(__float_as_uint(pmax), __float_as_uint(pmax), false, false);
    pmax = fmaxf(__uint_as_float(rr[0]), __uint_as_float(rr[1])); }
  if (__builtin_expect(__all(pmax - m_reg <= THR9 / ATT_SCALE), 1)) { mn = m_reg; alpha = 1.f; }
  else { mn = fmaxf(m_reg, pmax); alpha = __builtin_amdgcn_exp2f((m_reg - mn) * C); m_reg = mn; }
  float mnC = 4.f - mn * C;
#pragma unroll
  for (int r = 0; r < 16; ++r) p0[r] = fmaf(p0[r], C, mnC);
#pragma unroll
  for (int r = 0; r < 16; ++r) p1[r] = fmaf(p1[r], C, mnC);
#pragma unroll
  for (int r = 0; r < 16; ++r) p0[r] = __builtin_amdgcn_exp2f(p0[r]);
}
__device__ __forceinline__ void finishSM9(f32x16& p0, f32x16& p1, float alpha, float& l_reg, v8i& pf) {
#pragma unroll
  for (int r = 0; r < 16; ++r) p1[r] = __builtin_amdgcn_exp2f(p1[r]);
  float ps = 0;
#pragma unroll
  for (int r = 0; r < 16; ++r) ps += p0[r];
#pragma unroll
  for (int r = 0; r < 16; ++r) ps += p1[r];
  { auto rr = __builtin_amdgcn_permlane32_swap(__float_as_uint(ps), __float_as_uint(ps), false, false);
    ps = __uint_as_float(rr[0]) + __uint_as_float(rr[1]); }
  l_reg = l_reg * alpha + ps;
  unsigned a[4], b[4];
#pragma unroll
  for (int i = 0; i < 4; ++i) { a[i] = pk4_fp8(p0[4 * i], p0[4 * i + 1], p0[4 * i + 2], p0[4 * i + 3]); b[i] = pk4_fp8(p1[4 * i], p1[4 * i + 1], p1[4 * i + 2], p1[4 * i + 3]); }
#pragma unroll
  for (int i = 0; i < 4; ++i) { auto r = __builtin_amdgcn_permlane32_swap(a[i], b[i], false, false); pf[i] = (int)r[0]; pf[4 + i] = (int)r[1]; }
}
__device__ __forceinline__ void pv9(f32x16* o, const char* Vs, const v8i pf, int r32, int hi) {
  const char* vb = Vs + r32 * V8P + hi * 32;
#pragma unroll
  for (int d0 = 0; d0 < 4; ++d0) { const v8i vf = ld32(vb + d0 * 32 * V8P);
    o[d0] = __builtin_amdgcn_mfma_scale_f32_32x32x64_f8f6f4(pf, vf, o[d0], 0, 0, 0, 0x7f7f7f7f, 0, 0x7f7f7f7f); }
}
__device__ __forceinline__ void attn_unit9(const unsigned char* __restrict__ Q8n, const unsigned char* __restrict__ Q8r, const unsigned char* __restrict__ K8h,
                                           const unsigned char* __restrict__ Kr8, const unsigned char* __restrict__ VTh, bf16_t* __restrict__ Ob, int seq, char* lds, const int tid) {
  const int wid = tid >> 6, lane = tid & 63, r32 = lane & 31, hi = lane >> 5;
  char* V_lds = lds + O9_V; char* K_lds = lds + O9_K; char* Kr_lds = lds + O9_KR;
  float* ws = (float*)(lds + O9_WS) + wid * 64; float* li_l = ws; float* al_l = ws + 32;
  float m_reg = -1e30f, l_reg = 0; f32x16 o[4] = {}; v8i qf[3];
  { const unsigned char* qn = Q8n + (long)(wid * QBLK + r32) * LDQ + hi * 32; const unsigned char* qq = Q8r + (long)(wid * QBLK + r32) * LDQ + hi * 32;
    qf[0] = ld32((const char*)qn); qf[1] = ld32((const char*)qn + 64); qf[2] = ld32((const char*)qq); }
  const int k8r = tid >> 3, k8c = (tid & 7) * 16;
  const int r8r = (tid & 255) >> 2, r8c = (tid & 3) * 16;
  const int v8d = tid >> 2, v8c = tid & 3;
  const int v8w = v8d * V8P + (v8c >> 1) * 32 + (v8c & 1) * 8;
  u32x4 v8v, k8v, r8v;
  const unsigned offv8 = (unsigned)(v8d * SEQ + v8c * 16), offk8 = (unsigned)(k8r * 1024 + k8c), offr8 = (unsigned)(r8r * 64 + r8c);
#define SLOAD(k0) do { v8v = *reinterpret_cast<const u32x4*>((const char*)VTh + (size_t)(k0) + offv8); \
    k8v = *reinterpret_cast<const u32x4*>((const char*)K8h + (size_t)(k0) * 1024 + offk8); \
    if (tid < 256) r8v = *reinterpret_cast<const u32x4*>((const char*)Kr8 + (size_t)(k0) * 64 + offr8); } while (0)
#define SWRITE(b) do { char* vp_ = V_lds + (b) * SHM_V8 + v8w; *(unsigned*)(vp_) = v8v.x; *(unsigned*)(vp_ + 16) = v8v.y; *(unsigned*)(vp_ + 4) = v8v.z; *(unsigned*)(vp_ + 20) = v8v.w; \
    *(u32x4*)(K_lds + (b) * SHM_K8 + k8r * K8P + k8c) = k8v; if (tid < 256) *(u32x4*)(Kr_lds + (b) * SHM_KR8 + r8r * KR8P + r8c) = r8v; } while (0)
#define SWAIT() asm volatile("s_waitcnt vmcnt(0)" ::: "memory")
#define RESC(a) do { if (__any((a) < 1.f)) { if (hi == 0) al_l[r32] = (a); asm volatile("s_waitcnt lgkmcnt(0)" ::: "memory"); \
    _Pragma("unroll") for (int d = 0; d < 4; ++d) _Pragma("unroll") for (int r = 0; r < 16; ++r) o[d][r] *= al_l[crow(r, hi)]; } } while (0)
  f32x16 pA0, pA1, pB0, pB1; float mnA, mnB, alA, alB; v8i pf; const int NT = seq / KVBLK;
  SLOAD(0); SWAIT(); SWRITE(0); __syncthreads();
  qkt8(pA0, pA1, K_lds, Kr_lds, qf, r32, hi); partialSM9(pA0, pA1, m_reg, mnA, alA);
  SLOAD(KVBLK);
  SWAIT(); SWRITE(1); __syncthreads();
  for (int j = 1; j + 1 < NT; j += 2) {
    SBAR(); qkt8(pB0, pB1, K_lds + SHM_K8, Kr_lds + SHM_KR8, qf, r32, hi);
    finishSM9(pA0, pA1, alA, l_reg, pf); SBAR();
    SLOAD((j + 1) * KVBLK); SBAR();
    pv9(o, V_lds, pf, r32, hi); partialSM9(pB0, pB1, m_reg, mnB, alB);
    __syncthreads(); SWAIT(); SWRITE(0);
    RESC(alB); __syncthreads();
    SBAR(); qkt8(pA0, pA1, K_lds, Kr_lds, qf, r32, hi);
    finishSM9(pB0, pB1, alB, l_reg, pf); SBAR();
    SLOAD((j + 2) * KVBLK); SBAR();
    pv9(o, V_lds + SHM_V8, pf, r32, hi); partialSM9(pA0, pA1, m_reg, mnA, alA);
    __syncthreads(); SWAIT(); SWRITE(1);
    RESC(alA); __syncthreads();
  }
  SBAR(); qkt8(pB0, pB1, K_lds + SHM_K8, Kr_lds + SHM_KR8, qf, r32, hi);
  finishSM9(pA0, pA1, alA, l_reg, pf); SBAR();
  pv9(o, V_lds, pf, r32, hi); partialSM9(pB0, pB1, m_reg, mnB, alB);
  __syncthreads(); RESC(alB);
  finishSM9(pB0, pB1, alB, l_reg, pf); SBAR();
  pv9(o, V_lds + SHM_V8, pf, r32, hi);
  if (hi == 0) li_l[r32] = l_reg; asm volatile("s_waitcnt lgkmcnt(0)" ::: "memory");
  float rli[16];
#pragma unroll
  for (int r = 0; r < 16; ++r) rli[r] = __builtin_amdgcn_rcpf(li_l[crow(r, hi)]);
  bf16_t* Ow = Ob + (long)(wid * QBLK) * LDO;
#pragma unroll
  for (int r = 0; r < 16; ++r) { const int orow = crow(r, hi);
#pragma unroll
    for (int d0 = 0; d0 < 4; ++d0) Ow[(long)orow * LDO + d0 * 32 + r32] = f2bf(o[d0][r] * rli[r]); }
  __syncthreads();
#undef SLOAD
#undef SWRITE
#undef SWAIT
#undef RESC
}
#undef SBAR
}

constexpr int NWAVES = 8;
constexpr int N_LAUNCHES = MK_N_LAUNCHES;
constexpr int N_PHASES = 15;
static_assert(N_LAUNCHES == 1 || N_LAUNCHES == N_PHASES, "MK_N_LAUNCHES is 1 or 15");

constexpr size_t MiB = 1u << 20;
constexpr size_t WS_CTL = 0, CTL_ZERO_BYTES = 32768;
constexpr size_t WS_ROPE = 1 * MiB;
constexpr size_t WS_RSTD0 = 3 * MiB, WS_RSTDQ = WS_RSTD0 + 65536, WS_RSTDKV = WS_RSTDQ + 65536, WS_RSTDM = WS_RSTDKV + 65536;
constexpr size_t WS_SSQ = 4 * MiB;
constexpr size_t WS_AFF = 5 * MiB;
constexpr size_t WS_INV = 6 * MiB;
constexpr size_t WS_IDX = 7 * MiB, WS_GATE = WS_IDX + 131072;
constexpr size_t WS_MEMB = 8 * MiB;
constexpr size_t WS_MKV = 9 * MiB;
constexpr size_t WS_QKT = 11 * MiB, WS_VWT = 15 * MiB;
constexpr size_t WS_WIN = 19 * MiB;
constexpr size_t WS_WCO = 30 * MiB, WS_WMO = 32 * MiB, WS_WMIX = 34 * MiB, WS_WUQ = 36 * MiB, WS_WUKV = 37 * MiB, WS_WMQH = 38 * MiB, WS_WOHT = 40 * MiB, WS_WMKV = 42 * MiB;
constexpr size_t WS_XGG = 48 * MiB, WS_QB = 48 * MiB, WS_MIXA = 96 * MiB, WS_WGU = 48 * MiB, WS_WD = 112 * MiB, WS_Y = 48 * MiB;
constexpr size_t WS_XB = 144 * MiB, WS_ACONV = 144 * MiB, WS_OB = 144 * MiB, WS_X1B = 144 * MiB, WS_XG = 144 * MiB;
constexpr size_t WS_SIGA = 176 * MiB, WS_MIXED = 176 * MiB, WS_PM = 176 * MiB;
constexpr size_t WS_SIGB = 208 * MiB, WS_H3 = 208 * MiB, WS_H = 144 * MiB;
constexpr size_t WS_CQ = 240 * MiB, WS_CKV = 248 * MiB, WS_KR = 252 * MiB, WS_KROPE = 254 * MiB;
constexpr size_t WS_KN8 = 128 * MiB;
constexpr size_t WS_X2B = 256 * MiB;
constexpr size_t WS_END = RESID_BF16 ? 288 * MiB : 256 * MiB;
constexpr int CW_TMO = 0, CW_BAR = 4096;

constexpr int RING_BYTES = 131072, EPI_OFF = 131072, EPI_BYTES = 8192, LDSCTL_OFF = 140288, MISC_OFF = LDSCTL_OFF + 320;
constexpr int LDS_BYTES = 148480;
static_assert(2 * 16 * 1028 * 4 + 8192 <= LDSCTL_OFF && EPI_OFF + EPI_BYTES <= LDSCTL_OFF, "LDS map (router, epilogue scratch)");
static_assert(MISC_OFF + 128 <= LDS_BYTES && att::SHM_ATTN <= RING_BYTES && att::SHM_ATTN8 <= RING_BYTES, "LDS map");

typedef GAS unsigned gu32;
#define RLX_AGENT __ATOMIC_RELAXED, __HIP_MEMORY_SCOPE_AGENT

#define XB_TMO      128
#define XB_XCNT(j)  (256  + 64 * (j))
#define XB_XSUB(j)  (1280 + 64 * (j))
#define XB_XGEN(j)  (2304 + 64 * (j))
#define XB_TOP      3328
#define XB_TOPGEN   3392
#define XCD_BAR_WORDS 3456
#define XB_SPIN_CAP (1u << 18)
__device__ __forceinline__ unsigned xb_ld(unsigned* p)              { return __hip_atomic_load(p, __ATOMIC_RELAXED, __HIP_MEMORY_SCOPE_AGENT); }
__device__ __forceinline__ unsigned xb_add(unsigned* p, unsigned v) { return __hip_atomic_fetch_add(p, v, __ATOMIC_RELAXED, __HIP_MEMORY_SCOPE_AGENT); }
__device__ __forceinline__ unsigned xb_xcc_id() { return (unsigned)__builtin_amdgcn_s_getreg((3 << 11) | 20) & 0xFu; }
#define XB_SPIN(cond, bar) do { unsigned _sp = 0; while (cond) { __builtin_amdgcn_s_sleep(1); \
    if ((++_sp & 255u) == 0u) { if (xb_ld(&(bar)[XB_TMO])) break; if (_sp > XB_SPIN_CAP) { atomicAdd(&(bar)[XB_TMO], 1u); break; } } } } while (0)
struct XcdBarrier { unsigned* bar; unsigned x; volatile LAS unsigned* st; };
__device__ __forceinline__ XcdBarrier xcd_barrier_post(unsigned* bar, volatile LAS unsigned* st, const bool t0) {
    XcdBarrier b; b.bar = bar; b.x = xb_xcc_id(); b.st = st;
    if (t0) (void)xb_add(&bar[XB_XCNT(b.x)], 1u);
    return b;
}
__device__ __forceinline__ void xcd_barrier_complete(unsigned* bar, unsigned x, unsigned& nloc, unsigned& nx) {
    const unsigned G = gridDim.x * gridDim.y * gridDim.z;
    unsigned sum, cnt, mine, sp = 0u;
    for (;;) {
        sum = 0u; cnt = 0u; mine = 0u;
#pragma unroll
        for (unsigned j = 0; j < 16; ++j) { const unsigned c = xb_ld(&bar[XB_XCNT(j)]); sum += c; cnt += (c > 0u) ? 1u : 0u; mine = (j == x) ? c : mine; }
        if (sum == G) break;
        __builtin_amdgcn_s_sleep(1);
        if ((++sp & 255u) == 0u) { if (xb_ld(&bar[XB_TMO])) break; if (sp > XB_SPIN_CAP) { atomicAdd(&bar[XB_TMO], 1u); break; } }
    }
    nloc = mine > 0u ? mine : 1u; nx = cnt > 0u ? cnt : 1u;
}
__device__ __forceinline__ void xcd_barrier(const XcdBarrier& b, const bool t0) {
    asm volatile("s_waitcnt vmcnt(0)" ::: "memory");
    __syncthreads();
    if (t0) {
        unsigned* bar = b.bar;
        __builtin_amdgcn_s_waitcnt(0);
        unsigned nloc = b.st[0], nx = b.st[1];
        if (nloc == 0u) { xcd_barrier_complete(bar, b.x, nloc, nx); b.st[0] = nloc; b.st[1] = nx; }
        const unsigned old = xb_add(&bar[XB_XSUB(b.x)], 1u);
        const unsigned gen = old / nloc;
        if (old + 1u == (gen + 1u) * nloc) {
            __builtin_amdgcn_fence(__ATOMIC_RELEASE, "agent");
            asm volatile("s_waitcnt vmcnt(0)" ::: "memory");
            const unsigned og = xb_add(&bar[XB_TOP], 1u);
            const unsigned tg = og / nx;
            __builtin_amdgcn_fence(__ATOMIC_ACQUIRE, "agent");
            if (og + 1u == (tg + 1u) * nx) (void)__hip_atomic_fetch_add(&bar[XB_TOPGEN], 1u, __ATOMIC_RELAXED, __HIP_MEMORY_SCOPE_AGENT);
            else XB_SPIN(xb_ld(&bar[XB_TOPGEN]) == tg, bar);
            (void)__hip_atomic_fetch_add(&bar[XB_XGEN(b.x)], 1u, __ATOMIC_RELAXED, __HIP_MEMORY_SCOPE_AGENT);
            asm volatile("s_waitcnt vmcnt(0)" ::: "memory");
        } else {
            __builtin_amdgcn_fence(__ATOMIC_ACQUIRE, "agent");
            XB_SPIN(xb_ld(&bar[XB_XGEN(b.x)]) == gen, bar);
            asm volatile("s_waitcnt vmcnt(0)" ::: "memory");
        }
    }
    __syncthreads();
}

struct Args {
    const float* in[25];
    float* out; unsigned char* ws;
    int ph_lo, ph_hi;
};
enum { I_X = 0, I_MEM, I_NORM_MIX_G, I_W_IN, I_CONV_W, I_CONV_B, I_W_CONV_OUT, I_Q_NORM_G, I_W_UQ, I_KV_NORM_G, I_W_UKV, I_W_MLA_OUT, I_B_GATE, I_W_MIX_OUT,
       I_NORM_MEM_G, I_NORM_MEMKV_G, I_W_MEM_Q, I_W_MEM_KV, I_W_MEM_OUT, I_NORM_MOE_G, I_W_ROUTER, I_W_EXP_GATE, I_W_EXP_UP, I_W_EXP_DOWN, I_NORM_FINAL_G };

constexpr int TP_PITCH = 65, TP_BYTES = 64 * TP_PITCH * 4;
template <class SrcF, class DstF>
__device__ __forceinline__ void transpose_item(SrcF srcp, DstF dstp, int ld, const float* gain, int k0, LAS float* scr, int lane) {
    const int n4 = (lane & 15) * 4, kr = lane >> 4;
    const float* sp = srcp(n4);
    f32x4 v[16];
#pragma unroll
    for (int i = 0; i < 16; ++i) v[i] = sp ? *(const f32x4*)(sp + (size_t)(k0 + 4 * i + kr) * ld) : (f32x4){0.f, 0.f, 0.f, 0.f};
    if (gain) {
#pragma unroll
        for (int i = 0; i < 16; ++i) v[i] = v[i] * gain[k0 + 4 * i + kr]; }
#pragma unroll
    for (int i = 0; i < 16; ++i)
#pragma unroll
        for (int e = 0; e < 4; ++e) scr[(n4 + e) * TP_PITCH + 4 * i + kr] = v[i][e];
    asm volatile("s_waitcnt lgkmcnt(0)" ::: "memory");
    const int c = lane & 7;
#pragma unroll
    for (int j = 0; j < 8; ++j) { const int n = (lane >> 3) + 8 * j; const LAS float* s = scr + n * TP_PITCH + 8 * c;
        u32x4 o; o.x = cvtpk(s[0], s[1]); o.y = cvtpk(s[2], s[3]); o.z = cvtpk(s[4], s[5]); o.w = cvtpk(s[6], s[7]);
        *(u32x4*)(dstp(n) + k0 + 8 * c) = o; }
    asm volatile("s_waitcnt lgkmcnt(0)" ::: "memory");
}
template <class MapF>
__device__ __forceinline__ void transpose_matrix(MapF map, bf16_t* dst, int NDST, int K, int ld, const float* gain, LAS float* scr, int lane, int gw, int NGW, int& itbase) {
    const int nkb = K / 64, nitems = (NDST / 64) * nkb;
    int first = (gw - (itbase % NGW) + NGW) % NGW;
    for (int it = first; it < nitems; it += NGW) { const int nb = it / nkb, kb = it % nkb, n0 = nb * 64;
        transpose_item([&](int n) { return map(n0 + n); }, [&](int n) { return dst + (size_t)(n0 + n) * K; }, ld, gain, kb * 64, scr, lane); }
    itbase += nitems;
}

__device__ __forceinline__ int rope_dim(int p) { return (p >> 3) * 4 + (p & 3) + 32 * ((p >> 2) & 1); }

template <int PHM> __global__ void __launch_bounds__(NWAVES * 64, 2) fwd_kernel(Args args) {
    extern __shared__ __attribute__((aligned(16))) unsigned char lds_raw[];
    LAS unsigned char* lds = (LAS unsigned char*)lds_raw;
    volatile LAS unsigned* MISC = (volatile LAS unsigned*)(lds + MISC_OFF);
    int tid = threadIdx.x, lane = tid & 63; const int wave = __builtin_amdgcn_readfirstlane(tid >> 6);
#define PHASE_BEGIN() do { lane = (int)__builtin_amdgcn_mbcnt_hi(~0u, __builtin_amdgcn_mbcnt_lo(~0u, 0u)); asm volatile("" : "+v"(lane)); tid = wave * 64 + lane; } while (0)
    const int G = gridDim.x; const int bx = blockIdx.x; const int vcu = (G % 8 == 0) ? (bx % 8) * (G / 8) + bx / 8 : bx;
    const int gw = vcu * NWAVES + wave, NGW = G * NWAVES;
    unsigned char* ws = args.ws;
    gu32* ctl = (gu32*)(ws + WS_CTL);
    for (int u = tid; u < (LDS_BYTES - LDSCTL_OFF) / 4; u += NWAVES * 64) ((LAS unsigned*)(lds + LDSCTL_OFF))[u] = 0u;
    __syncthreads();
    XcdBarrier bar; bar.bar = (unsigned*)(ctl + CW_BAR); bar.x = 0; bar.st = nullptr;
    if (N_LAUNCHES == 1) bar = xcd_barrier_post((unsigned*)(ctl + CW_BAR), MISC + 8, tid == 0);
#define GRID_BAR() do { if (N_LAUNCHES == 1) xcd_barrier(bar, wave == 0 && __builtin_amdgcn_mbcnt_hi(~0u, __builtin_amdgcn_mbcnt_lo(~0u, 0u)) == 0u); } while (0)
    const int lo = args.ph_lo, hi = args.ph_hi;
#define IN(k) (((PHM >> (k)) & 1) && lo <= (k) && (k) < hi)
#define SEAM(k) do { if (IN(k) && IN((k) + 1)) GRID_BAR(); } while (0)

    const float* x = args.in[I_X]; float* out = args.out;
#define rope ((f32x2*)(ws + WS_ROPE))
#define rstd0 ((float*)(ws + WS_RSTD0))
#define rstdq ((float*)(ws + WS_RSTDQ))
#define rstdkv ((float*)(ws + WS_RSTDKV))
#define rstdm ((float*)(ws + WS_RSTDM))
#define ssq ((float*)(ws + WS_SSQ))
#define aff ((float*)(ws + WS_AFF))
#define inv ((int*)(ws + WS_INV))
#define idx ((int*)(ws + WS_IDX))
#define gate ((float*)(ws + WS_GATE))
#define memb ((bf16_t*)(ws + WS_MEMB))
#define MKV ((bf16_t*)(ws + WS_MKV))
#define QKT ((bf16_t*)(ws + WS_QKT))
#define VWT ((bf16_t*)(ws + WS_VWT))
#define Win_t ((bf16_t*)(ws + WS_WIN))
#define Wco_t ((bf16_t*)(ws + WS_WCO))
#define Wmo_t ((bf16_t*)(ws + WS_WMO))
#define Wmix_t ((bf16_t*)(ws + WS_WMIX))
#define Wuq_t ((bf16_t*)(ws + WS_WUQ))
#define Wukv_t ((bf16_t*)(ws + WS_WUKV))
#define Wmqh ((bf16_t*)(ws + WS_WMQH))
#define Woht ((bf16_t*)(ws + WS_WOHT))
#define Wmkv_t ((bf16_t*)(ws + WS_WMKV))
#define XGG ((bf16_t*)(ws + WS_XGG))
#define QB ((bf16_t*)(ws + WS_QB))
#define MIXA ((bf16_t*)(ws + WS_MIXA))
#define Wgu_t ((bf16_t*)(ws + WS_WGU))
#define Wd_t ((bf16_t*)(ws + WS_WD))
#define Y ((bf16_t*)(ws + WS_Y))
#define XB ((bf16_t*)(ws + WS_XB))
#define KN8 ((unsigned char*)(ws + WS_KN8))
#define VT8 ((unsigned char*)out)
#define Q8 ((unsigned char*)(ws + WS_QB))
#define KR8 ((unsigned char*)(ws + WS_KROPE))
#define X2B ((bf16_t*)(ws + WS_X2B))
#define ACONV ((bf16_t*)(ws + WS_ACONV))
#define OB ((bf16_t*)(ws + WS_OB))
#define X1B ((bf16_t*)(ws + WS_X1B))
#define XG ((bf16_t*)(ws + WS_XG))
#define SIGA ((bf16_t*)(ws + WS_SIGA))
#define MIXED ((bf16_t*)(ws + WS_MIXED))
#define PM ((bf16_t*)(ws + WS_PM))
#define SIGB ((bf16_t*)(ws + WS_SIGB))
#define H3 ((bf16_t*)(ws + WS_H3))
#define HB ((bf16_t*)(ws + WS_H))
#define CQ ((bf16_t*)(ws + WS_CQ))
#define CKV ((bf16_t*)(ws + WS_CKV))
#define KR ((bf16_t*)(ws + WS_KR))
#define KROPE ((bf16_t*)(ws + WS_KROPE))
#define KVB ((bf16_t*)out)
    LAS float* scr = (LAS float*)(lds + wave * TP_BYTES);

    if (IN(0)) { PHASE_BEGIN();
        int itb = 0;
        { const float* W = args.in[I_W_IN]; const float* gn = args.in[I_NORM_MIX_G];
          transpose_matrix([&](int n) -> const float* { if (n < 2048) { const int t = n >> 8, half = (n >> 7) & 1, c = n & 127; return W + (half ? 2048 : 0) + 128 * t + c; }
                                                         if (n < 3072) return W + 1024 + (n - 2048); if (n < 3520) return W + n; if (n < 3584) return nullptr; return W + (n - 64); },
                           Win_t, NU, 1024, 5568, gn, scr, lane, gw, NGW, itb); }
        { const float* W = args.in[I_W_CONV_OUT]; transpose_matrix([&](int n) -> const float* { return W + n; }, Wco_t, 1024, 1024, 1024, nullptr, scr, lane, gw, NGW, itb); }
        { const float* W = args.in[I_W_MLA_OUT]; transpose_matrix([&](int n) -> const float* { return W + n; }, Wmo_t, 1024, 1024, 1024, nullptr, scr, lane, gw, NGW, itb); }
        { const float* W = args.in[I_W_MIX_OUT]; transpose_matrix([&](int n) -> const float* { return W + n; }, Wmix_t, 1024, 1024, 1024, nullptr, scr, lane, gw, NGW, itb); }
        { const float* W = args.in[I_W_UQ]; const float* gn = args.in[I_Q_NORM_G];
          transpose_matrix([&](int n) -> const float* { if (n < 1024) return W + (n >> 7) * 192 + (n & 127); const int r = n - 1024; return W + (r >> 6) * 192 + 128 + rope_dim(r & 63); },
                           Wuq_t, 1536, 256, 1536, gn, scr, lane, gw, NGW, itb); }
        { const float* W = args.in[I_W_UKV]; const float* gn = args.in[I_KV_NORM_G];
          transpose_matrix([&](int n) -> const float* { if (n < 1024) return W + (n >> 7) * 256 + (n & 127); const int r = n - 1024; return W + (r >> 7) * 256 + 128 + (r & 127); },
                           Wukv_t, 2048, 128, 2048, gn, scr, lane, gw, NGW, itb); }
        { const float* W = args.in[I_W_MEM_KV]; const float* gn = args.in[I_NORM_MEMKV_G];
          transpose_matrix([&](int n) -> const float* { return W + n; }, Wmkv_t, 2048, 1024, 2048, gn, scr, lane, gw, NGW, itb); }
        for (int h = 0; h < 4; ++h) { const float* W = args.in[I_W_MEM_OUT] + (size_t)h * 256 * 1024;
          transpose_matrix([&](int n) -> const float* { return W + n; }, Woht + (size_t)h * 1024 * 256, 1024, 256, 1024, nullptr, scr, lane, gw, NGW, itb); }
        { const float* W = args.in[I_W_MEM_Q]; const float* gn = args.in[I_NORM_MEM_G];
          for (int c = gw * 64 + lane; c < 1024 * 1024 / 8; c += NGW * 64) { const int e0 = c * 8, h = e0 >> 18, d = (e0 >> 8) & 1023, j = e0 & 255; const float g = gn[d];
              const float* s = W + (size_t)d * 1024 + h * 256 + j; const f32x4 a = *(const f32x4*)s, b = *(const f32x4*)(s + 4);
              const float o[8] = {a[0] * g, a[1] * g, a[2] * g, a[3] * g, b[0] * g, b[1] * g, b[2] * g, b[3] * g}; *(u32x4*)(Wmqh + e0) = pack8(o); } }
        for (int r = gw; r < MT + NB * MEM_LEN; r += NGW) { const bool isx = r < MT; const int rr = isx ? r : r - MT;
            const float* src = (isx ? x : args.in[I_MEM]) + (size_t)rr * 1024; bf16_t* dst = (isx ? XB : memb) + (size_t)rr * 1024; float s = 0.f;
#pragma unroll
            for (int j = 0; j < 4; ++j) { const f32x4 v = *(const f32x4*)(src + (lane + 64 * j) * 4); s += (v[0] * v[0] + v[1] * v[1]) + (v[2] * v[2] + v[3] * v[3]);
                u32x2 w; w.x = cvtpk(v[0], v[1]); w.y = cvtpk(v[2], v[3]); *(u32x2*)(dst + (lane + 64 * j) * 4) = w; }
            s = wave_sum(s); if (lane == 0) (isx ? rstd0 : rstdm)[rr] = 1.f / sqrtf(s * (1.f / 1024.f) + EPS); }
        for (int i = gw * 64 + lane; i < SEQ * 32; i += NGW * 64) { const int s = i >> 5, j = i & 31; const float invf = 1.0f / powf(10000.0f, (float)(2 * j) / 64.0f); const float ang = (float)s * invf;
            rope[i] = (f32x2){cosf(ang), sinf(ang)}; }
    }
    SEAM(0);

    if (IN(1)) { PHASE_BEGIN();
        { Gemm g = mkgemm(XB, Win_t, MT, NU, 1024, 1024, 1024); StaticOrder S; S.init(MT, NU, G, bx);
          EpiU E{{rstd0, XGG, CQ, CKV, KR, SIGA, SIGB, args.in[I_B_GATE]}}; pg8::gemm_phase(lds, g, S, E, tid); }
        { Gemm g = mkgemm(memb, Wmkv_t, NB * MEM_LEN, 2048, 1024, 1024, 1024); StaticOrder S; S.init(NB * MEM_LEN, 2048, G, (bx + G / 2) % G);
          pg8::EpiChunk<FMemKV> E{{rstdm, MKV}}; pg8::gemm_phase(lds, g, S, E, tid); }
    }
    SEAM(1);

    if (IN(2)) { PHASE_BEGIN();
        const float* cw = args.in[I_CONV_W]; const float* cb = args.in[I_CONV_B];
        for (int blk = gw; blk < MT / 4; blk += NGW) { const int r0 = blk * 4, s0 = r0 & (SEQ - 1);
            u32x4 pxr[6][2], gbr[4][2]; u32x2 cqr[4]; unsigned ckr[4]; bf16_t k1[4], k2[4];
            const u32x4 z = {0u, 0u, 0u, 0u};
#pragma unroll
            for (int i = 0; i < 6; ++i) { const int rr = r0 - 1 + i; const bool ok = (i > 0 || s0 > 0) && (i < 5 || s0 + 4 < SEQ);
#pragma unroll
                for (int j = 0; j < 2; ++j) pxr[i][j] = ok ? *(const u32x4*)(XGG + (size_t)rr * 2048 + lane * 8 + 512 * j) : z; }
#pragma unroll
            for (int i = 0; i < 4; ++i) { const int rr = r0 + i;
#pragma unroll
                for (int j = 0; j < 2; ++j) gbr[i][j] = *(const u32x4*)(XGG + (size_t)rr * 2048 + 1024 + lane * 8 + 512 * j);
                cqr[i] = *(const u32x2*)(CQ + (size_t)rr * 256 + lane * 4); ckr[i] = *(const unsigned*)(CKV + (size_t)rr * 128 + lane * 2);
                { const int j_ = (lane >> 3) * 4 + (lane & 3); k1[i] = KR[(size_t)rr * 64 + j_]; k2[i] = KR[(size_t)rr * 64 + j_ + 32]; } }
#pragma unroll
            for (int j = 0; j < 2; ++j) { const int c0 = lane * 8 + 512 * j;
                float w0[8], w1[8], w2[8], bb[8];
                { const f32x4 a = *(const f32x4*)(cw + c0), b = *(const f32x4*)(cw + c0 + 4); w0[0] = a[0]; w0[1] = a[1]; w0[2] = a[2]; w0[3] = a[3]; w0[4] = b[0]; w0[5] = b[1]; w0[6] = b[2]; w0[7] = b[3]; }
                { const f32x4 a = *(const f32x4*)(cw + 1024 + c0), b = *(const f32x4*)(cw + 1024 + c0 + 4); w1[0] = a[0]; w1[1] = a[1]; w1[2] = a[2]; w1[3] = a[3]; w1[4] = b[0]; w1[5] = b[1]; w1[6] = b[2]; w1[7] = b[3]; }
                { const f32x4 a = *(const f32x4*)(cw + 2048 + c0), b = *(const f32x4*)(cw + 2048 + c0 + 4); w2[0] = a[0]; w2[1] = a[1]; w2[2] = a[2]; w2[3] = a[3]; w2[4] = b[0]; w2[5] = b[1]; w2[6] = b[2]; w2[7] = b[3]; }
                { const f32x4 a = *(const f32x4*)(cb + c0), b = *(const f32x4*)(cb + c0 + 4); bb[0] = a[0]; bb[1] = a[1]; bb[2] = a[2]; bb[3] = a[3]; bb[4] = b[0]; bb[5] = b[1]; bb[6] = b[2]; bb[7] = b[3]; }
                float p[6][8];
#pragma unroll
                for (int i = 0; i < 6; ++i) unpack8(pxr[i][j], p[i]);
#pragma unroll
                for (int i = 0; i < 4; ++i) { float gb[8], o[8]; unpack8(gbr[i][j], gb);
#pragma unroll
                    for (int e = 0; e < 8; ++e) o[e] = gb[e] * (w0[e] * p[i][e] + w1[e] * p[i + 1][e] + w2[e] * p[i + 2][e] + bb[e]);
                    *(u32x4*)(ACONV + (size_t)(r0 + i) * 1024 + c0) = pack8(o); } }
#pragma unroll
            for (int i = 0; i < 4; ++i) { const int r = r0 + i, s = r & (SEQ - 1);
                { const u32x2 w = cqr[i]; const float a = bflo(w.x), b = bfhi(w.x), c = bflo(w.y), d = bfhi(w.y);
                  const float sq = wave_sum((a * a + b * b) + (c * c + d * d)); if (lane == 0) rstdq[r] = 1.f / sqrtf(sq * (1.f / 256.f) + EPS); }
                { const unsigned w = ckr[i]; const float a = bflo(w), b = bfhi(w);
                  const float sq = wave_sum(a * a + b * b); if (lane == 0) rstdkv[r] = 1.f / sqrtf(sq * (1.f / 128.f) + EPS); }
                { const int pp = lane, j = (pp >> 3) * 4 + (pp & 3), half = (pp >> 2) & 1; const float v1 = bf2f(k1[i]), v2 = bf2f(k2[i]); const f32x2 cs = rope[s * 32 + j];
                  const float kv_ = half ? v1 * cs.y + v2 * cs.x : v1 * cs.x - v2 * cs.y;
#if ATT_FP8
                  KR8[(size_t)r * 64 + pp] = (unsigned char)(__builtin_amdgcn_cvt_pk_fp8_f32(kv_, kv_, 0u, false) & 0xffu);
#else
                  KROPE[(size_t)r * 64 + pp] = f2bf(kv_);
#endif
                } }
        }
    }
    SEAM(2);

    if (IN(3)) { PHASE_BEGIN();
        { Gemm g = mkgemm(ACONV, Wco_t, MT, 1024, 1024, 1024, 1024); StaticOrder S; S.init(MT, 1024, G, bx);
          pg8::EpiChunk<FGateMul> E{{SIGA, MIXA}}; pg8::gemm_phase(lds, g, S, E, tid); }
        { Gemm g = mkgemm(CQ, Wuq_t, MT, 1536, 256, 256, 256); StaticOrder S; S.init(MT, 1536, G, (bx + G / 2) % G);
          pg8::EpiChunk<FQ> E{{rstdq, rope, QB, ATT_FP8 ? Q8 : nullptr}}; pg8::gemm_phase(lds, g, S, E, tid); }
        { Gemm g = mkgemm(CKV, Wukv_t, MT, 2048, 128, 128, 128); StaticOrder S; S.init(MT, 2048, G, bx);
#if ATT_FP8
          (void)g; (void)S; }
        { Gemm g = mkgemm(CKV, Wukv_t, MT, 1024, 128, 128, 128); StaticOrder S; S.init(MT, 1024, G, bx);
          pg8::EpiChunk<FK8> E{{rstdkv, KN8}}; pg8::gemm_phase(lds, g, S, E, tid); }
        { Gemm g = mkgemm(Wukv_t + (size_t)1024 * 128, CKV, 1024, MT, 128, 128, 128); StaticOrder S; S.init(1024, MT, G, bx);
          pg8::EpiChunk<FVT8> E{{rstdkv, VT8}}; pg8::gemm_phase(lds, g, S, E, tid); }
#else
          pg8::EpiChunk<FScaleRow> E{{rstdkv, KVB, 2048}}; pg8::gemm_phase(lds, g, S, E, tid); }
#endif
        { Gemm g = mkgemm(MKV, Wmqh, 2048, 1024, 256, 256, 256, 1, 4, (size_t)1024 * 256); StaticOrder S; S.init(2048, 1024, G, bx);
          pg8::EpiChunk<FPlain> E{{QKT, 1024}}; pg8::gemm_phase(lds, g, S, E, tid); }
        for (int b = 0; b < NB; ++b) { Gemm g = mkgemm(Woht, MKV + (size_t)(8 + b * 4) * 65536, 4096, 256, 256, 256, 256, 4, 4, (size_t)65536); StaticOrder S; S.init(4096, 256, G, (bx + G - 64 - 16 * b) % G);
          pg8::EpiChunk<FVW> E{{VWT + (size_t)b * 1024 * 1024}}; pg8::gemm_phase(lds, g, S, E, tid); }
    }
    SEAM(3);

    if (IN(4)) { PHASE_BEGIN();
        for (int u = vcu; u < NB * NHEAD * (SEQ / 256); u += G) { const int bh = u >> 5, qb = u & 31, b = bh >> 3, h = bh & 7; const size_t row0 = (size_t)b * SEQ + qb * 256;
#if ATT_FP8
            att::attn_unit9(Q8 + row0 * 1536 + h * 128, Q8 + row0 * 1536 + 1024 + h * 64, KN8 + (size_t)b * SEQ * 1024 + h * 128, KR8 + (size_t)b * SEQ * 64,
                            VT8 + (size_t)(b * NHEAD + h) * 128 * SEQ, OB + row0 * 1024 + h * 128, SEQ, (char*)lds_raw, tid);
#else
            att::attn_unit(QB + row0 * 1536 + h * 128, QB + row0 * 1536 + 1024 + h * 64, KVB + (size_t)b * SEQ * 2048 + h * 128,
                           KROPE + (size_t)b * SEQ * 64, OB + row0 * 1024 + h * 128, SEQ, (char*)lds_raw, tid);
#endif
        }
    }
    SEAM(4);

    if (IN(5)) { PHASE_BEGIN(); Gemm g = mkgemm(OB, Wmo_t, MT, 1024, 1024, 1024, 1024); StaticOrder S; S.init(MT, 1024, G, bx);
        pg8::EpiChunk<FGateMulAdd> E{{SIGB, MIXA, MIXED}}; pg8::gemm_phase(lds, g, S, E, tid); }
    SEAM(5);

    if (IN(6)) { PHASE_BEGIN(); Gemm g = mkgemm(MIXED, Wmix_t, MT, 1024, 1024, 1024, 1024); StaticOrder S; S.init(MT, 1024, G, bx);
        EpiX1 E{x, RESID_BF16 ? nullptr : out, X1B, ssq}; pg8::gemm_phase(lds, g, S, E, tid); }
    SEAM(6);

    if (IN(7)) { PHASE_BEGIN(); Gemm g = mkgemm(X1B, QKT, MT, 1024, 1024, 1024, 1024, 32, 2, (size_t)1024 * 1024); StaticOrder S; S.init(MT, 1024, G, bx);
        EpiSoftmax E{ssq, PM}; pg8::gemm_phase(lds, g, S, E, tid); }
    SEAM(7);

    if (IN(8)) { PHASE_BEGIN(); Gemm g = mkgemm(PM, VWT, MT, 1024, 1024, 1024, 1024, 32, 2, (size_t)1024 * 1024); StaticOrder S; S.init(MT, 1024, G, bx);
#if RESID_BF16
        pg8::EpiChunk<FResidBf16> E{{X1B, X2B}}; pg8::gemm_phase(lds, g, S, E, tid); }
#else
        pg8::EpiChunk<FResidF32> E{{out, out}}; pg8::gemm_phase(lds, g, S, E, tid); }
#endif
    SEAM(8);

#if RESID_BF16
#define LDROW4(r_, j_) ([&]() -> f32x4 { const u32x2 w_ = *(const u32x2*)(X2B + (size_t)(r_) * 1024 + (lane + 64 * (j_)) * 4); return (f32x4){bflo(w_.x), bfhi(w_.x), bflo(w_.y), bfhi(w_.y)}; }())
#else
#define LDROW4(r_, j_) (*(const f32x4*)(out + (size_t)(r_) * 1024 + (lane + 64 * (j_)) * 4))
#endif
    if (IN(9)) { PHASE_BEGIN();
        constexpr int RP = 1028;
        LAS float* wt = (LAS float*)lds;
        LAS float* hb = (LAS float*)(lds + 16 * RP * 4);
        LAS float* part = (LAS float*)(lds + 2 * 16 * RP * 4);
        const float* wr_ = args.in[I_W_ROUTER]; const float* gn = args.in[I_NORM_MOE_G];
        for (int i = tid; i < 1024 * 16; i += NWAVES * 64) wt[(i & 15) * RP + (i >> 4)] = wr_[i];
        f32x4 gv[4];
#pragma unroll
        for (int j = 0; j < 4; ++j) gv[j] = *(const f32x4*)(gn + (lane + 64 * j) * 4);
        f32x4 v[2][4], vn[2][4];
        const int ngroups = MT / 16;
        if (vcu < ngroups) {
#pragma unroll
            for (int t = 0; t < 2; ++t)
#pragma unroll
                for (int j = 0; j < 4; ++j) v[t][j] = LDROW4(vcu * 16 + wave * 2 + t, j); }
        __syncthreads();
        for (int g = vcu; g < ngroups; g += G) { const int r0 = g * 16;
            if (g + G < ngroups) {
#pragma unroll
                for (int t = 0; t < 2; ++t)
#pragma unroll
                    for (int j = 0; j < 4; ++j) vn[t][j] = LDROW4((g + G) * 16 + wave * 2 + t, j); }
#pragma unroll
            for (int t = 0; t < 2; ++t) { const int tk = wave * 2 + t, r = r0 + tk; float s = 0.f;
#pragma unroll
                for (int j = 0; j < 4; ++j) s += (v[t][j][0] * v[t][j][0] + v[t][j][1] * v[t][j][1]) + (v[t][j][2] * v[t][j][2] + v[t][j][3] * v[t][j][3]);
                const float rs = 1.f / sqrtf(wave_sum(s) * (1.f / 1024.f) + EPS);
#pragma unroll
                for (int j = 0; j < 4; ++j) { const f32x4 hh = v[t][j] * rs * gv[j]; *(LAS f32x4*)(hb + tk * RP + (lane + 64 * j) * 4) = hh;
                    u32x2 w; w.x = cvtpk(hh[0], hh[1]); w.y = cvtpk(hh[2], hh[3]); *(u32x2*)(H3 + (size_t)r * 1024 + (lane + 64 * j) * 4) = w; } }
            __syncthreads();
            { f32x4 acc = {0.f, 0.f, 0.f, 0.f}; const LAS float* ap = wt + (lane & 15) * RP + wave * 128 + (lane >> 4); const LAS float* bp = hb + (lane & 15) * RP + wave * 128 + (lane >> 4);
#pragma unroll 8
                for (int st = 0; st < 32; ++st) acc = __builtin_amdgcn_mfma_f32_16x16x4f32(ap[4 * st], bp[4 * st], acc, 0, 0, 0);
                *(LAS f32x4*)(part + (wave * 16 + (lane & 15)) * 16 + 4 * (lane >> 4)) = acc; }
            __syncthreads();
            if (tid < 256) { const int tk = tid >> 4, e = tid & 15; float lg = 0.f;
#pragma unroll
                for (int w = 0; w < 8; ++w) lg += part[(w * 16 + tk) * 16 + e];
                float mx = lg;
#pragma unroll
                for (int o = 1; o < 16; o <<= 1) mx = fmaxf(mx, __shfl_xor(mx, o));
                const float p = __expf(lg - mx); float sm = p;
#pragma unroll
                for (int o = 1; o < 16; o <<= 1) sm += __shfl_xor(sm, o);
                const int r = r0 + tk, b = r >> 13, sidx = r & (SEQ - 1); aff[((size_t)b * NEXP + e) * SEQ + sidx] = p / sm; inv[(size_t)r * 16 + e] = -1; }
            __syncthreads();
#pragma unroll
            for (int t = 0; t < 2; ++t)
#pragma unroll
                for (int j = 0; j < 4; ++j) v[t][j] = vn[t][j];
        }
    }
    SEAM(9);

    if (IN(10)) { PHASE_BEGIN();
        if (vcu < NB * NEXP) {
            LAS unsigned* keys = (LAS unsigned*)lds; LAS unsigned* hist = (LAS unsigned*)(lds + 32768); LAS unsigned* misc = (LAS unsigned*)(lds + 32768 + 1024);
            for (int be = vcu; be < NB * NEXP; be += G) { const int b = be >> 4, e = be & 15; const float* a = aff + (size_t)be * SEQ;
#pragma unroll 1
                for (int i = tid; i < SEQ; i += NWAVES * 64) keys[i] = __float_as_uint(a[i]);
                unsigned prefix = 0u, kth = CAP;
#pragma unroll 1
                for (int pass = 0; pass < 4; ++pass) { const int shift = 24 - 8 * pass;
                    if (tid < 256) hist[tid] = 0u;
                    __syncthreads();
#pragma unroll 1
                    for (int i = tid; i < SEQ; i += NWAVES * 64) { const unsigned k = keys[i]; const bool match = (pass == 0) || ((k >> (shift + 8)) == (prefix >> (shift + 8)));
                        if (match) atomicAdd((unsigned*)(hist + ((k >> shift) & 255u)), 1u); }
                    __syncthreads();
                    if (wave == 0) { unsigned c[4]; unsigned tot = 0u;
#pragma unroll
                        for (int i = 0; i < 4; ++i) { c[i] = hist[255 - (4 * lane + i)]; tot += c[i]; }
                        unsigned incl = tot;
#pragma unroll
                        for (int o = 1; o < 64; o <<= 1) { const unsigned t = __shfl_up(incl, o); if (lane >= o) incl += t; }
                        unsigned run = incl - tot;
#pragma unroll
                        for (int i = 0; i < 4; ++i) { if (run < kth && run + c[i] >= kth) { misc[0] = 255u - (unsigned)(4 * lane + i); misc[1] = kth - run; } run += c[i]; } }
                    __syncthreads();
                    prefix |= misc[0] << shift; kth = misc[1];
                    __syncthreads();
                }
                const unsigned T = prefix; unsigned base_g = 0u, base_e = 0u;
#pragma unroll 1
                for (int it = 0; it < SEQ / (NWAVES * 64); ++it) { const int t = it * (NWAVES * 64) + tid; const unsigned k = keys[t]; const bool gt = k > T, eq = k == T;
                    const unsigned long long bg = __ballot(gt), bq = __ballot(eq); const unsigned long long lt = (1ull << lane) - 1ull;
                    if (lane == 0) { misc[8 + wave] = (unsigned)__popcll(bg); misc[16 + wave] = (unsigned)__popcll(bq); }
                    __syncthreads();
                    unsigned pg = base_g, pq = base_e, tg = 0u, tq = 0u;
#pragma unroll
                    for (int w = 0; w < NWAVES; ++w) { const unsigned cg = misc[8 + w], cq = misc[16 + w]; if (w < wave) { pg += cg; pq += cq; } tg += cg; tq += cq; }
                    pg += (unsigned)__popcll(bg & lt); pq += (unsigned)__popcll(bq & lt);
                    const bool sel = gt || (eq && pq < kth);
                    if (sel) { const unsigned pos = pg + (pq < kth ? pq : kth); idx[(size_t)be * CAP + pos] = t; gate[(size_t)be * CAP + pos] = __uint_as_float(k); inv[((size_t)b * SEQ + t) * 16 + e] = (int)pos; }
                    base_g += tg; base_e += tq;
                    __syncthreads();
                }
            }
        } else {
            const int cw_ = vcu - NB * NEXP, ncw = G - NB * NEXP; const int gw2 = cw_ * NWAVES + wave, NGW2 = ncw * NWAVES;
#pragma unroll 1
            for (int it = gw2; it < NEXP * 768; it += NGW2) { const int e = it / 768, r = it % 768;
                if (r < 512) { const int nb = r >> 4, kb = r & 15, n0 = nb * 64; const int f0 = (n0 >> 8) * 128 + (n0 & 127);
                    const float* W = (((n0 >> 7) & 1) ? args.in[I_W_EXP_UP] : args.in[I_W_EXP_GATE]) + (size_t)e * 1024 * 1024 + f0; bf16_t* D = Wgu_t + (size_t)e * 2048 * 1024 + (size_t)n0 * 1024;
                    transpose_item([&](int n) { return W + n; }, [&](int n) { return D + (size_t)n * 1024; }, 1024, nullptr, kb * 64, scr, lane); }
                else { const int r2 = r - 512, nb = r2 >> 4, kb = r2 & 15, n0 = nb * 64;
                    const float* W = args.in[I_W_EXP_DOWN] + (size_t)e * 1024 * 1024 + n0; bf16_t* D = Wd_t + (size_t)e * 1024 * 1024 + (size_t)n0 * 1024;
                    transpose_item([&](int n) { return W + n; }, [&](int n) { return D + (size_t)n * 1024; }, 1024, nullptr, kb * 64, scr, lane); } }
        }
    }
    if (IN(10) && IN(12)) GRID_BAR();

    if (IN(12)) { PHASE_BEGIN(); Gemm g = mkgemm(H3, Wgu_t, MOE_ROWS, 2048, 1024, 1024, 1024, 4, 16, (size_t)2048 * 1024); g.gidx = idx; StaticOrder S; S.init(MOE_ROWS, 2048, G, bx);
        EpiSwiglu E{HB}; pg8::gemm_phase<EpiSwiglu, StaticOrder, true>(lds, g, S, E, tid); }
    SEAM(12);

    if (IN(13)) { PHASE_BEGIN(); Gemm g = mkgemm(HB, Wd_t, MOE_ROWS, 1024, 1024, 1024, 1024, 4, 16, (size_t)1024 * 1024); StaticOrder S; S.init(MOE_ROWS, 1024, G, bx);
        pg8::EpiChunk<FGateRow> E{{gate, Y}}; pg8::gemm_phase(lds, g, S, E, tid); }
    SEAM(13);

    if (IN(14)) { PHASE_BEGIN();
        const float* gn = args.in[I_NORM_FINAL_G]; f32x4 gv[4];
#pragma unroll
        for (int j = 0; j < 4; ++j) gv[j] = *(const f32x4*)(gn + (lane + 64 * j) * 4);
        f32x4 v[4], vn[4]; int myslot = -1, nslot = -1;
        if (gw < MT) { myslot = inv[(size_t)gw * 16 + (lane & 15)];
#pragma unroll
            for (int j = 0; j < 4; ++j) v[j] = LDROW4(gw, j); }
        for (int r = gw; r < MT; r += NGW) { float* row = out + (size_t)r * 1024; const int b = r >> 13;
            if (r + NGW < MT) { nslot = inv[(size_t)(r + NGW) * 16 + (lane & 15)];
#pragma unroll
                for (int j = 0; j < 4; ++j) vn[j] = LDROW4(r + NGW, j); }
            unsigned long long em = __ballot(lane < 16 && myslot >= 0) & 0xffffull;
            while (em) { u32x2 w[4][4]; int ne = 0;
#pragma unroll
                for (int q = 0; q < 4; ++q) { if (em) { const int e = __builtin_ctzll(em); em &= em - 1; const int slot = __builtin_amdgcn_readlane(myslot, e);
                        const bf16_t* yr = Y + ((size_t)(b * NEXP + e) * CAP + slot) * 1024;
#pragma unroll
                        for (int j = 0; j < 4; ++j) w[q][j] = *(const u32x2*)(yr + (lane + 64 * j) * 4);
                        ne = q + 1; } }
#pragma unroll
                for (int q = 0; q < 4; ++q) { if (q < ne) {
#pragma unroll
                        for (int j = 0; j < 4; ++j) { v[j][0] += bflo(w[q][j].x); v[j][1] += bfhi(w[q][j].x); v[j][2] += bflo(w[q][j].y); v[j][3] += bfhi(w[q][j].y); } } } }
            float s = 0.f;
#pragma unroll
            for (int j = 0; j < 4; ++j) s += (v[j][0] * v[j][0] + v[j][1] * v[j][1]) + (v[j][2] * v[j][2] + v[j][3] * v[j][3]);
            const float rs = 1.f / sqrtf(wave_sum(s) * (1.f / 1024.f) + EPS);
#pragma unroll
            for (int j = 0; j < 4; ++j) *(f32x4*)(row + (lane + 64 * j) * 4) = v[j] * rs * gv[j];
#pragma unroll
            for (int j = 0; j < 4; ++j) v[j] = vn[j];
            myslot = nslot;
        }
    }
#undef IN
#undef SEAM
#undef GRID_BAR
}

#ifndef PH_MASK
#define PH_MASK 0x7fff
#endif
static const void* phase_fn(int k) {
#if MK_N_LAUNCHES == 1
    (void)k; return (const void*)fwd_kernel<PH_MASK>;
#else
    switch (k) {
    case 0: return (const void*)fwd_kernel<1 << 0>;   case 1: return (const void*)fwd_kernel<1 << 1>;   case 2: return (const void*)fwd_kernel<1 << 2>;   case 3: return (const void*)fwd_kernel<1 << 3>;
    case 4: return (const void*)fwd_kernel<1 << 4>;   case 5: return (const void*)fwd_kernel<1 << 5>;   case 6: return (const void*)fwd_kernel<1 << 6>;   case 7: return (const void*)fwd_kernel<1 << 7>;
    case 8: return (const void*)fwd_kernel<1 << 8>;   case 9: return (const void*)fwd_kernel<1 << 9>;   case 10: return (const void*)fwd_kernel<1 << 10>; case 11: return (const void*)fwd_kernel<1 << 11>;
    case 12: return (const void*)fwd_kernel<1 << 12>; case 13: return (const void*)fwd_kernel<1 << 13>; default: return (const void*)fwd_kernel<1 << 14>;
    }
#endif
}
extern "C" void kernel_launch(void* const* d_in, const int* in_sizes, int n_in, void* d_out, int out_size, void* d_ws, size_t ws_size, hipStream_t stream) {
    static int grid = 0;
    if (grid == 0) {
        if (n_in != 25 || in_sizes[0] != MT * DM || out_size != MT * DM || ws_size < WS_END) {
            fprintf(stderr, "kernel_launch: built for 25 inputs, x/out of %d floats, >= %zu bytes of workspace; got n_in %d, in0 %d, out %d, ws %zu; nothing launched\n", MT * DM, (size_t)WS_END, n_in, n_in > 0 ? in_sizes[0] : -1, out_size, ws_size);
            grid = -1; return; }
        int dev = 0, cus = 0;
        if (hipGetDevice(&dev) != hipSuccess || hipDeviceGetAttribute(&cus, hipDeviceAttributeMultiprocessorCount, dev) != hipSuccess) { fprintf(stderr, "kernel_launch: device query failed\n"); grid = -1; return; }
        for (int k = 0; k < (N_LAUNCHES == 1 ? 1 : N_PHASES); ++k)
            if (hipFuncSetAttribute(phase_fn(N_LAUNCHES == 1 ? -1 : k), hipFuncAttributeMaxDynamicSharedMemorySize, LDS_BYTES) != hipSuccess) { fprintf(stderr, "kernel_launch: hipFuncSetAttribute failed\n"); grid = -1; return; }
        (void)hipGetLastError();
        grid = cus;
    }
    if (grid < 0) return;
    if (hipMemsetAsync((char*)d_ws + WS_CTL, 0, CTL_ZERO_BYTES, stream) != hipSuccess) { fprintf(stderr, "kernel_launch: memset failed\n"); return; }
    Args a{};
    for (int i = 0; i < 25; ++i) a.in[i] = (const float*)d_in[i];
    a.out = (float*)d_out; a.ws = (unsigned char*)d_ws;
    for (int li = 0; li < N_LAUNCHES; ++li) {
        a.ph_lo = (N_LAUNCHES == 1) ? 0 : li; a.ph_hi = (N_LAUNCHES == 1) ? N_PHASES : li + 1;
        void* kargs[] = {&a};
        for (int rep = 0; rep < ((N_LAUNCHES != 1 && li == REP_PHASE) ? 2 : 1); ++rep)
            (void)hipLaunchKernel(phase_fn(N_LAUNCHES == 1 ? -1 : li), dim3(grid), dim3(NWAVES * 64), kargs, LDS_BYTES, stream);
        const hipError_t le = hipPeekAtLastError();
        if (le != hipSuccess) { fprintf(stderr, "kernel_launch: launch %d failed: %s\n", li, hipGetErrorName(le)); break; }
    }
}
```

```cpp
#include <hip/hip_runtime.h>
#include <cstdio>
#include <cstdint>

#ifndef MK_N_LAUNCHES
#define MK_N_LAUNCHES 1
#endif
#ifndef REP_PHASE
#define REP_PHASE -1
#endif
#ifndef RESID_BF16
#define RESID_BF16 1
#endif
#ifndef ATT_FP8
#define ATT_FP8 1
#endif
#ifndef GEMM_SIMPLE
#define GEMM_SIMPLE 0
#endif

#define LAS __attribute__((address_space(3)))
#define GAS __attribute__((address_space(1)))
typedef unsigned short bf16_t;
typedef short bf16x8 __attribute__((ext_vector_type(8)));
typedef short s16x4 __attribute__((ext_vector_type(4)));
typedef float f32x2 __attribute__((ext_vector_type(2)));
typedef float f32x4 __attribute__((ext_vector_type(4)));
typedef float f32x16 __attribute__((ext_vector_type(16)));
typedef unsigned u32x2 __attribute__((ext_vector_type(2)));
typedef unsigned u32x4 __attribute__((ext_vector_type(4)));
typedef __bf16 bf16x2_t __attribute__((ext_vector_type(2)));

constexpr int DM = 1024, NB = 2, SEQ = 8192, MT = NB * SEQ;
constexpr int NU = 5632;
constexpr int NHEAD = 8, QK_NOPE = 128, QK_ROPE = 64, V_HEAD = 128, Q_LORA = 256, KV_LORA = 128;
constexpr int MEM_LEN = 256, MEM_HEADS = 4, MEM_HD = 256;
constexpr int NEXP = 16, EFF = 1024, CAP = 1024;
constexpr int MOE_ROWS = NB * NEXP * CAP;
constexpr float EPS = 1e-6f;
constexpr float ATT_SCALE = 0.07216878364870322f;

__device__ __forceinline__ unsigned cvtpk(float lo, float hi) { f32x2 v = {lo, hi}; bf16x2_t b = __builtin_convertvector(v, bf16x2_t); return __builtin_bit_cast(unsigned, b); }
__device__ __forceinline__ float bflo(unsigned w) { return __builtin_bit_cast(float, w << 16); }
__device__ __forceinline__ float bfhi(unsigned w) { return __builtin_bit_cast(float, w & 0xffff0000u); }
__device__ __forceinline__ float bf2f(bf16_t h) { return __builtin_bit_cast(float, (unsigned)h << 16); }
__device__ __forceinline__ bf16_t f2bf(float f) { return (bf16_t)(cvtpk(f, 0.f) & 0xffffu); }
__device__ __forceinline__ void unpack8(const u32x4 w, float (&v)[8]) { v[0] = bflo(w.x); v[1] = bfhi(w.x); v[2] = bflo(w.y); v[3] = bfhi(w.y); v[4] = bflo(w.z); v[5] = bfhi(w.z); v[6] = bflo(w.w); v[7] = bfhi(w.w); }
__device__ __forceinline__ u32x4 pack8(const float (&v)[8]) { u32x4 w; w.x = cvtpk(v[0], v[1]); w.y = cvtpk(v[2], v[3]); w.z = cvtpk(v[4], v[5]); w.w = cvtpk(v[6], v[7]); return w; }
typedef int v8i __attribute__((ext_vector_type(8)));
__device__ __forceinline__ unsigned pk4_fp8(float a, float b, float c, float d) { unsigned w = 0; w = __builtin_amdgcn_cvt_pk_fp8_f32(a, b, w, false); w = __builtin_amdgcn_cvt_pk_fp8_f32(c, d, w, true); return w; }
__device__ __forceinline__ u32x2 pack8_fp8(const float (&v)[8]) { u32x2 w; w.x = pk4_fp8(v[0], v[1], v[2], v[3]); w.y = pk4_fp8(v[4], v[5], v[6], v[7]); return w; }
__device__ __forceinline__ float wave_sum(float v) {
#pragma unroll
    for (int o = 1; o < 64; o <<= 1) v += __shfl_xor(v, o);
    return v;
}

namespace pg8 {
constexpr int BM = 256, BK = 64, HALF = 128, HTB = HALF * BK * 2, STAGE_BYTES = 8 * HTB, NXCD = 8, WGM = 8;
__host__ __device__ __forceinline__ int lds_byte(int r, int c) { const int st = (r >> 4) * 2 + (c >> 5), rr = r & 15, cc = c & 31, ob = rr * 64 + cc * 2; return st * 1024 + (ob ^ (((ob >> 9) & 1) << 5)); }
__host__ __device__ __forceinline__ void stage_rc(int b, int& R, int& C) { const int st = b / 1024, sb = b % 1024, swz = sb ^ (((sb >> 9) & 1) << 5); R = (st >> 1) * 16 + swz / 64; C = (st & 1) * 32 + (swz % 64) / 2; }
__host__ __device__ __forceinline__ int perm32(int rho) { const int n = rho >> 4, i = rho & 15; return 8 * (i >> 2) + 4 * n + (i & 3); }

struct Unit { int pm, pn; };
struct Gemm { const bf16_t* A; const bf16_t* Bt; int M, N, K, lda, ldb, bdiv, bmod; size_t bstride; const int* gidx; };
__device__ __forceinline__ Gemm mkgemm(const bf16_t* A, const bf16_t* Bt, int M, int N, int K, int lda, int ldb, int bdiv = 1, int bmod = 1, size_t bstride = 0) {
    Gemm g; g.A = A; g.Bt = Bt; g.M = M; g.N = N; g.K = K; g.lda = lda; g.ldb = ldb; g.bdiv = bdiv; g.bmod = bmod; g.bstride = bstride; g.gidx = nullptr; return g; }

struct StaticOrder {
    int nM, nN, nwg, G, c;
    __host__ __device__ void init(int M, int N, int G_, int c_) { nM = M / BM; nN = N / BM; nwg = nM * nN; G = G_; c = c_; }
    __host__ __device__ bool next(int i, Unit& u) const {
        const long L = (long)i * G + c; if (L >= nwg) return false;
        int wgid = (int)L; { const int q = nwg / NXCD, r = nwg % NXCD, xcd = wgid % NXCD, off = wgid / NXCD; wgid = (xcd < r ? xcd * (q + 1) : r * (q + 1) + (xcd - r) * q) + off; }
        const int nig = WGM * nN, gid = wgid / nig, fm = gid * WGM, gsz = (nM - fm) < WGM ? (nM - fm) : WGM;
        u.pm = fm + ((wgid % nig) % gsz); u.pn = (wgid % nig) / gsz; return true;
    }
};

typedef f32x4 Acc[2][2][4][2];

template <class Epi, class Sched>
__device__ __forceinline__ void gemm_simple(LAS unsigned char* lds, const Gemm g, const Sched& S, const Epi& E, const int tid) {
    const int wid = __builtin_amdgcn_readfirstlane(tid >> 6), lane = tid & 63, wr = wid >> 2, wc = wid & 3, fr = lane & 15, fq = lane >> 4;
    Unit u;
    for (int i = 0; S.next(i, u); ++i) {
        Acc acc;
#pragma unroll
        for (int a = 0; a < 2; ++a)
#pragma unroll
            for (int b = 0; b < 2; ++b)
#pragma unroll
                for (int m = 0; m < 4; ++m)
#pragma unroll
                    for (int n = 0; n < 2; ++n) acc[a][b][m][n] = (f32x4){0.f, 0.f, 0.f, 0.f};
        const bf16_t* Ab = g.A + (size_t)u.pm * BM * g.lda + (size_t)(wr * 64 + fr) * g.lda + fq * 8;
        const bf16_t* Bb = g.Bt + (size_t)((u.pm / g.bdiv) % g.bmod) * g.bstride + (size_t)u.pn * BM * g.ldb + fq * 8;
        int brow[2][2];
#pragma unroll
        for (int bj = 0; bj < 2; ++bj)
#pragma unroll
            for (int n = 0; n < 2; ++n) brow[bj][n] = bj * HALF + wc * 32 + perm32(n * 16 + fr);
#pragma unroll 1
        for (int k0 = 0; k0 < g.K; k0 += 32) {
            bf16x8 b[2][2];
#pragma unroll
            for (int bj = 0; bj < 2; ++bj)
#pragma unroll
                for (int n = 0; n < 2; ++n) b[bj][n] = *(const bf16x8*)(Bb + (size_t)brow[bj][n] * g.ldb + k0);
#pragma unroll
            for (int ai = 0; ai < 2; ++ai) { bf16x8 a[4];
#pragma unroll
                for (int m = 0; m < 4; ++m) a[m] = *(const bf16x8*)(Ab + (size_t)(ai * HALF + m * 16) * g.lda + k0);
#pragma unroll
                for (int bj = 0; bj < 2; ++bj)
#pragma unroll
                    for (int m = 0; m < 4; ++m)
#pragma unroll
                        for (int n = 0; n < 2; ++n) acc[ai][bj][m][n] = __builtin_amdgcn_mfma_f32_16x16x32_bf16(b[bj][n], a[m], acc[ai][bj][m][n], 0, 0, 0); }
        }
        E.run(acc, u, wr, wc, fr, fq, lds, wid, lane);
        if (Epi::USES_LDS) __syncthreads();
    }
}

template <class Epi, class Sched, bool GATHER>
__device__ __forceinline__ void gemm_fast(LAS unsigned char* lds, const Gemm g, const Sched& S, const Epi& E, const int tid) {
    const int wid = __builtin_amdgcn_readfirstlane(tid >> 6), lane = tid & 63, wr = wid >> 2, wc = wid & 3, fr = lane & 15, fq = lane >> 4;
    int Kop = g.K; asm volatile("" : "+s"(Kop));
    const int K = Kop, nt = K / BK;
    int Rr[2], Cc[2]; unsigned voffB[2];
    unsigned cvA0[2], cvA1[2], nvA0[2], nvA1[2];
    const size_t kstep = (size_t)(BK * 2);
    const size_t hstepA = (size_t)HALF * g.lda * 2, hstepB = (size_t)HALF * g.ldb * 2;
    const size_t tstepA = 2 * hstepA, tstepB = 2 * hstepB;
#pragma unroll
    for (int i = 0; i < 2; ++i) { stage_rc(tid * 16 + i * 8192, Rr[i], Cc[i]); const int Rb = (Rr[i] & ~31) + perm32(Rr[i] & 31);
        voffB[i] = (unsigned)(Rb * g.ldb + Cc[i]) * 2u;
        cvA0[i] = (unsigned)(Rr[i] * g.lda + Cc[i]) * 2u; cvA1[i] = cvA0[i] + (unsigned)hstepA; nvA0[i] = cvA0[i]; nvA1[i] = cvA1[i]; }
    const unsigned ldsw = (unsigned)wid * 1024u;
    const int aoff = lds_byte(wr * 64 + fr, fq * 8), boff = lds_byte(wc * 32 + fr, fq * 8);
#define PG8_SA(b, h) (((b) * 2 + (h)) * HTB)
#define PG8_SB(b, h) ((4 + (b) * 2 + (h)) * HTB)
#define PG8_STAGE(bufoff, gbase, voff) do { _Pragma("unroll") for (int _i = 0; _i < 2; ++_i) \
        __builtin_amdgcn_global_load_lds((const unsigned*)((const char*)(gbase) + (voff)[_i]), (LAS unsigned*)(lds + (bufoff) + ldsw + _i * 8192), 16, 0, 0); } while (0)
#define PG8_LDA(dst, b, h) do { _Pragma("unroll") for (int m = 0; m < 4; ++m) _Pragma("unroll") for (int k = 0; k < 2; ++k) dst[m][k] = *(const LAS bf16x8*)(lds + PG8_SA(b, h) + aoff + m * 2048 + k * 1024); } while (0)
#define PG8_LDB(dst, b, h) do { _Pragma("unroll") for (int n = 0; n < 2; ++n) _Pragma("unroll") for (int k = 0; k < 2; ++k) dst[n][k] = *(const LAS bf16x8*)(lds + PG8_SB(b, h) + boff + n * 2048 + k * 1024); } while (0)
#define PG8_MMA(ai, bj, At, Bt) do { __builtin_amdgcn_s_setprio(1); _Pragma("unroll") for (int m = 0; m < 4; ++m) _Pragma("unroll") for (int n = 0; n < 2; ++n) _Pragma("unroll") for (int k = 0; k < 2; ++k) \
        acc[ai][bj][m][n] = __builtin_amdgcn_mfma_f32_16x16x32_bf16(Bt[n][k], At[m][k], acc[ai][bj][m][n], 0, 0, 0); __builtin_amdgcn_s_setprio(0); } while (0)
#define PG8_WAIT_V(n) asm volatile("s_waitcnt vmcnt(" #n ")" ::: "memory")
#define PG8_WAIT_L(n) asm volatile("s_waitcnt lgkmcnt(" #n ")" ::: "memory")
#define PG8_BAR __builtin_amdgcn_s_barrier()
#define PG8_SCHED __builtin_amdgcn_sched_barrier(0)
#define PG8_GIDX(u, raw) do { const int* ip_ = g.gidx + (size_t)(u).pm * BM; raw[0] = ip_[Rr[0]]; raw[1] = ip_[Rr[1]]; raw[2] = ip_[HALF + Rr[0]]; raw[3] = ip_[HALF + Rr[1]]; } while (0)
#define PG8_GOFF(u, raw, v0, v1) do { const unsigned bb_ = (unsigned)((u).pm >> 6) * (unsigned)SEQ; _Pragma("unroll") for (int _i = 0; _i < 2; ++_i) { \
        v0[_i] = ((bb_ + (unsigned)raw[_i]) * (unsigned)g.lda + (unsigned)Cc[_i]) * 2u; v1[_i] = ((bb_ + (unsigned)raw[2 + _i]) * (unsigned)g.lda + (unsigned)Cc[_i]) * 2u; } } while (0)
    Unit cur, nxt; int ui = 0;
    if (!S.next(0, cur)) return;
    Acc acc;
#pragma unroll
    for (int a = 0; a < 2; ++a)
#pragma unroll
        for (int b = 0; b < 2; ++b)
#pragma unroll
            for (int m = 0; m < 4; ++m)
#pragma unroll
                for (int n = 0; n < 2; ++n) acc[a][b][m][n] = (f32x4){0.f, 0.f, 0.f, 0.f};
    bf16x8 At[4][2], B0[2][2], B1[2][2];
    int nraw[4] = {0, 0, 0, 0};
    const char* cA = GATHER ? (const char*)g.A : (const char*)g.A + (size_t)cur.pm * tstepA;
    const char* cB = (const char*)g.Bt + (size_t)((cur.pm / g.bdiv) % g.bmod) * g.bstride * 2 + (size_t)cur.pn * tstepB;
    if constexpr (GATHER) { int craw[4]; PG8_GIDX(cur, craw); PG8_GOFF(cur, craw, cvA0, cvA1); }
    PG8_STAGE(PG8_SB(0, 0), cB, voffB); PG8_STAGE(PG8_SB(0, 1), cB + hstepB, voffB); PG8_STAGE(PG8_SA(0, 0), cA, cvA0); PG8_STAGE(PG8_SA(0, 1), cA, cvA1);
    if (wr == 1) PG8_BAR;
    PG8_WAIT_V(2); PG8_BAR;
    PG8_STAGE(PG8_SB(1, 0), cB + kstep, voffB); PG8_STAGE(PG8_SA(1, 0), cA + kstep, cvA0); PG8_STAGE(PG8_SB(1, 1), cB + hstepB + kstep, voffB);
    PG8_WAIT_V(6); PG8_BAR;
    for (;;) {
        const bool has_next = S.next(ui + 1, nxt);
        const char* nA = GATHER ? (const char*)g.A : (has_next ? (const char*)g.A + (size_t)nxt.pm * tstepA : cA);
        const char* nB = has_next ? (const char*)g.Bt + (size_t)((nxt.pm / g.bdiv) % g.bmod) * g.bstride * 2 + (size_t)nxt.pn * tstepB : cB;
        if constexpr (GATHER) { if (has_next) PG8_GIDX(nxt, nraw); }
        for (int t = 0; t < nt; t += 2) {
            const bool last = (t == nt - 2);
            const char* a1 = cA + (size_t)(t + 1) * kstep;
            const char* a2 = last ? nA : cA + (size_t)(t + 2) * kstep; const char* b2 = last ? nB : cB + (size_t)(t + 2) * kstep;
            const char* a3 = a2 + kstep; const char* b3 = b2 + kstep;
            unsigned sA0[2] = {cvA0[0], cvA0[1]}, sA1[2] = {cvA1[0], cvA1[1]};
            if constexpr (GATHER) { if (last) { if (has_next) PG8_GOFF(nxt, nraw, nvA0, nvA1); else { nvA0[0] = cvA0[0]; nvA0[1] = cvA0[1]; nvA1[0] = cvA1[0]; nvA1[1] = cvA1[1]; }
                                                 sA0[0] = nvA0[0]; sA0[1] = nvA0[1]; sA1[0] = nvA1[0]; sA1[1] = nvA1[1]; } }
            PG8_LDB(B0, 0, 0); PG8_LDB(B1, 0, 1); PG8_SCHED; PG8_LDA(At, 0, 0); PG8_STAGE(PG8_SA(1, 1), a1, cvA1);
            PG8_WAIT_V(8); PG8_WAIT_L(0); PG8_BAR; PG8_MMA(0, 0, At, B0); PG8_MMA(0, 1, At, B1); PG8_BAR; PG8_SCHED;
            PG8_LDA(At, 0, 1); PG8_STAGE(PG8_SB(0, 0), b2, voffB); PG8_STAGE(PG8_SB(0, 1), b2 + hstepB, voffB); PG8_STAGE(PG8_SA(0, 0), a2, sA0);
            PG8_WAIT_V(8); PG8_WAIT_L(0); PG8_BAR; PG8_MMA(1, 0, At, B0); PG8_MMA(1, 1, At, B1); PG8_BAR; PG8_SCHED;
            PG8_LDB(B0, 1, 0); PG8_LDB(B1, 1, 1); PG8_SCHED; PG8_LDA(At, 1, 0); PG8_STAGE(PG8_SA(0, 1), a2, sA1);
            PG8_WAIT_V(8); PG8_WAIT_L(0); PG8_BAR; PG8_MMA(0, 0, At, B0); PG8_MMA(0, 1, At, B1); PG8_BAR; PG8_SCHED;
            PG8_LDA(At, 1, 1); PG8_STAGE(PG8_SB(1, 0), b3, voffB); PG8_STAGE(PG8_SB(1, 1), b3 + hstepB, voffB); PG8_STAGE(PG8_SA(1, 0), a3, sA0);
            PG8_WAIT_V(8); PG8_WAIT_L(0); PG8_BAR; PG8_MMA(1, 0, At, B0); PG8_MMA(1, 1, At, B1); PG8_BAR; PG8_SCHED;
        }
        if (wr == 0) PG8_BAR;
        E.run(acc, cur, wr, wc, fr, fq, lds + STAGE_BYTES, wid, lane);
        if (!has_next) break;
#pragma unroll
        for (int a = 0; a < 2; ++a)
#pragma unroll
            for (int b = 0; b < 2; ++b)
#pragma unroll
                for (int m = 0; m < 4; ++m)
#pragma unroll
                    for (int n = 0; n < 2; ++n) acc[a][b][m][n] = (f32x4){0.f, 0.f, 0.f, 0.f};
        cur = nxt; cA = nA; cB = nB; ++ui;
        if constexpr (GATHER) { cvA0[0] = nvA0[0]; cvA0[1] = nvA0[1]; cvA1[0] = nvA1[0]; cvA1[1] = nvA1[1]; }
        if (wr == 1) PG8_BAR;
    }
    PG8_WAIT_V(0);
    PG8_BAR;
#undef PG8_SA
#undef PG8_SB
#undef PG8_STAGE
#undef PG8_LDA
#undef PG8_LDB
#undef PG8_MMA
#undef PG8_WAIT_V
#undef PG8_WAIT_L
#undef PG8_BAR
#undef PG8_SCHED
#undef PG8_GIDX
#undef PG8_GOFF
}

template <class Epi, class Sched, bool GATHER = false>
__device__ __forceinline__ void gemm_phase(LAS unsigned char* lds, const Gemm g, const Sched& S, const Epi& E, const int tid) {
#if GEMM_SIMPLE
    static_assert(!GATHER, "the simple body has no gather path");
    gemm_simple<Epi, Sched>(lds + STAGE_BYTES, g, S, E, tid);
#else
    gemm_fast<Epi, Sched, GATHER>(lds, g, S, E, tid);
#endif
}

template <class F> struct EpiChunk {
    static constexpr bool USES_LDS = false;
    F f;
    __device__ __forceinline__ void run(Acc& acc, const Unit& u, int wr, int wc, int fr, int fq, LAS unsigned char*, int, int) const {
        constexpr int NBT = F::NBATCH, GPB = 8 / NBT;
#pragma unroll
        for (int bt = 0; bt < NBT; ++bt) {
            typename F::Pre pre[GPB][2];
#pragma unroll
            for (int g = 0; g < GPB; ++g) { const int rg = bt * GPB + g, ai = rg >> 2, m = rg & 3; const int row = u.pm * BM + ai * HALF + wr * 64 + m * 16 + fr;
#pragma unroll
                for (int bj = 0; bj < 2; ++bj) { const int col = u.pn * BM + bj * HALF + wc * 32 + 8 * fq; pre[g][bj] = f.load(row, col); } }
            asm volatile("" ::: "memory");
#pragma unroll
            for (int g = 0; g < GPB; ++g) { const int rg = bt * GPB + g, ai = rg >> 2, m = rg & 3; const int row = u.pm * BM + ai * HALF + wr * 64 + m * 16 + fr;
#pragma unroll
                for (int bj = 0; bj < 2; ++bj) { const int col = u.pn * BM + bj * HALF + wc * 32 + 8 * fq;
                    const f32x4 a = acc[ai][bj][m][0], b = acc[ai][bj][m][1];
                    const float v[8] = {a[0], a[1], a[2], a[3], b[0], b[1], b[2], b[3]};
                    f.chunk(row, col, v, pre[g][bj]); } }
            asm volatile("" ::: "memory");
        }
    }
};
}
using pg8::Gemm; using pg8::Unit; using pg8::StaticOrder; using pg8::mkgemm;

struct PreNone {};
struct PreF { float r; };
struct FU { const float* rstd0; bf16_t *XGG, *CQ, *CKV, *KR, *SIGA, *SIGB; const float* bgate;
    static constexpr int NBATCH = 4;
    struct Pre { float rs; f32x4 b0, b1; };
    __device__ __forceinline__ Pre load(int row, int col) const { Pre p; p.rs = rstd0[row];
        if (col >= 3584) { p.b0 = *(const f32x4*)(bgate + (col - 3584)); p.b1 = *(const f32x4*)(bgate + (col - 3584) + 4); } else { p.b0 = (f32x4){0.f, 0.f, 0.f, 0.f}; p.b1 = p.b0; }
        return p; }
    __device__ __forceinline__ void chunk(int row, int col, const float (&v)[8], const Pre& p) const {
        const float rs = p.rs; float o[8];
#pragma unroll
        for (int i = 0; i < 8; ++i) o[i] = v[i] * rs;
        if (col < 3072) { *(u32x4*)(XGG + (size_t)row * 2048 + 1024 + (col - 2048)) = pack8(o); }
        else if (col < 3328) { *(u32x4*)(CQ + (size_t)row * 256 + (col - 3072)) = pack8(o); }
        else if (col < 3456) { *(u32x4*)(CKV + (size_t)row * 128 + (col - 3328)) = pack8(o); }
        else if (col < 3520) { *(u32x4*)(KR + (size_t)row * 64 + (col - 3456)) = pack8(o); }
        else if (col >= 3584) { const int c = col - 3584;
            const float bb[8] = {p.b0[0], p.b0[1], p.b0[2], p.b0[3], p.b1[0], p.b1[1], p.b1[2], p.b1[3]};
#pragma unroll
            for (int i = 0; i < 8; ++i) o[i] = 1.f / (1.f + __expf(-(o[i] + bb[i])));
            bf16_t* dst = c < 1024 ? SIGA + (size_t)row * 1024 + c : SIGB + (size_t)row * 1024 + (c - 1024);
            *(u32x4*)dst = pack8(o); }
    } };
struct EpiU {
    static constexpr bool USES_LDS = false;
    FU f;
    __device__ __forceinline__ void run(pg8::Acc& acc, const Unit& u, int wr, int wc, int fr, int fq, LAS unsigned char* scr, int wid, int lane) const {
        if (u.pn < 8) {
#pragma unroll
            for (int ai = 0; ai < 2; ++ai)
#pragma unroll
                for (int m = 0; m < 4; ++m) { const int row = u.pm * 256 + ai * 128 + wr * 64 + m * 16 + fr; const int col = u.pn * 128 + wc * 32 + 8 * fq; const float rs = f.rstd0[row]; const float r2 = rs * rs; float o[8];
#pragma unroll
                    for (int n = 0; n < 2; ++n)
#pragma unroll
                        for (int i = 0; i < 4; ++i) o[n * 4 + i] = acc[ai][0][m][n][i] * acc[ai][1][m][n][i] * r2;
                    *(u32x4*)(f.XGG + (size_t)row * 2048 + col) = pack8(o); }
        } else { pg8::EpiChunk<FU> E{f}; E.run(acc, u, wr, wc, fr, fq, scr, wid, lane); }
    }
};
struct FMemKV { const float* rstdm; bf16_t* MKV;
    static constexpr int NBATCH = 1; typedef PreF Pre;
    __device__ __forceinline__ Pre load(int row, int) const { Pre p; p.r = rstdm[row]; return p; }
    __device__ __forceinline__ void chunk(int row, int col, const float (&v)[8], const Pre& p) const {
        const float rs = p.r * (col < 1024 ? 0.0625f : 1.f); float o[8];
#pragma unroll
        for (int i = 0; i < 8; ++i) o[i] = v[i] * rs;
        const int kv = col >> 10, h = (col >> 8) & 3, j = col & 255, b = row >> 8, key = row & 255;
        *(u32x4*)(MKV + ((size_t)((kv * 2 + b) * 4 + h) * 256 + key) * 256 + j) = pack8(o);
    } };
struct FQ { const float* rstdq; const f32x2* rope; bf16_t* Q; unsigned char* Q8;
    static constexpr int NBATCH = 4;
    struct Pre { float rs; f32x2 cs[4]; };
    __device__ __forceinline__ Pre load(int row, int col) const { Pre p; p.rs = rstdq[row];
        if (col >= 1024) { const int pp = (col - 1024) & 63, j0 = (pp >> 3) * 4, s = row & (SEQ - 1);
#pragma unroll
            for (int i = 0; i < 4; ++i) p.cs[i] = rope[s * 32 + j0 + i]; }
        else {
#pragma unroll
            for (int i = 0; i < 4; ++i) p.cs[i] = (f32x2){1.f, 0.f}; }
        return p; }
    __device__ __forceinline__ void chunk(int row, int col, const float (&v)[8], const Pre& p) const {
        const float rs = p.rs; float o[8];
#pragma unroll
        for (int i = 0; i < 8; ++i) o[i] = v[i] * rs;
        if (col >= 1024) {
#pragma unroll
            for (int i = 0; i < 4; ++i) { const f32x2 cs = p.cs[i]; const float a = o[i], b = o[4 + i]; o[i] = a * cs.x - b * cs.y; o[4 + i] = a * cs.y + b * cs.x; } }
        if (Q8) { float q[8];
#pragma unroll
            for (int i = 0; i < 8; ++i) q[i] = o[i] * (ATT_SCALE * 1.4426950408889634f);
            *(u32x2*)(Q8 + (size_t)row * 1536 + col) = pack8_fp8(q); }
        else *(u32x4*)(Q + (size_t)row * 1536 + col) = pack8(o);
    } };
struct FScaleRow { const float* rs; bf16_t* O; int ldo;
    static constexpr int NBATCH = 1; typedef PreF Pre;
    __device__ __forceinline__ Pre load(int row, int) const { Pre p; p.r = rs[row]; return p; }
    __device__ __forceinline__ void chunk(int row, int col, const float (&v)[8], const Pre& p) const {
        const float r = p.r; float o[8];
#pragma unroll
        for (int i = 0; i < 8; ++i) o[i] = v[i] * r;
        *(u32x4*)(O + (size_t)row * ldo + col) = pack8(o);
    } };
struct FKV8 { const float* rs; bf16_t* KV; unsigned char* K8;
    static constexpr int NBATCH = 1; typedef PreF Pre;
    __device__ __forceinline__ Pre load(int row, int) const { Pre p; p.r = rs[row]; return p; }
    __device__ __forceinline__ void chunk(int row, int col, const float (&v)[8], const Pre& p) const {
        const float r = p.r; float o[8];
#pragma unroll
        for (int i = 0; i < 8; ++i) o[i] = v[i] * r;
        if (col < 1024) *(u32x2*)(K8 + (size_t)row * 1024 + col) = pack8_fp8(o); else *(u32x4*)(KV + (size_t)row * 2048 + col) = pack8(o);
    } };
struct FK8 { const float* rs; unsigned char* K8;
    static constexpr int NBATCH = 1; typedef PreF Pre;
    __device__ __forceinline__ Pre load(int row, int) const { Pre p; p.r = rs[row]; return p; }
    __device__ __forceinline__ void chunk(int row, int col, const float (&v)[8], const Pre& p) const {
        const float r = p.r; float o[8];
#pragma unroll
        for (int i = 0; i < 8; ++i) o[i] = v[i] * r;
        *(u32x2*)(K8 + (size_t)row * 1024 + col) = pack8_fp8(o);
    } };
struct FVT8 { const float* rs; unsigned char* VT;
    static constexpr int NBATCH = 2;
    struct Pre { f32x4 a, b; };
    __device__ __forceinline__ Pre load(int, int col) const { Pre p; p.a = *(const f32x4*)(rs + col); p.b = *(const f32x4*)(rs + col + 4); return p; }
    __device__ __forceinline__ void chunk(int row, int col, const float (&v)[8], const Pre& p) const {
        const float o[8] = {v[0] * p.a[0], v[1] * p.a[1], v[2] * p.a[2], v[3] * p.a[3], v[4] * p.b[0], v[5] * p.b[1], v[6] * p.b[2], v[7] * p.b[3]};
        *(u32x2*)(VT + (size_t)(col >> 13) * ((size_t)1024 * SEQ) + (size_t)row * SEQ + (col & (SEQ - 1))) = pack8_fp8(o);
    } };
struct FPlain { bf16_t* O; int ldo;
    static constexpr int NBATCH = 1; typedef PreNone Pre;
    __device__ __forceinline__ Pre load(int, int) const { return Pre{}; }
    __device__ __forceinline__ void chunk(int row, int col, const float (&v)[8], const Pre&) const { *(u32x4*)(O + (size_t)row * ldo + col) = pack8(v); } };
struct FVW { bf16_t* O;
    static constexpr int NBATCH = 1; typedef PreNone Pre;
    __device__ __forceinline__ Pre load(int, int) const { return Pre{}; }
    __device__ __forceinline__ void chunk(int row, int col, const float (&v)[8], const Pre&) const { const int h = row >> 10, n = row & 1023; *(u32x4*)(O + (size_t)n * 1024 + h * 256 + col) = pack8(v); } };
struct FGateMul { const bf16_t* G; bf16_t* O;
    static constexpr int NBATCH = 2;
    struct Pre { u32x4 g; };
    __device__ __forceinline__ Pre load(int row, int col) const { Pre p; p.g = *(const u32x4*)(G + (size_t)row * 1024 + col); return p; }
    __device__ __forceinline__ void chunk(int row, int col, const float (&v)[8], const Pre& p) const {
        float g[8], o[8]; unpack8(p.g, g);
#pragma unroll
        for (int i = 0; i < 8; ++i) o[i] = g[i] * v[i];
        *(u32x4*)(O + (size_t)row * 1024 + col) = pack8(o);
    } };
struct FGateMulAdd { const bf16_t* G; const bf16_t* Pv; bf16_t* O;
    static constexpr int NBATCH = 2;
    struct Pre { u32x4 g, p; };
    __device__ __forceinline__ Pre load(int row, int col) const { Pre p; p.g = *(const u32x4*)(G + (size_t)row * 1024 + col); p.p = *(const u32x4*)(Pv + (size_t)row * 1024 + col); return p; }
    __device__ __forceinline__ void chunk(int row, int col, const float (&v)[8], const Pre& pr) const {
        float g[8], p[8], o[8]; unpack8(pr.g, g); unpack8(pr.p, p);
#pragma unroll
        for (int i = 0; i < 8; ++i) o[i] = p[i] + g[i] * v[i];
        *(u32x4*)(O + (size_t)row * 1024 + col) = pack8(o);
    } };
struct FResidF32 { const float* base; float* out;
    static constexpr int NBATCH = 2;
    struct Pre { f32x4 a, b; };
    __device__ __forceinline__ Pre load(int row, int col) const { const size_t off = (size_t)row * 1024 + col; Pre p; p.a = *(const f32x4*)(base + off); p.b = *(const f32x4*)(base + off + 4); return p; }
    __device__ __forceinline__ void chunk(int row, int col, const float (&v)[8], const Pre& p) const {
        const size_t off = (size_t)row * 1024 + col; const f32x4 a = p.a, b = p.b;
        *(f32x4*)(out + off) = (f32x4){a[0] + v[0], a[1] + v[1], a[2] + v[2], a[3] + v[3]}; *(f32x4*)(out + off + 4) = (f32x4){b[0] + v[4], b[1] + v[5], b[2] + v[6], b[3] + v[7]};
    } };
struct FResidBf16 { const bf16_t* base; bf16_t* out;
    static constexpr int NBATCH = 1;
    struct Pre { u32x4 a; };
    __device__ __forceinline__ Pre load(int row, int col) const { Pre p; p.a = *(const u32x4*)(base + (size_t)row * 1024 + col); return p; }
    __device__ __forceinline__ void chunk(int row, int col, const float (&v)[8], const Pre& p) const {
        float a[8], o[8]; unpack8(p.a, a);
#pragma unroll
        for (int i = 0; i < 8; ++i) o[i] = a[i] + v[i];
        *(u32x4*)(out + (size_t)row * 1024 + col) = pack8(o);
    } };
struct FGateRow { const float* gate; bf16_t* O;
    static constexpr int NBATCH = 1; typedef PreF Pre;
    __device__ __forceinline__ Pre load(int row, int) const { Pre p; p.r = gate[row]; return p; }
    __device__ __forceinline__ void chunk(int row, int col, const float (&v)[8], const Pre& p) const {
        const float r = p.r; float o[8];
#pragma unroll
        for (int i = 0; i < 8; ++i) o[i] = v[i] * r;
        *(u32x4*)(O + (size_t)row * 1024 + col) = pack8(o);
    } };

struct EpiX1 {
    static constexpr bool USES_LDS = false;
    const float* base; float* out; bf16_t* xb; float* ssq;
    __device__ __forceinline__ void run(pg8::Acc& acc, const Unit& u, int wr, int wc, int fr, int fq, LAS unsigned char*, int, int) const {
#pragma unroll
        for (int bt = 0; bt < 4; ++bt) { f32x4 pa[2][2], pb[2][2];
#pragma unroll
            for (int g = 0; g < 2; ++g) { const int rg = bt * 2 + g, ai = rg >> 2, m = rg & 3; const int row = u.pm * 256 + ai * 128 + wr * 64 + m * 16 + fr;
#pragma unroll
                for (int bj = 0; bj < 2; ++bj) { const size_t off = (size_t)row * 1024 + u.pn * 256 + bj * 128 + wc * 32 + 8 * fq; pa[g][bj] = *(const f32x4*)(base + off); pb[g][bj] = *(const f32x4*)(base + off + 4); } }
            asm volatile("" ::: "memory");
#pragma unroll
            for (int g = 0; g < 2; ++g) { const int rg = bt * 2 + g, ai = rg >> 2, m = rg & 3; const int row = u.pm * 256 + ai * 128 + wr * 64 + m * 16 + fr; float s = 0.f;
#pragma unroll
                for (int bj = 0; bj < 2; ++bj) { const int col = u.pn * 256 + bj * 128 + wc * 32 + 8 * fq; const size_t off = (size_t)row * 1024 + col;
                    const f32x4 a = pa[g][bj], b = pb[g][bj]; const f32x4 c0 = acc[ai][bj][m][0], c1 = acc[ai][bj][m][1];
                    const float o[8] = {a[0] + c0[0], a[1] + c0[1], a[2] + c0[2], a[3] + c0[3], b[0] + c1[0], b[1] + c1[1], b[2] + c1[2], b[3] + c1[3]};
                    if (out) { *(f32x4*)(out + off) = (f32x4){o[0], o[1], o[2], o[3]}; *(f32x4*)(out + off + 4) = (f32x4){o[4], o[5], o[6], o[7]}; }
                    *(u32x4*)(xb + off) = pack8(o);
#pragma unroll
                    for (int i = 0; i < 8; ++i) s += o[i] * o[i]; }
                s += __shfl_xor(s, 16); s += __shfl_xor(s, 32);
                if (fq == 0) ssq[(size_t)row * 16 + u.pn * 4 + wc] = s; }
            asm volatile("" ::: "memory"); }
    }
};
struct EpiSoftmax {
    static constexpr bool USES_LDS = true;
    const float* ssq; bf16_t* P;
    __device__ __forceinline__ void run(pg8::Acc& acc, const Unit& u, int wr, int wc, int fr, int fq, LAS unsigned char* scr, int wid_, int lane_) const {
        LAS float* PM = (LAS float*)scr;
        LAS float* PS = (LAS float*)(scr + 4096);
        LAS float* RS = (LAS float*)(scr + 4096);
        { const int t = wid_ * 64 + lane_; if (t < 256) { const f32x4* sp = (const f32x4*)((const char*)ssq + (unsigned)(u.pm * 256 + t) * 64u); const f32x4 q0 = sp[0], q1 = sp[1], q2 = sp[2], q3 = sp[3];
            float tt = ((q0[0] + q0[1]) + (q0[2] + q0[3])) + ((q1[0] + q1[1]) + (q1[2] + q1[3])); tt += ((q2[0] + q2[1]) + (q2[2] + q2[3])) + ((q3[0] + q3[1]) + (q3[2] + q3[3]));
            RS[t] = 1.f / sqrtf(tt * (1.f / 1024.f) + EPS); } }
        __syncthreads();
#pragma unroll
        for (int ai = 0; ai < 2; ++ai)
#pragma unroll
            for (int m = 0; m < 4; ++m) { const int rl = ai * 128 + wr * 64 + m * 16 + fr;
                const float rs = RS[rl];
                float mx = -3.0e38f;
#pragma unroll
                for (int bj = 0; bj < 2; ++bj)
#pragma unroll
                    for (int n = 0; n < 2; ++n)
#pragma unroll
                        for (int i = 0; i < 4; ++i) { const float s = acc[ai][bj][m][n][i] * rs; acc[ai][bj][m][n][i] = s; mx = fmaxf(mx, s); }
                mx = fmaxf(mx, __shfl_xor(mx, 16)); mx = fmaxf(mx, __shfl_xor(mx, 32));
                if (fq == 0) PM[rl * 4 + wc] = mx;
                asm volatile("" ::: "memory"); }
        __syncthreads();
#pragma unroll
        for (int ai = 0; ai < 2; ++ai)
#pragma unroll
            for (int m = 0; m < 4; ++m) { const int rl = ai * 128 + wr * 64 + m * 16 + fr;
                const f32x4 pm4 = *(const LAS f32x4*)(PM + rl * 4); const float mx = fmaxf(fmaxf(pm4[0], pm4[1]), fmaxf(pm4[2], pm4[3]));
                float s = 0.f;
#pragma unroll
                for (int bj = 0; bj < 2; ++bj)
#pragma unroll
                    for (int n = 0; n < 2; ++n)
#pragma unroll
                        for (int i = 0; i < 4; ++i) { const float e = __expf(acc[ai][bj][m][n][i] - mx); acc[ai][bj][m][n][i] = e; s += e; }
                s += __shfl_xor(s, 16); s += __shfl_xor(s, 32);
                if (fq == 0) PS[rl * 4 + wc] = s;
                asm volatile("" ::: "memory"); }
        __syncthreads();
#pragma unroll
        for (int ai = 0; ai < 2; ++ai)
#pragma unroll
            for (int m = 0; m < 4; ++m) { const int rl = ai * 128 + wr * 64 + m * 16 + fr; const int row = u.pm * 256 + rl;
                const f32x4 ps4 = *(const LAS f32x4*)(PS + rl * 4); const float inv = 1.f / ((ps4[0] + ps4[1]) + (ps4[2] + ps4[3]));
#pragma unroll
                for (int bj = 0; bj < 2; ++bj) { const int col = u.pn * 256 + bj * 128 + wc * 32 + 8 * fq; float o[8];
#pragma unroll
                    for (int n = 0; n < 2; ++n)
#pragma unroll
                        for (int i = 0; i < 4; ++i) o[n * 4 + i] = acc[ai][bj][m][n][i] * inv;
                    *(u32x4*)((char*)P + ((unsigned)row * 1024u + (unsigned)col) * 2u) = pack8(o); }
                asm volatile("" ::: "memory"); }
    }
};
struct EpiSwiglu {
    static constexpr bool USES_LDS = false;
    bf16_t* H;
    __device__ __forceinline__ void run(pg8::Acc& acc, const Unit& u, int wr, int wc, int fr, int fq, LAS unsigned char*, int, int) const {
#pragma unroll
        for (int ai = 0; ai < 2; ++ai)
#pragma unroll
            for (int m = 0; m < 4; ++m) { const int row = u.pm * 256 + ai * 128 + wr * 64 + m * 16 + fr; const int col = u.pn * 128 + wc * 32 + 8 * fq; float o[8];
#pragma unroll
                for (int n = 0; n < 2; ++n)
#pragma unroll
                    for (int i = 0; i < 4; ++i) { const float g = acc[ai][0][m][n][i], up = acc[ai][1][m][n][i]; o[n * 4 + i] = g / (1.f + __expf(-g)) * up; }
                *(u32x4*)(H + (size_t)row * 1024 + col) = pack8(o); }
    }
};

namespace att {
constexpr int QBLK = 32, KVBLK = 64, NW = 8;
constexpr int LDQ = 1536, LDKV = 2048, LDKR = 64, LDO = 1024;
constexpr int KPITCH = 272, KRPITCH = 144;
constexpr int SHM_V = KVBLK * 128 * 2, SHM_K = KVBLK * KPITCH, SHM_KR = KVBLK * KRPITCH;
constexpr int OFF_V = 0, OFF_K = 2 * SHM_V, OFF_KR = OFF_K + 2 * SHM_K, OFF_WS = OFF_KR + 2 * SHM_KR, OFF_QR = OFF_WS + NW * 64 * 4, SHM_ATTN = OFF_QR + NW * 4096;
constexpr float THR = 8.f;
#define KSWZ(row, colB) ((row) * KPITCH + (colB))
#define KRSWZ(row, colB) ((row) * KRPITCH + (colB))
#define SBAR() __builtin_amdgcn_sched_barrier(0)
__device__ __forceinline__ int crow(int r, int hi) { return (r & 3) + 8 * (r >> 2) + 4 * hi; }
__device__ __forceinline__ unsigned cvtpk_a(float lo, float hi) { unsigned r; asm volatile("v_cvt_pk_bf16_f32 %0, %1, %2" : "=v"(r) : "v"(lo), "v"(hi)); return r; }

__device__ __forceinline__ void partialSM(f32x16& p0, f32x16& p1, float& m_reg, float& mn, float& alpha) {
  constexpr float C = ATT_SCALE * 1.4426950408889634f;
  float pmax = p0[0];
#pragma unroll
  for (int r = 1; r < 16; ++r) pmax = fmaxf(pmax, p0[r]);
#pragma unroll
  for (int r = 0; r < 16; ++r) pmax = fmaxf(pmax, p1[r]);
  { auto rr = __builtin_amdgcn_permlane32_swap(__float_as_uint(pmax), __float_as_uint(pmax), false, false);
    pmax = fmaxf(__uint_as_float(rr[0]), __uint_as_float(rr[1])); }
  if (__builtin_expect(__all(pmax - m_reg <= THR / ATT_SCALE), 1)) { mn = m_reg; alpha = 1.f; }
  else { mn = fmaxf(m_reg, pmax); alpha = __builtin_amdgcn_exp2f((m_reg - mn) * C); m_reg = mn; }
  float mnC = -mn * C;
#pragma unroll
  for (int r = 0; r < 16; ++r) p0[r] = fmaf(p0[r], C, mnC);
#pragma unroll
  for (int r = 0; r < 16; ++r) p1[r] = fmaf(p1[r], C, mnC);
#pragma unroll
  for (int r = 0; r < 16; ++r) p0[r] = __builtin_amdgcn_exp2f(p0[r]);
}
__device__ __forceinline__ void finishSM(f32x16& p0, f32x16& p1, float alpha, float& l_reg, bf16x8& pa0, bf16x8& pa1, bf16x8& pa2, bf16x8& pa3) {
#pragma unroll
  for (int r = 0; r < 16; ++r) p1[r] = __builtin_amdgcn_exp2f(p1[r]);
  float ps = 0;
#pragma unroll
  for (int r = 0; r < 16; ++r) ps += p0[r];
#pragma unroll
  for (int r = 0; r < 16; ++r) ps += p1[r];
  { auto rr = __builtin_amdgcn_permlane32_swap(__float_as_uint(ps), __float_as_uint(ps), false, false);
    ps = __uint_as_float(rr[0]) + __uint_as_float(rr[1]); }
  l_reg = l_reg * alpha + ps;
#define PK4(P, BASE, OUT) do { unsigned a0 = cvtpk_a(P[BASE + 0], P[BASE + 1]), a1 = cvtpk_a(P[BASE + 2], P[BASE + 3]);   \
    unsigned b0 = cvtpk_a(P[BASE + 4], P[BASE + 5]), b1 = cvtpk_a(P[BASE + 6], P[BASE + 7]);                              \
    auto r0 = __builtin_amdgcn_permlane32_swap(a0, b0, false, false); auto r1 = __builtin_amdgcn_permlane32_swap(a1, b1, false, false); \
    u32x4 w = {r0[0], r1[0], r0[1], r1[1]}; OUT = *reinterpret_cast<bf16x8*>(&w); } while (0)
  PK4(p0, 0, pa0); PK4(p0, 8, pa1); PK4(p1, 0, pa2); PK4(p1, 8, pa3);
#undef PK4
}
__device__ __forceinline__ void qkt(f32x16& p0, f32x16& p1, const char* Ks, const char* Krs, const bf16x8* qr, const char* qpark, int r32, int hi) {
  p0 = f32x16{}; p1 = f32x16{};
  const char* kb = Ks + r32 * KPITCH + hi * 16; const char* rb = Krs + r32 * KRPITCH + hi * 16;
#pragma unroll
  for (int d0 = 0; d0 < 8; ++d0) {
    bf16x8 b0 = *reinterpret_cast<const bf16x8*>(kb + d0 * 32);
    bf16x8 b1 = *reinterpret_cast<const bf16x8*>(kb + 32 * KPITCH + d0 * 32);
    p0 = __builtin_amdgcn_mfma_f32_32x32x16_bf16(b0, qr[d0], p0, 0, 0, 0);
    p1 = __builtin_amdgcn_mfma_f32_32x32x16_bf16(b1, qr[d0], p1, 0, 0, 0); }
#pragma unroll
  for (int d0 = 0; d0 < 4; ++d0) {
    bf16x8 b0 = *reinterpret_cast<const bf16x8*>(rb + d0 * 32);
    bf16x8 b1 = *reinterpret_cast<const bf16x8*>(rb + 32 * KRPITCH + d0 * 32);
    const bf16x8 qf = qr[8 + d0];
    p0 = __builtin_amdgcn_mfma_f32_32x32x16_bf16(b0, qf, p0, 0, 0, 0);
    p1 = __builtin_amdgcn_mfma_f32_32x32x16_bf16(b1, qf, p1, 0, 0, 0); }
}
__device__ __forceinline__ int v_st(int k, int c) { const int kk = (k & ~0xC) | ((k & 4) << 1) | ((k & 8) >> 1); return ((kk >> 3) * 4 + (c >> 5)) * 512 + ((kk & 7) * 32 + (c & 31)) * 2; }
__device__ __forceinline__ int v_rd_base(int lane) { return ((lane & 3) << 3) | (((lane >> 2) & 3) << 6) | (((lane >> 4) & 1) << 5) | (((lane >> 5) & 1) << 8); }
constexpr int v_rd_off(int d0, int ks, int half) { return d0 * 512 + ks * 4096 + half * 2048; }
template <int OFF> __device__ __forceinline__ s16x4 tr_read(int vb) {
  s16x4 r; asm volatile("ds_read_b64_tr_b16 %0, %1 offset:%2" : "=&v"(r) : "v"(vb), "i"(OFF) : "memory"); return r;
}
template <int D0> __device__ __forceinline__ void pv_one(f32x16& od, int vb, bf16x8 pa0, bf16x8 pa1, bf16x8 pa2, bf16x8 pa3) {
  const s16x4 l0 = tr_read<v_rd_off(D0, 0, 0)>(vb), h0 = tr_read<v_rd_off(D0, 0, 1)>(vb), l1 = tr_read<v_rd_off(D0, 1, 0)>(vb), h1 = tr_read<v_rd_off(D0, 1, 1)>(vb);
  const s16x4 l2 = tr_read<v_rd_off(D0, 2, 0)>(vb), h2 = tr_read<v_rd_off(D0, 2, 1)>(vb), l3 = tr_read<v_rd_off(D0, 3, 0)>(vb), h3 = tr_read<v_rd_off(D0, 3, 1)>(vb);
  asm volatile("s_waitcnt lgkmcnt(0)" ::: "memory"); SBAR();
#define PK(L, H) (bf16x8){L[0], L[1], L[2], L[3], H[0], H[1], H[2], H[3]}
  od = __builtin_amdgcn_mfma_f32_32x32x16_bf16(pa0, PK(l0, h0), od, 0, 0, 0);
  od = __builtin_amdgcn_mfma_f32_32x32x16_bf16(pa1, PK(l1, h1), od, 0, 0, 0);
  od = __builtin_amdgcn_mfma_f32_32x32x16_bf16(pa2, PK(l2, h2), od, 0, 0, 0);
  od = __builtin_amdgcn_mfma_f32_32x32x16_bf16(pa3, PK(l3, h3), od, 0, 0, 0);
#undef PK
}
__device__ __forceinline__ void pv_d0(f32x16* o, int vb, bf16x8 pa0, bf16x8 pa1, bf16x8 pa2, bf16x8 pa3) {
  pv_one<0>(o[0], vb, pa0, pa1, pa2, pa3); pv_one<1>(o[1], vb, pa0, pa1, pa2, pa3); pv_one<2>(o[2], vb, pa0, pa1, pa2, pa3); pv_one<3>(o[3], vb, pa0, pa1, pa2, pa3);
}

__device__ __forceinline__ void attn_unit(const bf16_t* __restrict__ Qn, const bf16_t* __restrict__ Qr, const bf16_t* __restrict__ Kh,
                                          const bf16_t* __restrict__ Krh, bf16_t* __restrict__ Ob, int seq, char* lds, const int tid) {
  const int wid = tid >> 6, lane = tid & 63, r32 = lane & 31, hi = lane >> 5;
  char* V_lds = lds + OFF_V; char* K_lds = lds + OFF_K; char* Kr_lds = lds + OFF_KR;
  float* ws = (float*)(lds + OFF_WS) + wid * 64; float* li_l = ws; float* al_l = ws + 32;
  float m_reg = -1e30f, l_reg = 0; f32x16 o[4] = {}; bf16x8 qr[12];
  char* qpark = nullptr;
  { const bf16_t* qn = Qn + (long)(wid * QBLK + r32) * LDQ + hi * 8; const bf16_t* qq = Qr + (long)(wid * QBLK + r32) * LDQ + hi * 8;
#pragma unroll
    for (int d0 = 0; d0 < 8; ++d0) qr[d0] = *reinterpret_cast<const bf16x8*>(qn + d0 * 16);
#pragma unroll
    for (int d0 = 0; d0 < 4; ++d0) qr[8 + d0] = *reinterpret_cast<const bf16x8*>(qq + d0 * 16); }
  const int sr = tid >> 4, sc = (tid & 15) * 8, vst0 = v_st(sr, sc), vst1 = v_st(32 + sr, sc);
  const int krr = tid >> 3, krc = (tid & 7) * 8;
  const int vb0 = (int)(uintptr_t)V_lds + v_rd_base(lane);
  bf16x8 vs0, vs1, ks0, ks1, kr0;
  const unsigned offkv = (unsigned)(sr * LDKV + sc) * 2u, offkr = (unsigned)(krr * LDKR + krc) * 2u;
#define SLOAD(k0) do { const char* kb_ = (const char*)Kh + (size_t)(k0) * (LDKV * 2); const char* kb2_ = kb_ + 32 * LDKV * 2; const char* rb_ = (const char*)Krh + (size_t)(k0) * (LDKR * 2); \
    ks0 = *reinterpret_cast<const bf16x8*>(kb_ + offkv); vs0 = *reinterpret_cast<const bf16x8*>(kb_ + offkv + 2048); \
    ks1 = *reinterpret_cast<const bf16x8*>(kb2_ + offkv); vs1 = *reinterpret_cast<const bf16x8*>(kb2_ + offkv + 2048); \
    kr0 = *reinterpret_cast<const bf16x8*>(rb_ + offkr); } while (0)
#define SWRITE(b) do { *(bf16x8*)(V_lds + (b) * SHM_V + vst0) = vs0; *(bf16x8*)(V_lds + (b) * SHM_V + vst1) = vs1; const int kc = sc * 2; \
    *(bf16x8*)(K_lds + (b) * SHM_K + KSWZ(sr, kc)) = ks0; *(bf16x8*)(K_lds + (b) * SHM_K + KSWZ(32 + sr, kc)) = ks1; \
    *(bf16x8*)(Kr_lds + (b) * SHM_KR + KRSWZ(krr, krc * 2)) = kr0; } while (0)
#define SWAIT() asm volatile("s_waitcnt vmcnt(0)" ::: "memory")
#define RESC(a) do { if (__any((a) < 1.f)) { if (hi == 0) al_l[r32] = (a); asm volatile("s_waitcnt lgkmcnt(0)" ::: "memory"); \
    _Pragma("unroll") for (int d = 0; d < 4; ++d) _Pragma("unroll") for (int r = 0; r < 16; ++r) o[d][r] *= al_l[crow(r, hi)]; } } while (0)
  f32x16 pA0, pA1, pB0, pB1; float mnA, mnB, alA, alB; bf16x8 pa0, pa1, pa2, pa3; const int NT = seq / KVBLK;
  SLOAD(0); SWAIT(); SWRITE(0); __syncthreads();
  qkt(pA0, pA1, K_lds, Kr_lds, qr, qpark, r32, hi); partialSM(pA0, pA1, m_reg, mnA, alA);
  SLOAD(KVBLK);
  SWAIT(); SWRITE(1); __syncthreads();
  for (int j = 1; j + 1 < NT; j += 2) {
    SBAR(); qkt(pB0, pB1, K_lds + SHM_K, Kr_lds + SHM_KR, qr, qpark, r32, hi);
    finishSM(pA0, pA1, alA, l_reg, pa0, pa1, pa2, pa3); SBAR();
    SLOAD((j + 1) * KVBLK); SBAR();
    pv_d0(o, vb0, pa0, pa1, pa2, pa3); partialSM(pB0, pB1, m_reg, mnB, alB);
    __syncthreads(); SWAIT(); SWRITE(0);
    RESC(alB); __syncthreads();
    SBAR(); qkt(pA0, pA1, K_lds, Kr_lds, qr, qpark, r32, hi);
    finishSM(pB0, pB1, alB, l_reg, pa0, pa1, pa2, pa3); SBAR();
    SLOAD((j + 2) * KVBLK); SBAR();
    pv_d0(o, vb0 + SHM_V, pa0, pa1, pa2, pa3); partialSM(pA0, pA1, m_reg, mnA, alA);
    __syncthreads(); SWAIT(); SWRITE(1);
    RESC(alA); __syncthreads();
  }
  SBAR(); qkt(pB0, pB1, K_lds + SHM_K, Kr_lds + SHM_KR, qr, qpark, r32, hi);
  finishSM(pA0, pA1, alA, l_reg, pa0, pa1, pa2, pa3); SBAR();
  pv_d0(o, vb0, pa0, pa1, pa2, pa3); partialSM(pB0, pB1, m_reg, mnB, alB);
  __syncthreads(); RESC(alB);
  finishSM(pB0, pB1, alB, l_reg, pa0, pa1, pa2, pa3); SBAR();
  pv_d0(o, vb0 + SHM_V, pa0, pa1, pa2, pa3);
  if (hi == 0) li_l[r32] = l_reg; asm volatile("s_waitcnt lgkmcnt(0)" ::: "memory");
  float rli[16];
#pragma unroll
  for (int r = 0; r < 16; ++r) rli[r] = __builtin_amdgcn_rcpf(li_l[crow(r, hi)]);
  bf16_t* Ow = Ob + (long)(wid * QBLK) * LDO;
#pragma unroll
  for (int r = 0; r < 16; ++r) { const int orow = crow(r, hi);
#pragma unroll
    for (int d0 = 0; d0 < 4; ++d0) Ow[(long)orow * LDO + d0 * 32 + r32] = f2bf(o[d0][r] * rli[r]); }
  __syncthreads();
#undef SLOAD
#undef SWRITE
#undef SWAIT
#undef RESC
}

constexpr int K8P = 144, KR8P = 80, SHM_K8 = KVBLK * K8P, SHM_KR8 = KVBLK * KR8P;
constexpr int O8_V = 0, O8_K = 2 * SHM_V, O8_KR = O8_K + 2 * SHM_K8, O8_WS = O8_KR + 2 * SHM_KR8, SHM_ATTN8 = O8_WS + NW * 64 * 4;
__device__ __forceinline__ v8i ld32(const char* p) { const u32x4 a = *reinterpret_cast<const u32x4*>(p), b = *reinterpret_cast<const u32x4*>(p + 16); return (v8i){(int)a.x, (int)a.y, (int)a.z, (int)a.w, (int)b.x, (int)b.y, (int)b.z, (int)b.w}; }
__device__ __forceinline__ void qkt8(f32x16& p0, f32x16& p1, const char* Ks, const char* Krs, const v8i* qf, int r32, int hi) {
  p0 = f32x16{}; p1 = f32x16{};
  const char* kb = Ks + r32 * K8P + hi * 32; const char* rb = Krs + r32 * KR8P + hi * 32;
#pragma unroll
  for (int st = 0; st < 2; ++st) { const v8i a0 = ld32(kb + st * 64), a1 = ld32(kb + 32 * K8P + st * 64);
    p0 = __builtin_amdgcn_mfma_scale_f32_32x32x64_f8f6f4(a0, qf[st], p0, 0, 0, 0, 0x7f7f7f7f, 0, 0x7f7f7f7f);
    p1 = __builtin_amdgcn_mfma_scale_f32_32x32x64_f8f6f4(a1, qf[st], p1, 0, 0, 0, 0x7f7f7f7f, 0, 0x7f7f7f7f); }
  { const v8i a0 = ld32(rb), a1 = ld32(rb + 32 * KR8P);
    p0 = __builtin_amdgcn_mfma_scale_f32_32x32x64_f8f6f4(a0, qf[2], p0, 0, 0, 0, 0x7f7f7f7f, 0, 0x7f7f7f7f);
    p1 = __builtin_amdgcn_mfma_scale_f32_32x32x64_f8f6f4(a1, qf[2], p1, 0, 0, 0, 0x7f7f7f7f, 0, 0x7f7f7f7f); }
}
__device__ __forceinline__ void attn_unit8(const unsigned char* __restrict__ Q8n, const unsigned char* __restrict__ Q8r, const unsigned char* __restrict__ K8h,
                                           const unsigned char* __restrict__ Kr8, const bf16_t* __restrict__ Vh, bf16_t* __restrict__ Ob, int seq, char* lds, const int tid) {
  const int wid = tid >> 6, lane = tid & 63, r32 = lane & 31, hi = lane >> 5;
  char* V_lds = lds + O8_V; char* K_lds = lds + O8_K; char* Kr_lds = lds + O8_KR;
  float* ws = (float*)(lds + O8_WS) + wid * 64; float* li_l = ws; float* al_l = ws + 32;
  float m_reg = -1e30f, l_reg = 0; f32x16 o[4] = {}; v8i qf[3];
  { const unsigned char* qn = Q8n + (long)(wid * QBLK + r32) * LDQ + hi * 32; const unsigned char* qq = Q8r + (long)(wid * QBLK + r32) * LDQ + hi * 32;
    qf[0] = ld32((const char*)qn); qf[1] = ld32((const char*)qn + 64); qf[2] = ld32((const char*)qq); }
  const int sr = tid >> 4, sc = (tid & 15) * 8, vst0 = v_st(sr, sc), vst1 = v_st(32 + sr, sc);
  const int k8r = tid >> 3, k8c = (tid & 7) * 16;
  const int r8r = (tid & 255) >> 2, r8c = (tid & 3) * 16;
  const int vb0 = (int)(uintptr_t)V_lds + v_rd_base(lane);
  bf16x8 vs0, vs1; u32x4 k8v, r8v;
  const unsigned offv = (unsigned)(sr * LDKV + sc) * 2u, offk8 = (unsigned)(k8r * 1024 + k8c), offr8 = (unsigned)(r8r * 64 + r8c);
#define SLOAD(k0) do { const char* vb_ = (const char*)Vh + (size_t)(k0) * (LDKV * 2); const char* vb2_ = vb_ + 32 * LDKV * 2; \
    vs0 = *reinterpret_cast<const bf16x8*>(vb_ + offv); vs1 = *reinterpret_cast<const bf16x8*>(vb2_ + offv); \
    k8v = *reinterpret_cast<const u32x4*>((const char*)K8h + (size_t)(k0) * 1024 + offk8); \
    if (tid < 256) r8v = *reinterpret_cast<const u32x4*>((const char*)Kr8 + (size_t)(k0) * 64 + offr8); } while (0)
#define SWRITE(b) do { *(bf16x8*)(V_lds + (b) * SHM_V + vst0) = vs0; *(bf16x8*)(V_lds + (b) * SHM_V + vst1) = vs1; \
    *(u32x4*)(K_lds + (b) * SHM_K8 + k8r * K8P + k8c) = k8v; if (tid < 256) *(u32x4*)(Kr_lds + (b) * SHM_KR8 + r8r * KR8P + r8c) = r8v; } while (0)
#define SWAIT() asm volatile("s_waitcnt vmcnt(0)" ::: "memory")
#define RESC(a) do { if (__any((a) < 1.f)) { if (hi == 0) al_l[r32] = (a); asm volatile("s_waitcnt lgkmcnt(0)" ::: "memory"); \
    _Pragma("unroll") for (int d = 0; d < 4; ++d) _Pragma("unroll") for (int r = 0; r < 16; ++r) o[d][r] *= al_l[crow(r, hi)]; } } while (0)
  f32x16 pA0, pA1, pB0, pB1; float mnA, mnB, alA, alB; bf16x8 pa0, pa1, pa2, pa3; const int NT = seq / KVBLK;
  SLOAD(0); SWAIT(); SWRITE(0); __syncthreads();
  qkt8(pA0, pA1, K_lds, Kr_lds, qf, r32, hi); partialSM(pA0, pA1, m_reg, mnA, alA);
  SLOAD(KVBLK);
  SWAIT(); SWRITE(1); __syncthreads();
  for (int j = 1; j + 1 < NT; j += 2) {
    SBAR(); qkt8(pB0, pB1, K_lds + SHM_K8, Kr_lds + SHM_KR8, qf, r32, hi);
    finishSM(pA0, pA1, alA, l_reg, pa0, pa1, pa2, pa3); SBAR();
    SLOAD((j + 1) * KVBLK); SBAR();
    pv_d0(o, vb0, pa0, pa1, pa2, pa3); partialSM(pB0, pB1, m_reg, mnB, alB);
    __syncthreads(); SWAIT(); SWRITE(0);
    RESC(alB); __syncthreads();
    SBAR(); qkt8(pA0, pA1, K_lds, Kr_lds, qf, r32, hi);
    finishSM(pB0, pB1, alB, l_reg, pa0, pa1, pa2, pa3); SBAR();
    SLOAD((j + 2) * KVBLK); SBAR();
    pv_d0(o, vb0 + SHM_V, pa0, pa1, pa2, pa3); partialSM(pA0, pA1, m_reg, mnA, alA);
    __syncthreads(); SWAIT(); SWRITE(1);
    RESC(alA); __syncthreads();
  }
  SBAR(); qkt8(pB0, pB1, K_lds + SHM_K8, Kr_lds + SHM_KR8, qf, r32, hi);
  finishSM(pA0, pA1, alA, l_reg, pa0, pa1, pa2, pa3); SBAR();
  pv_d0(o, vb0, pa0, pa1, pa2, pa3); partialSM(pB0, pB1, m_reg, mnB, alB);
  __syncthreads(); RESC(alB);
  finishSM(pB0, pB1, alB, l_reg, pa0, pa1, pa2, pa3); SBAR();
  pv_d0(o, vb0 + SHM_V, pa0, pa1, pa2, pa3);
  if (hi == 0) li_l[r32] = l_reg; asm volatile("s_waitcnt lgkmcnt(0)" ::: "memory");
  float rli[16];
#pragma unroll
  for (int r = 0; r < 16; ++r) rli[r] = __builtin_amdgcn_rcpf(li_l[crow(r, hi)]);
  bf16_t* Ow = Ob + (long)(wid * QBLK) * LDO;
#pragma unroll
  for (int r = 0; r < 16; ++r) { const int orow = crow(r, hi);
#pragma unroll
    for (int d0 = 0; d0 < 4; ++d0) Ow[(long)orow * LDO + d0 * 32 + r32] = f2bf(o[d0][r] * rli[r]); }
  __syncthreads();
#undef SLOAD
#undef SWRITE
#undef SWAIT
#undef RESC
}

constexpr int V8P = 80, SHM_V8 = 128 * V8P;
constexpr int O9_V = 0, O9_K = 2 * SHM_V8, O9_KR = O9_K + 2 * SHM_K8, O9_WS = O9_KR + 2 * SHM_KR8, SHM_ATTN9 = O9_WS + NW * 64 * 4;
constexpr float THR9 = 2.f, THRL9 = THR9 * 1.4426950408889634f;
__device__ __forceinline__ void qkt9(f32x16& p0, f32x16& p1, const char* Ks, const char* Krs, const v8i* qf, const f32x16& negm, int r32, int hi) {
  const char* kb = Ks + r32 * K8P + hi * 32; const char* rb = Krs + r32 * KR8P + hi * 32;
  { const v8i a0 = ld32(kb), a1 = ld32(kb + 32 * K8P);
    p0 = __builtin_amdgcn_mfma_scale_f32_32x32x64_f8f6f4(a0, qf[0], negm, 0, 0, 0, 0x7f7f7f7f, 0, 0x7f7f7f7f);
    p1 = __builtin_amdgcn_mfma_scale_f32_32x32x64_f8f6f4(a1, qf[0], negm, 0, 0, 0, 0x7f7f7f7f, 0, 0x7f7f7f7f); }
  { const v8i a0 = ld32(kb + 64), a1 = ld32(kb + 32 * K8P + 64);
    p0 = __builtin_amdgcn_mfma_scale_f32_32x32x64_f8f6f4(a0, qf[1], p0, 0, 0, 0, 0x7f7f7f7f, 0, 0x7f7f7f7f);
    p1 = __builtin_amdgcn_mfma_scale_f32_32x32x64_f8f6f4(a1, qf[1], p1, 0, 0, 0, 0x7f7f7f7f, 0, 0x7f7f7f7f); }
  { const v8i a0 = ld32(rb), a1 = ld32(rb + 32 * KR8P);
    p0 = __builtin_amdgcn_mfma_scale_f32_32x32x64_f8f6f4(a0, qf[2], p0, 0, 0, 0, 0x7f7f7f7f, 0, 0x7f7f7f7f);
    p1 = __builtin_amdgcn_mfma_scale_f32_32x32x64_f8f6f4(a1, qf[2], p1, 0, 0, 0, 0x7f7f7f7f, 0, 0x7f7f7f7f); }
}
template <bool FIRST> __device__ __forceinline__ void partialSM9n(f32x16& p0, f32x16& p1, f32x16& negm, float& alpha) {
  float pmax = p0[0];
#pragma unroll
  for (int r = 1; r < 16; ++r) pmax = fmaxf(pmax, p0[r]);
#pragma unroll
  for (int r = 0; r < 16; ++r) pmax = fmaxf(pmax, p1[r]);
  { auto rr = __builtin_amdgcn_permlane32_swap(__float_as_uint(pmax), __float_as_uint(pmax), false, false);
    pmax = fmaxf(__uint_as_float(rr[0]), __uint_as_float(rr[1])); }
  const float ex = pmax - 4.f;
  if (!FIRST && __builtin_expect(__all(ex <= THRL9), 1)) { alpha = 1.f; }
  else { const float d = FIRST ? ex : fmaxf(ex, 0.f); alpha = FIRST ? 1.f : __builtin_amdgcn_exp2f(-d);
#pragma unroll
    for (int r = 0; r < 16; ++r) { p0[r] -= d; p1[r] -= d; }
#pragma unroll
    for (int r = 0; r < 16; ++r) negm[r] -= d;
    asm volatile("" : "+v"(negm)); }
#pragma unroll
  for (int r = 0; r < 16; ++r) p0[r] = __builtin_amdgcn_exp2f(p0[r]);
}
__device__ __forceinline__ void partialSM9(f32x16& p0, f32x16& p1, float& m_reg, float& mn, float& alpha) {
  constexpr float C = ATT_SCALE * 1.4426950408889634f;
  float pmax = p0[0];
#pragma unroll
  for (int r = 1; r < 16; ++r) pmax = fmaxf(pmax, p0[r]);
#pragma unroll
  for (int r = 0; r < 16; ++r) pmax = fmaxf(pmax, p1[r]);
  { auto rr = __builtin_amdgcn_permlane32_swap(__float_as_uint(pmax), __float_as_uint(pmax), false, false);
    pmax = fmaxf(__uint_as_float(rr[0]), __uint_as_float(rr[1])); }
  if (__builtin_expect(__all(pmax - m_reg <= THR9 / ATT_SCALE), 1)) { mn = m_reg; alpha = 1.f; }
  else { mn = fmaxf(m_reg, pmax); alpha = __builtin_amdgcn_exp2f((m_reg - mn) * C); m_reg = mn; }
  float mnC = 4.f - mn * C;
#pragma unroll
  for (int r = 0; r < 16; ++r) p0[r] = fmaf(p0[r], C, mnC);
#pragma unroll
  for (int r = 0; r < 16; ++r) p1[r] = fmaf(p1[r], C, mnC);
#pragma unroll
  for (int r = 0; r < 16; ++r) p0[r] = __builtin_amdgcn_exp2f(p0[r]);
}
__device__ __forceinline__ void finishSM9(f32x16& p0, f32x16& p1, float alpha, float& l_reg, v8i& pf) {
#pragma unroll
  for (int r = 0; r < 16; ++r) p1[r] = __builtin_amdgcn_exp2f(p1[r]);
  float ps = 0;
#pragma unroll
  for (int r = 0; r < 16; ++r) ps += p0[r];
#pragma unroll
  for (int r = 0; r < 16; ++r) ps += p1[r];
  { auto rr = __builtin_amdgcn_permlane32_swap(__float_as_uint(ps), __float_as_uint(ps), false, false);
    ps = __uint_as_float(rr[0]) + __uint_as_float(rr[1]); }
  l_reg = l_reg * alpha + ps;
  unsigned a[4], b[4];
#pragma unroll
  for (int i = 0; i < 4; ++i) { a[i] = pk4_fp8(p0[4 * i], p0[4 * i + 1], p0[4 * i + 2], p0[4 * i + 3]); b[i] = pk4_fp8(p1[4 * i], p1[4 * i + 1], p1[4 * i + 2], p1[4 * i + 3]); }
#pragma unroll
  for (int i = 0; i < 4; ++i) { auto r = __builtin_amdgcn_permlane32_swap(a[i], b[i], false, false); pf[i] = (int)r[0]; pf[4 + i] = (int)r[1]; }
}
__device__ __forceinline__ void pv9(f32x16* o, const char* Vs, const v8i pf, int r32, int hi) {
  const char* vb = Vs + r32 * V8P + hi * 32;
#pragma unroll
  for (int d0 = 0; d0 < 4; ++d0) { const v8i vf = ld32(vb + d0 * 32 * V8P);
    o[d0] = __builtin_amdgcn_mfma_scale_f32_32x32x64_f8f6f4(pf, vf, o[d0], 0, 0, 0, 0x7f7f7f7f, 0, 0x7f7f7f7f); }
}
__device__ __forceinline__ void attn_unit9(const unsigned char* __restrict__ Q8n, const unsigned char* __restrict__ Q8r, const unsigned char* __restrict__ K8h,
                                           const unsigned char* __restrict__ Kr8, const unsigned char* __restrict__ VTh, bf16_t* __restrict__ Ob, int seq, char* lds, const int tid) {
  const int wid = tid >> 6, lane = tid & 63, r32 = lane & 31, hi = lane >> 5;
  char* V_lds = lds + O9_V; char* K_lds = lds + O9_K; char* Kr_lds = lds + O9_KR;
  float* ws = (float*)(lds + O9_WS) + wid * 64; float* li_l = ws; float* al_l = ws + 32;
  float l_reg = 0; f32x16 o[4] = {}; v8i qf[3]; f32x16 negm;
#pragma unroll
  for (int r = 0; r < 16; ++r) negm[r] = 4.f;
  { const unsigned char* qn = Q8n + (long)(wid * QBLK + r32) * LDQ + hi * 32; const unsigned char* qq = Q8r + (long)(wid * QBLK + r32) * LDQ + hi * 32;
    qf[0] = ld32((const char*)qn); qf[1] = ld32((const char*)qn + 64); qf[2] = ld32((const char*)qq); }
  const int k8r = tid >> 3, k8c = (tid & 7) * 16;
  const int r8r = (tid & 255) >> 2, r8c = (tid & 3) * 16;
  const int v8d = tid >> 2, v8c = tid & 3;
  const int v8w = v8d * V8P + (v8c >> 1) * 32 + (v8c & 1) * 8;
  u32x4 v8v, k8v, r8v;
  const unsigned offv8 = (unsigned)(v8d * SEQ + v8c * 16), offk8 = (unsigned)(k8r * 1024 + k8c), offr8 = (unsigned)(r8r * 64 + r8c);
#define SLOAD(k0) do { v8v = *reinterpret_cast<const u32x4*>((const char*)VTh + (size_t)(k0) + offv8); \
    k8v = *reinterpret_cast<const u32x4*>((const char*)K8h + (size_t)(k0) * 1024 + offk8); \
    if (tid < 256) r8v = *reinterpret_cast<const u32x4*>((const char*)Kr8 + (size_t)(k0) * 64 + offr8); } while (0)
#define SWRITE(b) do { char* vp_ = V_lds + (b) * SHM_V8 + v8w; *(unsigned*)(vp_) = v8v.x; *(unsigned*)(vp_ + 16) = v8v.y; *(unsigned*)(vp_ + 4) = v8v.z; *(unsigned*)(vp_ + 20) = v8v.w; \
    *(u32x4*)(K_lds + (b) * SHM_K8 + k8r * K8P + k8c) = k8v; if (tid < 256) *(u32x4*)(Kr_lds + (b) * SHM_KR8 + r8r * KR8P + r8c) = r8v; } while (0)
#define SWAIT() asm volatile("s_waitcnt vmcnt(0)" ::: "memory")
#define RESC(a) do { if (__any((a) < 1.f)) { if (hi == 0) al_l[r32] = (a); asm volatile("s_waitcnt lgkmcnt(0)" ::: "memory"); \
    _Pragma("unroll") for (int d = 0; d < 4; ++d) _Pragma("unroll") for (int r = 0; r < 16; ++r) o[d][r] *= al_l[crow(r, hi)]; } } while (0)
  f32x16 pA0, pA1, pB0, pB1; float alA, alB; v8i pf; const int NT = seq / KVBLK;
  SLOAD(0); SWAIT(); SWRITE(0); __syncthreads();
  qkt9(pA0, pA1, K_lds, Kr_lds, qf, negm, r32, hi); partialSM9n<true>(pA0, pA1, negm, alA);
  SLOAD(KVBLK);
  SWAIT(); SWRITE(1); __syncthreads();
  for (int j = 1; j + 1 < NT; j += 2) {
    SBAR(); qkt9(pB0, pB1, K_lds + SHM_K8, Kr_lds + SHM_KR8, qf, negm, r32, hi);
    finishSM9(pA0, pA1, alA, l_reg, pf); SBAR();
    SLOAD((j + 1) * KVBLK); SBAR();
    pv9(o, V_lds, pf, r32, hi); partialSM9n<false>(pB0, pB1, negm, alB);
    __syncthreads(); SWAIT(); SWRITE(0);
    RESC(alB); __syncthreads();
    SBAR(); qkt9(pA0, pA1, K_lds, Kr_lds, qf, negm, r32, hi);
    finishSM9(pB0, pB1, alB, l_reg, pf); SBAR();
    SLOAD((j + 2) * KVBLK); SBAR();
    pv9(o, V_lds + SHM_V8, pf, r32, hi); partialSM9n<false>(pA0, pA1, negm, alA);
    __syncthreads(); SWAIT(); SWRITE(1);
    RESC(alA); __syncthreads();
  }
  SBAR(); qkt9(pB0, pB1, K_lds + SHM_K8, Kr_lds + SHM_KR8, qf, negm, r32, hi);
  finishSM9(pA0, pA1, alA, l_reg, pf); SBAR();
  pv9(o, V_lds, pf, r32, hi); partialSM9n<false>(pB0, pB1, negm, alB);
  __syncthreads(); RESC(alB);
  finishSM9(pB0, pB1, alB, l_reg, pf); SBAR();
  pv9(o, V_lds + SHM_V8, pf, r32, hi);
  if (hi == 0) li_l[r32] = l_reg; asm volatile("s_waitcnt lgkmcnt(0)" ::: "memory");
  float rli[16];
#pragma unroll
  for (int r = 0; r < 16; ++r) rli[r] = __builtin_amdgcn_rcpf(li_l[crow(r, hi)]);
  bf16_t* Ow = Ob + (long)(wid * QBLK) * LDO;
#pragma unroll
  for (int r = 0; r < 16; ++r) { const int orow = crow(r, hi);
#pragma unroll
    for (int d0 = 0; d0 < 4; ++d0) Ow[(long)orow * LDO + d0 * 32 + r32] = f2bf(o[d0][r] * rli[r]); }
  __syncthreads();
#undef SLOAD
#undef SWRITE
#undef SWAIT
#undef RESC
}
#undef SBAR
}

constexpr int NWAVES = 8;
constexpr int N_LAUNCHES = MK_N_LAUNCHES;
constexpr int N_PHASES = 15;
static_assert(N_LAUNCHES == 1 || N_LAUNCHES == N_PHASES, "MK_N_LAUNCHES is 1 or 15");

constexpr size_t MiB = 1u << 20;
constexpr size_t WS_CTL = 0, CTL_ZERO_BYTES = 32768;
constexpr size_t WS_ROPE = 1 * MiB;
constexpr size_t WS_RSTD0 = 3 * MiB, WS_RSTDQ = WS_RSTD0 + 65536, WS_RSTDKV = WS_RSTDQ + 65536, WS_RSTDM = WS_RSTDKV + 65536;
constexpr size_t WS_SSQ = 4 * MiB;
constexpr size_t WS_AFF = 5 * MiB;
constexpr size_t WS_INV = 6 * MiB;
constexpr size_t WS_IDX = 7 * MiB, WS_GATE = WS_IDX + 131072;
constexpr size_t WS_MEMB = 8 * MiB;
constexpr size_t WS_MKV = 9 * MiB;
constexpr size_t WS_QKT = 11 * MiB, WS_VWT = 15 * MiB;
constexpr size_t WS_WIN = 19 * MiB;
constexpr size_t WS_WCO = 30 * MiB, WS_WMO = 32 * MiB, WS_WMIX = 34 * MiB, WS_WUQ = 36 * MiB, WS_WUKV = 37 * MiB, WS_WMQH = 38 * MiB, WS_WOHT = 40 * MiB, WS_WMKV = 42 * MiB;
constexpr size_t WS_XGG = 48 * MiB, WS_QB = 48 * MiB, WS_MIXA = 96 * MiB, WS_WGU = 48 * MiB, WS_WD = 112 * MiB, WS_Y = 48 * MiB;
constexpr size_t WS_XB = 144 * MiB, WS_ACONV = 144 * MiB, WS_OB = 144 * MiB, WS_X1B = 144 * MiB, WS_XG = 144 * MiB;
constexpr size_t WS_SIGA = 176 * MiB, WS_MIXED = 176 * MiB, WS_PM = 176 * MiB;
constexpr size_t WS_SIGB = 208 * MiB, WS_H3 = 208 * MiB, WS_H = 144 * MiB;
constexpr size_t WS_CQ = 240 * MiB, WS_CKV = 248 * MiB, WS_KR = 252 * MiB, WS_KROPE = 254 * MiB;
constexpr size_t WS_KN8 = 128 * MiB;
constexpr size_t WS_X2B = 256 * MiB;
constexpr size_t WS_END = RESID_BF16 ? 288 * MiB : 256 * MiB;
constexpr int CW_TMO = 0, CW_BAR = 4096;

constexpr int RING_BYTES = 131072, EPI_OFF = 131072, EPI_BYTES = 8192, LDSCTL_OFF = 140288, MISC_OFF = LDSCTL_OFF + 320;
constexpr int LDS_BYTES = 148480;
static_assert(2 * 16 * 1028 * 4 + 8192 <= LDSCTL_OFF && EPI_OFF + EPI_BYTES <= LDSCTL_OFF, "LDS map (router, epilogue scratch)");
static_assert(MISC_OFF + 128 <= LDS_BYTES && att::SHM_ATTN <= RING_BYTES && att::SHM_ATTN8 <= RING_BYTES, "LDS map");

typedef GAS unsigned gu32;
#define RLX_AGENT __ATOMIC_RELAXED, __HIP_MEMORY_SCOPE_AGENT

#define XB_TMO      128
#define XB_XCNT(j)  (256  + 64 * (j))
#define XB_XSUB(j)  (1280 + 64 * (j))
#define XB_XGEN(j)  (2304 + 64 * (j))
#define XB_TOP      3328
#define XB_TOPGEN   3392
#define XCD_BAR_WORDS 3456
#define XB_SPIN_CAP (1u << 18)
__device__ __forceinline__ unsigned xb_ld(unsigned* p)              { return __hip_atomic_load(p, __ATOMIC_RELAXED, __HIP_MEMORY_SCOPE_AGENT); }
__device__ __forceinline__ unsigned xb_add(unsigned* p, unsigned v) { return __hip_atomic_fetch_add(p, v, __ATOMIC_RELAXED, __HIP_MEMORY_SCOPE_AGENT); }
__device__ __forceinline__ unsigned xb_xcc_id() { return (unsigned)__builtin_amdgcn_s_getreg((3 << 11) | 20) & 0xFu; }
#define XB_SPIN(cond, bar) do { unsigned _sp = 0; while (cond) { __builtin_amdgcn_s_sleep(1); \
    if ((++_sp & 255u) == 0u) { if (xb_ld(&(bar)[XB_TMO])) break; if (_sp > XB_SPIN_CAP) { atomicAdd(&(bar)[XB_TMO], 1u); break; } } } } while (0)
struct XcdBarrier { unsigned* bar; unsigned x; volatile LAS unsigned* st; };
__device__ __forceinline__ XcdBarrier xcd_barrier_post(unsigned* bar, volatile LAS unsigned* st, const bool t0) {
    XcdBarrier b; b.bar = bar; b.x = xb_xcc_id(); b.st = st;
    if (t0) (void)xb_add(&bar[XB_XCNT(b.x)], 1u);
    return b;
}
__device__ __forceinline__ void xcd_barrier_complete(unsigned* bar, unsigned x, unsigned& nloc, unsigned& nx) {
    const unsigned G = gridDim.x * gridDim.y * gridDim.z;
    unsigned sum, cnt, mine, sp = 0u;
    for (;;) {
        sum = 0u; cnt = 0u; mine = 0u;
#pragma unroll
        for (unsigned j = 0; j < 16; ++j) { const unsigned c = xb_ld(&bar[XB_XCNT(j)]); sum += c; cnt += (c > 0u) ? 1u : 0u; mine = (j == x) ? c : mine; }
        if (sum == G) break;
        __builtin_amdgcn_s_sleep(1);
        if ((++sp & 255u) == 0u) { if (xb_ld(&bar[XB_TMO])) break; if (sp > XB_SPIN_CAP) { atomicAdd(&bar[XB_TMO], 1u); break; } }
    }
    nloc = mine > 0u ? mine : 1u; nx = cnt > 0u ? cnt : 1u;
}
__device__ __forceinline__ void xcd_barrier(const XcdBarrier& b, const bool t0) {
    asm volatile("s_waitcnt vmcnt(0)" ::: "memory");
    __syncthreads();
    if (t0) {
        unsigned* bar = b.bar;
        __builtin_amdgcn_s_waitcnt(0);
        unsigned nloc = b.st[0], nx = b.st[1];
        if (nloc == 0u) { xcd_barrier_complete(bar, b.x, nloc, nx); b.st[0] = nloc; b.st[1] = nx; }
        const unsigned old = xb_add(&bar[XB_XSUB(b.x)], 1u);
        const unsigned gen = old / nloc;
        if (old + 1u == (gen + 1u) * nloc) {
            __builtin_amdgcn_fence(__ATOMIC_RELEASE, "agent");
            asm volatile("s_waitcnt vmcnt(0)" ::: "memory");
            const unsigned og = xb_add(&bar[XB_TOP], 1u);
            const unsigned tg = og / nx;
            __builtin_amdgcn_fence(__ATOMIC_ACQUIRE, "agent");
            if (og + 1u == (tg + 1u) * nx) (void)__hip_atomic_fetch_add(&bar[XB_TOPGEN], 1u, __ATOMIC_RELAXED, __HIP_MEMORY_SCOPE_AGENT);
            else XB_SPIN(xb_ld(&bar[XB_TOPGEN]) == tg, bar);
            (void)__hip_atomic_fetch_add(&bar[XB_XGEN(b.x)], 1u, __ATOMIC_RELAXED, __HIP_MEMORY_SCOPE_AGENT);
            asm volatile("s_waitcnt vmcnt(0)" ::: "memory");
        } else {
            __builtin_amdgcn_fence(__ATOMIC_ACQUIRE, "agent");
            XB_SPIN(xb_ld(&bar[XB_XGEN(b.x)]) == gen, bar);
            asm volatile("s_waitcnt vmcnt(0)" ::: "memory");
        }
    }
    __syncthreads();
}

struct Args {
    const float* in[25];
    float* out; unsigned char* ws;
    int ph_lo, ph_hi;
};
enum { I_X = 0, I_MEM, I_NORM_MIX_G, I_W_IN, I_CONV_W, I_CONV_B, I_W_CONV_OUT, I_Q_NORM_G, I_W_UQ, I_KV_NORM_G, I_W_UKV, I_W_MLA_OUT, I_B_GATE, I_W_MIX_OUT,
       I_NORM_MEM_G, I_NORM_MEMKV_G, I_W_MEM_Q, I_W_MEM_KV, I_W_MEM_OUT, I_NORM_MOE_G, I_W_ROUTER, I_W_EXP_GATE, I_W_EXP_UP, I_W_EXP_DOWN, I_NORM_FINAL_G };

constexpr int TP_PITCH = 65, TP_BYTES = 64 * TP_PITCH * 4;
template <class SrcF, class DstF>
__device__ __forceinline__ void transpose_item(SrcF srcp, DstF dstp, int ld, const float* gain, int k0, LAS float* scr, int lane) {
    const int n4 = (lane & 15) * 4, kr = lane >> 4;
    const float* sp = srcp(n4);
    f32x4 v[16];
#pragma unroll
    for (int i = 0; i < 16; ++i) v[i] = sp ? *(const f32x4*)(sp + (size_t)(k0 + 4 * i + kr) * ld) : (f32x4){0.f, 0.f, 0.f, 0.f};
    if (gain) {
#pragma unroll
        for (int i = 0; i < 16; ++i) v[i] = v[i] * gain[k0 + 4 * i + kr]; }
#pragma unroll
    for (int i = 0; i < 16; ++i)
#pragma unroll
        for (int e = 0; e < 4; ++e) scr[(n4 + e) * TP_PITCH + 4 * i + kr] = v[i][e];
    asm volatile("s_waitcnt lgkmcnt(0)" ::: "memory");
    const int c = lane & 7;
#pragma unroll
    for (int j = 0; j < 8; ++j) { const int n = (lane >> 3) + 8 * j; const LAS float* s = scr + n * TP_PITCH + 8 * c;
        u32x4 o; o.x = cvtpk(s[0], s[1]); o.y = cvtpk(s[2], s[3]); o.z = cvtpk(s[4], s[5]); o.w = cvtpk(s[6], s[7]);
        *(u32x4*)(dstp(n) + k0 + 8 * c) = o; }
    asm volatile("s_waitcnt lgkmcnt(0)" ::: "memory");
}
template <class MapF>
__device__ __forceinline__ void transpose_matrix(MapF map, bf16_t* dst, int NDST, int K, int ld, const float* gain, LAS float* scr, int lane, int gw, int NGW, int& itbase) {
    const int nkb = K / 64, nitems = (NDST / 64) * nkb;
    int first = (gw - (itbase % NGW) + NGW) % NGW;
    for (int it = first; it < nitems; it += NGW) { const int nb = it / nkb, kb = it % nkb, n0 = nb * 64;
        transpose_item([&](int n) { return map(n0 + n); }, [&](int n) { return dst + (size_t)(n0 + n) * K; }, ld, gain, kb * 64, scr, lane); }
    itbase += nitems;
}

__device__ __forceinline__ int rope_dim(int p) { return (p >> 3) * 4 + (p & 3) + 32 * ((p >> 2) & 1); }

template <int PHM> __global__ void __launch_bounds__(NWAVES * 64, 2) fwd_kernel(Args args) {
    extern __shared__ __attribute__((aligned(16))) unsigned char lds_raw[];
    LAS unsigned char* lds = (LAS unsigned char*)lds_raw;
    volatile LAS unsigned* MISC = (volatile LAS unsigned*)(lds + MISC_OFF);
    int tid = threadIdx.x, lane = tid & 63; const int wave = __builtin_amdgcn_readfirstlane(tid >> 6);
#define PHASE_BEGIN() do { lane = (int)__builtin_amdgcn_mbcnt_hi(~0u, __builtin_amdgcn_mbcnt_lo(~0u, 0u)); asm volatile("" : "+v"(lane)); tid = wave * 64 + lane; } while (0)
    const int G = gridDim.x; const int bx = blockIdx.x; const int vcu = (G % 8 == 0) ? (bx % 8) * (G / 8) + bx / 8 : bx;
    const int gw = vcu * NWAVES + wave, NGW = G * NWAVES;
    unsigned char* ws = args.ws;
    gu32* ctl = (gu32*)(ws + WS_CTL);
    for (int u = tid; u < (LDS_BYTES - LDSCTL_OFF) / 4; u += NWAVES * 64) ((LAS unsigned*)(lds + LDSCTL_OFF))[u] = 0u;
    __syncthreads();
    XcdBarrier bar; bar.bar = (unsigned*)(ctl + CW_BAR); bar.x = 0; bar.st = nullptr;
    if (N_LAUNCHES == 1) bar = xcd_barrier_post((unsigned*)(ctl + CW_BAR), MISC + 8, tid == 0);
#define GRID_BAR() do { if (N_LAUNCHES == 1) xcd_barrier(bar, wave == 0 && __builtin_amdgcn_mbcnt_hi(~0u, __builtin_amdgcn_mbcnt_lo(~0u, 0u)) == 0u); } while (0)
    const int lo = args.ph_lo, hi = args.ph_hi;
#define IN(k) (((PHM >> (k)) & 1) && lo <= (k) && (k) < hi)
#define SEAM(k) do { if (IN(k) && IN((k) + 1)) GRID_BAR(); } while (0)

    const float* x = args.in[I_X]; float* out = args.out;
#define rope ((f32x2*)(ws + WS_ROPE))
#define rstd0 ((float*)(ws + WS_RSTD0))
#define rstdq ((float*)(ws + WS_RSTDQ))
#define rstdkv ((float*)(ws + WS_RSTDKV))
#define rstdm ((float*)(ws + WS_RSTDM))
#define ssq ((float*)(ws + WS_SSQ))
#define aff ((float*)(ws + WS_AFF))
#define inv ((int*)(ws + WS_INV))
#define idx ((int*)(ws + WS_IDX))
#define gate ((float*)(ws + WS_GATE))
#define memb ((bf16_t*)(ws + WS_MEMB))
#define MKV ((bf16_t*)(ws + WS_MKV))
#define QKT ((bf16_t*)(ws + WS_QKT))
#define VWT ((bf16_t*)(ws + WS_VWT))
#define Win_t ((bf16_t*)(ws + WS_WIN))
#define Wco_t ((bf16_t*)(ws + WS_WCO))
#define Wmo_t ((bf16_t*)(ws + WS_WMO))
#define Wmix_t ((bf16_t*)(ws + WS_WMIX))
#define Wuq_t ((bf16_t*)(ws + WS_WUQ))
#define Wukv_t ((bf16_t*)(ws + WS_WUKV))
#define Wmqh ((bf16_t*)(ws + WS_WMQH))
#define Woht ((bf16_t*)(ws + WS_WOHT))
#define Wmkv_t ((bf16_t*)(ws + WS_WMKV))
#define XGG ((bf16_t*)(ws + WS_XGG))
#define QB ((bf16_t*)(ws + WS_QB))
#define MIXA ((bf16_t*)(ws + WS_MIXA))
#define Wgu_t ((bf16_t*)(ws + WS_WGU))
#define Wd_t ((bf16_t*)(ws + WS_WD))
#define Y ((bf16_t*)(ws + WS_Y))
#define XB ((bf16_t*)(ws + WS_XB))
#define KN8 ((unsigned char*)(ws + WS_KN8))
#define VT8 ((unsigned char*)out)
#define Q8 ((unsigned char*)(ws + WS_QB))
#define KR8 ((unsigned char*)(ws + WS_KROPE))
#define X2B ((bf16_t*)(ws + WS_X2B))
#define ACONV ((bf16_t*)(ws + WS_ACONV))
#define OB ((bf16_t*)(ws + WS_OB))
#define X1B ((bf16_t*)(ws + WS_X1B))
#define XG ((bf16_t*)(ws + WS_XG))
#define SIGA ((bf16_t*)(ws + WS_SIGA))
#define MIXED ((bf16_t*)(ws + WS_MIXED))
#define PM ((bf16_t*)(ws + WS_PM))
#define SIGB ((bf16_t*)(ws + WS_SIGB))
#define H3 ((bf16_t*)(ws + WS_H3))
#define HB ((bf16_t*)(ws + WS_H))
#define CQ ((bf16_t*)(ws + WS_CQ))
#define CKV ((bf16_t*)(ws + WS_CKV))
#define KR ((bf16_t*)(ws + WS_KR))
#define KROPE ((bf16_t*)(ws + WS_KROPE))
#define KVB ((bf16_t*)out)
    LAS float* scr = (LAS float*)(lds + wave * TP_BYTES);

    if (IN(0)) { PHASE_BEGIN();
        int itb = 0;
        { const float* W = args.in[I_W_IN]; const float* gn = args.in[I_NORM_MIX_G];
          transpose_matrix([&](int n) -> const float* { if (n < 2048) { const int t = n >> 8, half = (n >> 7) & 1, c = n & 127; return W + (half ? 2048 : 0) + 128 * t + c; }
                                                         if (n < 3072) return W + 1024 + (n - 2048); if (n < 3520) return W + n; if (n < 3584) return nullptr; return W + (n - 64); },
                           Win_t, NU, 1024, 5568, gn, scr, lane, gw, NGW, itb); }
        { const float* W = args.in[I_W_CONV_OUT]; transpose_matrix([&](int n) -> const float* { return W + n; }, Wco_t, 1024, 1024, 1024, nullptr, scr, lane, gw, NGW, itb); }
        { const float* W = args.in[I_W_MLA_OUT]; transpose_matrix([&](int n) -> const float* { return W + n; }, Wmo_t, 1024, 1024, 1024, nullptr, scr, lane, gw, NGW, itb); }
        { const float* W = args.in[I_W_MIX_OUT]; transpose_matrix([&](int n) -> const float* { return W + n; }, Wmix_t, 1024, 1024, 1024, nullptr, scr, lane, gw, NGW, itb); }
        { const float* W = args.in[I_W_UQ]; const float* gn = args.in[I_Q_NORM_G];
          transpose_matrix([&](int n) -> const float* { if (n < 1024) return W + (n >> 7) * 192 + (n & 127); const int r = n - 1024; return W + (r >> 6) * 192 + 128 + rope_dim(r & 63); },
                           Wuq_t, 1536, 256, 1536, gn, scr, lane, gw, NGW, itb); }
        { const float* W = args.in[I_W_UKV]; const float* gn = args.in[I_KV_NORM_G];
          transpose_matrix([&](int n) -> const float* { if (n < 1024) return W + (n >> 7) * 256 + (n & 127); const int r = n - 1024; return W + (r >> 7) * 256 + 128 + (r & 127); },
                           Wukv_t, 2048, 128, 2048, gn, scr, lane, gw, NGW, itb); }
        { const float* W = args.in[I_W_MEM_KV]; const float* gn = args.in[I_NORM_MEMKV_G];
          transpose_matrix([&](int n) -> const float* { return W + n; }, Wmkv_t, 2048, 1024, 2048, gn, scr, lane, gw, NGW, itb); }
        for (int h = 0; h < 4; ++h) { const float* W = args.in[I_W_MEM_OUT] + (size_t)h * 256 * 1024;
          transpose_matrix([&](int n) -> const float* { return W + n; }, Woht + (size_t)h * 1024 * 256, 1024, 256, 1024, nullptr, scr, lane, gw, NGW, itb); }
        { const float* W = args.in[I_W_MEM_Q]; const float* gn = args.in[I_NORM_MEM_G];
          for (int c = gw * 64 + lane; c < 1024 * 1024 / 8; c += NGW * 64) { const int e0 = c * 8, h = e0 >> 18, d = (e0 >> 8) & 1023, j = e0 & 255; const float g = gn[d];
              const float* s = W + (size_t)d * 1024 + h * 256 + j; const f32x4 a = *(const f32x4*)s, b = *(const f32x4*)(s + 4);
              const float o[8] = {a[0] * g, a[1] * g, a[2] * g, a[3] * g, b[0] * g, b[1] * g, b[2] * g, b[3] * g}; *(u32x4*)(Wmqh + e0) = pack8(o); } }
        for (int r = gw; r < MT + NB * MEM_LEN; r += NGW) { const bool isx = r < MT; const int rr = isx ? r : r - MT;
            const float* src = (isx ? x : args.in[I_MEM]) + (size_t)rr * 1024; bf16_t* dst = (isx ? XB : memb) + (size_t)rr * 1024; float s = 0.f;
#pragma unroll
            for (int j = 0; j < 4; ++j) { const f32x4 v = *(const f32x4*)(src + (lane + 64 * j) * 4); s += (v[0] * v[0] + v[1] * v[1]) + (v[2] * v[2] + v[3] * v[3]);
                u32x2 w; w.x = cvtpk(v[0], v[1]); w.y = cvtpk(v[2], v[3]); *(u32x2*)(dst + (lane + 64 * j) * 4) = w; }
            s = wave_sum(s); if (lane == 0) (isx ? rstd0 : rstdm)[rr] = 1.f / sqrtf(s * (1.f / 1024.f) + EPS); }
        for (int i = gw * 64 + lane; i < SEQ * 32; i += NGW * 64) { const int s = i >> 5, j = i & 31; const float invf = 1.0f / powf(10000.0f, (float)(2 * j) / 64.0f); const float ang = (float)s * invf;
            rope[i] = (f32x2){cosf(ang), sinf(ang)}; }
    }
    SEAM(0);

    if (IN(1)) { PHASE_BEGIN();
        { Gemm g = mkgemm(XB, Win_t, MT, NU, 1024, 1024, 1024); StaticOrder S; S.init(MT, NU, G, bx);
          EpiU E{{rstd0, XGG, CQ, CKV, KR, SIGA, SIGB, args.in[I_B_GATE]}}; pg8::gemm_phase(lds, g, S, E, tid); }
        { Gemm g = mkgemm(memb, Wmkv_t, NB * MEM_LEN, 2048, 1024, 1024, 1024); StaticOrder S; S.init(NB * MEM_LEN, 2048, G, (bx + G / 2) % G);
          pg8::EpiChunk<FMemKV> E{{rstdm, MKV}}; pg8::gemm_phase(lds, g, S, E, tid); }
    }
    SEAM(1);

    if (IN(2)) { PHASE_BEGIN();
        const float* cw = args.in[I_CONV_W]; const float* cb = args.in[I_CONV_B];
        for (int blk = gw; blk < MT / 4; blk += NGW) { const int r0 = blk * 4, s0 = r0 & (SEQ - 1);
            u32x4 pxr[6][2], gbr[4][2]; u32x2 cqr[4]; unsigned ckr[4]; bf16_t k1[4], k2[4];
            const u32x4 z = {0u, 0u, 0u, 0u};
#pragma unroll
            for (int i = 0; i < 6; ++i) { const int rr = r0 - 1 + i; const bool ok = (i > 0 || s0 > 0) && (i < 5 || s0 + 4 < SEQ);
#pragma unroll
                for (int j = 0; j < 2; ++j) pxr[i][j] = ok ? *(const u32x4*)(XGG + (size_t)rr * 2048 + lane * 8 + 512 * j) : z; }
#pragma unroll
            for (int i = 0; i < 4; ++i) { const int rr = r0 + i;
#pragma unroll
                for (int j = 0; j < 2; ++j) gbr[i][j] = *(const u32x4*)(XGG + (size_t)rr * 2048 + 1024 + lane * 8 + 512 * j);
                cqr[i] = *(const u32x2*)(CQ + (size_t)rr * 256 + lane * 4); ckr[i] = *(const unsigned*)(CKV + (size_t)rr * 128 + lane * 2);
                { const int j_ = (lane >> 3) * 4 + (lane & 3); k1[i] = KR[(size_t)rr * 64 + j_]; k2[i] = KR[(size_t)rr * 64 + j_ + 32]; } }
#pragma unroll
            for (int j = 0; j < 2; ++j) { const int c0 = lane * 8 + 512 * j;
                float w0[8], w1[8], w2[8], bb[8];
                { const f32x4 a = *(const f32x4*)(cw + c0), b = *(const f32x4*)(cw + c0 + 4); w0[0] = a[0]; w0[1] = a[1]; w0[2] = a[2]; w0[3] = a[3]; w0[4] = b[0]; w0[5] = b[1]; w0[6] = b[2]; w0[7] = b[3]; }
                { const f32x4 a = *(const f32x4*)(cw + 1024 + c0), b = *(const f32x4*)(cw + 1024 + c0 + 4); w1[0] = a[0]; w1[1] = a[1]; w1[2] = a[2]; w1[3] = a[3]; w1[4] = b[0]; w1[5] = b[1]; w1[6] = b[2]; w1[7] = b[3]; }
                { const f32x4 a = *(const f32x4*)(cw + 2048 + c0), b = *(const f32x4*)(cw + 2048 + c0 + 4); w2[0] = a[0]; w2[1] = a[1]; w2[2] = a[2]; w2[3] = a[3]; w2[4] = b[0]; w2[5] = b[1]; w2[6] = b[2]; w2[7] = b[3]; }
                { const f32x4 a = *(const f32x4*)(cb + c0), b = *(const f32x4*)(cb + c0 + 4); bb[0] = a[0]; bb[1] = a[1]; bb[2] = a[2]; bb[3] = a[3]; bb[4] = b[0]; bb[5] = b[1]; bb[6] = b[2]; bb[7] = b[3]; }
                float p[6][8];
#pragma unroll
                for (int i = 0; i < 6; ++i) unpack8(pxr[i][j], p[i]);
#pragma unroll
                for (int i = 0; i < 4; ++i) { float gb[8], o[8]; unpack8(gbr[i][j], gb);
#pragma unroll
                    for (int e = 0; e < 8; ++e) o[e] = gb[e] * (w0[e] * p[i][e] + w1[e] * p[i + 1][e] + w2[e] * p[i + 2][e] + bb[e]);
                    *(u32x4*)(ACONV + (size_t)(r0 + i) * 1024 + c0) = pack8(o); } }
#pragma unroll
            for (int i = 0; i < 4; ++i) { const int r = r0 + i, s = r & (SEQ - 1);
                { const u32x2 w = cqr[i]; const float a = bflo(w.x), b = bfhi(w.x), c = bflo(w.y), d = bfhi(w.y);
                  const float sq = wave_sum((a * a + b * b) + (c * c + d * d)); if (lane == 0) rstdq[r] = 1.f / sqrtf(sq * (1.f / 256.f) + EPS); }
                { const unsigned w = ckr[i]; const float a = bflo(w), b = bfhi(w);
                  const float sq = wave_sum(a * a + b * b); if (lane == 0) rstdkv[r] = 1.f / sqrtf(sq * (1.f / 128.f) + EPS); }
                { const int pp = lane, j = (pp >> 3) * 4 + (pp & 3), half = (pp >> 2) & 1; const float v1 = bf2f(k1[i]), v2 = bf2f(k2[i]); const f32x2 cs = rope[s * 32 + j];
                  const float kv_ = half ? v1 * cs.y + v2 * cs.x : v1 * cs.x - v2 * cs.y;
#if ATT_FP8
                  KR8[(size_t)r * 64 + pp] = (unsigned char)(__builtin_amdgcn_cvt_pk_fp8_f32(kv_, kv_, 0u, false) & 0xffu);
#else
                  KROPE[(size_t)r * 64 + pp] = f2bf(kv_);
#endif
                } }
        }
    }
    SEAM(2);

    if (IN(3)) { PHASE_BEGIN();
        { Gemm g = mkgemm(ACONV, Wco_t, MT, 1024, 1024, 1024, 1024); StaticOrder S; S.init(MT, 1024, G, bx);
          pg8::EpiChunk<FGateMul> E{{SIGA, MIXA}}; pg8::gemm_phase(lds, g, S, E, tid); }
        { Gemm g = mkgemm(CQ, Wuq_t, MT, 1536, 256, 256, 256); StaticOrder S; S.init(MT, 1536, G, (bx + G / 2) % G);
          pg8::EpiChunk<FQ> E{{rstdq, rope, QB, ATT_FP8 ? Q8 : nullptr}}; pg8::gemm_phase(lds, g, S, E, tid); }
        { Gemm g = mkgemm(CKV, Wukv_t, MT, 2048, 128, 128, 128); StaticOrder S; S.init(MT, 2048, G, bx);
#if ATT_FP8
          (void)g; (void)S; }
        { Gemm g = mkgemm(CKV, Wukv_t, MT, 1024, 128, 128, 128); StaticOrder S; S.init(MT, 1024, G, bx);
          pg8::EpiChunk<FK8> E{{rstdkv, KN8}}; pg8::gemm_phase(lds, g, S, E, tid); }
        { Gemm g = mkgemm(Wukv_t + (size_t)1024 * 128, CKV, 1024, MT, 128, 128, 128); StaticOrder S; S.init(1024, MT, G, bx);
          pg8::EpiChunk<FVT8> E{{rstdkv, VT8}}; pg8::gemm_phase(lds, g, S, E, tid); }
#else
          pg8::EpiChunk<FScaleRow> E{{rstdkv, KVB, 2048}}; pg8::gemm_phase(lds, g, S, E, tid); }
#endif
        { Gemm g = mkgemm(MKV, Wmqh, 2048, 1024, 256, 256, 256, 1, 4, (size_t)1024 * 256); StaticOrder S; S.init(2048, 1024, G, bx);
          pg8::EpiChunk<FPlain> E{{QKT, 1024}}; pg8::gemm_phase(lds, g, S, E, tid); }
        for (int b = 0; b < NB; ++b) { Gemm g = mkgemm(Woht, MKV + (size_t)(8 + b * 4) * 65536, 4096, 256, 256, 256, 256, 4, 4, (size_t)65536); StaticOrder S; S.init(4096, 256, G, (bx + G - 64 - 16 * b) % G);
          pg8::EpiChunk<FVW> E{{VWT + (size_t)b * 1024 * 1024}}; pg8::gemm_phase(lds, g, S, E, tid); }
    }
    SEAM(3);

    if (IN(4)) { PHASE_BEGIN();
        for (int u = vcu; u < NB * NHEAD * (SEQ / 256); u += G) { const int bh = u >> 5, qb = u & 31, b = bh >> 3, h = bh & 7; const size_t row0 = (size_t)b * SEQ + qb * 256;
#if ATT_FP8
            att::attn_unit9(Q8 + row0 * 1536 + h * 128, Q8 + row0 * 1536 + 1024 + h * 64, KN8 + (size_t)b * SEQ * 1024 + h * 128, KR8 + (size_t)b * SEQ * 64,
                            VT8 + (size_t)(b * NHEAD + h) * 128 * SEQ, OB + row0 * 1024 + h * 128, SEQ, (char*)lds_raw, tid);
#else
            att::attn_unit(QB + row0 * 1536 + h * 128, QB + row0 * 1536 + 1024 + h * 64, KVB + (size_t)b * SEQ * 2048 + h * 128,
                           KROPE + (size_t)b * SEQ * 64, OB + row0 * 1024 + h * 128, SEQ, (char*)lds_raw, tid);
#endif
        }
    }
    SEAM(4);

    if (IN(5)) { PHASE_BEGIN(); Gemm g = mkgemm(OB, Wmo_t, MT, 1024, 1024, 1024, 1024); StaticOrder S; S.init(MT, 1024, G, bx);
        pg8::EpiChunk<FGateMulAdd> E{{SIGB, MIXA, MIXED}}; pg8::gemm_phase(lds, g, S, E, tid); }
    SEAM(5);

    if (IN(6)) { PHASE_BEGIN(); Gemm g = mkgemm(MIXED, Wmix_t, MT, 1024, 1024, 1024, 1024); StaticOrder S; S.init(MT, 1024, G, bx);
        EpiX1 E{x, RESID_BF16 ? nullptr : out, X1B, ssq}; pg8::gemm_phase(lds, g, S, E, tid); }
    SEAM(6);

    if (IN(7)) { PHASE_BEGIN(); Gemm g = mkgemm(X1B, QKT, MT, 1024, 1024, 1024, 1024, 32, 2, (size_t)1024 * 1024); StaticOrder S; S.init(MT, 1024, G, bx);
        EpiSoftmax E{ssq, PM}; pg8::gemm_phase(lds, g, S, E, tid); }
    SEAM(7);

    if (IN(8)) { PHASE_BEGIN(); Gemm g = mkgemm(PM, VWT, MT, 1024, 1024, 1024, 1024, 32, 2, (size_t)1024 * 1024); StaticOrder S; S.init(MT, 1024, G, bx);
#if RESID_BF16
        pg8::EpiChunk<FResidBf16> E{{X1B, X2B}}; pg8::gemm_phase(lds, g, S, E, tid); }
#else
        pg8::EpiChunk<FResidF32> E{{out, out}}; pg8::gemm_phase(lds, g, S, E, tid); }
#endif
    SEAM(8);

#if RESID_BF16
#define LDROW4(r_, j_) ([&]() -> f32x4 { const u32x2 w_ = *(const u32x2*)(X2B + (size_t)(r_) * 1024 + (lane + 64 * (j_)) * 4); return (f32x4){bflo(w_.x), bfhi(w_.x), bflo(w_.y), bfhi(w_.y)}; }())
#else
#define LDROW4(r_, j_) (*(const f32x4*)(out + (size_t)(r_) * 1024 + (lane + 64 * (j_)) * 4))
#endif
    if (IN(9)) { PHASE_BEGIN();
        constexpr int RP = 1028;
        LAS float* wt = (LAS float*)lds;
        LAS float* hb = (LAS float*)(lds + 16 * RP * 4);
        LAS float* part = (LAS float*)(lds + 2 * 16 * RP * 4);
        const float* wr_ = args.in[I_W_ROUTER]; const float* gn = args.in[I_NORM_MOE_G];
        for (int i = tid; i < 1024 * 16; i += NWAVES * 64) wt[(i & 15) * RP + (i >> 4)] = wr_[i];
        f32x4 gv[4];
#pragma unroll
        for (int j = 0; j < 4; ++j) gv[j] = *(const f32x4*)(gn + (lane + 64 * j) * 4);
        f32x4 v[2][4], vn[2][4];
        const int ngroups = MT / 16;
        if (vcu < ngroups) {
#pragma unroll
            for (int t = 0; t < 2; ++t)
#pragma unroll
                for (int j = 0; j < 4; ++j) v[t][j] = LDROW4(vcu * 16 + wave * 2 + t, j); }
        __syncthreads();
        for (int g = vcu; g < ngroups; g += G) { const int r0 = g * 16;
            if (g + G < ngroups) {
#pragma unroll
                for (int t = 0; t < 2; ++t)
#pragma unroll
                    for (int j = 0; j < 4; ++j) vn[t][j] = LDROW4((g + G) * 16 + wave * 2 + t, j); }
#pragma unroll
            for (int t = 0; t < 2; ++t) { const int tk = wave * 2 + t, r = r0 + tk; float s = 0.f;
#pragma unroll
                for (int j = 0; j < 4; ++j) s += (v[t][j][0] * v[t][j][0] + v[t][j][1] * v[t][j][1]) + (v[t][j][2] * v[t][j][2] + v[t][j][3] * v[t][j][3]);
                const float rs = 1.f / sqrtf(wave_sum(s) * (1.f / 1024.f) + EPS);
#pragma unroll
                for (int j = 0; j < 4; ++j) { const f32x4 hh = v[t][j] * rs * gv[j]; *(LAS f32x4*)(hb + tk * RP + (lane + 64 * j) * 4) = hh;
                    u32x2 w; w.x = cvtpk(hh[0], hh[1]); w.y = cvtpk(hh[2], hh[3]); *(u32x2*)(H3 + (size_t)r * 1024 + (lane + 64 * j) * 4) = w; } }
            __syncthreads();
            { f32x4 acc = {0.f, 0.f, 0.f, 0.f}; const LAS float* ap = wt + (lane & 15) * RP + wave * 128 + (lane >> 4); const LAS float* bp = hb + (lane & 15) * RP + wave * 128 + (lane >> 4);
#pragma unroll 8
                for (int st = 0; st < 32; ++st) acc = __builtin_amdgcn_mfma_f32_16x16x4f32(ap[4 * st], bp[4 * st], acc, 0, 0, 0);
                *(LAS f32x4*)(part + (wave * 16 + (lane & 15)) * 16 + 4 * (lane >> 4)) = acc; }
            __syncthreads();
            if (tid < 256) { const int tk = tid >> 4, e = tid & 15; float lg = 0.f;
#pragma unroll
                for (int w = 0; w < 8; ++w) lg += part[(w * 16 + tk) * 16 + e];
                float mx = lg;
#pragma unroll
                for (int o = 1; o < 16; o <<= 1) mx = fmaxf(mx, __shfl_xor(mx, o));
                const float p = __expf(lg - mx); float sm = p;
#pragma unroll
                for (int o = 1; o < 16; o <<= 1) sm += __shfl_xor(sm, o);
                const int r = r0 + tk, b = r >> 13, sidx = r & (SEQ - 1); aff[((size_t)b * NEXP + e) * SEQ + sidx] = p / sm; inv[(size_t)r * 16 + e] = -1; }
            __syncthreads();
#pragma unroll
            for (int t = 0; t < 2; ++t)
#pragma unroll
                for (int j = 0; j < 4; ++j) v[t][j] = vn[t][j];
        }
    }
    SEAM(9);

    if (IN(10)) { PHASE_BEGIN();
        if (vcu < NB * NEXP) {
            LAS unsigned* keys = (LAS unsigned*)lds; LAS unsigned* hist = (LAS unsigned*)(lds + 32768); LAS unsigned* misc = (LAS unsigned*)(lds + 32768 + 1024);
            for (int be = vcu; be < NB * NEXP; be += G) { const int b = be >> 4, e = be & 15; const float* a = aff + (size_t)be * SEQ;
#pragma unroll 1
                for (int i = tid; i < SEQ; i += NWAVES * 64) keys[i] = __float_as_uint(a[i]);
                unsigned prefix = 0u, kth = CAP;
#pragma unroll 1
                for (int pass = 0; pass < 4; ++pass) { const int shift = 24 - 8 * pass;
                    if (tid < 256) hist[tid] = 0u;
                    __syncthreads();
#pragma unroll 1
                    for (int i = tid; i < SEQ; i += NWAVES * 64) { const unsigned k = keys[i]; const bool match = (pass == 0) || ((k >> (shift + 8)) == (prefix >> (shift + 8)));
                        if (match) atomicAdd((unsigned*)(hist + ((k >> shift) & 255u)), 1u); }
                    __syncthreads();
                    if (wave == 0) { unsigned c[4]; unsigned tot = 0u;
#pragma unroll
                        for (int i = 0; i < 4; ++i) { c[i] = hist[255 - (4 * lane + i)]; tot += c[i]; }
                        unsigned incl = tot;
#pragma unroll
                        for (int o = 1; o < 64; o <<= 1) { const unsigned t = __shfl_up(incl, o); if (lane >= o) incl += t; }
                        unsigned run = incl - tot;
#pragma unroll
                        for (int i = 0; i < 4; ++i) { if (run < kth && run + c[i] >= kth) { misc[0] = 255u - (unsigned)(4 * lane + i); misc[1] = kth - run; } run += c[i]; } }
                    __syncthreads();
                    prefix |= misc[0] << shift; kth = misc[1];
                    __syncthreads();
                }
                const unsigned T = prefix; unsigned base_g = 0u, base_e = 0u;
#pragma unroll 1
                for (int it = 0; it < SEQ / (NWAVES * 64); ++it) { const int t = it * (NWAVES * 64) + tid; const unsigned k = keys[t]; const bool gt = k > T, eq = k == T;
                    const unsigned long long bg = __ballot(gt), bq = __ballot(eq); const unsigned long long lt = (1ull << lane) - 1ull;
                    if (lane == 0) { misc[8 + wave] = (unsigned)__popcll(bg); misc[16 + wave] = (unsigned)__popcll(bq); }
                    __syncthreads();
                    unsigned pg = base_g, pq = base_e, tg = 0u, tq = 0u;
#pragma unroll
                    for (int w = 0; w < NWAVES; ++w) { const unsigned cg = misc[8 + w], cq = misc[16 + w]; if (w < wave) { pg += cg; pq += cq; } tg += cg; tq += cq; }
                    pg += (unsigned)__popcll(bg & lt); pq += (unsigned)__popcll(bq & lt);
                    const bool sel = gt || (eq && pq < kth);
                    if (sel) { const unsigned pos = pg + (pq < kth ? pq : kth); idx[(size_t)be * CAP + pos] = t; gate[(size_t)be * CAP + pos] = __uint_as_float(k); inv[((size_t)b * SEQ + t) * 16 + e] = (int)pos; }
                    base_g += tg; base_e += tq;
                    __syncthreads();
                }
            }
        } else {
            const int cw_ = vcu - NB * NEXP, ncw = G - NB * NEXP; const int gw2 = cw_ * NWAVES + wave, NGW2 = ncw * NWAVES;
#pragma unroll 1
            for (int it = gw2; it < NEXP * 768; it += NGW2) { const int e = it / 768, r = it % 768;
                if (r < 512) { const int nb = r >> 4, kb = r & 15, n0 = nb * 64; const int f0 = (n0 >> 8) * 128 + (n0 & 127);
                    const float* W = (((n0 >> 7) & 1) ? args.in[I_W_EXP_UP] : args.in[I_W_EXP_GATE]) + (size_t)e * 1024 * 1024 + f0; bf16_t* D = Wgu_t + (size_t)e * 2048 * 1024 + (size_t)n0 * 1024;
                    transpose_item([&](int n) { return W + n; }, [&](int n) { return D + (size_t)n * 1024; }, 1024, nullptr, kb * 64, scr, lane); }
                else { const int r2 = r - 512, nb = r2 >> 4, kb = r2 & 15, n0 = nb * 64;
                    const float* W = args.in[I_W_EXP_DOWN] + (size_t)e * 1024 * 1024 + n0; bf16_t* D = Wd_t + (size_t)e * 1024 * 1024 + (size_t)n0 * 1024;
                    transpose_item([&](int n) { return W + n; }, [&](int n) { return D + (size_t)n * 1024; }, 1024, nullptr, kb * 64, scr, lane); } }
        }
    }
    if (IN(10) && IN(12)) GRID_BAR();

    if (IN(12)) { PHASE_BEGIN(); Gemm g = mkgemm(H3, Wgu_t, MOE_ROWS, 2048, 1024, 1024, 1024, 4, 16, (size_t)2048 * 1024); g.gidx = idx; StaticOrder S; S.init(MOE_ROWS, 2048, G, bx);
        EpiSwiglu E{HB}; pg8::gemm_phase<EpiSwiglu, StaticOrder, true>(lds, g, S, E, tid); }
    SEAM(12);

    if (IN(13)) { PHASE_BEGIN(); Gemm g = mkgemm(HB, Wd_t, MOE_ROWS, 1024, 1024, 1024, 1024, 4, 16, (size_t)1024 * 1024); StaticOrder S; S.init(MOE_ROWS, 1024, G, bx);
        pg8::EpiChunk<FGateRow> E{{gate, Y}}; pg8::gemm_phase(lds, g, S, E, tid); }
    SEAM(13);

    if (IN(14)) { PHASE_BEGIN();
        const float* gn = args.in[I_NORM_FINAL_G]; f32x4 gv[4];
#pragma unroll
        for (int j = 0; j < 4; ++j) gv[j] = *(const f32x4*)(gn + (lane + 64 * j) * 4);
        f32x4 v[4], vn[4]; int myslot = -1, nslot = -1;
        if (gw < MT) { myslot = inv[(size_t)gw * 16 + (lane & 15)];
#pragma unroll
            for (int j = 0; j < 4; ++j) v[j] = LDROW4(gw, j); }
        for (int r = gw; r < MT; r += NGW) { float* row = out + (size_t)r * 1024; const int b = r >> 13;
            if (r + NGW < MT) { nslot = inv[(size_t)(r + NGW) * 16 + (lane & 15)];
#pragma unroll
                for (int j = 0; j < 4; ++j) vn[j] = LDROW4(r + NGW, j); }
            unsigned long long em = __ballot(lane < 16 && myslot >= 0) & 0xffffull;
            while (em) { u32x2 w[4][4]; int ne = 0;
#pragma unroll
                for (int q = 0; q < 4; ++q) { if (em) { const int e = __builtin_ctzll(em); em &= em - 1; const int slot = __builtin_amdgcn_readlane(myslot, e);
                        const bf16_t* yr = Y + ((size_t)(b * NEXP + e) * CAP + slot) * 1024;
#pragma unroll
                        for (int j = 0; j < 4; ++j) w[q][j] = *(const u32x2*)(yr + (lane + 64 * j) * 4);
                        ne = q + 1; } }
#pragma unroll
                for (int q = 0; q < 4; ++q) { if (q < ne) {
#pragma unroll
                        for (int j = 0; j < 4; ++j) { v[j][0] += bflo(w[q][j].x); v[j][1] += bfhi(w[q][j].x); v[j][2] += bflo(w[q][j].y); v[j][3] += bfhi(w[q][j].y); } } } }
            float s = 0.f;
#pragma unroll
            for (int j = 0; j < 4; ++j) s += (v[j][0] * v[j][0] + v[j][1] * v[j][1]) + (v[j][2] * v[j][2] + v[j][3] * v[j][3]);
            const float rs = 1.f / sqrtf(wave_sum(s) * (1.f / 1024.f) + EPS);
#pragma unroll
            for (int j = 0; j < 4; ++j) *(f32x4*)(row + (lane + 64 * j) * 4) = v[j] * rs * gv[j];
#pragma unroll
            for (int j = 0; j < 4; ++j) v[j] = vn[j];
            myslot = nslot;
        }
    }
#undef IN
#undef SEAM
#undef GRID_BAR
}

#ifndef PH_MASK
#define PH_MASK 0x7fff
#endif
static const void* phase_fn(int k) {
#if MK_N_LAUNCHES == 1
    (void)k; return (const void*)fwd_kernel<PH_MASK>;
#else
    switch (k) {
    case 0: return (const void*)fwd_kernel<1 << 0>;   case 1: return (const void*)fwd_kernel<1 << 1>;   case 2: return (const void*)fwd_kernel<1 << 2>;   case 3: return (const void*)fwd_kernel<1 << 3>;
    case 4: return (const void*)fwd_kernel<1 << 4>;   case 5: return (const void*)fwd_kernel<1 << 5>;   case 6: return (const void*)fwd_kernel<1 << 6>;   case 7: return (const void*)fwd_kernel<1 << 7>;
    case 8: return (const void*)fwd_kernel<1 << 8>;   case 9: return (const void*)fwd_kernel<1 << 9>;   case 10: return (const void*)fwd_kernel<1 << 10>; case 11: return (const void*)fwd_kernel<1 << 11>;
    case 12: return (const void*)fwd_kernel<1 << 12>; case 13: return (const void*)fwd_kernel<1 << 13>; default: return (const void*)fwd_kernel<1 << 14>;
    }
#endif
}
extern "C" void kernel_launch(void* const* d_in, const int* in_sizes, int n_in, void* d_out, int out_size, void* d_ws, size_t ws_size, hipStream_t stream) {
    static int grid = 0;
    if (grid == 0) {
        if (n_in != 25 || in_sizes[0] != MT * DM || out_size != MT * DM || ws_size < WS_END) {
            fprintf(stderr, "kernel_launch: built for 25 inputs, x/out of %d floats, >= %zu bytes of workspace; got n_in %d, in0 %d, out %d, ws %zu; nothing launched\n", MT * DM, (size_t)WS_END, n_in, n_in > 0 ? in_sizes[0] : -1, out_size, ws_size);
            grid = -1; return; }
        int dev = 0, cus = 0;
        if (hipGetDevice(&dev) != hipSuccess || hipDeviceGetAttribute(&cus, hipDeviceAttributeMultiprocessorCount, dev) != hipSuccess) { fprintf(stderr, "kernel_launch: device query failed\n"); grid = -1; return; }
        for (int k = 0; k < (N_LAUNCHES == 1 ? 1 : N_PHASES); ++k)
            if (hipFuncSetAttribute(phase_fn(N_LAUNCHES == 1 ? -1 : k), hipFuncAttributeMaxDynamicSharedMemorySize, LDS_BYTES) != hipSuccess) { fprintf(stderr, "kernel_launch: hipFuncSetAttribute failed\n"); grid = -1; return; }
        (void)hipGetLastError();
        grid = cus;
    }
    if (grid < 0) return;
    if (hipMemsetAsync((char*)d_ws + WS_CTL, 0, CTL_ZERO_BYTES, stream) != hipSuccess) { fprintf(stderr, "kernel_launch: memset failed\n"); return; }
    Args a{};
    for (int i = 0; i < 25; ++i) a.in[i] = (const float*)d_in[i];
    a.out = (float*)d_out; a.ws = (unsigned char*)d_ws;
    for (int li = 0; li < N_LAUNCHES; ++li) {
        a.ph_lo = (N_LAUNCHES == 1) ? 0 : li; a.ph_hi = (N_LAUNCHES == 1) ? N_PHASES : li + 1;
        void* kargs[] = {&a};
        for (int rep = 0; rep < ((N_LAUNCHES != 1 && li == REP_PHASE) ? 2 : 1); ++rep)
            (void)hipLaunchKernel(phase_fn(N_LAUNCHES == 1 ? -1 : li), dim3(grid), dim3(NWAVES * 64), kargs, LDS_BYTES, stream);
        const hipError_t le = hipPeekAtLastError();
        if (le != hipSuccess) { fprintf(stderr, "kernel_launch: launch %d failed: %s\n", li, hipGetErrorName(le)); break; }
    }
}
```

```cpp
#include <hip/hip_runtime.h>
#include <cstdio>
#include <cstdint>

#ifndef MK_N_LAUNCHES
#define MK_N_LAUNCHES 1
#endif
#ifndef REP_PHASE
#define REP_PHASE -1
#endif
#ifndef RESID_BF16
#define RESID_BF16 1
#endif
#ifndef ATT_FP8
#define ATT_FP8 1
#endif
#ifndef GEMM_SIMPLE
#define GEMM_SIMPLE 0
#endif

#define LAS __attribute__((address_space(3)))
#define GAS __attribute__((address_space(1)))
typedef unsigned short bf16_t;
typedef short bf16x8 __attribute__((ext_vector_type(8)));
typedef short s16x4 __attribute__((ext_vector_type(4)));
typedef float f32x2 __attribute__((ext_vector_type(2)));
typedef float f32x4 __attribute__((ext_vector_type(4)));
typedef float f32x16 __attribute__((ext_vector_type(16)));
typedef unsigned u32x2 __attribute__((ext_vector_type(2)));
typedef unsigned u32x4 __attribute__((ext_vector_type(4)));
typedef __bf16 bf16x2_t __attribute__((ext_vector_type(2)));

constexpr int DM = 1024, NB = 2, SEQ = 8192, MT = NB * SEQ;
constexpr int NU = 5632;
constexpr int NHEAD = 8, QK_NOPE = 128, QK_ROPE = 64, V_HEAD = 128, Q_LORA = 256, KV_LORA = 128;
constexpr int MEM_LEN = 256, MEM_HEADS = 4, MEM_HD = 256;
constexpr int NEXP = 16, EFF = 1024, CAP = 1024;
constexpr int MOE_ROWS = NB * NEXP * CAP;
constexpr float EPS = 1e-6f;
constexpr float ATT_SCALE = 0.07216878364870322f;

__device__ __forceinline__ unsigned cvtpk(float lo, float hi) { f32x2 v = {lo, hi}; bf16x2_t b = __builtin_convertvector(v, bf16x2_t); return __builtin_bit_cast(unsigned, b); }
__device__ __forceinline__ float bflo(unsigned w) { return __builtin_bit_cast(float, w << 16); }
__device__ __forceinline__ float bfhi(unsigned w) { return __builtin_bit_cast(float, w & 0xffff0000u); }
__device__ __forceinline__ float bf2f(bf16_t h) { return __builtin_bit_cast(float, (unsigned)h << 16); }
__device__ __forceinline__ bf16_t f2bf(float f) { return (bf16_t)(cvtpk(f, 0.f) & 0xffffu); }
__device__ __forceinline__ void unpack8(const u32x4 w, float (&v)[8]) { v[0] = bflo(w.x); v[1] = bfhi(w.x); v[2] = bflo(w.y); v[3] = bfhi(w.y); v[4] = bflo(w.z); v[5] = bfhi(w.z); v[6] = bflo(w.w); v[7] = bfhi(w.w); }
__device__ __forceinline__ u32x4 pack8(const float (&v)[8]) { u32x4 w; w.x = cvtpk(v[0], v[1]); w.y = cvtpk(v[2], v[3]); w.z = cvtpk(v[4], v[5]); w.w = cvtpk(v[6], v[7]); return w; }
typedef int v8i __attribute__((ext_vector_type(8)));
__device__ __forceinline__ unsigned pk4_fp8(float a, float b, float c, float d) { unsigned w = 0; w = __builtin_amdgcn_cvt_pk_fp8_f32(a, b, w, false); w = __builtin_amdgcn_cvt_pk_fp8_f32(c, d, w, true); return w; }
__device__ __forceinline__ u32x2 pack8_fp8(const float (&v)[8]) { u32x2 w; w.x = pk4_fp8(v[0], v[1], v[2], v[3]); w.y = pk4_fp8(v[4], v[5], v[6], v[7]); return w; }
__device__ __forceinline__ float wave_sum(float v) {
#pragma unroll
    for (int o = 1; o < 64; o <<= 1) v += __shfl_xor(v, o);
    return v;
}

namespace pg8 {
constexpr int BM = 256, BK = 64, HALF = 128, HTB = HALF * BK * 2, STAGE_BYTES = 8 * HTB, NXCD = 8, WGM = 8;
__host__ __device__ __forceinline__ int lds_byte(int r, int c) { const int st = (r >> 4) * 2 + (c >> 5), rr = r & 15, cc = c & 31, ob = rr * 64 + cc * 2; return st * 1024 + (ob ^ (((ob >> 9) & 1) << 5)); }
__host__ __device__ __forceinline__ void stage_rc(int b, int& R, int& C) { const int st = b / 1024, sb = b % 1024, swz = sb ^ (((sb >> 9) & 1) << 5); R = (st >> 1) * 16 + swz / 64; C = (st & 1) * 32 + (swz % 64) / 2; }
__host__ __device__ __forceinline__ int perm32(int rho) { const int n = rho >> 4, i = rho & 15; return 8 * (i >> 2) + 4 * n + (i & 3); }

struct Unit { int pm, pn; };
struct Gemm { const bf16_t* A; const bf16_t* Bt; int M, N, K, lda, ldb, bdiv, bmod; size_t bstride; const int* gidx; };
__device__ __forceinline__ Gemm mkgemm(const bf16_t* A, const bf16_t* Bt, int M, int N, int K, int lda, int ldb, int bdiv = 1, int bmod = 1, size_t bstride = 0) {
    Gemm g; g.A = A; g.Bt = Bt; g.M = M; g.N = N; g.K = K; g.lda = lda; g.ldb = ldb; g.bdiv = bdiv; g.bmod = bmod; g.bstride = bstride; g.gidx = nullptr; return g; }

struct StaticOrder {
    int nM, nN, nwg, G, c;
    __host__ __device__ void init(int M, int N, int G_, int c_) { nM = M / BM; nN = N / BM; nwg = nM * nN; G = G_; c = c_; }
    __host__ __device__ bool next(int i, Unit& u) const {
        const long L = (long)i * G + c; if (L >= nwg) return false;
        int wgid = (int)L; { const int q = nwg / NXCD, r = nwg % NXCD, xcd = wgid % NXCD, off = wgid / NXCD; wgid = (xcd < r ? xcd * (q + 1) : r * (q + 1) + (xcd - r) * q) + off; }
        const int nig = WGM * nN, gid = wgid / nig, fm = gid * WGM, gsz = (nM - fm) < WGM ? (nM - fm) : WGM;
        u.pm = fm + ((wgid % nig) % gsz); u.pn = (wgid % nig) / gsz; return true;
    }
};

typedef f32x4 Acc[2][2][4][2];

template <class Epi, class Sched>
__device__ __forceinline__ void gemm_simple(LAS unsigned char* lds, const Gemm g, const Sched& S, const Epi& E, const int tid) {
    const int wid = __builtin_amdgcn_readfirstlane(tid >> 6), lane = tid & 63, wr = wid >> 2, wc = wid & 3, fr = lane & 15, fq = lane >> 4;
    Unit u;
    for (int i = 0; S.next(i, u); ++i) {
        Acc acc;
#pragma unroll
        for (int a = 0; a < 2; ++a)
#pragma unroll
            for (int b = 0; b < 2; ++b)
#pragma unroll
                for (int m = 0; m < 4; ++m)
#pragma unroll
                    for (int n = 0; n < 2; ++n) acc[a][b][m][n] = (f32x4){0.f, 0.f, 0.f, 0.f};
        const bf16_t* Ab = g.A + (size_t)u.pm * BM * g.lda + (size_t)(wr * 64 + fr) * g.lda + fq * 8;
        const bf16_t* Bb = g.Bt + (size_t)((u.pm / g.bdiv) % g.bmod) * g.bstride + (size_t)u.pn * BM * g.ldb + fq * 8;
        int brow[2][2];
#pragma unroll
        for (int bj = 0; bj < 2; ++bj)
#pragma unroll
            for (int n = 0; n < 2; ++n) brow[bj][n] = bj * HALF + wc * 32 + perm32(n * 16 + fr);
#pragma unroll 1
        for (int k0 = 0; k0 < g.K; k0 += 32) {
            bf16x8 b[2][2];
#pragma unroll
            for (int bj = 0; bj < 2; ++bj)
#pragma unroll
                for (int n = 0; n < 2; ++n) b[bj][n] = *(const bf16x8*)(Bb + (size_t)brow[bj][n] * g.ldb + k0);
#pragma unroll
            for (int ai = 0; ai < 2; ++ai) { bf16x8 a[4];
#pragma unroll
                for (int m = 0; m < 4; ++m) a[m] = *(const bf16x8*)(Ab + (size_t)(ai * HALF + m * 16) * g.lda + k0);
#pragma unroll
                for (int bj = 0; bj < 2; ++bj)
#pragma unroll
                    for (int m = 0; m < 4; ++m)
#pragma unroll
                        for (int n = 0; n < 2; ++n) acc[ai][bj][m][n] = __builtin_amdgcn_mfma_f32_16x16x32_bf16(b[bj][n], a[m], acc[ai][bj][m][n], 0, 0, 0); }
        }
        E.run(acc, u, wr, wc, fr, fq, lds, wid, lane);
        if (Epi::USES_LDS) __syncthreads();
    }
}

template <class Epi, class Sched, bool GATHER>
__device__ __forceinline__ void gemm_fast(LAS unsigned char* lds, const Gemm g, const Sched& S, const Epi& E, const int tid) {
    const int wid = __builtin_amdgcn_readfirstlane(tid >> 6), lane = tid & 63, wr = wid >> 2, wc = wid & 3, fr = lane & 15, fq = lane >> 4;
    int Kop = g.K; asm volatile("" : "+s"(Kop));
    const int K = Kop, nt = K / BK;
    int Rr[2], Cc[2]; unsigned voffB[2];
    unsigned cvA0[2], cvA1[2], nvA0[2], nvA1[2];
    const size_t kstep = (size_t)(BK * 2);
    const size_t hstepA = (size_t)HALF * g.lda * 2, hstepB = (size_t)HALF * g.ldb * 2;
    const size_t tstepA = 2 * hstepA, tstepB = 2 * hstepB;
#pragma unroll
    for (int i = 0; i < 2; ++i) { stage_rc(tid * 16 + i * 8192, Rr[i], Cc[i]); const int Rb = (Rr[i] & ~31) + perm32(Rr[i] & 31);
        voffB[i] = (unsigned)(Rb * g.ldb + Cc[i]) * 2u;
        cvA0[i] = (unsigned)(Rr[i] * g.lda + Cc[i]) * 2u; cvA1[i] = cvA0[i] + (unsigned)hstepA; nvA0[i] = cvA0[i]; nvA1[i] = cvA1[i]; }
    const unsigned ldsw = (unsigned)wid * 1024u;
    const int aoff = lds_byte(wr * 64 + fr, fq * 8), boff = lds_byte(wc * 32 + fr, fq * 8);
#define PG8_SA(b, h) (((b) * 2 + (h)) * HTB)
#define PG8_SB(b, h) ((4 + (b) * 2 + (h)) * HTB)
#define PG8_STAGE(bufoff, gbase, voff) do { _Pragma("unroll") for (int _i = 0; _i < 2; ++_i) \
        __builtin_amdgcn_global_load_lds((const unsigned*)((const char*)(gbase) + (voff)[_i]), (LAS unsigned*)(lds + (bufoff) + ldsw + _i * 8192), 16, 0, 0); } while (0)
#define PG8_LDA(dst, b, h) do { _Pragma("unroll") for (int m = 0; m < 4; ++m) _Pragma("unroll") for (int k = 0; k < 2; ++k) dst[m][k] = *(const LAS bf16x8*)(lds + PG8_SA(b, h) + aoff + m * 2048 + k * 1024); } while (0)
#define PG8_LDB(dst, b, h) do { _Pragma("unroll") for (int n = 0; n < 2; ++n) _Pragma("unroll") for (int k = 0; k < 2; ++k) dst[n][k] = *(const LAS bf16x8*)(lds + PG8_SB(b, h) + boff + n * 2048 + k * 1024); } while (0)
#define PG8_MMA(ai, bj, At, Bt) do { __builtin_amdgcn_s_setprio(1); _Pragma("unroll") for (int m = 0; m < 4; ++m) _Pragma("unroll") for (int n = 0; n < 2; ++n) _Pragma("unroll") for (int k = 0; k < 2; ++k) \
        acc[ai][bj][m][n] = __builtin_amdgcn_mfma_f32_16x16x32_bf16(Bt[n][k], At[m][k], acc[ai][bj][m][n], 0, 0, 0); __builtin_amdgcn_s_setprio(0); } while (0)
#define PG8_WAIT_V(n) asm volatile("s_waitcnt vmcnt(" #n ")" ::: "memory")
#define PG8_WAIT_L(n) asm volatile("s_waitcnt lgkmcnt(" #n ")" ::: "memory")
#define PG8_BAR __builtin_amdgcn_s_barrier()
#define PG8_SCHED __builtin_amdgcn_sched_barrier(0)
#define PG8_GIDX(u, raw) do { const int* ip_ = g.gidx + (size_t)(u).pm * BM; raw[0] = ip_[Rr[0]]; raw[1] = ip_[Rr[1]]; raw[2] = ip_[HALF + Rr[0]]; raw[3] = ip_[HALF + Rr[1]]; } while (0)
#define PG8_GOFF(u, raw, v0, v1) do { const unsigned bb_ = (unsigned)((u).pm >> 6) * (unsigned)SEQ; _Pragma("unroll") for (int _i = 0; _i < 2; ++_i) { \
        v0[_i] = ((bb_ + (unsigned)raw[_i]) * (unsigned)g.lda + (unsigned)Cc[_i]) * 2u; v1[_i] = ((bb_ + (unsigned)raw[2 + _i]) * (unsigned)g.lda + (unsigned)Cc[_i]) * 2u; } } while (0)
    Unit cur, nxt; int ui = 0;
    if (!S.next(0, cur)) return;
    Acc acc;
#pragma unroll
    for (int a = 0; a < 2; ++a)
#pragma unroll
        for (int b = 0; b < 2; ++b)
#pragma unroll
            for (int m = 0; m < 4; ++m)
#pragma unroll
                for (int n = 0; n < 2; ++n) acc[a][b][m][n] = (f32x4){0.f, 0.f, 0.f, 0.f};
    bf16x8 At[4][2], B0[2][2], B1[2][2];
    int nraw[4] = {0, 0, 0, 0};
    const char* cA = GATHER ? (const char*)g.A : (const char*)g.A + (size_t)cur.pm * tstepA;
    const char* cB = (const char*)g.Bt + (size_t)((cur.pm / g.bdiv) % g.bmod) * g.bstride * 2 + (size_t)cur.pn * tstepB;
    if constexpr (GATHER) { int craw[4]; PG8_GIDX(cur, craw); PG8_GOFF(cur, craw, cvA0, cvA1); }
    PG8_STAGE(PG8_SB(0, 0), cB, voffB); PG8_STAGE(PG8_SB(0, 1), cB + hstepB, voffB); PG8_STAGE(PG8_SA(0, 0), cA, cvA0); PG8_STAGE(PG8_SA(0, 1), cA, cvA1);
    if (wr == 1) PG8_BAR;
    PG8_WAIT_V(2); PG8_BAR;
    PG8_STAGE(PG8_SB(1, 0), cB + kstep, voffB); PG8_STAGE(PG8_SA(1, 0), cA + kstep, cvA0); PG8_STAGE(PG8_SB(1, 1), cB + hstepB + kstep, voffB);
    PG8_WAIT_V(6); PG8_BAR;
    for (;;) {
        const bool has_next = S.next(ui + 1, nxt);
        const char* nA = GATHER ? (const char*)g.A : (has_next ? (const char*)g.A + (size_t)nxt.pm * tstepA : cA);
        const char* nB = has_next ? (const char*)g.Bt + (size_t)((nxt.pm / g.bdiv) % g.bmod) * g.bstride * 2 + (size_t)nxt.pn * tstepB : cB;
        if constexpr (GATHER) { if (has_next) PG8_GIDX(nxt, nraw); }
        for (int t = 0; t < nt; t += 2) {
            const bool last = (t == nt - 2);
            const char* a1 = cA + (size_t)(t + 1) * kstep;
            const char* a2 = last ? nA : cA + (size_t)(t + 2) * kstep; const char* b2 = last ? nB : cB + (size_t)(t + 2) * kstep;
            const char* a3 = a2 + kstep; const char* b3 = b2 + kstep;
            unsigned sA0[2] = {cvA0[0], cvA0[1]}, sA1[2] = {cvA1[0], cvA1[1]};
            if constexpr (GATHER) { if (last) { if (has_next) PG8_GOFF(nxt, nraw, nvA0, nvA1); else { nvA0[0] = cvA0[0]; nvA0[1] = cvA0[1]; nvA1[0] = cvA1[0]; nvA1[1] = cvA1[1]; }
                                                 sA0[0] = nvA0[0]; sA0[1] = nvA0[1]; sA1[0] = nvA1[0]; sA1[1] = nvA1[1]; } }
            PG8_LDB(B0, 0, 0); PG8_LDB(B1, 0, 1); PG8_SCHED; PG8_LDA(At, 0, 0); PG8_STAGE(PG8_SA(1, 1), a1, cvA1);
            PG8_WAIT_V(8); PG8_WAIT_L(0); PG8_BAR; PG8_MMA(0, 0, At, B0); PG8_MMA(0, 1, At, B1); PG8_BAR; PG8_SCHED;
            PG8_LDA(At, 0, 1); PG8_STAGE(PG8_SB(0, 0), b2, voffB); PG8_STAGE(PG8_SB(0, 1), b2 + hstepB, voffB); PG8_STAGE(PG8_SA(0, 0), a2, sA0);
            PG8_WAIT_V(8); PG8_WAIT_L(0); PG8_BAR; PG8_MMA(1, 0, At, B0); PG8_MMA(1, 1, At, B1); PG8_BAR; PG8_SCHED;
            PG8_LDB(B0, 1, 0); PG8_LDB(B1, 1, 1); PG8_SCHED; PG8_LDA(At, 1, 0); PG8_STAGE(PG8_SA(0, 1), a2, sA1);
            PG8_WAIT_V(8); PG8_WAIT_L(0); PG8_BAR; PG8_MMA(0, 0, At, B0); PG8_MMA(0, 1, At, B1); PG8_BAR; PG8_SCHED;
            PG8_LDA(At, 1, 1); PG8_STAGE(PG8_SB(1, 0), b3, voffB); PG8_STAGE(PG8_SB(1, 1), b3 + hstepB, voffB); PG8_STAGE(PG8_SA(1, 0), a3, sA0);
            PG8_WAIT_V(8); PG8_WAIT_L(0); PG8_BAR; PG8_MMA(1, 0, At, B0); PG8_MMA(1, 1, At, B1); PG8_BAR; PG8_SCHED;
        }
        if (wr == 0) PG8_BAR;
        E.run(acc, cur, wr, wc, fr, fq, lds + STAGE_BYTES, wid, lane);
        if (!has_next) break;
#pragma unroll
        for (int a = 0; a < 2; ++a)
#pragma unroll
            for (int b = 0; b < 2; ++b)
#pragma unroll
                for (int m = 0; m < 4; ++m)
#pragma unroll
                    for (int n = 0; n < 2; ++n) acc[a][b][m][n] = (f32x4){0.f, 0.f, 0.f, 0.f};
        cur = nxt; cA = nA; cB = nB; ++ui;
        if constexpr (GATHER) { cvA0[0] = nvA0[0]; cvA0[1] = nvA0[1]; cvA1[0] = nvA1[0]; cvA1[1] = nvA1[1]; }
        if (wr == 1) PG8_BAR;
    }
    PG8_WAIT_V(0);
    PG8_BAR;
#undef PG8_SA
#undef PG8_SB
#undef PG8_STAGE
#undef PG8_LDA
#undef PG8_LDB
#undef PG8_MMA
#undef PG8_WAIT_V
#undef PG8_WAIT_L
#undef PG8_BAR
#undef PG8_SCHED
#undef PG8_GIDX
#undef PG8_GOFF
}

template <class Epi, class Sched, bool GATHER = false>
__device__ __forceinline__ void gemm_phase(LAS unsigned char* lds, const Gemm g, const Sched& S, const Epi& E, const int tid) {
#if GEMM_SIMPLE
    static_assert(!GATHER, "the simple body has no gather path");
    gemm_simple<Epi, Sched>(lds + STAGE_BYTES, g, S, E, tid);
#else
    gemm_fast<Epi, Sched, GATHER>(lds, g, S, E, tid);
#endif
}

template <class F> struct EpiChunk {
    static constexpr bool USES_LDS = false;
    F f;
    __device__ __forceinline__ void run(Acc& acc, const Unit& u, int wr, int wc, int fr, int fq, LAS unsigned char*, int, int) const {
        constexpr int NBT = F::NBATCH, GPB = 8 / NBT;
#pragma unroll
        for (int bt = 0; bt < NBT; ++bt) {
            typename F::Pre pre[GPB][2];
#pragma unroll
            for (int g = 0; g < GPB; ++g) { const int rg = bt * GPB + g, ai = rg >> 2, m = rg & 3; const int row = u.pm * BM + ai * HALF + wr * 64 + m * 16 + fr;
#pragma unroll
                for (int bj = 0; bj < 2; ++bj) { const int col = u.pn * BM + bj * HALF + wc * 32 + 8 * fq; pre[g][bj] = f.load(row, col); } }
            asm volatile("" ::: "memory");
#pragma unroll
            for (int g = 0; g < GPB; ++g) { const int rg = bt * GPB + g, ai = rg >> 2, m = rg & 3; const int row = u.pm * BM + ai * HALF + wr * 64 + m * 16 + fr;
#pragma unroll
                for (int bj = 0; bj < 2; ++bj) { const int col = u.pn * BM + bj * HALF + wc * 32 + 8 * fq;
                    const f32x4 a = acc[ai][bj][m][0], b = acc[ai][bj][m][1];
                    const float v[8] = {a[0], a[1], a[2], a[3], b[0], b[1], b[2], b[3]};
                    f.chunk(row, col, v, pre[g][bj]); } }
            asm volatile("" ::: "memory");
        }
    }
};
}
using pg8::Gemm; using pg8::Unit; using pg8::StaticOrder; using pg8::mkgemm;

struct PreNone {};
struct PreF { float r; };
struct FU { const float* rstd0; bf16_t *XGG, *CQ, *CKV, *KR, *SIGA, *SIGB; const float* bgate;
    static constexpr int NBATCH = 4;
    struct Pre { float rs; f32x4 b0, b1; };
    __device__ __forceinline__ Pre load(int row, int col) const { Pre p; p.rs = rstd0[row];
        if (col >= 3584) { p.b0 = *(const f32x4*)(bgate + (col - 3584)); p.b1 = *(const f32x4*)(bgate + (col - 3584) + 4); } else { p.b0 = (f32x4){0.f, 0.f, 0.f, 0.f}; p.b1 = p.b0; }
        return p; }
    __device__ __forceinline__ void chunk(int row, int col, const float (&v)[8], const Pre& p) const {
        const float rs = p.rs; float o[8];
#pragma unroll
        for (int i = 0; i < 8; ++i) o[i] = v[i] * rs;
        if (col < 3072) { *(u32x4*)(XGG + (size_t)row * 2048 + 1024 + (col - 2048)) = pack8(o); }
        else if (col < 3328) { *(u32x4*)(CQ + (size_t)row * 256 + (col - 3072)) = pack8(o); }
        else if (col < 3456) { *(u32x4*)(CKV + (size_t)row * 128 + (col - 3328)) = pack8(o); }
        else if (col < 3520) { *(u32x4*)(KR + (size_t)row * 64 + (col - 3456)) = pack8(o); }
        else if (col >= 3584) { const int c = col - 3584;
            const float bb[8] = {p.b0[0], p.b0[1], p.b0[2], p.b0[3], p.b1[0], p.b1[1], p.b1[2], p.b1[3]};
#pragma unroll
            for (int i = 0; i < 8; ++i) o[i] = 1.f / (1.f + __expf(-(o[i] + bb[i])));
            bf16_t* dst = c < 1024 ? SIGA + (size_t)row * 1024 + c : SIGB + (size_t)row * 1024 + (c - 1024);
            *(u32x4*)dst = pack8(o); }
    } };
struct EpiU {
    static constexpr bool USES_LDS = false;
    FU f;
    __device__ __forceinline__ void run(pg8::Acc& acc, const Unit& u, int wr, int wc, int fr, int fq, LAS unsigned char* scr, int wid, int lane) const {
        if (u.pn < 8) {
#pragma unroll
            for (int ai = 0; ai < 2; ++ai)
#pragma unroll
                for (int m = 0; m < 4; ++m) { const int row = u.pm * 256 + ai * 128 + wr * 64 + m * 16 + fr; const int col = u.pn * 128 + wc * 32 + 8 * fq; const float rs = f.rstd0[row]; const float r2 = rs * rs; float o[8];
#pragma unroll
                    for (int n = 0; n < 2; ++n)
#pragma unroll
                        for (int i = 0; i < 4; ++i) o[n * 4 + i] = acc[ai][0][m][n][i] * acc[ai][1][m][n][i] * r2;
                    *(u32x4*)(f.XGG + (size_t)row * 2048 + col) = pack8(o); }
        } else { pg8::EpiChunk<FU> E{f}; E.run(acc, u, wr, wc, fr, fq, scr, wid, lane); }
    }
};
struct FMemKV { const float* rstdm; bf16_t* MKV;
    static constexpr int NBATCH = 1; typedef PreF Pre;
    __device__ __forceinline__ Pre load(int row, int) const { Pre p; p.r = rstdm[row]; return p; }
    __device__ __forceinline__ void chunk(int row, int col, const float (&v)[8], const Pre& p) const {
        const float rs = p.r * (col < 1024 ? 0.0625f : 1.f); float o[8];
#pragma unroll
        for (int i = 0; i < 8; ++i) o[i] = v[i] * rs;
        const int kv = col >> 10, h = (col >> 8) & 3, j = col & 255, b = row >> 8, key = row & 255;
        *(u32x4*)(MKV + ((size_t)((kv * 2 + b) * 4 + h) * 256 + key) * 256 + j) = pack8(o);
    } };
struct FQ { const float* rstdq; const f32x2* rope; bf16_t* Q; unsigned char* Q8;
    static constexpr int NBATCH = 4;
    struct Pre { float rs; f32x2 cs[4]; };
    __device__ __forceinline__ Pre load(int row, int col) const { Pre p; p.rs = rstdq[row];
        if (col >= 1024) { const int pp = (col - 1024) & 63, j0 = (pp >> 3) * 4, s = row & (SEQ - 1);
#pragma unroll
            for (int i = 0; i < 4; ++i) p.cs[i] = rope[s * 32 + j0 + i]; }
        else {
#pragma unroll
            for (int i = 0; i < 4; ++i) p.cs[i] = (f32x2){1.f, 0.f}; }
        return p; }
    __device__ __forceinline__ void chunk(int row, int col, const float (&v)[8], const Pre& p) const {
        const float rs = p.rs; float o[8];
#pragma unroll
        for (int i = 0; i < 8; ++i) o[i] = v[i] * rs;
        if (col >= 1024) {
#pragma unroll
            for (int i = 0; i < 4; ++i) { const f32x2 cs = p.cs[i]; const float a = o[i], b = o[4 + i]; o[i] = a * cs.x - b * cs.y; o[4 + i] = a * cs.y + b * cs.x; } }
        if (Q8) { float q[8];
#pragma unroll
            for (int i = 0; i < 8; ++i) q[i] = o[i] * (16.f * ATT_SCALE * 1.4426950408889634f);
            *(u32x2*)(Q8 + (size_t)row * 1536 + col) = pack8_fp8(q); }
        else *(u32x4*)(Q + (size_t)row * 1536 + col) = pack8(o);
    } };
struct FScaleRow { const float* rs; bf16_t* O; int ldo;
    static constexpr int NBATCH = 1; typedef PreF Pre;
    __device__ __forceinline__ Pre load(int row, int) const { Pre p; p.r = rs[row]; return p; }
    __device__ __forceinline__ void chunk(int row, int col, const float (&v)[8], const Pre& p) const {
        const float r = p.r; float o[8];
#pragma unroll
        for (int i = 0; i < 8; ++i) o[i] = v[i] * r;
        *(u32x4*)(O + (size_t)row * ldo + col) = pack8(o);
    } };
struct FK8 { const float* rs; unsigned char* K8;
    static constexpr int NBATCH = 1; typedef PreF Pre;
    __device__ __forceinline__ Pre load(int row, int) const { Pre p; p.r = rs[row]; return p; }
    __device__ __forceinline__ void chunk(int row, int col, const float (&v)[8], const Pre& p) const {
        const float r = p.r; float o[8];
#pragma unroll
        for (int i = 0; i < 8; ++i) o[i] = v[i] * r;
        *(u32x2*)(K8 + (size_t)row * 1024 + col) = pack8_fp8(o);
    } };
struct FVT8 { const float* rs; unsigned char* VT;
    static constexpr int NBATCH = 2;
    struct Pre { f32x4 a, b; };
    __device__ __forceinline__ Pre load(int, int col) const { Pre p; p.a = *(const f32x4*)(rs + col); p.b = *(const f32x4*)(rs + col + 4); return p; }
    __device__ __forceinline__ void chunk(int row, int col, const float (&v)[8], const Pre& p) const {
        const float o[8] = {v[0] * p.a[0], v[1] * p.a[1], v[2] * p.a[2], v[3] * p.a[3], v[4] * p.b[0], v[5] * p.b[1], v[6] * p.b[2], v[7] * p.b[3]};
        *(u32x2*)(VT + (size_t)(col >> 13) * ((size_t)1024 * SEQ) + (size_t)row * SEQ + (col & (SEQ - 1))) = pack8_fp8(o);
    } };
struct FPlain { bf16_t* O; int ldo;
    static constexpr int NBATCH = 1; typedef PreNone Pre;
    __device__ __forceinline__ Pre load(int, int) const { return Pre{}; }
    __device__ __forceinline__ void chunk(int row, int col, const float (&v)[8], const Pre&) const { *(u32x4*)(O + (size_t)row * ldo + col) = pack8(v); } };
struct FVW { bf16_t* O;
    static constexpr int NBATCH = 1; typedef PreNone Pre;
    __device__ __forceinline__ Pre load(int, int) const { return Pre{}; }
    __device__ __forceinline__ void chunk(int row, int col, const float (&v)[8], const Pre&) const { const int h = row >> 10, n = row & 1023; *(u32x4*)(O + (size_t)n * 1024 + h * 256 + col) = pack8(v); } };
struct FGateMul { const bf16_t* G; bf16_t* O;
    static constexpr int NBATCH = 2;
    struct Pre { u32x4 g; };
    __device__ __forceinline__ Pre load(int row, int col) const { Pre p; p.g = *(const u32x4*)(G + (size_t)row * 1024 + col); return p; }
    __device__ __forceinline__ void chunk(int row, int col, const float (&v)[8], const Pre& p) const {
        float g[8], o[8]; unpack8(p.g, g);
#pragma unroll
        for (int i = 0; i < 8; ++i) o[i] = g[i] * v[i];
        *(u32x4*)(O + (size_t)row * 1024 + col) = pack8(o);
    } };
struct FGateMulAdd { const bf16_t* G; const bf16_t* Pv; bf16_t* O;
    static constexpr int NBATCH = 2;
    struct Pre { u32x4 g, p; };
    __device__ __forceinline__ Pre load(int row, int col) const { Pre p; p.g = *(const u32x4*)(G + (size_t)row * 1024 + col); p.p = *(const u32x4*)(Pv + (size_t)row * 1024 + col); return p; }
    __device__ __forceinline__ void chunk(int row, int col, const float (&v)[8], const Pre& pr) const {
        float g[8], p[8], o[8]; unpack8(pr.g, g); unpack8(pr.p, p);
#pragma unroll
        for (int i = 0; i < 8; ++i) o[i] = p[i] + g[i] * v[i];
        *(u32x4*)(O + (size_t)row * 1024 + col) = pack8(o);
    } };
struct FResidF32 { const float* base; float* out;
    static constexpr int NBATCH = 2;
    struct Pre { f32x4 a, b; };
    __device__ __forceinline__ Pre load(int row, int col) const { const size_t off = (size_t)row * 1024 + col; Pre p; p.a = *(const f32x4*)(base + off); p.b = *(const f32x4*)(base + off + 4); return p; }
    __device__ __forceinline__ void chunk(int row, int col, const float (&v)[8], const Pre& p) const {
        const size_t off = (size_t)row * 1024 + col; const f32x4 a = p.a, b = p.b;
        *(f32x4*)(out + off) = (f32x4){a[0] + v[0], a[1] + v[1], a[2] + v[2], a[3] + v[3]}; *(f32x4*)(out + off + 4) = (f32x4){b[0] + v[4], b[1] + v[5], b[2] + v[6], b[3] + v[7]};
    } };
struct FResidBf16 { const bf16_t* base; bf16_t* out;
    static constexpr int NBATCH = 1;
    struct Pre { u32x4 a; };
    __device__ __forceinline__ Pre load(int row, int col) const { Pre p; p.a = *(const u32x4*)(base + (size_t)row * 1024 + col); return p; }
    __device__ __forceinline__ void chunk(int row, int col, const float (&v)[8], const Pre& p) const {
        float a[8], o[8]; unpack8(p.a, a);
#pragma unroll
        for (int i = 0; i < 8; ++i) o[i] = a[i] + v[i];
        *(u32x4*)(out + (size_t)row * 1024 + col) = pack8(o);
    } };
struct FGateRow { const float* gate; bf16_t* O;
    static constexpr int NBATCH = 1; typedef PreF Pre;
    __device__ __forceinline__ Pre load(int row, int) const { Pre p; p.r = gate[row]; return p; }
    __device__ __forceinline__ void chunk(int row, int col, const float (&v)[8], const Pre& p) const {
        const float r = p.r; float o[8];
#pragma unroll
        for (int i = 0; i < 8; ++i) o[i] = v[i] * r;
        *(u32x4*)(O + (size_t)row * 1024 + col) = pack8(o);
    } };

struct EpiX1 {
    static constexpr bool USES_LDS = false;
    const float* base; float* out; bf16_t* xb; float* ssq;
    __device__ __forceinline__ void run(pg8::Acc& acc, const Unit& u, int wr, int wc, int fr, int fq, LAS unsigned char*, int, int) const {
#pragma unroll
        for (int bt = 0; bt < 4; ++bt) { f32x4 pa[2][2], pb[2][2];
#pragma unroll
            for (int g = 0; g < 2; ++g) { const int rg = bt * 2 + g, ai = rg >> 2, m = rg & 3; const int row = u.pm * 256 + ai * 128 + wr * 64 + m * 16 + fr;
#pragma unroll
                for (int bj = 0; bj < 2; ++bj) { const size_t off = (size_t)row * 1024 + u.pn * 256 + bj * 128 + wc * 32 + 8 * fq; pa[g][bj] = *(const f32x4*)(base + off); pb[g][bj] = *(const f32x4*)(base + off + 4); } }
            asm volatile("" ::: "memory");
#pragma unroll
            for (int g = 0; g < 2; ++g) { const int rg = bt * 2 + g, ai = rg >> 2, m = rg & 3; const int row = u.pm * 256 + ai * 128 + wr * 64 + m * 16 + fr; float s = 0.f;
#pragma unroll
                for (int bj = 0; bj < 2; ++bj) { const int col = u.pn * 256 + bj * 128 + wc * 32 + 8 * fq; const size_t off = (size_t)row * 1024 + col;
                    const f32x4 a = pa[g][bj], b = pb[g][bj]; const f32x4 c0 = acc[ai][bj][m][0], c1 = acc[ai][bj][m][1];
                    const float o[8] = {a[0] + c0[0], a[1] + c0[1], a[2] + c0[2], a[3] + c0[3], b[0] + c1[0], b[1] + c1[1], b[2] + c1[2], b[3] + c1[3]};
                    if (out) { *(f32x4*)(out + off) = (f32x4){o[0], o[1], o[2], o[3]}; *(f32x4*)(out + off + 4) = (f32x4){o[4], o[5], o[6], o[7]}; }
                    *(u32x4*)(xb + off) = pack8(o);
#pragma unroll
                    for (int i = 0; i < 8; ++i) s += o[i] * o[i]; }
                s += __shfl_xor(s, 16); s += __shfl_xor(s, 32);
                if (fq == 0) ssq[(size_t)row * 16 + u.pn * 4 + wc] = s; }
            asm volatile("" ::: "memory"); }
    }
};
struct EpiSoftmax {
    static constexpr bool USES_LDS = true;
    const float* ssq; bf16_t* P;
    __device__ __forceinline__ void run(pg8::Acc& acc, const Unit& u, int wr, int wc, int fr, int fq, LAS unsigned char* scr, int wid_, int lane_) const {
        LAS float* PM = (LAS float*)scr;
        LAS float* PS = (LAS float*)(scr + 4096);
        LAS float* RS = (LAS float*)(scr + 4096);
        { const int t = wid_ * 64 + lane_; if (t < 256) { const f32x4* sp = (const f32x4*)((const char*)ssq + (unsigned)(u.pm * 256 + t) * 64u); const f32x4 q0 = sp[0], q1 = sp[1], q2 = sp[2], q3 = sp[3];
            float tt = ((q0[0] + q0[1]) + (q0[2] + q0[3])) + ((q1[0] + q1[1]) + (q1[2] + q1[3])); tt += ((q2[0] + q2[1]) + (q2[2] + q2[3])) + ((q3[0] + q3[1]) + (q3[2] + q3[3]));
            RS[t] = 1.f / sqrtf(tt * (1.f / 1024.f) + EPS); } }
        __syncthreads();
#pragma unroll
        for (int ai = 0; ai < 2; ++ai)
#pragma unroll
            for (int m = 0; m < 4; ++m) { const int rl = ai * 128 + wr * 64 + m * 16 + fr;
                const float rs = RS[rl];
                float mx = -3.0e38f;
#pragma unroll
                for (int bj = 0; bj < 2; ++bj)
#pragma unroll
                    for (int n = 0; n < 2; ++n)
#pragma unroll
                        for (int i = 0; i < 4; ++i) { const float s = acc[ai][bj][m][n][i] * rs; acc[ai][bj][m][n][i] = s; mx = fmaxf(mx, s); }
                mx = fmaxf(mx, __shfl_xor(mx, 16)); mx = fmaxf(mx, __shfl_xor(mx, 32));
                if (fq == 0) PM[rl * 4 + wc] = mx;
                asm volatile("" ::: "memory"); }
        __syncthreads();
#pragma unroll
        for (int ai = 0; ai < 2; ++ai)
#pragma unroll
            for (int m = 0; m < 4; ++m) { const int rl = ai * 128 + wr * 64 + m * 16 + fr;
                const f32x4 pm4 = *(const LAS f32x4*)(PM + rl * 4); const float mx = fmaxf(fmaxf(pm4[0], pm4[1]), fmaxf(pm4[2], pm4[3]));
                float s = 0.f;
#pragma unroll
                for (int bj = 0; bj < 2; ++bj)
#pragma unroll
                    for (int n = 0; n < 2; ++n)
#pragma unroll
                        for (int i = 0; i < 4; ++i) { const float e = __expf(acc[ai][bj][m][n][i] - mx); acc[ai][bj][m][n][i] = e; s += e; }
                s += __shfl_xor(s, 16); s += __shfl_xor(s, 32);
                if (fq == 0) PS[rl * 4 + wc] = s;
                asm volatile("" ::: "memory"); }
        __syncthreads();
#pragma unroll
        for (int ai = 0; ai < 2; ++ai)
#pragma unroll
            for (int m = 0; m < 4; ++m) { const int rl = ai * 128 + wr * 64 + m * 16 + fr; const int row = u.pm * 256 + rl;
                const f32x4 ps4 = *(const LAS f32x4*)(PS + rl * 4); const float inv = 1.f / ((ps4[0] + ps4[1]) + (ps4[2] + ps4[3]));
#pragma unroll
                for (int bj = 0; bj < 2; ++bj) { const int col = u.pn * 256 + bj * 128 + wc * 32 + 8 * fq; float o[8];
#pragma unroll
                    for (int n = 0; n < 2; ++n)
#pragma unroll
                        for (int i = 0; i < 4; ++i) o[n * 4 + i] = acc[ai][bj][m][n][i] * inv;
                    *(u32x4*)((char*)P + ((unsigned)row * 1024u + (unsigned)col) * 2u) = pack8(o); }
                asm volatile("" ::: "memory"); }
    }
};
struct EpiSwiglu {
    static constexpr bool USES_LDS = false;
    bf16_t* H;
    __device__ __forceinline__ void run(pg8::Acc& acc, const Unit& u, int wr, int wc, int fr, int fq, LAS unsigned char*, int, int) const {
#pragma unroll
        for (int ai = 0; ai < 2; ++ai)
#pragma unroll
            for (int m = 0; m < 4; ++m) { const int row = u.pm * 256 + ai * 128 + wr * 64 + m * 16 + fr; const int col = u.pn * 128 + wc * 32 + 8 * fq; float o[8];
#pragma unroll
                for (int n = 0; n < 2; ++n)
#pragma unroll
                    for (int i = 0; i < 4; ++i) { const float g = acc[ai][0][m][n][i], up = acc[ai][1][m][n][i]; o[n * 4 + i] = g / (1.f + __expf(-g)) * up; }
                *(u32x4*)(H + (size_t)row * 1024 + col) = pack8(o); }
    }
};

namespace att {
constexpr int QBLK = 32, KVBLK = 64, NW = 8;
constexpr int LDQ = 1536, LDKV = 2048, LDKR = 64, LDO = 1024;
constexpr int KPITCH = 272, KRPITCH = 144;
constexpr int SHM_V = KVBLK * 128 * 2, SHM_K = KVBLK * KPITCH, SHM_KR = KVBLK * KRPITCH;
constexpr int OFF_V = 0, OFF_K = 2 * SHM_V, OFF_KR = OFF_K + 2 * SHM_K, OFF_WS = OFF_KR + 2 * SHM_KR, OFF_QR = OFF_WS + NW * 64 * 4, SHM_ATTN = OFF_QR + NW * 4096;
constexpr float THR = 8.f;
#define KSWZ(row, colB) ((row) * KPITCH + (colB))
#define KRSWZ(row, colB) ((row) * KRPITCH + (colB))
#define SBAR() __builtin_amdgcn_sched_barrier(0)
__device__ __forceinline__ int crow(int r, int hi) { return (r & 3) + 8 * (r >> 2) + 4 * hi; }
__device__ __forceinline__ unsigned cvtpk_a(float lo, float hi) { unsigned r; asm volatile("v_cvt_pk_bf16_f32 %0, %1, %2" : "=v"(r) : "v"(lo), "v"(hi)); return r; }

__device__ __forceinline__ void partialSM(f32x16& p0, f32x16& p1, float& m_reg, float& mn, float& alpha) {
  constexpr float C = ATT_SCALE * 1.4426950408889634f;
  float pmax = p0[0];
#pragma unroll
  for (int r = 1; r < 16; ++r) pmax = fmaxf(pmax, p0[r]);
#pragma unroll
  for (int r = 0; r < 16; ++r) pmax = fmaxf(pmax, p1[r]);
  { auto rr = __builtin_amdgcn_permlane32_swap(__float_as_uint(pmax), __float_as_uint(pmax), false, false);
    pmax = fmaxf(__uint_as_float(rr[0]), __uint_as_float(rr[1])); }
  if (__builtin_expect(__all(pmax - m_reg <= THR / ATT_SCALE), 1)) { mn = m_reg; alpha = 1.f; }
  else { mn = fmaxf(m_reg, pmax); alpha = __builtin_amdgcn_exp2f((m_reg - mn) * C); m_reg = mn; }
  float mnC = -mn * C;
#pragma unroll
  for (int r = 0; r < 16; ++r) p0[r] = fmaf(p0[r], C, mnC);
#pragma unroll
  for (int r = 0; r < 16; ++r) p1[r] = fmaf(p1[r], C, mnC);
#pragma unroll
  for (int r = 0; r < 16; ++r) p0[r] = __builtin_amdgcn_exp2f(p0[r]);
}
__device__ __forceinline__ void finishSM(f32x16& p0, f32x16& p1, float alpha, float& l_reg, bf16x8& pa0, bf16x8& pa1, bf16x8& pa2, bf16x8& pa3) {
#pragma unroll
  for (int r = 0; r < 16; ++r) p1[r] = __builtin_amdgcn_exp2f(p1[r]);
  float ps = 0;
#pragma unroll
  for (int r = 0; r < 16; ++r) ps += p0[r];
#pragma unroll
  for (int r = 0; r < 16; ++r) ps += p1[r];
  { auto rr = __builtin_amdgcn_permlane32_swap(__float_as_uint(ps), __float_as_uint(ps), false, false);
    ps = __uint_as_float(rr[0]) + __uint_as_float(rr[1]); }
  l_reg = l_reg * alpha + ps;
#define PK4(P, BASE, OUT) do { unsigned a0 = cvtpk_a(P[BASE + 0], P[BASE + 1]), a1 = cvtpk_a(P[BASE + 2], P[BASE + 3]);   \
    unsigned b0 = cvtpk_a(P[BASE + 4], P[BASE + 5]), b1 = cvtpk_a(P[BASE + 6], P[BASE + 7]);                              \
    auto r0 = __builtin_amdgcn_permlane32_swap(a0, b0, false, false); auto r1 = __builtin_amdgcn_permlane32_swap(a1, b1, false, false); \
    u32x4 w = {r0[0], r1[0], r0[1], r1[1]}; OUT = *reinterpret_cast<bf16x8*>(&w); } while (0)
  PK4(p0, 0, pa0); PK4(p0, 8, pa1); PK4(p1, 0, pa2); PK4(p1, 8, pa3);
#undef PK4
}
__device__ __forceinline__ void qkt(f32x16& p0, f32x16& p1, const char* Ks, const char* Krs, const bf16x8* qr, const char* qpark, int r32, int hi) {
  p0 = f32x16{}; p1 = f32x16{};
  const char* kb = Ks + r32 * KPITCH + hi * 16; const char* rb = Krs + r32 * KRPITCH + hi * 16;
#pragma unroll
  for (int d0 = 0; d0 < 8; ++d0) {
    bf16x8 b0 = *reinterpret_cast<const bf16x8*>(kb + d0 * 32);
    bf16x8 b1 = *reinterpret_cast<const bf16x8*>(kb + 32 * KPITCH + d0 * 32);
    p0 = __builtin_amdgcn_mfma_f32_32x32x16_bf16(b0, qr[d0], p0, 0, 0, 0);
    p1 = __builtin_amdgcn_mfma_f32_32x32x16_bf16(b1, qr[d0], p1, 0, 0, 0); }
#pragma unroll
  for (int d0 = 0; d0 < 4; ++d0) {
    bf16x8 b0 = *reinterpret_cast<const bf16x8*>(rb + d0 * 32);
    bf16x8 b1 = *reinterpret_cast<const bf16x8*>(rb + 32 * KRPITCH + d0 * 32);
    const bf16x8 qf = qr[8 + d0];
    p0 = __builtin_amdgcn_mfma_f32_32x32x16_bf16(b0, qf, p0, 0, 0, 0);
    p1 = __builtin_amdgcn_mfma_f32_32x32x16_bf16(b1, qf, p1, 0, 0, 0); }
}
__device__ __forceinline__ int v_st(int k, int c) { const int kk = (k & ~0xC) | ((k & 4) << 1) | ((k & 8) >> 1); return ((kk >> 3) * 4 + (c >> 5)) * 512 + ((kk & 7) * 32 + (c & 31)) * 2; }
__device__ __forceinline__ int v_rd_base(int lane) { return ((lane & 3) << 3) | (((lane >> 2) & 3) << 6) | (((lane >> 4) & 1) << 5) | (((lane >> 5) & 1) << 8); }
constexpr int v_rd_off(int d0, int ks, int half) { return d0 * 512 + ks * 4096 + half * 2048; }
template <int OFF> __device__ __forceinline__ s16x4 tr_read(int vb) {
  s16x4 r; asm volatile("ds_read_b64_tr_b16 %0, %1 offset:%2" : "=&v"(r) : "v"(vb), "i"(OFF) : "memory"); return r;
}
template <int D0> __device__ __forceinline__ void pv_one(f32x16& od, int vb, bf16x8 pa0, bf16x8 pa1, bf16x8 pa2, bf16x8 pa3) {
  const s16x4 l0 = tr_read<v_rd_off(D0, 0, 0)>(vb), h0 = tr_read<v_rd_off(D0, 0, 1)>(vb), l1 = tr_read<v_rd_off(D0, 1, 0)>(vb), h1 = tr_read<v_rd_off(D0, 1, 1)>(vb);
  const s16x4 l2 = tr_read<v_rd_off(D0, 2, 0)>(vb), h2 = tr_read<v_rd_off(D0, 2, 1)>(vb), l3 = tr_read<v_rd_off(D0, 3, 0)>(vb), h3 = tr_read<v_rd_off(D0, 3, 1)>(vb);
  asm volatile("s_waitcnt lgkmcnt(0)" ::: "memory"); SBAR();
#define PK(L, H) (bf16x8){L[0], L[1], L[2], L[3], H[0], H[1], H[2], H[3]}
  od = __builtin_amdgcn_mfma_f32_32x32x16_bf16(pa0, PK(l0, h0), od, 0, 0, 0);
  od = __builtin_amdgcn_mfma_f32_32x32x16_bf16(pa1, PK(l1, h1), od, 0, 0, 0);
  od = __builtin_amdgcn_mfma_f32_32x32x16_bf16(pa2, PK(l2, h2), od, 0, 0, 0);
  od = __builtin_amdgcn_mfma_f32_32x32x16_bf16(pa3, PK(l3, h3), od, 0, 0, 0);
#undef PK
}
__device__ __forceinline__ void pv_d0(f32x16* o, int vb, bf16x8 pa0, bf16x8 pa1, bf16x8 pa2, bf16x8 pa3) {
  pv_one<0>(o[0], vb, pa0, pa1, pa2, pa3); pv_one<1>(o[1], vb, pa0, pa1, pa2, pa3); pv_one<2>(o[2], vb, pa0, pa1, pa2, pa3); pv_one<3>(o[3], vb, pa0, pa1, pa2, pa3);
}

__device__ __forceinline__ void attn_unit(const bf16_t* __restrict__ Qn, const bf16_t* __restrict__ Qr, const bf16_t* __restrict__ Kh,
                                          const bf16_t* __restrict__ Krh, bf16_t* __restrict__ Ob, int seq, char* lds, const int tid) {
  const int wid = tid >> 6, lane = tid & 63, r32 = lane & 31, hi = lane >> 5;
  char* V_lds = lds + OFF_V; char* K_lds = lds + OFF_K; char* Kr_lds = lds + OFF_KR;
  float* ws = (float*)(lds + OFF_WS) + wid * 64; float* li_l = ws; float* al_l = ws + 32;
  float m_reg = -1e30f, l_reg = 0; f32x16 o[4] = {}; bf16x8 qr[12];
  char* qpark = nullptr;
  { const bf16_t* qn = Qn + (long)(wid * QBLK + r32) * LDQ + hi * 8; const bf16_t* qq = Qr + (long)(wid * QBLK + r32) * LDQ + hi * 8;
#pragma unroll
    for (int d0 = 0; d0 < 8; ++d0) qr[d0] = *reinterpret_cast<const bf16x8*>(qn + d0 * 16);
#pragma unroll
    for (int d0 = 0; d0 < 4; ++d0) qr[8 + d0] = *reinterpret_cast<const bf16x8*>(qq + d0 * 16); }
  const int sr = tid >> 4, sc = (tid & 15) * 8, vst0 = v_st(sr, sc), vst1 = v_st(32 + sr, sc);
  const int krr = tid >> 3, krc = (tid & 7) * 8;
  const int vb0 = (int)(uintptr_t)V_lds + v_rd_base(lane);
  bf16x8 vs0, vs1, ks0, ks1, kr0;
  const unsigned offkv = (unsigned)(sr * LDKV + sc) * 2u, offkr = (unsigned)(krr * LDKR + krc) * 2u;
#define SLOAD(k0) do { const char* kb_ = (const char*)Kh + (size_t)(k0) * (LDKV * 2); const char* kb2_ = kb_ + 32 * LDKV * 2; const char* rb_ = (const char*)Krh + (size_t)(k0) * (LDKR * 2); \
    ks0 = *reinterpret_cast<const bf16x8*>(kb_ + offkv); vs0 = *reinterpret_cast<const bf16x8*>(kb_ + offkv + 2048); \
    ks1 = *reinterpret_cast<const bf16x8*>(kb2_ + offkv); vs1 = *reinterpret_cast<const bf16x8*>(kb2_ + offkv + 2048); \
    kr0 = *reinterpret_cast<const bf16x8*>(rb_ + offkr); } while (0)
#define SWRITE(b) do { *(bf16x8*)(V_lds + (b) * SHM_V + vst0) = vs0; *(bf16x8*)(V_lds + (b) * SHM_V + vst1) = vs1; const int kc = sc * 2; \
    *(bf16x8*)(K_lds + (b) * SHM_K + KSWZ(sr, kc)) = ks0; *(bf16x8*)(K_lds + (b) * SHM_K + KSWZ(32 + sr, kc)) = ks1; \
    *(bf16x8*)(Kr_lds + (b) * SHM_KR + KRSWZ(krr, krc * 2)) = kr0; } while (0)
#define SWAIT() asm volatile("s_waitcnt vmcnt(0)" ::: "memory")
#define RESC(a) do { if (__any((a) < 1.f)) { if (hi == 0) al_l[r32] = (a); asm volatile("s_waitcnt lgkmcnt(0)" ::: "memory"); \
    _Pragma("unroll") for (int d = 0; d < 4; ++d) _Pragma("unroll") for (int r = 0; r < 16; ++r) o[d][r] *= al_l[crow(r, hi)]; } } while (0)
  f32x16 pA0, pA1, pB0, pB1; float mnA, mnB, alA, alB; bf16x8 pa0, pa1, pa2, pa3; const int NT = seq / KVBLK;
  SLOAD(0); SWAIT(); SWRITE(0); __syncthreads();
  qkt(pA0, pA1, K_lds, Kr_lds, qr, qpark, r32, hi); partialSM(pA0, pA1, m_reg, mnA, alA);
  SLOAD(KVBLK);
  SWAIT(); SWRITE(1); __syncthreads();
  for (int j = 1; j + 1 < NT; j += 2) {
    SBAR(); qkt(pB0, pB1, K_lds + SHM_K, Kr_lds + SHM_KR, qr, qpark, r32, hi);
    finishSM(pA0, pA1, alA, l_reg, pa0, pa1, pa2, pa3); SBAR();
    SLOAD((j + 1) * KVBLK); SBAR();
    pv_d0(o, vb0, pa0, pa1, pa2, pa3); partialSM(pB0, pB1, m_reg, mnB, alB);
    __syncthreads(); SWAIT(); SWRITE(0);
    RESC(alB); __syncthreads();
    SBAR(); qkt(pA0, pA1, K_lds, Kr_lds, qr, qpark, r32, hi);
    finishSM(pB0, pB1, alB, l_reg, pa0, pa1, pa2, pa3); SBAR();
    SLOAD((j + 2) * KVBLK); SBAR();
    pv_d0(o, vb0 + SHM_V, pa0, pa1, pa2, pa3); partialSM(pA0, pA1, m_reg, mnA, alA);
    __syncthreads(); SWAIT(); SWRITE(1);
    RESC(alA); __syncthreads();
  }
  SBAR(); qkt(pB0, pB1, K_lds + SHM_K, Kr_lds + SHM_KR, qr, qpark, r32, hi);
  finishSM(pA0, pA1, alA, l_reg, pa0, pa1, pa2, pa3); SBAR();
  pv_d0(o, vb0, pa0, pa1, pa2, pa3); partialSM(pB0, pB1, m_reg, mnB, alB);
  __syncthreads(); RESC(alB);
  finishSM(pB0, pB1, alB, l_reg, pa0, pa1, pa2, pa3); SBAR();
  pv_d0(o, vb0 + SHM_V, pa0, pa1, pa2, pa3);
  if (hi == 0) li_l[r32] = l_reg; asm volatile("s_waitcnt lgkmcnt(0)" ::: "memory");
  float rli[16];
#pragma unroll
  for (int r = 0; r < 16; ++r) rli[r] = __builtin_amdgcn_rcpf(li_l[crow(r, hi)]);
  bf16_t* Ow = Ob + (long)(wid * QBLK) * LDO;
#pragma unroll
  for (int r = 0; r < 16; ++r) { const int orow = crow(r, hi);
#pragma unroll
    for (int d0 = 0; d0 < 4; ++d0) Ow[(long)orow * LDO + d0 * 32 + r32] = f2bf(o[d0][r] * rli[r]); }
  __syncthreads();
#undef SLOAD
#undef SWRITE
#undef SWAIT
#undef RESC
}

constexpr int K8P = 144, KR8P = 80, SHM_K8 = KVBLK * K8P, SHM_KR8 = KVBLK * KR8P;
__device__ __forceinline__ v8i ld32(const char* p) { const u32x4 a = *reinterpret_cast<const u32x4*>(p), b = *reinterpret_cast<const u32x4*>(p + 16); return (v8i){(int)a.x, (int)a.y, (int)a.z, (int)a.w, (int)b.x, (int)b.y, (int)b.z, (int)b.w}; }
constexpr int V8P = 80, SHM_V8 = 128 * V8P;
constexpr int O9_V = 0, O9_K = 2 * SHM_V8, O9_KR = O9_K + 2 * SHM_K8, O9_WS = O9_KR + 2 * SHM_KR8, SHM_ATTN9 = O9_WS + NW * 64 * 4;
constexpr float THR9 = 2.f, THRL9 = THR9 * 1.4426950408889634f;
__device__ __forceinline__ void qkt9(f32x16& p0, f32x16& p1, const char* Ks, const char* Krs, const v8i* qf, const f32x16& negm, int r32, int hi) {
  const char* kb = Ks + r32 * K8P + hi * 32; const char* rb = Krs + r32 * KR8P + hi * 32;
  { const v8i a0 = ld32(kb), a1 = ld32(kb + 32 * K8P);
    p0 = __builtin_amdgcn_mfma_scale_f32_32x32x64_f8f6f4(a0, qf[0], negm, 0, 0, 0, 0x7f7f7f7f, 0, 0x7b7b7b7b);
    p1 = __builtin_amdgcn_mfma_scale_f32_32x32x64_f8f6f4(a1, qf[0], negm, 0, 0, 0, 0x7f7f7f7f, 0, 0x7b7b7b7b); }
  { const v8i a0 = ld32(kb + 64), a1 = ld32(kb + 32 * K8P + 64);
    p0 = __builtin_amdgcn_mfma_scale_f32_32x32x64_f8f6f4(a0, qf[1], p0, 0, 0, 0, 0x7f7f7f7f, 0, 0x7b7b7b7b);
    p1 = __builtin_amdgcn_mfma_scale_f32_32x32x64_f8f6f4(a1, qf[1], p1, 0, 0, 0, 0x7f7f7f7f, 0, 0x7b7b7b7b); }
  { const v8i a0 = ld32(rb), a1 = ld32(rb + 32 * KR8P);
    p0 = __builtin_amdgcn_mfma_scale_f32_32x32x64_f8f6f4(a0, qf[2], p0, 0, 0, 0, 0x7f7f7f7f, 0, 0x7b7b7b7b);
    p1 = __builtin_amdgcn_mfma_scale_f32_32x32x64_f8f6f4(a1, qf[2], p1, 0, 0, 0, 0x7f7f7f7f, 0, 0x7b7b7b7b); }
}
template <bool FIRST> __device__ __forceinline__ void partialSM9n(f32x16& p0, f32x16& p1, f32x16& negm, float& alpha) {
  float pmax = p0[0];
#pragma unroll
  for (int r = 1; r < 16; ++r) pmax = fmaxf(pmax, p0[r]);
#pragma unroll
  for (int r = 0; r < 16; ++r) pmax = fmaxf(pmax, p1[r]);
  { auto rr = __builtin_amdgcn_permlane32_swap(__float_as_uint(pmax), __float_as_uint(pmax), false, false);
    pmax = fmaxf(__uint_as_float(rr[0]), __uint_as_float(rr[1])); }
  const float ex = pmax - 4.f;
  if (!FIRST && __builtin_expect(__all(ex <= THRL9), 1)) { alpha = 1.f; }
  else { const float d = FIRST ? ex : fmaxf(ex, 0.f); alpha = FIRST ? 1.f : __builtin_amdgcn_exp2f(-d);
#pragma unroll
    for (int r = 0; r < 16; ++r) { p0[r] -= d; p1[r] -= d; }
#pragma unroll
    for (int r = 0; r < 16; ++r) negm[r] -= d;
    asm volatile("" : "+v"(negm)); }
#pragma unroll
  for (int r = 0; r < 16; ++r) p0[r] = __builtin_amdgcn_exp2f(p0[r]);
}
__device__ __forceinline__ void partialSM9(f32x16& p0, f32x16& p1, float& m_reg, float& mn, float& alpha) {
  constexpr float C = ATT_SCALE * 1.4426950408889634f;
  float pmax = p0[0];
#pragma unroll
  for (int r = 1; r < 16; ++r) pmax = fmaxf(pmax, p0[r]);
#pragma unroll
  for (int r = 0; r < 16; ++r) pmax = fmaxf(pmax, p1[r]);
  { auto rr = __builtin_amdgcn_permlane32_swap(__float_as_uint(pmax), __float_as_uint(pmax), false, false);
    pmax = fmaxf(__uint_as_float(rr[0]), __uint_as_float(rr[1])); }
  if (__builtin_expect(__all(pmax - m_reg <= THR9 / ATT_SCALE), 1)) { mn = m_reg; alpha = 1.f; }
  else { mn = fmaxf(m_reg, pmax); alpha = __builtin_amdgcn_exp2f((m_reg - mn) * C); m_reg = mn; }
  float mnC = 4.f - mn * C;
#pragma unroll
  for (int r = 0; r < 16; ++r) p0[r] = fmaf(p0[r], C, mnC);
#pragma unroll
  for (int r = 0; r < 16; ++r) p1[r] = fmaf(p1[r], C, mnC);
#pragma unroll
  for (int r = 0; r < 16; ++r) p0[r] = __builtin_amdgcn_exp2f(p0[r]);
}
__device__ __forceinline__ void finishSM9(f32x16& p0, f32x16& p1, float alpha, float& l_reg, v8i& pf) {
#pragma unroll
  for (int r = 0; r < 16; ++r) p1[r] = __builtin_amdgcn_exp2f(p1[r]);
  float ps = 0;
#pragma unroll
  for (int r = 0; r < 16; ++r) ps += p0[r];
#pragma unroll
  for (int r = 0; r < 16; ++r) ps += p1[r];
  { auto rr = __builtin_amdgcn_permlane32_swap(__float_as_uint(ps), __float_as_uint(ps), false, false);
    ps = __uint_as_float(rr[0]) + __uint_as_float(rr[1]); }
  l_reg = l_reg * alpha + ps;
  unsigned a[4], b[4];
#pragma unroll
  for (int i = 0; i < 4; ++i) { a[i] = pk4_fp8(p0[4 * i], p0[4 * i + 1], p0[4 * i + 2], p0[4 * i + 3]); b[i] = pk4_fp8(p1[4 * i], p1[4 * i + 1], p1[4 * i + 2], p1[4 * i + 3]); }
#pragma unroll
  for (int i = 0; i < 4; ++i) { auto r = __builtin_amdgcn_permlane32_swap(a[i], b[i], false, false); pf[i] = (int)r[0]; pf[4 + i] = (int)r[1]; }
}
__device__ __forceinline__ void pv9(f32x16* o, const char* Vs, const v8i pf, int r32, int hi) {
  const char* vb = Vs + r32 * V8P + hi * 32;
#pragma unroll
  for (int d0 = 0; d0 < 4; ++d0) { const v8i vf = ld32(vb + d0 * 32 * V8P);
    o[d0] = __builtin_amdgcn_mfma_scale_f32_32x32x64_f8f6f4(pf, vf, o[d0], 0, 0, 0, 0x7f7f7f7f, 0, 0x7f7f7f7f); }
}
__device__ __forceinline__ void attn_unit9(const unsigned char* __restrict__ Q8n, const unsigned char* __restrict__ Q8r, const unsigned char* __restrict__ K8h,
                                           const unsigned char* __restrict__ Kr8, const unsigned char* __restrict__ VTh, bf16_t* __restrict__ Ob, int seq, char* lds, const int tid) {
  const int wid = tid >> 6, lane = tid & 63, r32 = lane & 31, hi = lane >> 5;
  char* V_lds = lds + O9_V; char* K_lds = lds + O9_K; char* Kr_lds = lds + O9_KR;
  float* ws = (float*)(lds + O9_WS) + wid * 64; float* li_l = ws; float* al_l = ws + 32;
  float l_reg = 0; f32x16 o[4] = {}; v8i qf[3]; f32x16 negm;
#pragma unroll
  for (int r = 0; r < 16; ++r) negm[r] = 4.f;
  { const unsigned char* qn = Q8n + (long)(wid * QBLK + r32) * LDQ + hi * 32; const unsigned char* qq = Q8r + (long)(wid * QBLK + r32) * LDQ + hi * 32;
    qf[0] = ld32((const char*)qn); qf[1] = ld32((const char*)qn + 64); qf[2] = ld32((const char*)qq); }
  const int k8r = tid >> 3, k8c = (tid & 7) * 16;
  const int r8r = (tid & 255) >> 2, r8c = (tid & 3) * 16;
  const int v8d = tid >> 2, v8c = tid & 3;
  const int v8w = v8d * V8P + (v8c >> 1) * 32 + (v8c & 1) * 8;
  u32x4 v8v, k8v, r8v;
  const unsigned offv8 = (unsigned)(v8d * SEQ + v8c * 16), offk8 = (unsigned)(k8r * 1024 + k8c), offr8 = (unsigned)(r8r * 64 + r8c);
#define SLOAD(k0) do { v8v = *reinterpret_cast<const u32x4*>((const char*)VTh + (size_t)(k0) + offv8); \
    k8v = *reinterpret_cast<const u32x4*>((const char*)K8h + (size_t)(k0) * 1024 + offk8); \
    if (tid < 256) r8v = *reinterpret_cast<const u32x4*>((const char*)Kr8 + (size_t)(k0) * 64 + offr8); } while (0)
#define SWRITE(b) do { char* vp_ = V_lds + (b) * SHM_V8 + v8w; *(unsigned*)(vp_) = v8v.x; *(unsigned*)(vp_ + 16) = v8v.y; *(unsigned*)(vp_ + 4) = v8v.z; *(unsigned*)(vp_ + 20) = v8v.w; \
    *(u32x4*)(K_lds + (b) * SHM_K8 + k8r * K8P + k8c) = k8v; if (tid < 256) *(u32x4*)(Kr_lds + (b) * SHM_KR8 + r8r * KR8P + r8c) = r8v; } while (0)
#define SWAIT() asm volatile("s_waitcnt vmcnt(0)" ::: "memory")
#define RESC(a) do { if (__any((a) < 1.f)) { if (hi == 0) al_l[r32] = (a); asm volatile("s_waitcnt lgkmcnt(0)" ::: "memory"); \
    _Pragma("unroll") for (int d = 0; d < 4; ++d) _Pragma("unroll") for (int r = 0; r < 16; ++r) o[d][r] *= al_l[crow(r, hi)]; } } while (0)
  f32x16 pA0, pA1, pB0, pB1; float alA, alB; v8i pf; const int NT = seq / KVBLK;
  SLOAD(0); SWAIT(); SWRITE(0); __syncthreads();
  qkt9(pA0, pA1, K_lds, Kr_lds, qf, negm, r32, hi); partialSM9n<true>(pA0, pA1, negm, alA);
  SLOAD(KVBLK);
  SWAIT(); SWRITE(1); __syncthreads();
  for (int j = 1; j + 1 < NT; j += 2) {
    SBAR(); qkt9(pB0, pB1, K_lds + SHM_K8, Kr_lds + SHM_KR8, qf, negm, r32, hi);
    finishSM9(pA0, pA1, alA, l_reg, pf); SBAR();
    SLOAD((j + 1) * KVBLK); SBAR();
    pv9(o, V_lds, pf, r32, hi); partialSM9n<false>(pB0, pB1, negm, alB);
    __syncthreads(); SWAIT(); SWRITE(0);
    RESC(alB); __syncthreads();
    SBAR(); qkt9(pA0, pA1, K_lds, Kr_lds, qf, negm, r32, hi);
    finishSM9(pB0, pB1, alB, l_reg, pf); SBAR();
    SLOAD((j + 2) * KVBLK); SBAR();
    pv9(o, V_lds + SHM_V8, pf, r32, hi); partialSM9n<false>(pA0, pA1, negm, alA);
    __syncthreads(); SWAIT(); SWRITE(1);
    RESC(alA); __syncthreads();
  }
  SBAR(); qkt9(pB0, pB1, K_lds + SHM_K8, Kr_lds + SHM_KR8, qf, negm, r32, hi);
  finishSM9(pA0, pA1, alA, l_reg, pf); SBAR();
  pv9(o, V_lds, pf, r32, hi); partialSM9n<false>(pB0, pB1, negm, alB);
  __syncthreads(); RESC(alB);
  finishSM9(pB0, pB1, alB, l_reg, pf); SBAR();
  pv9(o, V_lds + SHM_V8, pf, r32, hi);
  if (hi == 0) li_l[r32] = l_reg; asm volatile("s_waitcnt lgkmcnt(0)" ::: "memory");
  float rli[16];
#pragma unroll
  for (int r = 0; r < 16; ++r) rli[r] = __builtin_amdgcn_rcpf(li_l[crow(r, hi)]);
  bf16_t* Ow = Ob + (long)(wid * QBLK) * LDO;
#pragma unroll
  for (int r = 0; r < 16; ++r) { const int orow = crow(r, hi);
#pragma unroll
    for (int d0 = 0; d0 < 4; ++d0) Ow[(long)orow * LDO + d0 * 32 + r32] = f2bf(o[d0][r] * rli[r]); }
  __syncthreads();
#undef SLOAD
#undef SWRITE
#undef SWAIT
#undef RESC
}
#undef SBAR
}

constexpr int NWAVES = 8;
constexpr int N_LAUNCHES = MK_N_LAUNCHES;
constexpr int N_PHASES = 15;
static_assert(N_LAUNCHES == 1 || N_LAUNCHES == N_PHASES, "MK_N_LAUNCHES is 1 or 15");

constexpr size_t MiB = 1u << 20;
constexpr size_t WS_CTL = 0, CTL_ZERO_BYTES = 32768;
constexpr size_t WS_ROPE = 1 * MiB;
constexpr size_t WS_RSTD0 = 3 * MiB, WS_RSTDQ = WS_RSTD0 + 65536, WS_RSTDKV = WS_RSTDQ + 65536, WS_RSTDM = WS_RSTDKV + 65536;
constexpr size_t WS_SSQ = 4 * MiB;
constexpr size_t WS_AFF = 5 * MiB;
constexpr size_t WS_INV = 6 * MiB;
constexpr size_t WS_IDX = 7 * MiB, WS_GATE = WS_IDX + 131072;
constexpr size_t WS_MEMB = 8 * MiB;
constexpr size_t WS_MKV = 9 * MiB;
constexpr size_t WS_QKT = 11 * MiB, WS_VWT = 15 * MiB;
constexpr size_t WS_WIN = 19 * MiB;
constexpr size_t WS_WCO = 30 * MiB, WS_WMO = 32 * MiB, WS_WMIX = 34 * MiB, WS_WUQ = 36 * MiB, WS_WUKV = 37 * MiB, WS_WMQH = 38 * MiB, WS_WOHT = 40 * MiB, WS_WMKV = 42 * MiB;
constexpr size_t WS_XGG = 48 * MiB, WS_QB = 48 * MiB, WS_MIXA = 96 * MiB, WS_WGU = 48 * MiB, WS_WD = 112 * MiB, WS_Y = 48 * MiB;
constexpr size_t WS_XB = 144 * MiB, WS_ACONV = 144 * MiB, WS_OB = 144 * MiB, WS_X1B = 144 * MiB, WS_XG = 144 * MiB;
constexpr size_t WS_SIGA = 176 * MiB, WS_MIXED = 176 * MiB, WS_PM = 176 * MiB;
constexpr size_t WS_SIGB = 208 * MiB, WS_H3 = 208 * MiB, WS_H = 144 * MiB;
constexpr size_t WS_CQ = 240 * MiB, WS_CKV = 248 * MiB, WS_KR = 252 * MiB, WS_KROPE = 254 * MiB;
constexpr size_t WS_KN8 = 128 * MiB;
constexpr size_t WS_X2B = 256 * MiB;
constexpr size_t WS_END = RESID_BF16 ? 288 * MiB : 256 * MiB;
constexpr int CW_TMO = 0, CW_BAR = 4096;

constexpr int RING_BYTES = 131072, EPI_OFF = 131072, EPI_BYTES = 8192, LDSCTL_OFF = 140288, MISC_OFF = LDSCTL_OFF + 320;
constexpr int LDS_BYTES = 148480;
static_assert(2 * 16 * 1028 * 4 + 8192 <= LDSCTL_OFF && EPI_OFF + EPI_BYTES <= LDSCTL_OFF, "LDS map (router, epilogue scratch)");
static_assert(MISC_OFF + 128 <= LDS_BYTES && att::SHM_ATTN <= RING_BYTES, "LDS map");

typedef GAS unsigned gu32;
#define RLX_AGENT __ATOMIC_RELAXED, __HIP_MEMORY_SCOPE_AGENT

#define XB_TMO      128
#define XB_XCNT(j)  (256  + 64 * (j))
#define XB_XSUB(j)  (1280 + 64 * (j))
#define XB_XGEN(j)  (2304 + 64 * (j))
#define XB_TOP      3328
#define XB_TOPGEN   3392
#define XCD_BAR_WORDS 3456
#define XB_SPIN_CAP (1u << 18)
__device__ __forceinline__ unsigned xb_ld(unsigned* p)              { return __hip_atomic_load(p, __ATOMIC_RELAXED, __HIP_MEMORY_SCOPE_AGENT); }
__device__ __forceinline__ unsigned xb_add(unsigned* p, unsigned v) { return __hip_atomic_fetch_add(p, v, __ATOMIC_RELAXED, __HIP_MEMORY_SCOPE_AGENT); }
__device__ __forceinline__ unsigned xb_xcc_id() { return (unsigned)__builtin_amdgcn_s_getreg((3 << 11) | 20) & 0xFu; }
#define XB_SPIN(cond, bar) do { unsigned _sp = 0; while (cond) { __builtin_amdgcn_s_sleep(1); \
    if ((++_sp & 255u) == 0u) { if (xb_ld(&(bar)[XB_TMO])) break; if (_sp > XB_SPIN_CAP) { atomicAdd(&(bar)[XB_TMO], 1u); break; } } } } while (0)
struct XcdBarrier { unsigned* bar; unsigned x; volatile LAS unsigned* st; };
__device__ __forceinline__ XcdBarrier xcd_barrier_post(unsigned* bar, volatile LAS unsigned* st, const bool t0) {
    XcdBarrier b; b.bar = bar; b.x = xb_xcc_id(); b.st = st;
    if (t0) (void)xb_add(&bar[XB_XCNT(b.x)], 1u);
    return b;
}
__device__ __forceinline__ void xcd_barrier_complete(unsigned* bar, unsigned x, unsigned& nloc, unsigned& nx) {
    const unsigned G = gridDim.x * gridDim.y * gridDim.z;
    unsigned sum, cnt, mine, sp = 0u;
    for (;;) {
        sum = 0u; cnt = 0u; mine = 0u;
#pragma unroll
        for (unsigned j = 0; j < 16; ++j) { const unsigned c = xb_ld(&bar[XB_XCNT(j)]); sum += c; cnt += (c > 0u) ? 1u : 0u; mine = (j == x) ? c : mine; }
        if (sum == G) break;
        __builtin_amdgcn_s_sleep(1);
        if ((++sp & 255u) == 0u) { if (xb_ld(&bar[XB_TMO])) break; if (sp > XB_SPIN_CAP) { atomicAdd(&bar[XB_TMO], 1u); break; } }
    }
    nloc = mine > 0u ? mine : 1u; nx = cnt > 0u ? cnt : 1u;
}
__device__ __forceinline__ void xcd_barrier(const XcdBarrier& b, const bool t0) {
    asm volatile("s_waitcnt vmcnt(0)" ::: "memory");
    __syncthreads();
    if (t0) {
        unsigned* bar = b.bar;
        __builtin_amdgcn_s_waitcnt(0);
        unsigned nloc = b.st[0], nx = b.st[1];
        if (nloc == 0u) { xcd_barrier_complete(bar, b.x, nloc, nx); b.st[0] = nloc; b.st[1] = nx; }
        const unsigned old = xb_add(&bar[XB_XSUB(b.x)], 1u);
        const unsigned gen = old / nloc;
        if (old + 1u == (gen + 1u) * nloc) {
            __builtin_amdgcn_fence(__ATOMIC_RELEASE, "agent");
            asm volatile("s_waitcnt vmcnt(0)" ::: "memory");
            const unsigned og = xb_add(&bar[XB_TOP], 1u);
            const unsigned tg = og / nx;
            __builtin_amdgcn_fence(__ATOMIC_ACQUIRE, "agent");
            if (og + 1u == (tg + 1u) * nx) (void)__hip_atomic_fetch_add(&bar[XB_TOPGEN], 1u, __ATOMIC_RELAXED, __HIP_MEMORY_SCOPE_AGENT);
            else XB_SPIN(xb_ld(&bar[XB_TOPGEN]) == tg, bar);
            (void)__hip_atomic_fetch_add(&bar[XB_XGEN(b.x)], 1u, __ATOMIC_RELAXED, __HIP_MEMORY_SCOPE_AGENT);
            asm volatile("s_waitcnt vmcnt(0)" ::: "memory");
        } else {
            __builtin_amdgcn_fence(__ATOMIC_ACQUIRE, "agent");
            XB_SPIN(xb_ld(&bar[XB_XGEN(b.x)]) == gen, bar);
            asm volatile("s_waitcnt vmcnt(0)" ::: "memory");
        }
    }
    __syncthreads();
}

struct Args {
    const float* in[25];
    float* out; unsigned char* ws;
    int ph_lo, ph_hi;
};
enum { I_X = 0, I_MEM, I_NORM_MIX_G, I_W_IN, I_CONV_W, I_CONV_B, I_W_CONV_OUT, I_Q_NORM_G, I_W_UQ, I_KV_NORM_G, I_W_UKV, I_W_MLA_OUT, I_B_GATE, I_W_MIX_OUT,
       I_NORM_MEM_G, I_NORM_MEMKV_G, I_W_MEM_Q, I_W_MEM_KV, I_W_MEM_OUT, I_NORM_MOE_G, I_W_ROUTER, I_W_EXP_GATE, I_W_EXP_UP, I_W_EXP_DOWN, I_NORM_FINAL_G };

constexpr int TP_PITCH = 65, TP_BYTES = 64 * TP_PITCH * 4;
template <class SrcF, class DstF>
__device__ __forceinline__ void transpose_item(SrcF srcp, DstF dstp, int ld, const float* gain, int k0, LAS float* scr, int lane) {
    const int n4 = (lane & 15) * 4, kr = lane >> 4;
    const float* sp = srcp(n4);
    f32x4 v[16];
#pragma unroll
    for (int i = 0; i < 16; ++i) v[i] = sp ? *(const f32x4*)(sp + (size_t)(k0 + 4 * i + kr) * ld) : (f32x4){0.f, 0.f, 0.f, 0.f};
    if (gain) {
#pragma unroll
        for (int i = 0; i < 16; ++i) v[i] = v[i] * gain[k0 + 4 * i + kr]; }
#pragma unroll
    for (int i = 0; i < 16; ++i)
#pragma unroll
        for (int e = 0; e < 4; ++e) scr[(n4 + e) * TP_PITCH + 4 * i + kr] = v[i][e];
    asm volatile("s_waitcnt lgkmcnt(0)" ::: "memory");
    const int c = lane & 7;
#pragma unroll
    for (int j = 0; j < 8; ++j) { const int n = (lane >> 3) + 8 * j; const LAS float* s = scr + n * TP_PITCH + 8 * c;
        u32x4 o; o.x = cvtpk(s[0], s[1]); o.y = cvtpk(s[2], s[3]); o.z = cvtpk(s[4], s[5]); o.w = cvtpk(s[6], s[7]);
        *(u32x4*)(dstp(n) + k0 + 8 * c) = o; }
    asm volatile("s_waitcnt lgkmcnt(0)" ::: "memory");
}
template <class MapF>
__device__ __forceinline__ void transpose_matrix(MapF map, bf16_t* dst, int NDST, int K, int ld, const float* gain, LAS float* scr, int lane, int gw, int NGW, int& itbase) {
    const int nkb = K / 64, nitems = (NDST / 64) * nkb;
    int first = (gw - (itbase % NGW) + NGW) % NGW;
    for (int it = first; it < nitems; it += NGW) { const int nb = it / nkb, kb = it % nkb, n0 = nb * 64;
        transpose_item([&](int n) { return map(n0 + n); }, [&](int n) { return dst + (size_t)(n0 + n) * K; }, ld, gain, kb * 64, scr, lane); }
    itbase += nitems;
}

__device__ __forceinline__ int rope_dim(int p) { return (p >> 3) * 4 + (p & 3) + 32 * ((p >> 2) & 1); }

template <int PHM> __global__ void __launch_bounds__(NWAVES * 64, 2) fwd_kernel(Args args) {
    extern __shared__ __attribute__((aligned(16))) unsigned char lds_raw[];
    LAS unsigned char* lds = (LAS unsigned char*)lds_raw;
    volatile LAS unsigned* MISC = (volatile LAS unsigned*)(lds + MISC_OFF);
    int tid = threadIdx.x, lane = tid & 63; const int wave = __builtin_amdgcn_readfirstlane(tid >> 6);
#define PHASE_BEGIN() do { lane = (int)__builtin_amdgcn_mbcnt_hi(~0u, __builtin_amdgcn_mbcnt_lo(~0u, 0u)); asm volatile("" : "+v"(lane)); tid = wave * 64 + lane; } while (0)
    const int G = gridDim.x; const int bx = blockIdx.x; const int vcu = (G % 8 == 0) ? (bx % 8) * (G / 8) + bx / 8 : bx;
    const int gw = vcu * NWAVES + wave, NGW = G * NWAVES;
    unsigned char* ws = args.ws;
    gu32* ctl = (gu32*)(ws + WS_CTL);
    for (int u = tid; u < (LDS_BYTES - LDSCTL_OFF) / 4; u += NWAVES * 64) ((LAS unsigned*)(lds + LDSCTL_OFF))[u] = 0u;
    __syncthreads();
    XcdBarrier bar; bar.bar = (unsigned*)(ctl + CW_BAR); bar.x = 0; bar.st = nullptr;
    if (N_LAUNCHES == 1) bar = xcd_barrier_post((unsigned*)(ctl + CW_BAR), MISC + 8, tid == 0);
#define GRID_BAR() do { if (N_LAUNCHES == 1) xcd_barrier(bar, wave == 0 && __builtin_amdgcn_mbcnt_hi(~0u, __builtin_amdgcn_mbcnt_lo(~0u, 0u)) == 0u); } while (0)
    const int lo = args.ph_lo, hi = args.ph_hi;
#define IN(k) (((PHM >> (k)) & 1) && lo <= (k) && (k) < hi)
#define SEAM(k) do { if (IN(k) && IN((k) + 1)) GRID_BAR(); } while (0)

    const float* x = args.in[I_X]; float* out = args.out;
#define rope ((f32x2*)(ws + WS_ROPE))
#define rstd0 ((float*)(ws + WS_RSTD0))
#define rstdq ((float*)(ws + WS_RSTDQ))
#define rstdkv ((float*)(ws + WS_RSTDKV))
#define rstdm ((float*)(ws + WS_RSTDM))
#define ssq ((float*)(ws + WS_SSQ))
#define aff ((float*)(ws + WS_AFF))
#define inv ((int*)(ws + WS_INV))
#define idx ((int*)(ws + WS_IDX))
#define gate ((float*)(ws + WS_GATE))
#define memb ((bf16_t*)(ws + WS_MEMB))
#define MKV ((bf16_t*)(ws + WS_MKV))
#define QKT ((bf16_t*)(ws + WS_QKT))
#define VWT ((bf16_t*)(ws + WS_VWT))
#define Win_t ((bf16_t*)(ws + WS_WIN))
#define Wco_t ((bf16_t*)(ws + WS_WCO))
#define Wmo_t ((bf16_t*)(ws + WS_WMO))
#define Wmix_t ((bf16_t*)(ws + WS_WMIX))
#define Wuq_t ((bf16_t*)(ws + WS_WUQ))
#define Wukv_t ((bf16_t*)(ws + WS_WUKV))
#define Wmqh ((bf16_t*)(ws + WS_WMQH))
#define Woht ((bf16_t*)(ws + WS_WOHT))
#define Wmkv_t ((bf16_t*)(ws + WS_WMKV))
#define XGG ((bf16_t*)(ws + WS_XGG))
#define QB ((bf16_t*)(ws + WS_QB))
#define MIXA ((bf16_t*)(ws + WS_MIXA))
#define Wgu_t ((bf16_t*)(ws + WS_WGU))
#define Wd_t ((bf16_t*)(ws + WS_WD))
#define Y ((bf16_t*)(ws + WS_Y))
#define XB ((bf16_t*)(ws + WS_XB))
#define KN8 ((unsigned char*)(ws + WS_KN8))
#define VT8 ((unsigned char*)out)
#define Q8 ((unsigned char*)(ws + WS_QB))
#define KR8 ((unsigned char*)(ws + WS_KROPE))
#define X2B ((bf16_t*)(ws + WS_X2B))
#define ACONV ((bf16_t*)(ws + WS_ACONV))
#define OB ((bf16_t*)(ws + WS_OB))
#define X1B ((bf16_t*)(ws + WS_X1B))
#define XG ((bf16_t*)(ws + WS_XG))
#define SIGA ((bf16_t*)(ws + WS_SIGA))
#define MIXED ((bf16_t*)(ws + WS_MIXED))
#define PM ((bf16_t*)(ws + WS_PM))
#define SIGB ((bf16_t*)(ws + WS_SIGB))
#define H3 ((bf16_t*)(ws + WS_H3))
#define HB ((bf16_t*)(ws + WS_H))
#define CQ ((bf16_t*)(ws + WS_CQ))
#define CKV ((bf16_t*)(ws + WS_CKV))
#define KR ((bf16_t*)(ws + WS_KR))
#define KROPE ((bf16_t*)(ws + WS_KROPE))
#define KVB ((bf16_t*)out)
    LAS float* scr = (LAS float*)(lds + wave * TP_BYTES);

    if (IN(0)) { PHASE_BEGIN();
        int itb = 0;
        { const float* W = args.in[I_W_IN]; const float* gn = args.in[I_NORM_MIX_G];
          transpose_matrix([&](int n) -> const float* { if (n < 2048) { const int t = n >> 8, half = (n >> 7) & 1, c = n & 127; return W + (half ? 2048 : 0) + 128 * t + c; }
                                                         if (n < 3072) return W + 1024 + (n - 2048); if (n < 3520) return W + n; if (n < 3584) return nullptr; return W + (n - 64); },
                           Win_t, NU, 1024, 5568, gn, scr, lane, gw, NGW, itb); }
        { const float* W = args.in[I_W_CONV_OUT]; transpose_matrix([&](int n) -> const float* { return W + n; }, Wco_t, 1024, 1024, 1024, nullptr, scr, lane, gw, NGW, itb); }
        { const float* W = args.in[I_W_MLA_OUT]; transpose_matrix([&](int n) -> const float* { return W + n; }, Wmo_t, 1024, 1024, 1024, nullptr, scr, lane, gw, NGW, itb); }
        { const float* W = args.in[I_W_MIX_OUT]; transpose_matrix([&](int n) -> const float* { return W + n; }, Wmix_t, 1024, 1024, 1024, nullptr, scr, lane, gw, NGW, itb); }
        { const float* W = args.in[I_W_UQ]; const float* gn = args.in[I_Q_NORM_G];
          transpose_matrix([&](int n) -> const float* { if (n < 1024) return W + (n >> 7) * 192 + (n & 127); const int r = n - 1024; return W + (r >> 6) * 192 + 128 + rope_dim(r & 63); },
                           Wuq_t, 1536, 256, 1536, gn, scr, lane, gw, NGW, itb); }
        { const float* W = args.in[I_W_UKV]; const float* gn = args.in[I_KV_NORM_G];
          transpose_matrix([&](int n) -> const float* { if (n < 1024) return W + (n >> 7) * 256 + (n & 127); const int r = n - 1024; return W + (r >> 7) * 256 + 128 + (r & 127); },
                           Wukv_t, 2048, 128, 2048, gn, scr, lane, gw, NGW, itb); }
        { const float* W = args.in[I_W_MEM_KV]; const float* gn = args.in[I_NORM_MEMKV_G];
          transpose_matrix([&](int n) -> const float* { return W + n; }, Wmkv_t, 2048, 1024, 2048, gn, scr, lane, gw, NGW, itb); }
        for (int h = 0; h < 4; ++h) { const float* W = args.in[I_W_MEM_OUT] + (size_t)h * 256 * 1024;
          transpose_matrix([&](int n) -> const float* { return W + n; }, Woht + (size_t)h * 1024 * 256, 1024, 256, 1024, nullptr, scr, lane, gw, NGW, itb); }
        { const float* W = args.in[I_W_MEM_Q]; const float* gn = args.in[I_NORM_MEM_G];
          for (int c = gw * 64 + lane; c < 1024 * 1024 / 8; c += NGW * 64) { const int e0 = c * 8, h = e0 >> 18, d = (e0 >> 8) & 1023, j = e0 & 255; const float g = gn[d];
              const float* s = W + (size_t)d * 1024 + h * 256 + j; const f32x4 a = *(const f32x4*)s, b = *(const f32x4*)(s + 4);
              const float o[8] = {a[0] * g, a[1] * g, a[2] * g, a[3] * g, b[0] * g, b[1] * g, b[2] * g, b[3] * g}; *(u32x4*)(Wmqh + e0) = pack8(o); } }
        for (int r = gw; r < MT + NB * MEM_LEN; r += NGW) { const bool isx = r < MT; const int rr = isx ? r : r - MT;
            const float* src = (isx ? x : args.in[I_MEM]) + (size_t)rr * 1024; bf16_t* dst = (isx ? XB : memb) + (size_t)rr * 1024; float s = 0.f;
#pragma unroll
            for (int j = 0; j < 4; ++j) { const f32x4 v = *(const f32x4*)(src + (lane + 64 * j) * 4); s += (v[0] * v[0] + v[1] * v[1]) + (v[2] * v[2] + v[3] * v[3]);
                u32x2 w; w.x = cvtpk(v[0], v[1]); w.y = cvtpk(v[2], v[3]); *(u32x2*)(dst + (lane + 64 * j) * 4) = w; }
            s = wave_sum(s); if (lane == 0) (isx ? rstd0 : rstdm)[rr] = 1.f / sqrtf(s * (1.f / 1024.f) + EPS); }
        for (int i = gw * 64 + lane; i < SEQ * 32; i += NGW * 64) { const int s = i >> 5, j = i & 31; const float invf = 1.0f / powf(10000.0f, (float)(2 * j) / 64.0f); const float ang = (float)s * invf;
            rope[i] = (f32x2){cosf(ang), sinf(ang)}; }
    }
    SEAM(0);

    if (IN(1)) { PHASE_BEGIN();
        { Gemm g = mkgemm(XB, Win_t, MT, NU, 1024, 1024, 1024); StaticOrder S; S.init(MT, NU, G, bx);
          EpiU E{{rstd0, XGG, CQ, CKV, KR, SIGA, SIGB, args.in[I_B_GATE]}}; pg8::gemm_phase(lds, g, S, E, tid); }
        { Gemm g = mkgemm(memb, Wmkv_t, NB * MEM_LEN, 2048, 1024, 1024, 1024); StaticOrder S; S.init(NB * MEM_LEN, 2048, G, (bx + G / 2) % G);
          pg8::EpiChunk<FMemKV> E{{rstdm, MKV}}; pg8::gemm_phase(lds, g, S, E, tid); }
    }
    SEAM(1);

    if (IN(2)) { PHASE_BEGIN();
        const float* cw = args.in[I_CONV_W]; const float* cb = args.in[I_CONV_B];
        for (int blk = gw; blk < MT / 4; blk += NGW) { const int r0 = blk * 4, s0 = r0 & (SEQ - 1);
            u32x4 pxr[6][2], gbr[4][2]; u32x2 cqr[4]; unsigned ckr[4]; bf16_t k1[4], k2[4];
            const u32x4 z = {0u, 0u, 0u, 0u};
#pragma unroll
            for (int i = 0; i < 6; ++i) { const int rr = r0 - 1 + i; const bool ok = (i > 0 || s0 > 0) && (i < 5 || s0 + 4 < SEQ);
#pragma unroll
                for (int j = 0; j < 2; ++j) pxr[i][j] = ok ? *(const u32x4*)(XGG + (size_t)rr * 2048 + lane * 8 + 512 * j) : z; }
#pragma unroll
            for (int i = 0; i < 4; ++i) { const int rr = r0 + i;
#pragma unroll
                for (int j = 0; j < 2; ++j) gbr[i][j] = *(const u32x4*)(XGG + (size_t)rr * 2048 + 1024 + lane * 8 + 512 * j);
                cqr[i] = *(const u32x2*)(CQ + (size_t)rr * 256 + lane * 4); ckr[i] = *(const unsigned*)(CKV + (size_t)rr * 128 + lane * 2);
                { const int j_ = (lane >> 3) * 4 + (lane & 3); k1[i] = KR[(size_t)rr * 64 + j_]; k2[i] = KR[(size_t)rr * 64 + j_ + 32]; } }
#pragma unroll
            for (int j = 0; j < 2; ++j) { const int c0 = lane * 8 + 512 * j;
                float w0[8], w1[8], w2[8], bb[8];
                { const f32x4 a = *(const f32x4*)(cw + c0), b = *(const f32x4*)(cw + c0 + 4); w0[0] = a[0]; w0[1] = a[1]; w0[2] = a[2]; w0[3] = a[3]; w0[4] = b[0]; w0[5] = b[1]; w0[6] = b[2]; w0[7] = b[3]; }
                { const f32x4 a = *(const f32x4*)(cw + 1024 + c0), b = *(const f32x4*)(cw + 1024 + c0 + 4); w1[0] = a[0]; w1[1] = a[1]; w1[2] = a[2]; w1[3] = a[3]; w1[4] = b[0]; w1[5] = b[1]; w1[6] = b[2]; w1[7] = b[3]; }
                { const f32x4 a = *(const f32x4*)(cw + 2048 + c0), b = *(const f32x4*)(cw + 2048 + c0 + 4); w2[0] = a[0]; w2[1] = a[1]; w2[2] = a[2]; w2[3] = a[3]; w2[4] = b[0]; w2[5] = b[1]; w2[6] = b[2]; w2[7] = b[3]; }
                { const f32x4 a = *(const f32x4*)(cb + c0), b = *(const f32x4*)(cb + c0 + 4); bb[0] = a[0]; bb[1] = a[1]; bb[2] = a[2]; bb[3] = a[3]; bb[4] = b[0]; bb[5] = b[1]; bb[6] = b[2]; bb[7] = b[3]; }
                float p[6][8];
#pragma unroll
                for (int i = 0; i < 6; ++i) unpack8(pxr[i][j], p[i]);
#pragma unroll
                for (int i = 0; i < 4; ++i) { float gb[8], o[8]; unpack8(gbr[i][j], gb);
#pragma unroll
                    for (int e = 0; e < 8; ++e) o[e] = gb[e] * (w0[e] * p[i][e] + w1[e] * p[i + 1][e] + w2[e] * p[i + 2][e] + bb[e]);
                    *(u32x4*)(ACONV + (size_t)(r0 + i) * 1024 + c0) = pack8(o); } }
#pragma unroll
            for (int i = 0; i < 4; ++i) { const int r = r0 + i, s = r & (SEQ - 1);
                { const u32x2 w = cqr[i]; const float a = bflo(w.x), b = bfhi(w.x), c = bflo(w.y), d = bfhi(w.y);
                  const float sq = wave_sum((a * a + b * b) + (c * c + d * d)); if (lane == 0) rstdq[r] = 1.f / sqrtf(sq * (1.f / 256.f) + EPS); }
                { const unsigned w = ckr[i]; const float a = bflo(w), b = bfhi(w);
                  const float sq = wave_sum(a * a + b * b); if (lane == 0) rstdkv[r] = 1.f / sqrtf(sq * (1.f / 128.f) + EPS); }
                { const int pp = lane, j = (pp >> 3) * 4 + (pp & 3), half = (pp >> 2) & 1; const float v1 = bf2f(k1[i]), v2 = bf2f(k2[i]); const f32x2 cs = rope[s * 32 + j];
                  const float kv_ = half ? v1 * cs.y + v2 * cs.x : v1 * cs.x - v2 * cs.y;
#if ATT_FP8
                  KR8[(size_t)r * 64 + pp] = (unsigned char)(__builtin_amdgcn_cvt_pk_fp8_f32(kv_, kv_, 0u, false) & 0xffu);
#else
                  KROPE[(size_t)r * 64 + pp] = f2bf(kv_);
#endif
                } }
        }
    }
    SEAM(2);

    if (IN(3)) { PHASE_BEGIN();
        { Gemm g = mkgemm(ACONV, Wco_t, MT, 1024, 1024, 1024, 1024); StaticOrder S; S.init(MT, 1024, G, bx);
          pg8::EpiChunk<FGateMul> E{{SIGA, MIXA}}; pg8::gemm_phase(lds, g, S, E, tid); }
        { Gemm g = mkgemm(CQ, Wuq_t, MT, 1536, 256, 256, 256); StaticOrder S; S.init(MT, 1536, G, (bx + G / 2) % G);
          pg8::EpiChunk<FQ> E{{rstdq, rope, QB, ATT_FP8 ? Q8 : nullptr}}; pg8::gemm_phase(lds, g, S, E, tid); }
        { Gemm g = mkgemm(CKV, Wukv_t, MT, 2048, 128, 128, 128); StaticOrder S; S.init(MT, 2048, G, bx);
#if ATT_FP8
          (void)g; (void)S; }
        { Gemm g = mkgemm(CKV, Wukv_t, MT, 1024, 128, 128, 128); StaticOrder S; S.init(MT, 1024, G, bx);
          pg8::EpiChunk<FK8> E{{rstdkv, KN8}}; pg8::gemm_phase(lds, g, S, E, tid); }
        { Gemm g = mkgemm(Wukv_t + (size_t)1024 * 128, CKV, 1024, MT, 128, 128, 128); StaticOrder S; S.init(1024, MT, G, bx);
          pg8::EpiChunk<FVT8> E{{rstdkv, VT8}}; pg8::gemm_phase(lds, g, S, E, tid); }
#else
          pg8::EpiChunk<FScaleRow> E{{rstdkv, KVB, 2048}}; pg8::gemm_phase(lds, g, S, E, tid); }
#endif
        { Gemm g = mkgemm(MKV, Wmqh, 2048, 1024, 256, 256, 256, 1, 4, (size_t)1024 * 256); StaticOrder S; S.init(2048, 1024, G, bx);
          pg8::EpiChunk<FPlain> E{{QKT, 1024}}; pg8::gemm_phase(lds, g, S, E, tid); }
        for (int b = 0; b < NB; ++b) { Gemm g = mkgemm(Woht, MKV + (size_t)(8 + b * 4) * 65536, 4096, 256, 256, 256, 256, 4, 4, (size_t)65536); StaticOrder S; S.init(4096, 256, G, (bx + G - 64 - 16 * b) % G);
          pg8::EpiChunk<FVW> E{{VWT + (size_t)b * 1024 * 1024}}; pg8::gemm_phase(lds, g, S, E, tid); }
    }
    SEAM(3);

    if (IN(4)) { PHASE_BEGIN();
        for (int u = vcu; u < NB * NHEAD * (SEQ / 256); u += G) { const int bh = u >> 5, qb = u & 31, b = bh >> 3, h = bh & 7; const size_t row0 = (size_t)b * SEQ + qb * 256;
#if ATT_FP8
            att::attn_unit9(Q8 + row0 * 1536 + h * 128, Q8 + row0 * 1536 + 1024 + h * 64, KN8 + (size_t)b * SEQ * 1024 + h * 128, KR8 + (size_t)b * SEQ * 64,
                            VT8 + (size_t)(b * NHEAD + h) * 128 * SEQ, OB + row0 * 1024 + h * 128, SEQ, (char*)lds_raw, tid);
#else
            att::attn_unit(QB + row0 * 1536 + h * 128, QB + row0 * 1536 + 1024 + h * 64, KVB + (size_t)b * SEQ * 2048 + h * 128,
                           KROPE + (size_t)b * SEQ * 64, OB + row0 * 1024 + h * 128, SEQ, (char*)lds_raw, tid);
#endif
        }
    }
    SEAM(4);

    if (IN(5)) { PHASE_BEGIN(); Gemm g = mkgemm(OB, Wmo_t, MT, 1024, 1024, 1024, 1024); StaticOrder S; S.init(MT, 1024, G, bx);
        pg8::EpiChunk<FGateMulAdd> E{{SIGB, MIXA, MIXED}}; pg8::gemm_phase(lds, g, S, E, tid); }
    SEAM(5);

    if (IN(6)) { PHASE_BEGIN(); Gemm g = mkgemm(MIXED, Wmix_t, MT, 1024, 1024, 1024, 1024); StaticOrder S; S.init(MT, 1024, G, bx);
        EpiX1 E{x, RESID_BF16 ? nullptr : out, X1B, ssq}; pg8::gemm_phase(lds, g, S, E, tid); }
    SEAM(6);

    if (IN(7)) { PHASE_BEGIN(); Gemm g = mkgemm(X1B, QKT, MT, 1024, 1024, 1024, 1024, 32, 2, (size_t)1024 * 1024); StaticOrder S; S.init(MT, 1024, G, bx);
        EpiSoftmax E{ssq, PM}; pg8::gemm_phase(lds, g, S, E, tid); }
    SEAM(7);

    if (IN(8)) { PHASE_BEGIN(); Gemm g = mkgemm(PM, VWT, MT, 1024, 1024, 1024, 1024, 32, 2, (size_t)1024 * 1024); StaticOrder S; S.init(MT, 1024, G, bx);
#if RESID_BF16
        pg8::EpiChunk<FResidBf16> E{{X1B, X2B}}; pg8::gemm_phase(lds, g, S, E, tid); }
#else
        pg8::EpiChunk<FResidF32> E{{out, out}}; pg8::gemm_phase(lds, g, S, E, tid); }
#endif
    SEAM(8);

#if RESID_BF16
#define LDROW4(r_, j_) ([&]() -> f32x4 { const u32x2 w_ = *(const u32x2*)(X2B + (size_t)(r_) * 1024 + (lane + 64 * (j_)) * 4); return (f32x4){bflo(w_.x), bfhi(w_.x), bflo(w_.y), bfhi(w_.y)}; }())
#else
#define LDROW4(r_, j_) (*(const f32x4*)(out + (size_t)(r_) * 1024 + (lane + 64 * (j_)) * 4))
#endif
    if (IN(9)) { PHASE_BEGIN();
        constexpr int RP = 1028;
        LAS float* wt = (LAS float*)lds;
        LAS float* hb = (LAS float*)(lds + 16 * RP * 4);
        LAS float* part = (LAS float*)(lds + 2 * 16 * RP * 4);
        const float* wr_ = args.in[I_W_ROUTER]; const float* gn = args.in[I_NORM_MOE_G];
        for (int i = tid; i < 1024 * 16; i += NWAVES * 64) wt[(i & 15) * RP + (i >> 4)] = wr_[i];
        f32x4 gv[4];
#pragma unroll
        for (int j = 0; j < 4; ++j) gv[j] = *(const f32x4*)(gn + (lane + 64 * j) * 4);
        f32x4 v[2][4], vn[2][4];
        const int ngroups = MT / 16;
        if (vcu < ngroups) {
#pragma unroll
            for (int t = 0; t < 2; ++t)
#pragma unroll
                for (int j = 0; j < 4; ++j) v[t][j] = LDROW4(vcu * 16 + wave * 2 + t, j); }
        __syncthreads();
        for (int g = vcu; g < ngroups; g += G) { const int r0 = g * 16;
            if (g + G < ngroups) {
#pragma unroll
                for (int t = 0; t < 2; ++t)
#pragma unroll
                    for (int j = 0; j < 4; ++j) vn[t][j] = LDROW4((g + G) * 16 + wave * 2 + t, j); }
#pragma unroll
            for (int t = 0; t < 2; ++t) { const int tk = wave * 2 + t, r = r0 + tk; float s = 0.f;
#pragma unroll
                for (int j = 0; j < 4; ++j) s += (v[t][j][0] * v[t][j][0] + v[t][j][1] * v[t][j][1]) + (v[t][j][2] * v[t][j][2] + v[t][j][3] * v[t][j][3]);
                const float rs = 1.f / sqrtf(wave_sum(s) * (1.f / 1024.f) + EPS);
#pragma unroll
                for (int j = 0; j < 4; ++j) { const f32x4 hh = v[t][j] * rs * gv[j]; *(LAS f32x4*)(hb + tk * RP + (lane + 64 * j) * 4) = hh;
                    u32x2 w; w.x = cvtpk(hh[0], hh[1]); w.y = cvtpk(hh[2], hh[3]); *(u32x2*)(H3 + (size_t)r * 1024 + (lane + 64 * j) * 4) = w; } }
            __syncthreads();
            { f32x4 acc = {0.f, 0.f, 0.f, 0.f}; const LAS float* ap = wt + (lane & 15) * RP + wave * 128 + (lane >> 4); const LAS float* bp = hb + (lane & 15) * RP + wave * 128 + (lane >> 4);
#pragma unroll 8
                for (int st = 0; st < 32; ++st) acc = __builtin_amdgcn_mfma_f32_16x16x4f32(ap[4 * st], bp[4 * st], acc, 0, 0, 0);
                *(LAS f32x4*)(part + (wave * 16 + (lane & 15)) * 16 + 4 * (lane >> 4)) = acc; }
            __syncthreads();
            if (tid < 256) { const int tk = tid >> 4, e = tid & 15; float lg = 0.f;
#pragma unroll
                for (int w = 0; w < 8; ++w) lg += part[(w * 16 + tk) * 16 + e];
                float mx = lg;
#pragma unroll
                for (int o = 1; o < 16; o <<= 1) mx = fmaxf(mx, __shfl_xor(mx, o));
                const float p = __expf(lg - mx); float sm = p;
#pragma unroll
                for (int o = 1; o < 16; o <<= 1) sm += __shfl_xor(sm, o);
                const int r = r0 + tk, b = r >> 13, sidx = r & (SEQ - 1); aff[((size_t)b * NEXP + e) * SEQ + sidx] = p / sm; inv[(size_t)r * 16 + e] = -1; }
            __syncthreads();
#pragma unroll
            for (int t = 0; t < 2; ++t)
#pragma unroll
                for (int j = 0; j < 4; ++j) v[t][j] = vn[t][j];
        }
    }
    SEAM(9);

    if (IN(10)) { PHASE_BEGIN();
        if (vcu < NB * NEXP) {
            LAS unsigned* keys = (LAS unsigned*)lds; LAS unsigned* hist = (LAS unsigned*)(lds + 32768); LAS unsigned* misc = (LAS unsigned*)(lds + 32768 + 1024);
            for (int be = vcu; be < NB * NEXP; be += G) { const int b = be >> 4, e = be & 15; const float* a = aff + (size_t)be * SEQ;
#pragma unroll 1
                for (int i = tid; i < SEQ; i += NWAVES * 64) keys[i] = __float_as_uint(a[i]);
                unsigned prefix = 0u, kth = CAP;
#pragma unroll 1
                for (int pass = 0; pass < 4; ++pass) { const int shift = 24 - 8 * pass;
                    if (tid < 256) hist[tid] = 0u;
                    __syncthreads();
#pragma unroll 1
                    for (int i = tid; i < SEQ; i += NWAVES * 64) { const unsigned k = keys[i]; const bool match = (pass == 0) || ((k >> (shift + 8)) == (prefix >> (shift + 8)));
                        if (match) atomicAdd((unsigned*)(hist + ((k >> shift) & 255u)), 1u); }
                    __syncthreads();
                    if (wave == 0) { unsigned c[4]; unsigned tot = 0u;
#pragma unroll
                        for (int i = 0; i < 4; ++i) { c[i] = hist[255 - (4 * lane + i)]; tot += c[i]; }
                        unsigned incl = tot;
#pragma unroll
                        for (int o = 1; o < 64; o <<= 1) { const unsigned t = __shfl_up(incl, o); if (lane >= o) incl += t; }
                        unsigned run = incl - tot;
#pragma unroll
                        for (int i = 0; i < 4; ++i) { if (run < kth && run + c[i] >= kth) { misc[0] = 255u - (unsigned)(4 * lane + i); misc[1] = kth - run; } run += c[i]; } }
                    __syncthreads();
                    prefix |= misc[0] << shift; kth = misc[1];
                    __syncthreads();
                }
                const unsigned T = prefix; unsigned base_g = 0u, base_e = 0u;
#pragma unroll 1
                for (int it = 0; it < SEQ / (NWAVES * 64); ++it) { const int t = it * (NWAVES * 64) + tid; const unsigned k = keys[t]; const bool gt = k > T, eq = k == T;
                    const unsigned long long bg = __ballot(gt), bq = __ballot(eq); const unsigned long long lt = (1ull << lane) - 1ull;
                    if (lane == 0) { misc[8 + wave] = (unsigned)__popcll(bg); misc[16 + wave] = (unsigned)__popcll(bq); }
                    __syncthreads();
                    unsigned pg = base_g, pq = base_e, tg = 0u, tq = 0u;
#pragma unroll
                    for (int w = 0; w < NWAVES; ++w) { const unsigned cg = misc[8 + w], cq = misc[16 + w]; if (w < wave) { pg += cg; pq += cq; } tg += cg; tq += cq; }
                    pg += (unsigned)__popcll(bg & lt); pq += (unsigned)__popcll(bq & lt);
                    const bool sel = gt || (eq && pq < kth);
                    if (sel) { const unsigned pos = pg + (pq < kth ? pq : kth); idx[(size_t)be * CAP + pos] = t; gate[(size_t)be * CAP + pos] = __uint_as_float(k); inv[((size_t)b * SEQ + t) * 16 + e] = (int)pos; }
                    base_g += tg; base_e += tq;
                    __syncthreads();
                }
            }
        } else {
            const int cw_ = vcu - NB * NEXP, ncw = G - NB * NEXP; const int gw2 = cw_ * NWAVES + wave, NGW2 = ncw * NWAVES;
#pragma unroll 1
            for (int it = gw2; it < NEXP * 768; it += NGW2) { const int e = it / 768, r = it % 768;
                if (r < 512) { const int nb = r >> 4, kb = r & 15, n0 = nb * 64; const int f0 = (n0 >> 8) * 128 + (n0 & 127);
                    const float* W = (((n0 >> 7) & 1) ? args.in[I_W_EXP_UP] : args.in[I_W_EXP_GATE]) + (size_t)e * 1024 * 1024 + f0; bf16_t* D = Wgu_t + (size_t)e * 2048 * 1024 + (size_t)n0 * 1024;
                    transpose_item([&](int n) { return W + n; }, [&](int n) { return D + (size_t)n * 1024; }, 1024, nullptr, kb * 64, scr, lane); }
                else { const int r2 = r - 512, nb = r2 >> 4, kb = r2 & 15, n0 = nb * 64;
                    const float* W = args.in[I_W_EXP_DOWN] + (size_t)e * 1024 * 1024 + n0; bf16_t* D = Wd_t + (size_t)e * 1024 * 1024 + (size_t)n0 * 1024;
                    transpose_item([&](int n) { return W + n; }, [&](int n) { return D + (size_t)n * 1024; }, 1024, nullptr, kb * 64, scr, lane); } }
        }
    }
    if (IN(10) && IN(12)) GRID_BAR();

    if (IN(12)) { PHASE_BEGIN(); Gemm g = mkgemm(H3, Wgu_t, MOE_ROWS, 2048, 1024, 1024, 1024, 4, 16, (size_t)2048 * 1024); g.gidx = idx; StaticOrder S; S.init(MOE_ROWS, 2048, G, bx);
        EpiSwiglu E{HB}; pg8::gemm_phase<EpiSwiglu, StaticOrder, true>(lds, g, S, E, tid); }
    SEAM(12);

    if (IN(13)) { PHASE_BEGIN(); Gemm g = mkgemm(HB, Wd_t, MOE_ROWS, 1024, 1024, 1024, 1024, 4, 16, (size_t)1024 * 1024); StaticOrder S; S.init(MOE_ROWS, 1024, G, bx);
        pg8::EpiChunk<FGateRow> E{{gate, Y}}; pg8::gemm_phase(lds, g, S, E, tid); }
    SEAM(13);

    if (IN(14)) { PHASE_BEGIN();
        const float* gn = args.in[I_NORM_FINAL_G]; f32x4 gv[4];
#pragma unroll
        for (int j = 0; j < 4; ++j) gv[j] = *(const f32x4*)(gn + (lane + 64 * j) * 4);
        f32x4 v[4], vn[4]; int myslot = -1, nslot = -1;
        if (gw < MT) { myslot = inv[(size_t)gw * 16 + (lane & 15)];
#pragma unroll
            for (int j = 0; j < 4; ++j) v[j] = LDROW4(gw, j); }
        for (int r = gw; r < MT; r += NGW) { float* row = out + (size_t)r * 1024; const int b = r >> 13;
            if (r + NGW < MT) { nslot = inv[(size_t)(r + NGW) * 16 + (lane & 15)];
#pragma unroll
                for (int j = 0; j < 4; ++j) vn[j] = LDROW4(r + NGW, j); }
            unsigned long long em = __ballot(lane < 16 && myslot >= 0) & 0xffffull;
            while (em) { u32x2 w[4][4]; int ne = 0;
#pragma unroll
                for (int q = 0; q < 4; ++q) { if (em) { const int e = __builtin_ctzll(em); em &= em - 1; const int slot = __builtin_amdgcn_readlane(myslot, e);
                        const bf16_t* yr = Y + ((size_t)(b * NEXP + e) * CAP + slot) * 1024;
#pragma unroll
                        for (int j = 0; j < 4; ++j) w[q][j] = *(const u32x2*)(yr + (lane + 64 * j) * 4);
                        ne = q + 1; } }
#pragma unroll
                for (int q = 0; q < 4; ++q) { if (q < ne) {
#pragma unroll
                        for (int j = 0; j < 4; ++j) { v[j][0] += bflo(w[q][j].x); v[j][1] += bfhi(w[q][j].x); v[j][2] += bflo(w[q][j].y); v[j][3] += bfhi(w[q][j].y); } } } }
            float s = 0.f;
#pragma unroll
            for (int j = 0; j < 4; ++j) s += (v[j][0] * v[j][0] + v[j][1] * v[j][1]) + (v[j][2] * v[j][2] + v[j][3] * v[j][3]);
            const float rs = 1.f / sqrtf(wave_sum(s) * (1.f / 1024.f) + EPS);
#pragma unroll
            for (int j = 0; j < 4; ++j) *(f32x4*)(row + (lane + 64 * j) * 4) = v[j] * rs * gv[j];
#pragma unroll
            for (int j = 0; j < 4; ++j) v[j] = vn[j];
            myslot = nslot;
        }
    }
#undef IN
#undef SEAM
#undef GRID_BAR
}

#ifndef PH_MASK
#define PH_MASK 0x7fff
#endif
static const void* phase_fn(int k) {
#if MK_N_LAUNCHES == 1
    (void)k; return (const void*)fwd_kernel<PH_MASK>;
#else
    switch (k) {
    case 0: return (const void*)fwd_kernel<1 << 0>;   case 1: return (const void*)fwd_kernel<1 << 1>;   case 2: return (const void*)fwd_kernel<1 << 2>;   case 3: return (const void*)fwd_kernel<1 << 3>;
    case 4: return (const void*)fwd_kernel<1 << 4>;   case 5: return (const void*)fwd_kernel<1 << 5>;   case 6: return (const void*)fwd_kernel<1 << 6>;   case 7: return (const void*)fwd_kernel<1 << 7>;
    case 8: return (const void*)fwd_kernel<1 << 8>;   case 9: return (const void*)fwd_kernel<1 << 9>;   case 10: return (const void*)fwd_kernel<1 << 10>; case 11: return (const void*)fwd_kernel<1 << 11>;
    case 12: return (const void*)fwd_kernel<1 << 12>; case 13: return (const void*)fwd_kernel<1 << 13>; default: return (const void*)fwd_kernel<1 << 14>;
    }
#endif
}
extern "C" void kernel_launch(void* const* d_in, const int* in_sizes, int n_in, void* d_out, int out_size, void* d_ws, size_t ws_size, hipStream_t stream) {
    static int grid = 0;
    if (grid == 0) {
        if (n_in != 25 || in_sizes[0] != MT * DM || out_size != MT * DM || ws_size < WS_END) {
            fprintf(stderr, "kernel_launch: built for 25 inputs, x/out of %d floats, >= %zu bytes of workspace; got n_in %d, in0 %d, out %d, ws %zu; nothing launched\n", MT * DM, (size_t)WS_END, n_in, n_in > 0 ? in_sizes[0] : -1, out_size, ws_size);
            grid = -1; return; }
        int dev = 0, cus = 0;
        if (hipGetDevice(&dev) != hipSuccess || hipDeviceGetAttribute(&cus, hipDeviceAttributeMultiprocessorCount, dev) != hipSuccess) { fprintf(stderr, "kernel_launch: device query failed\n"); grid = -1; return; }
        for (int k = 0; k < (N_LAUNCHES == 1 ? 1 : N_PHASES); ++k)
            if (hipFuncSetAttribute(phase_fn(N_LAUNCHES == 1 ? -1 : k), hipFuncAttributeMaxDynamicSharedMemorySize, LDS_BYTES) != hipSuccess) { fprintf(stderr, "kernel_launch: hipFuncSetAttribute failed\n"); grid = -1; return; }
        (void)hipGetLastError();
        grid = cus;
    }
    if (grid < 0) return;
    if (hipMemsetAsync((char*)d_ws + WS_CTL, 0, CTL_ZERO_BYTES, stream) != hipSuccess) { fprintf(stderr, "kernel_launch: memset failed\n"); return; }
    Args a{};
    for (int i = 0; i < 25; ++i) a.in[i] = (const float*)d_in[i];
    a.out = (float*)d_out; a.ws = (unsigned char*)d_ws;
    for (int li = 0; li < N_LAUNCHES; ++li) {
        a.ph_lo = (N_LAUNCHES == 1) ? 0 : li; a.ph_hi = (N_LAUNCHES == 1) ? N_PHASES : li + 1;
        void* kargs[] = {&a};
        for (int rep = 0; rep < ((N_LAUNCHES != 1 && li == REP_PHASE) ? 2 : 1); ++rep)
            (void)hipLaunchKernel(phase_fn(N_LAUNCHES == 1 ? -1 : li), dim3(grid), dim3(NWAVES * 64), kargs, LDS_BYTES, stream);
        const hipError_t le = hipPeekAtLastError();
        if (le != hipSuccess) { fprintf(stderr, "kernel_launch: launch %d failed: %s\n", li, hipGetErrorName(le)); break; }
    }
}
```

```cpp
#include <hip/hip_runtime.h>
#include <cstdio>
#include <cstdint>

#ifndef MK_N_LAUNCHES
#define MK_N_LAUNCHES 1
#endif
#ifndef REP_PHASE
#define REP_PHASE -1
#endif
#ifndef RESID_BF16
#define RESID_BF16 1
#endif
#ifndef ATT_FP8
#define ATT_FP8 1
#endif
#ifndef GEMM_SIMPLE
#define GEMM_SIMPLE 0
#endif

#define LAS __attribute__((address_space(3)))
#define GAS __attribute__((address_space(1)))
typedef unsigned short bf16_t;
typedef short bf16x8 __attribute__((ext_vector_type(8)));
typedef short s16x4 __attribute__((ext_vector_type(4)));
typedef float f32x2 __attribute__((ext_vector_type(2)));
typedef float f32x4 __attribute__((ext_vector_type(4)));
typedef float f32x16 __attribute__((ext_vector_type(16)));
typedef unsigned u32x2 __attribute__((ext_vector_type(2)));
typedef unsigned u32x4 __attribute__((ext_vector_type(4)));
typedef __bf16 bf16x2_t __attribute__((ext_vector_type(2)));

constexpr int DM = 1024, NB = 2, SEQ = 8192, MT = NB * SEQ;
constexpr int NU = 5632;
constexpr int NHEAD = 8, QK_NOPE = 128, QK_ROPE = 64, V_HEAD = 128, Q_LORA = 256, KV_LORA = 128;
constexpr int MEM_LEN = 256, MEM_HEADS = 4, MEM_HD = 256;
constexpr int NEXP = 16, EFF = 1024, CAP = 1024;
constexpr int MOE_ROWS = NB * NEXP * CAP;
constexpr float EPS = 1e-6f;
constexpr float ATT_SCALE = 0.07216878364870322f;

__device__ __forceinline__ unsigned cvtpk(float lo, float hi) { f32x2 v = {lo, hi}; bf16x2_t b = __builtin_convertvector(v, bf16x2_t); return __builtin_bit_cast(unsigned, b); }
__device__ __forceinline__ float bflo(unsigned w) { return __builtin_bit_cast(float, w << 16); }
__device__ __forceinline__ float bfhi(unsigned w) { return __builtin_bit_cast(float, w & 0xffff0000u); }
__device__ __forceinline__ float bf2f(bf16_t h) { return __builtin_bit_cast(float, (unsigned)h << 16); }
__device__ __forceinline__ bf16_t f2bf(float f) { return (bf16_t)(cvtpk(f, 0.f) & 0xffffu); }
__device__ __forceinline__ void unpack8(const u32x4 w, float (&v)[8]) { v[0] = bflo(w.x); v[1] = bfhi(w.x); v[2] = bflo(w.y); v[3] = bfhi(w.y); v[4] = bflo(w.z); v[5] = bfhi(w.z); v[6] = bflo(w.w); v[7] = bfhi(w.w); }
__device__ __forceinline__ u32x4 pack8(const float (&v)[8]) { u32x4 w; w.x = cvtpk(v[0], v[1]); w.y = cvtpk(v[2], v[3]); w.z = cvtpk(v[4], v[5]); w.w = cvtpk(v[6], v[7]); return w; }
typedef int v8i __attribute__((ext_vector_type(8)));
__device__ __forceinline__ unsigned pk4_fp8(float a, float b, float c, float d) { unsigned w = 0; w = __builtin_amdgcn_cvt_pk_fp8_f32(a, b, w, false); w = __builtin_amdgcn_cvt_pk_fp8_f32(c, d, w, true); return w; }
__device__ __forceinline__ u32x2 pack8_fp8(const float (&v)[8]) { u32x2 w; w.x = pk4_fp8(v[0], v[1], v[2], v[3]); w.y = pk4_fp8(v[4], v[5], v[6], v[7]); return w; }
__device__ __forceinline__ float wave_sum(float v) {
#pragma unroll
    for (int o = 1; o < 64; o <<= 1) v += __shfl_xor(v, o);
    return v;
}

namespace pg8 {
constexpr int BM = 256, BK = 64, HALF = 128, HTB = HALF * BK * 2, STAGE_BYTES = 8 * HTB, NXCD = 8, WGM = 8;
__host__ __device__ __forceinline__ int lds_byte(int r, int c) { const int st = (r >> 4) * 2 + (c >> 5), rr = r & 15, cc = c & 31, ob = rr * 64 + cc * 2; return st * 1024 + (ob ^ (((ob >> 9) & 1) << 5)); }
__host__ __device__ __forceinline__ void stage_rc(int b, int& R, int& C) { const int st = b / 1024, sb = b % 1024, swz = sb ^ (((sb >> 9) & 1) << 5); R = (st >> 1) * 16 + swz / 64; C = (st & 1) * 32 + (swz % 64) / 2; }
__host__ __device__ __forceinline__ int perm32(int rho) { const int n = rho >> 4, i = rho & 15; return 8 * (i >> 2) + 4 * n + (i & 3); }

struct Unit { int pm, pn; };
struct Gemm { const bf16_t* A; const bf16_t* Bt; int M, N, K, lda, ldb, bdiv, bmod; size_t bstride; const int* gidx; };
__device__ __forceinline__ Gemm mkgemm(const bf16_t* A, const bf16_t* Bt, int M, int N, int K, int lda, int ldb, int bdiv = 1, int bmod = 1, size_t bstride = 0) {
    Gemm g; g.A = A; g.Bt = Bt; g.M = M; g.N = N; g.K = K; g.lda = lda; g.ldb = ldb; g.bdiv = bdiv; g.bmod = bmod; g.bstride = bstride; g.gidx = nullptr; return g; }

struct StaticOrder {
    int nM, nN, nwg, G, c;
    __host__ __device__ void init(int M, int N, int G_, int c_) { nM = M / BM; nN = N / BM; nwg = nM * nN; G = G_; c = c_; }
    __host__ __device__ bool next(int i, Unit& u) const {
        const long L = (long)i * G + c; if (L >= nwg) return false;
        int wgid = (int)L; { const int q = nwg / NXCD, r = nwg % NXCD, xcd = wgid % NXCD, off = wgid / NXCD; wgid = (xcd < r ? xcd * (q + 1) : r * (q + 1) + (xcd - r) * q) + off; }
        const int nig = WGM * nN, gid = wgid / nig, fm = gid * WGM, gsz = (nM - fm) < WGM ? (nM - fm) : WGM;
        u.pm = fm + ((wgid % nig) % gsz); u.pn = (wgid % nig) / gsz; return true;
    }
};

typedef f32x4 Acc[2][2][4][2];

template <class Epi, class Sched>
__device__ __forceinline__ void gemm_simple(LAS unsigned char* lds, const Gemm g, const Sched& S, const Epi& E, const int tid) {
    const int wid = __builtin_amdgcn_readfirstlane(tid >> 6), lane = tid & 63, wr = wid >> 2, wc = wid & 3, fr = lane & 15, fq = lane >> 4;
    Unit u;
    for (int i = 0; S.next(i, u); ++i) {
        Acc acc;
#pragma unroll
        for (int a = 0; a < 2; ++a)
#pragma unroll
            for (int b = 0; b < 2; ++b)
#pragma unroll
                for (int m = 0; m < 4; ++m)
#pragma unroll
                    for (int n = 0; n < 2; ++n) acc[a][b][m][n] = (f32x4){0.f, 0.f, 0.f, 0.f};
        const bf16_t* Ab = g.A + (size_t)u.pm * BM * g.lda + (size_t)(wr * 64 + fr) * g.lda + fq * 8;
        const bf16_t* Bb = g.Bt + (size_t)((u.pm / g.bdiv) % g.bmod) * g.bstride + (size_t)u.pn * BM * g.ldb + fq * 8;
        int brow[2][2];
#pragma unroll
        for (int bj = 0; bj < 2; ++bj)
#pragma unroll
            for (int n = 0; n < 2; ++n) brow[bj][n] = bj * HALF + wc * 32 + perm32(n * 16 + fr);
#pragma unroll 1
        for (int k0 = 0; k0 < g.K; k0 += 32) {
            bf16x8 b[2][2];
#pragma unroll
            for (int bj = 0; bj < 2; ++bj)
#pragma unroll
                for (int n = 0; n < 2; ++n) b[bj][n] = *(const bf16x8*)(Bb + (size_t)brow[bj][n] * g.ldb + k0);
#pragma unroll
            for (int ai = 0; ai < 2; ++ai) { bf16x8 a[4];
#pragma unroll
                for (int m = 0; m < 4; ++m) a[m] = *(const bf16x8*)(Ab + (size_t)(ai * HALF + m * 16) * g.lda + k0);
#pragma unroll
                for (int bj = 0; bj < 2; ++bj)
#pragma unroll
                    for (int m = 0; m < 4; ++m)
#pragma unroll
                        for (int n = 0; n < 2; ++n) acc[ai][bj][m][n] = __builtin_amdgcn_mfma_f32_16x16x32_bf16(b[bj][n], a[m], acc[ai][bj][m][n], 0, 0, 0); }
        }
        E.run(acc, u, wr, wc, fr, fq, lds, wid, lane);
        if (Epi::USES_LDS) __syncthreads();
    }
}

template <class Epi, class Sched, bool GATHER>
__device__ __forceinline__ void gemm_fast(LAS unsigned char* lds, const Gemm g, const Sched& S, const Epi& E, const int tid) {
    const int wid = __builtin_amdgcn_readfirstlane(tid >> 6), lane = tid & 63, wr = wid >> 2, wc = wid & 3, fr = lane & 15, fq = lane >> 4;
    int Kop = g.K; asm volatile("" : "+s"(Kop));
    const int K = Kop, nt = K / BK;
    int Rr[2], Cc[2]; unsigned voffB[2];
    unsigned cvA0[2], cvA1[2], nvA0[2], nvA1[2];
    const size_t kstep = (size_t)(BK * 2);
    const size_t hstepA = (size_t)HALF * g.lda * 2, hstepB = (size_t)HALF * g.ldb * 2;
    const size_t tstepA = 2 * hstepA, tstepB = 2 * hstepB;
#pragma unroll
    for (int i = 0; i < 2; ++i) { stage_rc(tid * 16 + i * 8192, Rr[i], Cc[i]); const int Rb = (Rr[i] & ~31) + perm32(Rr[i] & 31);
        voffB[i] = (unsigned)(Rb * g.ldb + Cc[i]) * 2u;
        cvA0[i] = (unsigned)(Rr[i] * g.lda + Cc[i]) * 2u; cvA1[i] = cvA0[i] + (unsigned)hstepA; nvA0[i] = cvA0[i]; nvA1[i] = cvA1[i]; }
    const unsigned ldsw = (unsigned)wid * 1024u;
    const int aoff = lds_byte(wr * 64 + fr, fq * 8), boff = lds_byte(wc * 32 + fr, fq * 8);
#define PG8_SA(b, h) (((b) * 2 + (h)) * HTB)
#define PG8_SB(b, h) ((4 + (b) * 2 + (h)) * HTB)
#define PG8_STAGE(bufoff, gbase, voff) do { _Pragma("unroll") for (int _i = 0; _i < 2; ++_i) \
        __builtin_amdgcn_global_load_lds((const unsigned*)((const char*)(gbase) + (voff)[_i]), (LAS unsigned*)(lds + (bufoff) + ldsw + _i * 8192), 16, 0, 0); } while (0)
#define PG8_LDA(dst, b, h) do { _Pragma("unroll") for (int m = 0; m < 4; ++m) _Pragma("unroll") for (int k = 0; k < 2; ++k) dst[m][k] = *(const LAS bf16x8*)(lds + PG8_SA(b, h) + aoff + m * 2048 + k * 1024); } while (0)
#define PG8_LDB(dst, b, h) do { _Pragma("unroll") for (int n = 0; n < 2; ++n) _Pragma("unroll") for (int k = 0; k < 2; ++k) dst[n][k] = *(const LAS bf16x8*)(lds + PG8_SB(b, h) + boff + n * 2048 + k * 1024); } while (0)
#define PG8_MMA(ai, bj, At, Bt) do { __builtin_amdgcn_s_setprio(1); _Pragma("unroll") for (int m = 0; m < 4; ++m) _Pragma("unroll") for (int n = 0; n < 2; ++n) _Pragma("unroll") for (int k = 0; k < 2; ++k) \
        acc[ai][bj][m][n] = __builtin_amdgcn_mfma_f32_16x16x32_bf16(Bt[n][k], At[m][k], acc[ai][bj][m][n], 0, 0, 0); __builtin_amdgcn_s_setprio(0); } while (0)
#define PG8_WAIT_V(n) asm volatile("s_waitcnt vmcnt(" #n ")" ::: "memory")
#define PG8_WAIT_L(n) asm volatile("s_waitcnt lgkmcnt(" #n ")" ::: "memory")
#define PG8_BAR __builtin_amdgcn_s_barrier()
#define PG8_SCHED __builtin_amdgcn_sched_barrier(0)
#define PG8_GIDX(u, raw) do { const int* ip_ = g.gidx + (size_t)(u).pm * BM; raw[0] = ip_[Rr[0]]; raw[1] = ip_[Rr[1]]; raw[2] = ip_[HALF + Rr[0]]; raw[3] = ip_[HALF + Rr[1]]; } while (0)
#define PG8_GOFF(u, raw, v0, v1) do { const unsigned bb_ = (unsigned)((u).pm >> 6) * (unsigned)SEQ; _Pragma("unroll") for (int _i = 0; _i < 2; ++_i) { \
        v0[_i] = ((bb_ + (unsigned)raw[_i]) * (unsigned)g.lda + (unsigned)Cc[_i]) * 2u; v1[_i] = ((bb_ + (unsigned)raw[2 + _i]) * (unsigned)g.lda + (unsigned)Cc[_i]) * 2u; } } while (0)
    Unit cur, nxt; int ui = 0;
    if (!S.next(0, cur)) return;
    Acc acc;
#pragma unroll
    for (int a = 0; a < 2; ++a)
#pragma unroll
        for (int b = 0; b < 2; ++b)
#pragma unroll
            for (int m = 0; m < 4; ++m)
#pragma unroll
                for (int n = 0; n < 2; ++n) acc[a][b][m][n] = (f32x4){0.f, 0.f, 0.f, 0.f};
    bf16x8 At[4][2], B0[2][2], B1[2][2];
    int nraw[4] = {0, 0, 0, 0};
    const char* cA = GATHER ? (const char*)g.A : (const char*)g.A + (size_t)cur.pm * tstepA;
    const char* cB = (const char*)g.Bt + (size_t)((cur.pm / g.bdiv) % g.bmod) * g.bstride * 2 + (size_t)cur.pn * tstepB;
    if constexpr (GATHER) { int craw[4]; PG8_GIDX(cur, craw); PG8_GOFF(cur, craw, cvA0, cvA1); }
    PG8_STAGE(PG8_SB(0, 0), cB, voffB); PG8_STAGE(PG8_SB(0, 1), cB + hstepB, voffB); PG8_STAGE(PG8_SA(0, 0), cA, cvA0); PG8_STAGE(PG8_SA(0, 1), cA, cvA1);
    if (wr == 1) PG8_BAR;
    PG8_WAIT_V(2); PG8_BAR;
    PG8_STAGE(PG8_SB(1, 0), cB + kstep, voffB); PG8_STAGE(PG8_SA(1, 0), cA + kstep, cvA0); PG8_STAGE(PG8_SB(1, 1), cB + hstepB + kstep, voffB);
    PG8_WAIT_V(6); PG8_BAR;
    for (;;) {
        const bool has_next = S.next(ui + 1, nxt);
        const char* nA = GATHER ? (const char*)g.A : (has_next ? (const char*)g.A + (size_t)nxt.pm * tstepA : cA);
        const char* nB = has_next ? (const char*)g.Bt + (size_t)((nxt.pm / g.bdiv) % g.bmod) * g.bstride * 2 + (size_t)nxt.pn * tstepB : cB;
        if constexpr (GATHER) { if (has_next) PG8_GIDX(nxt, nraw); }
        for (int t = 0; t < nt; t += 2) {
            const bool last = (t == nt - 2);
            const char* a1 = cA + (size_t)(t + 1) * kstep;
            const char* a2 = last ? nA : cA + (size_t)(t + 2) * kstep; const char* b2 = last ? nB : cB + (size_t)(t + 2) * kstep;
            const char* a3 = a2 + kstep; const char* b3 = b2 + kstep;
            unsigned sA0[2] = {cvA0[0], cvA0[1]}, sA1[2] = {cvA1[0], cvA1[1]};
            if constexpr (GATHER) { if (last) { if (has_next) PG8_GOFF(nxt, nraw, nvA0, nvA1); else { nvA0[0] = cvA0[0]; nvA0[1] = cvA0[1]; nvA1[0] = cvA1[0]; nvA1[1] = cvA1[1]; }
                                                 sA0[0] = nvA0[0]; sA0[1] = nvA0[1]; sA1[0] = nvA1[0]; sA1[1] = nvA1[1]; } }
            PG8_LDB(B0, 0, 0); PG8_LDB(B1, 0, 1); PG8_SCHED; PG8_LDA(At, 0, 0); PG8_STAGE(PG8_SA(1, 1), a1, cvA1);
            PG8_WAIT_V(8); PG8_WAIT_L(0); PG8_BAR; PG8_MMA(0, 0, At, B0); PG8_MMA(0, 1, At, B1); PG8_BAR; PG8_SCHED;
            PG8_LDA(At, 0, 1); PG8_STAGE(PG8_SB(0, 0), b2, voffB); PG8_STAGE(PG8_SB(0, 1), b2 + hstepB, voffB); PG8_STAGE(PG8_SA(0, 0), a2, sA0);
            PG8_WAIT_V(8); PG8_WAIT_L(0); PG8_BAR; PG8_MMA(1, 0, At, B0); PG8_MMA(1, 1, At, B1); PG8_BAR; PG8_SCHED;
            PG8_LDB(B0, 1, 0); PG8_LDB(B1, 1, 1); PG8_SCHED; PG8_LDA(At, 1, 0); PG8_STAGE(PG8_SA(0, 1), a2, sA1);
            PG8_WAIT_V(8); PG8_WAIT_L(0); PG8_BAR; PG8_MMA(0, 0, At, B0); PG8_MMA(0, 1, At, B1); PG8_BAR; PG8_SCHED;
            PG8_LDA(At, 1, 1); PG8_STAGE(PG8_SB(1, 0), b3, voffB); PG8_STAGE(PG8_SB(1, 1), b3 + hstepB, voffB); PG8_STAGE(PG8_SA(1, 0), a3, sA0);
            PG8_WAIT_V(8); PG8_WAIT_L(0); PG8_BAR; PG8_MMA(1, 0, At, B0); PG8_MMA(1, 1, At, B1); PG8_BAR; PG8_SCHED;
        }
        if (wr == 0) PG8_BAR;
        E.run(acc, cur, wr, wc, fr, fq, lds + STAGE_BYTES, wid, lane);
        if (!has_next) break;
#pragma unroll
        for (int a = 0; a < 2; ++a)
#pragma unroll
            for (int b = 0; b < 2; ++b)
#pragma unroll
                for (int m = 0; m < 4; ++m)
#pragma unroll
                    for (int n = 0; n < 2; ++n) acc[a][b][m][n] = (f32x4){0.f, 0.f, 0.f, 0.f};
        cur = nxt; cA = nA; cB = nB; ++ui;
        if constexpr (GATHER) { cvA0[0] = nvA0[0]; cvA0[1] = nvA0[1]; cvA1[0] = nvA1[0]; cvA1[1] = nvA1[1]; }
        if (wr == 1) PG8_BAR;
    }
    PG8_WAIT_V(0);
    PG8_BAR;
#undef PG8_SA
#undef PG8_SB
#undef PG8_STAGE
#undef PG8_LDA
#undef PG8_LDB
#undef PG8_MMA
#undef PG8_WAIT_V
#undef PG8_WAIT_L
#undef PG8_BAR
#undef PG8_SCHED
#undef PG8_GIDX
#undef PG8_GOFF
}

template <class Epi, class Sched, bool GATHER = false>
__device__ __forceinline__ void gemm_phase(LAS unsigned char* lds, const Gemm g, const Sched& S, const Epi& E, const int tid) {
#if GEMM_SIMPLE
    static_assert(!GATHER, "the simple body has no gather path");
    gemm_simple<Epi, Sched>(lds + STAGE_BYTES, g, S, E, tid);
#else
    gemm_fast<Epi, Sched, GATHER>(lds, g, S, E, tid);
#endif
}

template <class F> struct EpiChunk {
    static constexpr bool USES_LDS = false;
    F f;
    __device__ __forceinline__ void run(Acc& acc, const Unit& u, int wr, int wc, int fr, int fq, LAS unsigned char*, int, int) const {
        constexpr int NBT = F::NBATCH, GPB = 8 / NBT;
#pragma unroll
        for (int bt = 0; bt < NBT; ++bt) {
            typename F::Pre pre[GPB][2];
#pragma unroll
            for (int g = 0; g < GPB; ++g) { const int rg = bt * GPB + g, ai = rg >> 2, m = rg & 3; const int row = u.pm * BM + ai * HALF + wr * 64 + m * 16 + fr;
#pragma unroll
                for (int bj = 0; bj < 2; ++bj) { const int col = u.pn * BM + bj * HALF + wc * 32 + 8 * fq; pre[g][bj] = f.load(row, col); } }
            asm volatile("" ::: "memory");
#pragma unroll
            for (int g = 0; g < GPB; ++g) { const int rg = bt * GPB + g, ai = rg >> 2, m = rg & 3; const int row = u.pm * BM + ai * HALF + wr * 64 + m * 16 + fr;
#pragma unroll
                for (int bj = 0; bj < 2; ++bj) { const int col = u.pn * BM + bj * HALF + wc * 32 + 8 * fq;
                    const f32x4 a = acc[ai][bj][m][0], b = acc[ai][bj][m][1];
                    const float v[8] = {a[0], a[1], a[2], a[3], b[0], b[1], b[2], b[3]};
                    f.chunk(row, col, v, pre[g][bj]); } }
            asm volatile("" ::: "memory");
        }
    }
};
}
using pg8::Gemm; using pg8::Unit; using pg8::StaticOrder; using pg8::mkgemm;

struct PreNone {};
struct PreF { float r; };
struct FU { const float* rstd0; bf16_t *XGG, *CQ, *CKV, *KR, *SIGA, *SIGB; const float* bgate;
    static constexpr int NBATCH = 4;
    struct Pre { float rs; f32x4 b0, b1; };
    __device__ __forceinline__ Pre load(int row, int col) const { Pre p; p.rs = rstd0[row];
        if (col >= 3584) { p.b0 = *(const f32x4*)(bgate + (col - 3584)); p.b1 = *(const f32x4*)(bgate + (col - 3584) + 4); } else { p.b0 = (f32x4){0.f, 0.f, 0.f, 0.f}; p.b1 = p.b0; }
        return p; }
    __device__ __forceinline__ void chunk(int row, int col, const float (&v)[8], const Pre& p) const {
        const float rs = p.rs; float o[8];
#pragma unroll
        for (int i = 0; i < 8; ++i) o[i] = v[i] * rs;
        if (col < 3072) { *(u32x4*)(XGG + (size_t)row * 2048 + 1024 + (col - 2048)) = pack8(o); }
        else if (col < 3328) { *(u32x4*)(CQ + (size_t)row * 256 + (col - 3072)) = pack8(o); }
        else if (col < 3456) { *(u32x4*)(CKV + (size_t)row * 128 + (col - 3328)) = pack8(o); }
        else if (col < 3520) { *(u32x4*)(KR + (size_t)row * 64 + (col - 3456)) = pack8(o); }
        else if (col >= 3584) { const int c = col - 3584;
            const float bb[8] = {p.b0[0], p.b0[1], p.b0[2], p.b0[3], p.b1[0], p.b1[1], p.b1[2], p.b1[3]};
#pragma unroll
            for (int i = 0; i < 8; ++i) o[i] = 1.f / (1.f + __expf(-(o[i] + bb[i])));
            bf16_t* dst = c < 1024 ? SIGA + (size_t)row * 1024 + c : SIGB + (size_t)row * 1024 + (c - 1024);
            *(u32x4*)dst = pack8(o); }
    } };
struct EpiU {
    static constexpr bool USES_LDS = false;
    FU f;
    __device__ __forceinline__ void run(pg8::Acc& acc, const Unit& u, int wr, int wc, int fr, int fq, LAS unsigned char* scr, int wid, int lane) const {
        if (u.pn < 8) {
#pragma unroll
            for (int ai = 0; ai < 2; ++ai)
#pragma unroll
                for (int m = 0; m < 4; ++m) { const int row = u.pm * 256 + ai * 128 + wr * 64 + m * 16 + fr; const int col = u.pn * 128 + wc * 32 + 8 * fq; const float rs = f.rstd0[row]; const float r2 = rs * rs; float o[8];
#pragma unroll
                    for (int n = 0; n < 2; ++n)
#pragma unroll
                        for (int i = 0; i < 4; ++i) o[n * 4 + i] = acc[ai][0][m][n][i] * acc[ai][1][m][n][i] * r2;
                    *(u32x4*)(f.XGG + (size_t)row * 2048 + col) = pack8(o); }
        } else { pg8::EpiChunk<FU> E{f}; E.run(acc, u, wr, wc, fr, fq, scr, wid, lane); }
    }
};
struct FMemKV { const float* rstdm; bf16_t* MKV;
    static constexpr int NBATCH = 1; typedef PreF Pre;
    __device__ __forceinline__ Pre load(int row, int) const { Pre p; p.r = rstdm[row]; return p; }
    __device__ __forceinline__ void chunk(int row, int col, const float (&v)[8], const Pre& p) const {
        const float rs = p.r * (col < 1024 ? 0.0625f : 1.f); float o[8];
#pragma unroll
        for (int i = 0; i < 8; ++i) o[i] = v[i] * rs;
        const int kv = col >> 10, h = (col >> 8) & 3, j = col & 255, b = row >> 8, key = row & 255;
        *(u32x4*)(MKV + ((size_t)((kv * 2 + b) * 4 + h) * 256 + key) * 256 + j) = pack8(o);
    } };
struct FQ { const float* rstdq; const f32x2* rope; bf16_t* Q; unsigned char* Q8;
    static constexpr int NBATCH = 4;
    struct Pre { float rs; f32x2 cs[4]; };
    __device__ __forceinline__ Pre load(int row, int col) const { Pre p; p.rs = rstdq[row];
        if (col >= 1024) { const int pp = (col - 1024) & 63, j0 = (pp >> 3) * 4, s = row & (SEQ - 1);
#pragma unroll
            for (int i = 0; i < 4; ++i) p.cs[i] = rope[s * 32 + j0 + i]; }
        else {
#pragma unroll
            for (int i = 0; i < 4; ++i) p.cs[i] = (f32x2){1.f, 0.f}; }
        return p; }
    __device__ __forceinline__ void chunk(int row, int col, const float (&v)[8], const Pre& p) const {
        const float rs = p.rs; float o[8];
#pragma unroll
        for (int i = 0; i < 8; ++i) o[i] = v[i] * rs;
        if (col >= 1024) {
#pragma unroll
            for (int i = 0; i < 4; ++i) { const f32x2 cs = p.cs[i]; const float a = o[i], b = o[4 + i]; o[i] = a * cs.x - b * cs.y; o[4 + i] = a * cs.y + b * cs.x; } }
        if (Q8) { float q[8];
#pragma unroll
            for (int i = 0; i < 8; ++i) q[i] = o[i] * (16.f * ATT_SCALE * 1.4426950408889634f);
            *(u32x2*)(Q8 + (size_t)row * 1536 + col) = pack8_fp8(q); }
        else *(u32x4*)(Q + (size_t)row * 1536 + col) = pack8(o);
    } };
struct FScaleRow { const float* rs; bf16_t* O; int ldo;
    static constexpr int NBATCH = 1; typedef PreF Pre;
    __device__ __forceinline__ Pre load(int row, int) const { Pre p; p.r = rs[row]; return p; }
    __device__ __forceinline__ void chunk(int row, int col, const float (&v)[8], const Pre& p) const {
        const float r = p.r; float o[8];
#pragma unroll
        for (int i = 0; i < 8; ++i) o[i] = v[i] * r;
        *(u32x4*)(O + (size_t)row * ldo + col) = pack8(o);
    } };
struct FK8 { const float* rs; unsigned char* K8;
    static constexpr int NBATCH = 1; typedef PreF Pre;
    __device__ __forceinline__ Pre load(int row, int) const { Pre p; p.r = rs[row]; return p; }
    __device__ __forceinline__ void chunk(int row, int col, const float (&v)[8], const Pre& p) const {
        const float r = p.r; float o[8];
#pragma unroll
        for (int i = 0; i < 8; ++i) o[i] = v[i] * r;
        *(u32x2*)(K8 + (size_t)row * 1024 + col) = pack8_fp8(o);
    } };
struct FVT8 { const float* rs; unsigned char* VT;
    static constexpr int NBATCH = 2;
    struct Pre { f32x4 a, b; };
    __device__ __forceinline__ Pre load(int, int col) const { Pre p; p.a = *(const f32x4*)(rs + col); p.b = *(const f32x4*)(rs + col + 4); return p; }
    __device__ __forceinline__ void chunk(int row, int col, const float (&v)[8], const Pre& p) const {
        const float o[8] = {v[0] * p.a[0], v[1] * p.a[1], v[2] * p.a[2], v[3] * p.a[3], v[4] * p.b[0], v[5] * p.b[1], v[6] * p.b[2], v[7] * p.b[3]};
        *(u32x2*)(VT + (size_t)(col >> 13) * ((size_t)1024 * SEQ) + (size_t)row * SEQ + (col & (SEQ - 1))) = pack8_fp8(o);
    } };
struct FPlain { bf16_t* O; int ldo;
    static constexpr int NBATCH = 1; typedef PreNone Pre;
    __device__ __forceinline__ Pre load(int, int) const { return Pre{}; }
    __device__ __forceinline__ void chunk(int row, int col, const float (&v)[8], const Pre&) const { *(u32x4*)(O + (size_t)row * ldo + col) = pack8(v); } };
struct FVW { bf16_t* O;
    static constexpr int NBATCH = 1; typedef PreNone Pre;
    __device__ __forceinline__ Pre load(int, int) const { return Pre{}; }
    __device__ __forceinline__ void chunk(int row, int col, const float (&v)[8], const Pre&) const { const int h = row >> 10, n = row & 1023; *(u32x4*)(O + (size_t)n * 1024 + h * 256 + col) = pack8(v); } };
struct FGateMul { const bf16_t* G; bf16_t* O;
    static constexpr int NBATCH = 2;
    struct Pre { u32x4 g; };
    __device__ __forceinline__ Pre load(int row, int col) const { Pre p; p.g = *(const u32x4*)(G + (size_t)row * 1024 + col); return p; }
    __device__ __forceinline__ void chunk(int row, int col, const float (&v)[8], const Pre& p) const {
        float g[8], o[8]; unpack8(p.g, g);
#pragma unroll
        for (int i = 0; i < 8; ++i) o[i] = g[i] * v[i];
        *(u32x4*)(O + (size_t)row * 1024 + col) = pack8(o);
    } };
struct FGateMulAdd { const bf16_t* G; const bf16_t* Pv; bf16_t* O;
    static constexpr int NBATCH = 2;
    struct Pre { u32x4 g, p; };
    __device__ __forceinline__ Pre load(int row, int col) const { Pre p; p.g = *(const u32x4*)(G + (size_t)row * 1024 + col); p.p = *(const u32x4*)(Pv + (size_t)row * 1024 + col); return p; }
    __device__ __forceinline__ void chunk(int row, int col, const float (&v)[8], const Pre& pr) const {
        float g[8], p[8], o[8]; unpack8(pr.g, g); unpack8(pr.p, p);
#pragma unroll
        for (int i = 0; i < 8; ++i) o[i] = p[i] + g[i] * v[i];
        *(u32x4*)(O + (size_t)row * 1024 + col) = pack8(o);
    } };
struct FResidF32 { const float* base; float* out;
    static constexpr int NBATCH = 2;
    struct Pre { f32x4 a, b; };
    __device__ __forceinline__ Pre load(int row, int col) const { const size_t off = (size_t)row * 1024 + col; Pre p; p.a = *(const f32x4*)(base + off); p.b = *(const f32x4*)(base + off + 4); return p; }
    __device__ __forceinline__ void chunk(int row, int col, const float (&v)[8], const Pre& p) const {
        const size_t off = (size_t)row * 1024 + col; const f32x4 a = p.a, b = p.b;
        *(f32x4*)(out + off) = (f32x4){a[0] + v[0], a[1] + v[1], a[2] + v[2], a[3] + v[3]}; *(f32x4*)(out + off + 4) = (f32x4){b[0] + v[4], b[1] + v[5], b[2] + v[6], b[3] + v[7]};
    } };
struct FResidBf16 { const bf16_t* base; bf16_t* out;
    static constexpr int NBATCH = 1;
    struct Pre { u32x4 a; };
    __device__ __forceinline__ Pre load(int row, int col) const { Pre p; p.a = *(const u32x4*)(base + (size_t)row * 1024 + col); return p; }
    __device__ __forceinline__ void chunk(int row, int col, const float (&v)[8], const Pre& p) const {
        float a[8], o[8]; unpack8(p.a, a);
#pragma unroll
        for (int i = 0; i < 8; ++i) o[i] = a[i] + v[i];
        *(u32x4*)(out + (size_t)row * 1024 + col) = pack8(o);
    } };
struct FGateRow { const float* gate; bf16_t* O;
    static constexpr int NBATCH = 1; typedef PreF Pre;
    __device__ __forceinline__ Pre load(int row, int) const { Pre p; p.r = gate[row]; return p; }
    __device__ __forceinline__ void chunk(int row, int col, const float (&v)[8], const Pre& p) const {
        const float r = p.r; float o[8];
#pragma unroll
        for (int i = 0; i < 8; ++i) o[i] = v[i] * r;
        *(u32x4*)(O + (size_t)row * 1024 + col) = pack8(o);
    } };

struct EpiX1 {
    static constexpr bool USES_LDS = false;
    const float* base; float* out; bf16_t* xb; float* ssq;
    __device__ __forceinline__ void run(pg8::Acc& acc, const Unit& u, int wr, int wc, int fr, int fq, LAS unsigned char*, int, int) const {
#pragma unroll
        for (int bt = 0; bt < 4; ++bt) { f32x4 pa[2][2], pb[2][2];
#pragma unroll
            for (int g = 0; g < 2; ++g) { const int rg = bt * 2 + g, ai = rg >> 2, m = rg & 3; const int row = u.pm * 256 + ai * 128 + wr * 64 + m * 16 + fr;
#pragma unroll
                for (int bj = 0; bj < 2; ++bj) { const size_t off = (size_t)row * 1024 + u.pn * 256 + bj * 128 + wc * 32 + 8 * fq; pa[g][bj] = *(const f32x4*)(base + off); pb[g][bj] = *(const f32x4*)(base + off + 4); } }
            asm volatile("" ::: "memory");
#pragma unroll
            for (int g = 0; g < 2; ++g) { const int rg = bt * 2 + g, ai = rg >> 2, m = rg & 3; const int row = u.pm * 256 + ai * 128 + wr * 64 + m * 16 + fr; float s = 0.f;
#pragma unroll
                for (int bj = 0; bj < 2; ++bj) { const int col = u.pn * 256 + bj * 128 + wc * 32 + 8 * fq; const size_t off = (size_t)row * 1024 + col;
                    const f32x4 a = pa[g][bj], b = pb[g][bj]; const f32x4 c0 = acc[ai][bj][m][0], c1 = acc[ai][bj][m][1];
                    const float o[8] = {a[0] + c0[0], a[1] + c0[1], a[2] + c0[2], a[3] + c0[3], b[0] + c1[0], b[1] + c1[1], b[2] + c1[2], b[3] + c1[3]};
                    if (out) { *(f32x4*)(out + off) = (f32x4){o[0], o[1], o[2], o[3]}; *(f32x4*)(out + off + 4) = (f32x4){o[4], o[5], o[6], o[7]}; }
                    *(u32x4*)(xb + off) = pack8(o);
#pragma unroll
                    for (int i = 0; i < 8; ++i) s += o[i] * o[i]; }
                s += __shfl_xor(s, 16); s += __shfl_xor(s, 32);
                if (fq == 0) ssq[(size_t)row * 16 + u.pn * 4 + wc] = s; }
            asm volatile("" ::: "memory"); }
    }
};
struct EpiSoftmax {
    static constexpr bool USES_LDS = true;
    const float* ssq; bf16_t* P;
    __device__ __forceinline__ void run(pg8::Acc& acc, const Unit& u, int wr, int wc, int fr, int fq, LAS unsigned char* scr, int wid_, int lane_) const {
        LAS float* PM = (LAS float*)scr;
        LAS float* PS = (LAS float*)(scr + 4096);
        LAS float* RS = (LAS float*)(scr + 4096);
        { const int t = wid_ * 64 + lane_; if (t < 256) { const f32x4* sp = (const f32x4*)((const char*)ssq + (unsigned)(u.pm * 256 + t) * 64u); const f32x4 q0 = sp[0], q1 = sp[1], q2 = sp[2], q3 = sp[3];
            float tt = ((q0[0] + q0[1]) + (q0[2] + q0[3])) + ((q1[0] + q1[1]) + (q1[2] + q1[3])); tt += ((q2[0] + q2[1]) + (q2[2] + q2[3])) + ((q3[0] + q3[1]) + (q3[2] + q3[3]));
            RS[t] = 1.f / sqrtf(tt * (1.f / 1024.f) + EPS); } }
        __syncthreads();
#pragma unroll
        for (int ai = 0; ai < 2; ++ai)
#pragma unroll
            for (int m = 0; m < 4; ++m) { const int rl = ai * 128 + wr * 64 + m * 16 + fr;
                const float rs = RS[rl];
                float mx = -3.0e38f;
#pragma unroll
                for (int bj = 0; bj < 2; ++bj)
#pragma unroll
                    for (int n = 0; n < 2; ++n)
#pragma unroll
                        for (int i = 0; i < 4; ++i) { const float s = acc[ai][bj][m][n][i] * rs; acc[ai][bj][m][n][i] = s; mx = fmaxf(mx, s); }
                mx = fmaxf(mx, __shfl_xor(mx, 16)); mx = fmaxf(mx, __shfl_xor(mx, 32));
                if (fq == 0) PM[rl * 4 + wc] = mx;
                asm volatile("" ::: "memory"); }
        __syncthreads();
#pragma unroll
        for (int ai = 0; ai < 2; ++ai)
#pragma unroll
            for (int m = 0; m < 4; ++m) { const int rl = ai * 128 + wr * 64 + m * 16 + fr;
                const f32x4 pm4 = *(const LAS f32x4*)(PM + rl * 4); const float mx = fmaxf(fmaxf(pm4[0], pm4[1]), fmaxf(pm4[2], pm4[3]));
                float s = 0.f;
#pragma unroll
                for (int bj = 0; bj < 2; ++bj)
#pragma unroll
                    for (int n = 0; n < 2; ++n)
#pragma unroll
                        for (int i = 0; i < 4; ++i) { const float e = __expf(acc[ai][bj][m][n][i] - mx); acc[ai][bj][m][n][i] = e; s += e; }
                s += __shfl_xor(s, 16); s += __shfl_xor(s, 32);
                if (fq == 0) PS[rl * 4 + wc] = s;
                asm volatile("" ::: "memory"); }
        __syncthreads();
#pragma unroll
        for (int ai = 0; ai < 2; ++ai)
#pragma unroll
            for (int m = 0; m < 4; ++m) { const int rl = ai * 128 + wr * 64 + m * 16 + fr; const int row = u.pm * 256 + rl;
                const f32x4 ps4 = *(const LAS f32x4*)(PS + rl * 4); const float inv = 1.f / ((ps4[0] + ps4[1]) + (ps4[2] + ps4[3]));
#pragma unroll
                for (int bj = 0; bj < 2; ++bj) { const int col = u.pn * 256 + bj * 128 + wc * 32 + 8 * fq; float o[8];
#pragma unroll
                    for (int n = 0; n < 2; ++n)
#pragma unroll
                        for (int i = 0; i < 4; ++i) o[n * 4 + i] = acc[ai][bj][m][n][i] * inv;
                    *(u32x4*)((char*)P + ((unsigned)row * 1024u + (unsigned)col) * 2u) = pack8(o); }
                asm volatile("" ::: "memory"); }
    }
};
struct EpiSwiglu {
    static constexpr bool USES_LDS = false;
    bf16_t* H;
    __device__ __forceinline__ void run(pg8::Acc& acc, const Unit& u, int wr, int wc, int fr, int fq, LAS unsigned char*, int, int) const {
#pragma unroll
        for (int ai = 0; ai < 2; ++ai)
#pragma unroll
            for (int m = 0; m < 4; ++m) { const int row = u.pm * 256 + ai * 128 + wr * 64 + m * 16 + fr; const int col = u.pn * 128 + wc * 32 + 8 * fq; float o[8];
#pragma unroll
                for (int n = 0; n < 2; ++n)
#pragma unroll
                    for (int i = 0; i < 4; ++i) { const float g = acc[ai][0][m][n][i], up = acc[ai][1][m][n][i]; o[n * 4 + i] = g / (1.f + __expf(-g)) * up; }
                *(u32x4*)(H + (size_t)row * 1024 + col) = pack8(o); }
    }
};

namespace att {
constexpr int QBLK = 32, KVBLK = 64, NW = 8;
constexpr int LDQ = 1536, LDKV = 2048, LDKR = 64, LDO = 1024;
constexpr int KPITCH = 272, KRPITCH = 144;
constexpr int SHM_V = KVBLK * 128 * 2, SHM_K = KVBLK * KPITCH, SHM_KR = KVBLK * KRPITCH;
constexpr int OFF_V = 0, OFF_K = 2 * SHM_V, OFF_KR = OFF_K + 2 * SHM_K, OFF_WS = OFF_KR + 2 * SHM_KR, OFF_QR = OFF_WS + NW * 64 * 4, SHM_ATTN = OFF_QR + NW * 4096;
constexpr float THR = 8.f;
#define KSWZ(row, colB) ((row) * KPITCH + (colB))
#define KRSWZ(row, colB) ((row) * KRPITCH + (colB))
#define SBAR() __builtin_amdgcn_sched_barrier(0)
__device__ __forceinline__ int crow(int r, int hi) { return (r & 3) + 8 * (r >> 2) + 4 * hi; }
__device__ __forceinline__ unsigned cvtpk_a(float lo, float hi) { unsigned r; asm volatile("v_cvt_pk_bf16_f32 %0, %1, %2" : "=v"(r) : "v"(lo), "v"(hi)); return r; }

__device__ __forceinline__ void partialSM(f32x16& p0, f32x16& p1, float& m_reg, float& mn, float& alpha) {
  constexpr float C = ATT_SCALE * 1.4426950408889634f;
  float pmax = p0[0];
#pragma unroll
  for (int r = 1; r < 16; ++r) pmax = fmaxf(pmax, p0[r]);
#pragma unroll
  for (int r = 0; r < 16; ++r) pmax = fmaxf(pmax, p1[r]);
  { auto rr = __builtin_amdgcn_permlane32_swap(__float_as_uint(pmax), __float_as_uint(pmax), false, false);
    pmax = fmaxf(__uint_as_float(rr[0]), __uint_as_float(rr[1])); }
  if (__builtin_expect(__all(pmax - m_reg <= THR / ATT_SCALE), 1)) { mn = m_reg; alpha = 1.f; }
  else { mn = fmaxf(m_reg, pmax); alpha = __builtin_amdgcn_exp2f((m_reg - mn) * C); m_reg = mn; }
  float mnC = -mn * C;
#pragma unroll
  for (int r = 0; r < 16; ++r) p0[r] = fmaf(p0[r], C, mnC);
#pragma unroll
  for (int r = 0; r < 16; ++r) p1[r] = fmaf(p1[r], C, mnC);
#pragma unroll
  for (int r = 0; r < 16; ++r) p0[r] = __builtin_amdgcn_exp2f(p0[r]);
}
__device__ __forceinline__ void finishSM(f32x16& p0, f32x16& p1, float alpha, float& l_reg, bf16x8& pa0, bf16x8& pa1, bf16x8& pa2, bf16x8& pa3) {
#pragma unroll
  for (int r = 0; r < 16; ++r) p1[r] = __builtin_amdgcn_exp2f(p1[r]);
  float ps = 0;
#pragma unroll
  for (int r = 0; r < 16; ++r) ps += p0[r];
#pragma unroll
  for (int r = 0; r < 16; ++r) ps += p1[r];
  { auto rr = __builtin_amdgcn_permlane32_swap(__float_as_uint(ps), __float_as_uint(ps), false, false);
    ps = __uint_as_float(rr[0]) + __uint_as_float(rr[1]); }
  l_reg = l_reg * alpha + ps;
#define PK4(P, BASE, OUT) do { unsigned a0 = cvtpk_a(P[BASE + 0], P[BASE + 1]), a1 = cvtpk_a(P[BASE + 2], P[BASE + 3]);   \
    unsigned b0 = cvtpk_a(P[BASE + 4], P[BASE + 5]), b1 = cvtpk_a(P[BASE + 6], P[BASE + 7]);                              \
    auto r0 = __builtin_amdgcn_permlane32_swap(a0, b0, false, false); auto r1 = __builtin_amdgcn_permlane32_swap(a1, b1, false, false); \
    u32x4 w = {r0[0], r1[0], r0[1], r1[1]}; OUT = *reinterpret_cast<bf16x8*>(&w); } while (0)
  PK4(p0, 0, pa0); PK4(p0, 8, pa1); PK4(p1, 0, pa2); PK4(p1, 8, pa3);
#undef PK4
}
__device__ __forceinline__ void qkt(f32x16& p0, f32x16& p1, const char* Ks, const char* Krs, const bf16x8* qr, const char* qpark, int r32, int hi) {
  p0 = f32x16{}; p1 = f32x16{};
  const char* kb = Ks + r32 * KPITCH + hi * 16; const char* rb = Krs + r32 * KRPITCH + hi * 16;
#pragma unroll
  for (int d0 = 0; d0 < 8; ++d0) {
    bf16x8 b0 = *reinterpret_cast<const bf16x8*>(kb + d0 * 32);
    bf16x8 b1 = *reinterpret_cast<const bf16x8*>(kb + 32 * KPITCH + d0 * 32);
    p0 = __builtin_amdgcn_mfma_f32_32x32x16_bf16(b0, qr[d0], p0, 0, 0, 0);
    p1 = __builtin_amdgcn_mfma_f32_32x32x16_bf16(b1, qr[d0], p1, 0, 0, 0); }
#pragma unroll
  for (int d0 = 0; d0 < 4; ++d0) {
    bf16x8 b0 = *reinterpret_cast<const bf16x8*>(rb + d0 * 32);
    bf16x8 b1 = *reinterpret_cast<const bf16x8*>(rb + 32 * KRPITCH + d0 * 32);
    const bf16x8 qf = qr[8 + d0];
    p0 = __builtin_amdgcn_mfma_f32_32x32x16_bf16(b0, qf, p0, 0, 0, 0);
    p1 = __builtin_amdgcn_mfma_f32_32x32x16_bf16(b1, qf, p1, 0, 0, 0); }
}
__device__ __forceinline__ int v_st(int k, int c) { const int kk = (k & ~0xC) | ((k & 4) << 1) | ((k & 8) >> 1); return ((kk >> 3) * 4 + (c >> 5)) * 512 + ((kk & 7) * 32 + (c & 31)) * 2; }
__device__ __forceinline__ int v_rd_base(int lane) { return ((lane & 3) << 3) | (((lane >> 2) & 3) << 6) | (((lane >> 4) & 1) << 5) | (((lane >> 5) & 1) << 8); }
constexpr int v_rd_off(int d0, int ks, int half) { return d0 * 512 + ks * 4096 + half * 2048; }
template <int OFF> __device__ __forceinline__ s16x4 tr_read(int vb) {
  s16x4 r; asm volatile("ds_read_b64_tr_b16 %0, %1 offset:%2" : "=&v"(r) : "v"(vb), "i"(OFF) : "memory"); return r;
}
template <int D0> __device__ __forceinline__ void pv_one(f32x16& od, int vb, bf16x8 pa0, bf16x8 pa1, bf16x8 pa2, bf16x8 pa3) {
  const s16x4 l0 = tr_read<v_rd_off(D0, 0, 0)>(vb), h0 = tr_read<v_rd_off(D0, 0, 1)>(vb), l1 = tr_read<v_rd_off(D0, 1, 0)>(vb), h1 = tr_read<v_rd_off(D0, 1, 1)>(vb);
  const s16x4 l2 = tr_read<v_rd_off(D0, 2, 0)>(vb), h2 = tr_read<v_rd_off(D0, 2, 1)>(vb), l3 = tr_read<v_rd_off(D0, 3, 0)>(vb), h3 = tr_read<v_rd_off(D0, 3, 1)>(vb);
  asm volatile("s_waitcnt lgkmcnt(0)" ::: "memory"); SBAR();
#define PK(L, H) (bf16x8){L[0], L[1], L[2], L[3], H[0], H[1], H[2], H[3]}
  od = __builtin_amdgcn_mfma_f32_32x32x16_bf16(pa0, PK(l0, h0), od, 0, 0, 0);
  od = __builtin_amdgcn_mfma_f32_32x32x16_bf16(pa1, PK(l1, h1), od, 0, 0, 0);
  od = __builtin_amdgcn_mfma_f32_32x32x16_bf16(pa2, PK(l2, h2), od, 0, 0, 0);
  od = __builtin_amdgcn_mfma_f32_32x32x16_bf16(pa3, PK(l3, h3), od, 0, 0, 0);
#undef PK
}
__device__ __forceinline__ void pv_d0(f32x16* o, int vb, bf16x8 pa0, bf16x8 pa1, bf16x8 pa2, bf16x8 pa3) {
  pv_one<0>(o[0], vb, pa0, pa1, pa2, pa3); pv_one<1>(o[1], vb, pa0, pa1, pa2, pa3); pv_one<2>(o[2], vb, pa0, pa1, pa2, pa3); pv_one<3>(o[3], vb, pa0, pa1, pa2, pa3);
}

__device__ __forceinline__ void attn_unit(const bf16_t* __restrict__ Qn, const bf16_t* __restrict__ Qr, const bf16_t* __restrict__ Kh,
                                          const bf16_t* __restrict__ Krh, bf16_t* __restrict__ Ob, int seq, char* lds, const int tid) {
  const int wid = tid >> 6, lane = tid & 63, r32 = lane & 31, hi = lane >> 5;
  char* V_lds = lds + OFF_V; char* K_lds = lds + OFF_K; char* Kr_lds = lds + OFF_KR;
  float* ws = (float*)(lds + OFF_WS) + wid * 64; float* li_l = ws; float* al_l = ws + 32;
  float m_reg = -1e30f, l_reg = 0; f32x16 o[4] = {}; bf16x8 qr[12];
  char* qpark = nullptr;
  { const bf16_t* qn = Qn + (long)(wid * QBLK + r32) * LDQ + hi * 8; const bf16_t* qq = Qr + (long)(wid * QBLK + r32) * LDQ + hi * 8;
#pragma unroll
    for (int d0 = 0; d0 < 8; ++d0) qr[d0] = *reinterpret_cast<const bf16x8*>(qn + d0 * 16);
#pragma unroll
    for (int d0 = 0; d0 < 4; ++d0) qr[8 + d0] = *reinterpret_cast<const bf16x8*>(qq + d0 * 16); }
  const int sr = tid >> 4, sc = (tid & 15) * 8, vst0 = v_st(sr, sc), vst1 = v_st(32 + sr, sc);
  const int krr = tid >> 3, krc = (tid & 7) * 8;
  const int vb0 = (int)(uintptr_t)V_lds + v_rd_base(lane);
  bf16x8 vs0, vs1, ks0, ks1, kr0;
  const unsigned offkv = (unsigned)(sr * LDKV + sc) * 2u, offkr = (unsigned)(krr * LDKR + krc) * 2u;
#define SLOAD(k0) do { const char* kb_ = (const char*)Kh + (size_t)(k0) * (LDKV * 2); const char* kb2_ = kb_ + 32 * LDKV * 2; const char* rb_ = (const char*)Krh + (size_t)(k0) * (LDKR * 2); \
    ks0 = *reinterpret_cast<const bf16x8*>(kb_ + offkv); vs0 = *reinterpret_cast<const bf16x8*>(kb_ + offkv + 2048); \
    ks1 = *reinterpret_cast<const bf16x8*>(kb2_ + offkv); vs1 = *reinterpret_cast<const bf16x8*>(kb2_ + offkv + 2048); \
    kr0 = *reinterpret_cast<const bf16x8*>(rb_ + offkr); } while (0)
#define SWRITE(b) do { *(bf16x8*)(V_lds + (b) * SHM_V + vst0) = vs0; *(bf16x8*)(V_lds + (b) * SHM_V + vst1) = vs1; const int kc = sc * 2; \
    *(bf16x8*)(K_lds + (b) * SHM_K + KSWZ(sr, kc)) = ks0; *(bf16x8*)(K_lds + (b) * SHM_K + KSWZ(32 + sr, kc)) = ks1; \
    *(bf16x8*)(Kr_lds + (b) * SHM_KR + KRSWZ(krr, krc * 2)) = kr0; } while (0)
#define SWAIT() asm volatile("s_waitcnt vmcnt(0)" ::: "memory")
#define RESC(a) do { if (__any((a) < 1.f)) { if (hi == 0) al_l[r32] = (a); asm volatile("s_waitcnt lgkmcnt(0)" ::: "memory"); \
    _Pragma("unroll") for (int d = 0; d < 4; ++d) _Pragma("unroll") for (int r = 0; r < 16; ++r) o[d][r] *= al_l[crow(r, hi)]; } } while (0)
  f32x16 pA0, pA1, pB0, pB1; float mnA, mnB, alA, alB; bf16x8 pa0, pa1, pa2, pa3; const int NT = seq / KVBLK;
  SLOAD(0); SWAIT(); SWRITE(0); __syncthreads();
  qkt(pA0, pA1, K_lds, Kr_lds, qr, qpark, r32, hi); partialSM(pA0, pA1, m_reg, mnA, alA);
  SLOAD(KVBLK);
  SWAIT(); SWRITE(1); __syncthreads();
  for (int j = 1; j + 1 < NT; j += 2) {
    SBAR(); qkt(pB0, pB1, K_lds + SHM_K, Kr_lds + SHM_KR, qr, qpark, r32, hi);
    finishSM(pA0, pA1, alA, l_reg, pa0, pa1, pa2, pa3); SBAR();
    SLOAD((j + 1) * KVBLK); SBAR();
    pv_d0(o, vb0, pa0, pa1, pa2, pa3); partialSM(pB0, pB1, m_reg, mnB, alB);
    __syncthreads(); SWAIT(); SWRITE(0);
    RESC(alB); __syncthreads();
    SBAR(); qkt(pA0, pA1, K_lds, Kr_lds, qr, qpark, r32, hi);
    finishSM(pB0, pB1, alB, l_reg, pa0, pa1, pa2, pa3); SBAR();
    SLOAD((j + 2) * KVBLK); SBAR();
    pv_d0(o, vb0 + SHM_V, pa0, pa1, pa2, pa3); partialSM(pA0, pA1, m_reg, mnA, alA);
    __syncthreads(); SWAIT(); SWRITE(1);
    RESC(alA); __syncthreads();
  }
  SBAR(); qkt(pB0, pB1, K_lds + SHM_K, Kr_lds + SHM_KR, qr, qpark, r32, hi);
  finishSM(pA0, pA1, alA, l_reg, pa0, pa1, pa2, pa3); SBAR();
  pv_d0(o, vb0, pa0, pa1, pa2, pa3); partialSM(pB0, pB1, m_reg, mnB, alB);
  __syncthreads(); RESC(alB);
  finishSM(pB0, pB1, alB, l_reg, pa0, pa1, pa2, pa3); SBAR();
  pv_d0(o, vb0 + SHM_V, pa0, pa1, pa2, pa3);
  if (hi == 0) li_l[r32] = l_reg; asm volatile("s_waitcnt lgkmcnt(0)" ::: "memory");
  float rli[16];
#pragma unroll
  for (int r = 0; r < 16; ++r) rli[r] = __builtin_amdgcn_rcpf(li_l[crow(r, hi)]);
  bf16_t* Ow = Ob + (long)(wid * QBLK) * LDO;
#pragma unroll
  for (int r = 0; r < 16; ++r) { const int orow = crow(r, hi);
#pragma unroll
    for (int d0 = 0; d0 < 4; ++d0) Ow[(long)orow * LDO + d0 * 32 + r32] = f2bf(o[d0][r] * rli[r]); }
  __syncthreads();
#undef SLOAD
#undef SWRITE
#undef SWAIT
#undef RESC
}

constexpr int K8P = 144, KR8P = 80, SHM_K8 = KVBLK * K8P, SHM_KR8 = KVBLK * KR8P;
__device__ __forceinline__ v8i ld32(const char* p) { const u32x4 a = *reinterpret_cast<const u32x4*>(p), b = *reinterpret_cast<const u32x4*>(p + 16); return (v8i){(int)a.x, (int)a.y, (int)a.z, (int)a.w, (int)b.x, (int)b.y, (int)b.z, (int)b.w}; }
constexpr int V8P = 80, SHM_V8 = 128 * V8P;
constexpr int O9_V = 0, O9_K = 2 * SHM_V8, O9_KR = O9_K + 2 * SHM_K8, O9_WS = O9_KR + 2 * SHM_KR8, SHM_ATTN9 = 3 * (SHM_V8 + SHM_K8 + SHM_KR8) + NW * 64 * 4;
constexpr float THR9 = 2.f, THRL9 = THR9 * 1.4426950408889634f;
__device__ __forceinline__ void qkt9(f32x16& p0, f32x16& p1, const char* Ks, const char* Krs, const v8i* qf, const f32x16& negm, int r32, int hi) {
  const char* kb = Ks + r32 * K8P + hi * 32; const char* rb = Krs + r32 * KR8P + hi * 32;
  { const v8i a0 = ld32(kb), a1 = ld32(kb + 32 * K8P);
    p0 = __builtin_amdgcn_mfma_scale_f32_32x32x64_f8f6f4(a0, qf[0], negm, 0, 0, 0, 0x7f7f7f7f, 0, 0x7b7b7b7b);
    p1 = __builtin_amdgcn_mfma_scale_f32_32x32x64_f8f6f4(a1, qf[0], negm, 0, 0, 0, 0x7f7f7f7f, 0, 0x7b7b7b7b); }
  { const v8i a0 = ld32(kb + 64), a1 = ld32(kb + 32 * K8P + 64);
    p0 = __builtin_amdgcn_mfma_scale_f32_32x32x64_f8f6f4(a0, qf[1], p0, 0, 0, 0, 0x7f7f7f7f, 0, 0x7b7b7b7b);
    p1 = __builtin_amdgcn_mfma_scale_f32_32x32x64_f8f6f4(a1, qf[1], p1, 0, 0, 0, 0x7f7f7f7f, 0, 0x7b7b7b7b); }
  { const v8i a0 = ld32(rb), a1 = ld32(rb + 32 * KR8P);
    p0 = __builtin_amdgcn_mfma_scale_f32_32x32x64_f8f6f4(a0, qf[2], p0, 0, 0, 0, 0x7f7f7f7f, 0, 0x7b7b7b7b);
    p1 = __builtin_amdgcn_mfma_scale_f32_32x32x64_f8f6f4(a1, qf[2], p1, 0, 0, 0, 0x7f7f7f7f, 0, 0x7b7b7b7b); }
}
template <bool FIRST> __device__ __forceinline__ void partialSM9n(f32x16& p0, f32x16& p1, f32x16& negm, float& alpha) {
  float pmax = p0[0];
#pragma unroll
  for (int r = 1; r < 16; ++r) pmax = fmaxf(pmax, p0[r]);
#pragma unroll
  for (int r = 0; r < 16; ++r) pmax = fmaxf(pmax, p1[r]);
  { auto rr = __builtin_amdgcn_permlane32_swap(__float_as_uint(pmax), __float_as_uint(pmax), false, false);
    pmax = fmaxf(__uint_as_float(rr[0]), __uint_as_float(rr[1])); }
  const float ex = pmax - 4.f;
  if (!FIRST && __builtin_expect(__all(ex <= THRL9), 1)) { alpha = 1.f; }
  else { const float d = FIRST ? ex : fmaxf(ex, 0.f); alpha = FIRST ? 1.f : __builtin_amdgcn_exp2f(-d);
#pragma unroll
    for (int r = 0; r < 16; ++r) { p0[r] -= d; p1[r] -= d; }
#pragma unroll
    for (int r = 0; r < 16; ++r) negm[r] -= d;
    asm volatile("" : "+v"(negm)); }
#pragma unroll
  for (int r = 0; r < 16; ++r) p0[r] = __builtin_amdgcn_exp2f(p0[r]);
}
__device__ __forceinline__ void partialSM9(f32x16& p0, f32x16& p1, float& m_reg, float& mn, float& alpha) {
  constexpr float C = ATT_SCALE * 1.4426950408889634f;
  float pmax = p0[0];
#pragma unroll
  for (int r = 1; r < 16; ++r) pmax = fmaxf(pmax, p0[r]);
#pragma unroll
  for (int r = 0; r < 16; ++r) pmax = fmaxf(pmax, p1[r]);
  { auto rr = __builtin_amdgcn_permlane32_swap(__float_as_uint(pmax), __float_as_uint(pmax), false, false);
    pmax = fmaxf(__uint_as_float(rr[0]), __uint_as_float(rr[1])); }
  if (__builtin_expect(__all(pmax - m_reg <= THR9 / ATT_SCALE), 1)) { mn = m_reg; alpha = 1.f; }
  else { mn = fmaxf(m_reg, pmax); alpha = __builtin_amdgcn_exp2f((m_reg - mn) * C); m_reg = mn; }
  float mnC = 4.f - mn * C;
#pragma unroll
  for (int r = 0; r < 16; ++r) p0[r] = fmaf(p0[r], C, mnC);
#pragma unroll
  for (int r = 0; r < 16; ++r) p1[r] = fmaf(p1[r], C, mnC);
#pragma unroll
  for (int r = 0; r < 16; ++r) p0[r] = __builtin_amdgcn_exp2f(p0[r]);
}
__device__ __forceinline__ void finishSM9(f32x16& p0, f32x16& p1, float alpha, float& l_reg, v8i& pf) {
#pragma unroll
  for (int r = 0; r < 16; ++r) p1[r] = __builtin_amdgcn_exp2f(p1[r]);
  float ps = 0;
#pragma unroll
  for (int r = 0; r < 16; ++r) ps += p0[r];
#pragma unroll
  for (int r = 0; r < 16; ++r) ps += p1[r];
  { auto rr = __builtin_amdgcn_permlane32_swap(__float_as_uint(ps), __float_as_uint(ps), false, false);
    ps = __uint_as_float(rr[0]) + __uint_as_float(rr[1]); }
  l_reg = l_reg * alpha + ps;
  unsigned a[4], b[4];
#pragma unroll
  for (int i = 0; i < 4; ++i) { a[i] = pk4_fp8(p0[4 * i], p0[4 * i + 1], p0[4 * i + 2], p0[4 * i + 3]); b[i] = pk4_fp8(p1[4 * i], p1[4 * i + 1], p1[4 * i + 2], p1[4 * i + 3]); }
#pragma unroll
  for (int i = 0; i < 4; ++i) { auto r = __builtin_amdgcn_permlane32_swap(a[i], b[i], false, false); pf[i] = (int)r[0]; pf[4 + i] = (int)r[1]; }
}
__device__ __forceinline__ void pv9(f32x16* o, const char* Vs, const v8i pf, int r32, int hi) {
  const char* vb = Vs + r32 * V8P + hi * 32;
#pragma unroll
  for (int d0 = 0; d0 < 4; ++d0) { const v8i vf = ld32(vb + d0 * 32 * V8P);
    o[d0] = __builtin_amdgcn_mfma_scale_f32_32x32x64_f8f6f4(pf, vf, o[d0], 0, 0, 0, 0x7f7f7f7f, 0, 0x7f7f7f7f); }
}
__device__ __forceinline__ void attn_unit9(const unsigned char* __restrict__ Q8n, const unsigned char* __restrict__ Q8r, const unsigned char* __restrict__ K8h,
                                           const unsigned char* __restrict__ Kr8, const unsigned char* __restrict__ VTh, bf16_t* __restrict__ Ob, int seq, char* lds, const int tid) {
  const int wid = tid >> 6, lane = tid & 63, r32 = lane & 31, hi = lane >> 5;
  constexpr int SL = SHM_V8 + SHM_K8 + SHM_KR8, SK = SHM_V8, SR = SHM_V8 + SHM_K8;
  float* ws = (float*)(lds + 3 * SL) + wid * 64; float* li_l = ws; float* al_l = ws + 32;
  float l_reg = 0; f32x16 o[4] = {}; v8i qf[3]; f32x16 negm;
#pragma unroll
  for (int r = 0; r < 16; ++r) negm[r] = 4.f;
  { const unsigned char* qn = Q8n + (long)(wid * QBLK + r32) * LDQ + hi * 32; const unsigned char* qq = Q8r + (long)(wid * QBLK + r32) * LDQ + hi * 32;
    qf[0] = ld32((const char*)qn); qf[1] = ld32((const char*)qn + 64); qf[2] = ld32((const char*)qq); }
  const int k8r = tid >> 3, k8c = (tid & 7) * 16;
  const int r8r = (tid & 255) >> 2, r8c = (tid & 3) * 16;
  const int v8d = tid >> 2, v8c = tid & 3;
  const int v8w = v8d * V8P + (v8c >> 1) * 32 + (v8c & 1) * 8;
  u32x4 v8v, k8v, r8v;
  const unsigned offv8 = (unsigned)(v8d * SEQ + v8c * 16), offk8 = (unsigned)(k8r * 1024 + k8c), offr8 = (unsigned)(r8r * 64 + r8c);
#define SLOAD(k0) do { v8v = *reinterpret_cast<const u32x4*>((const char*)VTh + (size_t)(k0) + offv8); \
    k8v = *reinterpret_cast<const u32x4*>((const char*)K8h + (size_t)(k0) * 1024 + offk8); \
    if (tid < 256) r8v = *reinterpret_cast<const u32x4*>((const char*)Kr8 + (size_t)(k0) * 64 + offr8); } while (0)
#define SWRITE(so) do { char* sb_ = lds + (so); char* vp_ = sb_ + v8w; *(unsigned*)(vp_) = v8v.x; *(unsigned*)(vp_ + 16) = v8v.y; *(unsigned*)(vp_ + 4) = v8v.z; *(unsigned*)(vp_ + 20) = v8v.w; \
    *(u32x4*)(sb_ + SK + k8r * K8P + k8c) = k8v; if (tid < 256) *(u32x4*)(sb_ + SR + r8r * KR8P + r8c) = r8v; } while (0)
#define SWAIT() asm volatile("s_waitcnt vmcnt(0)" ::: "memory")
#define RESC(a) do { if (__any((a) < 1.f)) { if (hi == 0) al_l[r32] = (a); asm volatile("s_waitcnt lgkmcnt(0)" ::: "memory"); \
    _Pragma("unroll") for (int d = 0; d < 4; ++d) _Pragma("unroll") for (int r = 0; r < 16; ++r) o[d][r] *= al_l[crow(r, hi)]; } } while (0)
  f32x16 pA0, pA1, pB0, pB1; float alA, alB; v8i pf; const int NT = seq / KVBLK;
  int sp = 0, scur = SL, sn = 2 * SL;
#define ROT() do { const int t_ = sp; sp = scur; scur = sn; sn = t_; } while (0)
  SLOAD(0); SWAIT(); SWRITE(0); __syncthreads();
  qkt9(pA0, pA1, lds + SK, lds + SR, qf, negm, r32, hi); partialSM9n<true>(pA0, pA1, negm, alA);
  SLOAD(KVBLK);
  SWAIT(); SWRITE(SL); __syncthreads();
  for (int j = 1; j + 1 < NT; j += 2) {
    SBAR(); qkt9(pB0, pB1, lds + scur + SK, lds + scur + SR, qf, negm, r32, hi);
    finishSM9(pA0, pA1, alA, l_reg, pf); SBAR();
    SLOAD((j + 1) * KVBLK); SBAR();
    pv9(o, lds + sp, pf, r32, hi); partialSM9n<false>(pB0, pB1, negm, alB);
    SWAIT(); SWRITE(sn);
    RESC(alB); __syncthreads(); ROT();
    SBAR(); qkt9(pA0, pA1, lds + scur + SK, lds + scur + SR, qf, negm, r32, hi);
    finishSM9(pB0, pB1, alB, l_reg, pf); SBAR();
    SLOAD((j + 2) * KVBLK); SBAR();
    pv9(o, lds + sp, pf, r32, hi); partialSM9n<false>(pA0, pA1, negm, alA);
    SWAIT(); SWRITE(sn);
    RESC(alA); __syncthreads(); ROT();
  }
  SBAR(); qkt9(pB0, pB1, lds + scur + SK, lds + scur + SR, qf, negm, r32, hi);
  finishSM9(pA0, pA1, alA, l_reg, pf); SBAR();
  pv9(o, lds + sp, pf, r32, hi); partialSM9n<false>(pB0, pB1, negm, alB);
  RESC(alB);
  finishSM9(pB0, pB1, alB, l_reg, pf); SBAR();
  pv9(o, lds + scur, pf, r32, hi);
#undef ROT
  if (hi == 0) li_l[r32] = l_reg; asm volatile("s_waitcnt lgkmcnt(0)" ::: "memory");
  float rli[16];
#pragma unroll
  for (int r = 0; r < 16; ++r) rli[r] = __builtin_amdgcn_rcpf(li_l[crow(r, hi)]);
  bf16_t* Ow = Ob + (long)(wid * QBLK) * LDO;
#pragma unroll
  for (int r = 0; r < 16; ++r) { const int orow = crow(r, hi);
#pragma unroll
    for (int d0 = 0; d0 < 4; ++d0) Ow[(long)orow * LDO + d0 * 32 + r32] = f2bf(o[d0][r] * rli[r]); }
  __syncthreads();
#undef SLOAD
#undef SWRITE
#undef SWAIT
#undef RESC
}
#undef SBAR
}

constexpr int NWAVES = 8;
constexpr int N_LAUNCHES = MK_N_LAUNCHES;
constexpr int N_PHASES = 15;
static_assert(N_LAUNCHES == 1 || N_LAUNCHES == N_PHASES, "MK_N_LAUNCHES is 1 or 15");

constexpr size_t MiB = 1u << 20;
constexpr size_t WS_CTL = 0, CTL_ZERO_BYTES = 32768;
constexpr size_t WS_ROPE = 1 * MiB;
constexpr size_t WS_RSTD0 = 3 * MiB, WS_RSTDQ = WS_RSTD0 + 65536, WS_RSTDKV = WS_RSTDQ + 65536, WS_RSTDM = WS_RSTDKV + 65536;
constexpr size_t WS_SSQ = 4 * MiB;
constexpr size_t WS_AFF = 5 * MiB;
constexpr size_t WS_INV = 6 * MiB;
constexpr size_t WS_IDX = 7 * MiB, WS_GATE = WS_IDX + 131072;
constexpr size_t WS_MEMB = 8 * MiB;
constexpr size_t WS_MKV = 9 * MiB;
constexpr size_t WS_QKT = 11 * MiB, WS_VWT = 15 * MiB;
constexpr size_t WS_WIN = 19 * MiB;
constexpr size_t WS_WCO = 30 * MiB, WS_WMO = 32 * MiB, WS_WMIX = 34 * MiB, WS_WUQ = 36 * MiB, WS_WUKV = 37 * MiB, WS_WMQH = 38 * MiB, WS_WOHT = 40 * MiB, WS_WMKV = 42 * MiB;
constexpr size_t WS_XGG = 48 * MiB, WS_QB = 48 * MiB, WS_MIXA = 96 * MiB, WS_WGU = 48 * MiB, WS_WD = 112 * MiB, WS_Y = 48 * MiB;
constexpr size_t WS_XB = 144 * MiB, WS_ACONV = 144 * MiB, WS_OB = 144 * MiB, WS_X1B = 144 * MiB, WS_XG = 144 * MiB;
constexpr size_t WS_SIGA = 176 * MiB, WS_MIXED = 176 * MiB, WS_PM = 176 * MiB;
constexpr size_t WS_SIGB = 208 * MiB, WS_H3 = 208 * MiB, WS_H = 144 * MiB;
constexpr size_t WS_CQ = 240 * MiB, WS_CKV = 248 * MiB, WS_KR = 252 * MiB, WS_KROPE = 254 * MiB;
constexpr size_t WS_KN8 = 128 * MiB;
constexpr size_t WS_X2B = 256 * MiB;
constexpr size_t WS_END = RESID_BF16 ? 288 * MiB : 256 * MiB;
constexpr int CW_TMO = 0, CW_BAR = 4096;

constexpr int RING_BYTES = 131072, EPI_OFF = 131072, EPI_BYTES = 8192, LDSCTL_OFF = 140288, MISC_OFF = LDSCTL_OFF + 320;
constexpr int LDS_BYTES = 148480;
static_assert(2 * 16 * 1028 * 4 + 8192 <= LDSCTL_OFF && EPI_OFF + EPI_BYTES <= LDSCTL_OFF, "LDS map (router, epilogue scratch)");
static_assert(MISC_OFF + 128 <= LDS_BYTES && att::SHM_ATTN <= RING_BYTES, "LDS map");

typedef GAS unsigned gu32;
#define RLX_AGENT __ATOMIC_RELAXED, __HIP_MEMORY_SCOPE_AGENT

#define XB_TMO      128
#define XB_XCNT(j)  (256  + 64 * (j))
#define XB_XSUB(j)  (1280 + 64 * (j))
#define XB_XGEN(j)  (2304 + 64 * (j))
#define XB_TOP      3328
#define XB_TOPGEN   3392
#define XCD_BAR_WORDS 3456
#define XB_SPIN_CAP (1u << 18)
__device__ __forceinline__ unsigned xb_ld(unsigned* p)              { return __hip_atomic_load(p, __ATOMIC_RELAXED, __HIP_MEMORY_SCOPE_AGENT); }
__device__ __forceinline__ unsigned xb_add(unsigned* p, unsigned v) { return __hip_atomic_fetch_add(p, v, __ATOMIC_RELAXED, __HIP_MEMORY_SCOPE_AGENT); }
__device__ __forceinline__ unsigned xb_xcc_id() { return (unsigned)__builtin_amdgcn_s_getreg((3 << 11) | 20) & 0xFu; }
#define XB_SPIN(cond, bar) do { unsigned _sp = 0; while (cond) { __builtin_amdgcn_s_sleep(1); \
    if ((++_sp & 255u) == 0u) { if (xb_ld(&(bar)[XB_TMO])) break; if (_sp > XB_SPIN_CAP) { atomicAdd(&(bar)[XB_TMO], 1u); break; } } } } while (0)
struct XcdBarrier { unsigned* bar; unsigned x; volatile LAS unsigned* st; };
__device__ __forceinline__ XcdBarrier xcd_barrier_post(unsigned* bar, volatile LAS unsigned* st, const bool t0) {
    XcdBarrier b; b.bar = bar; b.x = xb_xcc_id(); b.st = st;
    if (t0) (void)xb_add(&bar[XB_XCNT(b.x)], 1u);
    return b;
}
__device__ __forceinline__ void xcd_barrier_complete(unsigned* bar, unsigned x, unsigned& nloc, unsigned& nx) {
    const unsigned G = gridDim.x * gridDim.y * gridDim.z;
    unsigned sum, cnt, mine, sp = 0u;
    for (;;) {
        sum = 0u; cnt = 0u; mine = 0u;
#pragma unroll
        for (unsigned j = 0; j < 16; ++j) { const unsigned c = xb_ld(&bar[XB_XCNT(j)]); sum += c; cnt += (c > 0u) ? 1u : 0u; mine = (j == x) ? c : mine; }
        if (sum == G) break;
        __builtin_amdgcn_s_sleep(1);
        if ((++sp & 255u) == 0u) { if (xb_ld(&bar[XB_TMO])) break; if (sp > XB_SPIN_CAP) { atomicAdd(&bar[XB_TMO], 1u); break; } }
    }
    nloc = mine > 0u ? mine : 1u; nx = cnt > 0u ? cnt : 1u;
}
__device__ __forceinline__ void xcd_barrier(const XcdBarrier& b, const bool t0) {
    asm volatile("s_waitcnt vmcnt(0)" ::: "memory");
    __syncthreads();
    if (t0) {
        unsigned* bar = b.bar;
        __builtin_amdgcn_s_waitcnt(0);
        unsigned nloc = b.st[0], nx = b.st[1];
        if (nloc == 0u) { xcd_barrier_complete(bar, b.x, nloc, nx); b.st[0] = nloc; b.st[1] = nx; }
        const unsigned old = xb_add(&bar[XB_XSUB(b.x)], 1u);
        const unsigned gen = old / nloc;
        if (old + 1u == (gen + 1u) * nloc) {
            __builtin_amdgcn_fence(__ATOMIC_RELEASE, "agent");
            asm volatile("s_waitcnt vmcnt(0)" ::: "memory");
            const unsigned og = xb_add(&bar[XB_TOP], 1u);
            const unsigned tg = og / nx;
            __builtin_amdgcn_fence(__ATOMIC_ACQUIRE, "agent");
            if (og + 1u == (tg + 1u) * nx) (void)__hip_atomic_fetch_add(&bar[XB_TOPGEN], 1u, __ATOMIC_RELAXED, __HIP_MEMORY_SCOPE_AGENT);
            else XB_SPIN(xb_ld(&bar[XB_TOPGEN]) == tg, bar);
            (void)__hip_atomic_fetch_add(&bar[XB_XGEN(b.x)], 1u, __ATOMIC_RELAXED, __HIP_MEMORY_SCOPE_AGENT);
            asm volatile("s_waitcnt vmcnt(0)" ::: "memory");
        } else {
            __builtin_amdgcn_fence(__ATOMIC_ACQUIRE, "agent");
            XB_SPIN(xb_ld(&bar[XB_XGEN(b.x)]) == gen, bar);
            asm volatile("s_waitcnt vmcnt(0)" ::: "memory");
        }
    }
    __syncthreads();
}

struct Args {
    const float* in[25];
    float* out; unsigned char* ws;
    int ph_lo, ph_hi;
};
enum { I_X = 0, I_MEM, I_NORM_MIX_G, I_W_IN, I_CONV_W, I_CONV_B, I_W_CONV_OUT, I_Q_NORM_G, I_W_UQ, I_KV_NORM_G, I_W_UKV, I_W_MLA_OUT, I_B_GATE, I_W_MIX_OUT,
       I_NORM_MEM_G, I_NORM_MEMKV_G, I_W_MEM_Q, I_W_MEM_KV, I_W_MEM_OUT, I_NORM_MOE_G, I_W_ROUTER, I_W_EXP_GATE, I_W_EXP_UP, I_W_EXP_DOWN, I_NORM_FINAL_G };

constexpr int TP_PITCH = 65, TP_BYTES = 64 * TP_PITCH * 4;
template <class SrcF, class DstF>
__device__ __forceinline__ void transpose_item(SrcF srcp, DstF dstp, int ld, const float* gain, int k0, LAS float* scr, int lane) {
    const int n4 = (lane & 15) * 4, kr = lane >> 4;
    const float* sp = srcp(n4);
    f32x4 v[16];
#pragma unroll
    for (int i = 0; i < 16; ++i) v[i] = sp ? *(const f32x4*)(sp + (size_t)(k0 + 4 * i + kr) * ld) : (f32x4){0.f, 0.f, 0.f, 0.f};
    if (gain) {
#pragma unroll
        for (int i = 0; i < 16; ++i) v[i] = v[i] * gain[k0 + 4 * i + kr]; }
#pragma unroll
    for (int i = 0; i < 16; ++i)
#pragma unroll
        for (int e = 0; e < 4; ++e) scr[(n4 + e) * TP_PITCH + 4 * i + kr] = v[i][e];
    asm volatile("s_waitcnt lgkmcnt(0)" ::: "memory");
    const int c = lane & 7;
#pragma unroll
    for (int j = 0; j < 8; ++j) { const int n = (lane >> 3) + 8 * j; const LAS float* s = scr + n * TP_PITCH + 8 * c;
        u32x4 o; o.x = cvtpk(s[0], s[1]); o.y = cvtpk(s[2], s[3]); o.z = cvtpk(s[4], s[5]); o.w = cvtpk(s[6], s[7]);
        *(u32x4*)(dstp(n) + k0 + 8 * c) = o; }
    asm volatile("s_waitcnt lgkmcnt(0)" ::: "memory");
}
template <class MapF>
__device__ __forceinline__ void transpose_matrix(MapF map, bf16_t* dst, int NDST, int K, int ld, const float* gain, LAS float* scr, int lane, int gw, int NGW, int& itbase) {
    const int nkb = K / 64, nitems = (NDST / 64) * nkb;
    int first = (gw - (itbase % NGW) + NGW) % NGW;
    for (int it = first; it < nitems; it += NGW) { const int nb = it / nkb, kb = it % nkb, n0 = nb * 64;
        transpose_item([&](int n) { return map(n0 + n); }, [&](int n) { return dst + (size_t)(n0 + n) * K; }, ld, gain, kb * 64, scr, lane); }
    itbase += nitems;
}

__device__ __forceinline__ int rope_dim(int p) { return (p >> 3) * 4 + (p & 3) + 32 * ((p >> 2) & 1); }

template <int PHM> __global__ void __launch_bounds__(NWAVES * 64, 2) fwd_kernel(Args args) {
    extern __shared__ __attribute__((aligned(16))) unsigned char lds_raw[];
    LAS unsigned char* lds = (LAS unsigned char*)lds_raw;
    volatile LAS unsigned* MISC = (volatile LAS unsigned*)(lds + MISC_OFF);
    int tid = threadIdx.x, lane = tid & 63; const int wave = __builtin_amdgcn_readfirstlane(tid >> 6);
#define PHASE_BEGIN() do { lane = (int)__builtin_amdgcn_mbcnt_hi(~0u, __builtin_amdgcn_mbcnt_lo(~0u, 0u)); asm volatile("" : "+v"(lane)); tid = wave * 64 + lane; } while (0)
    const int G = gridDim.x; const int bx = blockIdx.x; const int vcu = (G % 8 == 0) ? (bx % 8) * (G / 8) + bx / 8 : bx;
    const int gw = vcu * NWAVES + wave, NGW = G * NWAVES;
    unsigned char* ws = args.ws;
    gu32* ctl = (gu32*)(ws + WS_CTL);
    for (int u = tid; u < (LDS_BYTES - LDSCTL_OFF) / 4; u += NWAVES * 64) ((LAS unsigned*)(lds + LDSCTL_OFF))[u] = 0u;
    __syncthreads();
    XcdBarrier bar; bar.bar = (unsigned*)(ctl + CW_BAR); bar.x = 0; bar.st = nullptr;
    if (N_LAUNCHES == 1) bar = xcd_barrier_post((unsigned*)(ctl + CW_BAR), MISC + 8, tid == 0);
#define GRID_BAR() do { if (N_LAUNCHES == 1) xcd_barrier(bar, wave == 0 && __builtin_amdgcn_mbcnt_hi(~0u, __builtin_amdgcn_mbcnt_lo(~0u, 0u)) == 0u); } while (0)
    const int lo = args.ph_lo, hi = args.ph_hi;
#define IN(k) (((PHM >> (k)) & 1) && lo <= (k) && (k) < hi)
#define SEAM(k) do { if (IN(k) && IN((k) + 1)) GRID_BAR(); } while (0)

    const float* x = args.in[I_X]; float* out = args.out;
#define rope ((f32x2*)(ws + WS_ROPE))
#define rstd0 ((float*)(ws + WS_RSTD0))
#define rstdq ((float*)(ws + WS_RSTDQ))
#define rstdkv ((float*)(ws + WS_RSTDKV))
#define rstdm ((float*)(ws + WS_RSTDM))
#define ssq ((float*)(ws + WS_SSQ))
#define aff ((float*)(ws + WS_AFF))
#define inv ((int*)(ws + WS_INV))
#define idx ((int*)(ws + WS_IDX))
#define gate ((float*)(ws + WS_GATE))
#define memb ((bf16_t*)(ws + WS_MEMB))
#define MKV ((bf16_t*)(ws + WS_MKV))
#define QKT ((bf16_t*)(ws + WS_QKT))
#define VWT ((bf16_t*)(ws + WS_VWT))
#define Win_t ((bf16_t*)(ws + WS_WIN))
#define Wco_t ((bf16_t*)(ws + WS_WCO))
#define Wmo_t ((bf16_t*)(ws + WS_WMO))
#define Wmix_t ((bf16_t*)(ws + WS_WMIX))
#define Wuq_t ((bf16_t*)(ws + WS_WUQ))
#define Wukv_t ((bf16_t*)(ws + WS_WUKV))
#define Wmqh ((bf16_t*)(ws + WS_WMQH))
#define Woht ((bf16_t*)(ws + WS_WOHT))
#define Wmkv_t ((bf16_t*)(ws + WS_WMKV))
#define XGG ((bf16_t*)(ws + WS_XGG))
#define QB ((bf16_t*)(ws + WS_QB))
#define MIXA ((bf16_t*)(ws + WS_MIXA))
#define Wgu_t ((bf16_t*)(ws + WS_WGU))
#define Wd_t ((bf16_t*)(ws + WS_WD))
#define Y ((bf16_t*)(ws + WS_Y))
#define XB ((bf16_t*)(ws + WS_XB))
#define KN8 ((unsigned char*)(ws + WS_KN8))
#define VT8 ((unsigned char*)out)
#define Q8 ((unsigned char*)(ws + WS_QB))
#define KR8 ((unsigned char*)(ws + WS_KROPE))
#define X2B ((bf16_t*)(ws + WS_X2B))
#define ACONV ((bf16_t*)(ws + WS_ACONV))
#define OB ((bf16_t*)(ws + WS_OB))
#define X1B ((bf16_t*)(ws + WS_X1B))
#define XG ((bf16_t*)(ws + WS_XG))
#define SIGA ((bf16_t*)(ws + WS_SIGA))
#define MIXED ((bf16_t*)(ws + WS_MIXED))
#define PM ((bf16_t*)(ws + WS_PM))
#define SIGB ((bf16_t*)(ws + WS_SIGB))
#define H3 ((bf16_t*)(ws + WS_H3))
#define HB ((bf16_t*)(ws + WS_H))
#define CQ ((bf16_t*)(ws + WS_CQ))
#define CKV ((bf16_t*)(ws + WS_CKV))
#define KR ((bf16_t*)(ws + WS_KR))
#define KROPE ((bf16_t*)(ws + WS_KROPE))
#define KVB ((bf16_t*)out)
    LAS float* scr = (LAS float*)(lds + wave * TP_BYTES);

    if (IN(0)) { PHASE_BEGIN();
        int itb = 0;
        { const float* W = args.in[I_W_IN]; const float* gn = args.in[I_NORM_MIX_G];
          transpose_matrix([&](int n) -> const float* { if (n < 2048) { const int t = n >> 8, half = (n >> 7) & 1, c = n & 127; return W + (half ? 2048 : 0) + 128 * t + c; }
                                                         if (n < 3072) return W + 1024 + (n - 2048); if (n < 3520) return W + n; if (n < 3584) return nullptr; return W + (n - 64); },
                           Win_t, NU, 1024, 5568, gn, scr, lane, gw, NGW, itb); }
        { const float* W = args.in[I_W_CONV_OUT]; transpose_matrix([&](int n) -> const float* { return W + n; }, Wco_t, 1024, 1024, 1024, nullptr, scr, lane, gw, NGW, itb); }
        { const float* W = args.in[I_W_MLA_OUT]; transpose_matrix([&](int n) -> const float* { return W + n; }, Wmo_t, 1024, 1024, 1024, nullptr, scr, lane, gw, NGW, itb); }
        { const float* W = args.in[I_W_MIX_OUT]; transpose_matrix([&](int n) -> const float* { return W + n; }, Wmix_t, 1024, 1024, 1024, nullptr, scr, lane, gw, NGW, itb); }
        { const float* W = args.in[I_W_UQ]; const float* gn = args.in[I_Q_NORM_G];
          transpose_matrix([&](int n) -> const float* { if (n < 1024) return W + (n >> 7) * 192 + (n & 127); const int r = n - 1024; return W + (r >> 6) * 192 + 128 + rope_dim(r & 63); },
                           Wuq_t, 1536, 256, 1536, gn, scr, lane, gw, NGW, itb); }
        { const float* W = args.in[I_W_UKV]; const float* gn = args.in[I_KV_NORM_G];
          transpose_matrix([&](int n) -> const float* { if (n < 1024) return W + (n >> 7) * 256 + (n & 127); const int r = n - 1024; return W + (r >> 7) * 256 + 128 + (r & 127); },
                           Wukv_t, 2048, 128, 2048, gn, scr, lane, gw, NGW, itb); }
        { const float* W = args.in[I_W_MEM_KV]; const float* gn = args.in[I_NORM_MEMKV_G];
          transpose_matrix([&](int n) -> const float* { return W + n; }, Wmkv_t, 2048, 1024, 2048, gn, scr, lane, gw, NGW, itb); }
        for (int h = 0; h < 4; ++h) { const float* W = args.in[I_W_MEM_OUT] + (size_t)h * 256 * 1024;
          transpose_matrix([&](int n) -> const float* { return W + n; }, Woht + (size_t)h * 1024 * 256, 1024, 256, 1024, nullptr, scr, lane, gw, NGW, itb); }
        { const float* W = args.in[I_W_MEM_Q]; const float* gn = args.in[I_NORM_MEM_G];
          for (int c = gw * 64 + lane; c < 1024 * 1024 / 8; c += NGW * 64) { const int e0 = c * 8, h = e0 >> 18, d = (e0 >> 8) & 1023, j = e0 & 255; const float g = gn[d];
              const float* s = W + (size_t)d * 1024 + h * 256 + j; const f32x4 a = *(const f32x4*)s, b = *(const f32x4*)(s + 4);
              const float o[8] = {a[0] * g, a[1] * g, a[2] * g, a[3] * g, b[0] * g, b[1] * g, b[2] * g, b[3] * g}; *(u32x4*)(Wmqh + e0) = pack8(o); } }
        for (int r = gw; r < MT + NB * MEM_LEN; r += NGW) { const bool isx = r < MT; const int rr = isx ? r : r - MT;
            const float* src = (isx ? x : args.in[I_MEM]) + (size_t)rr * 1024; bf16_t* dst = (isx ? XB : memb) + (size_t)rr * 1024; float s = 0.f;
#pragma unroll
            for (int j = 0; j < 4; ++j) { const f32x4 v = *(const f32x4*)(src + (lane + 64 * j) * 4); s += (v[0] * v[0] + v[1] * v[1]) + (v[2] * v[2] + v[3] * v[3]);
                u32x2 w; w.x = cvtpk(v[0], v[1]); w.y = cvtpk(v[2], v[3]); *(u32x2*)(dst + (lane + 64 * j) * 4) = w; }
            s = wave_sum(s); if (lane == 0) (isx ? rstd0 : rstdm)[rr] = 1.f / sqrtf(s * (1.f / 1024.f) + EPS); }
        for (int i = gw * 64 + lane; i < SEQ * 32; i += NGW * 64) { const int s = i >> 5, j = i & 31; const float invf = 1.0f / powf(10000.0f, (float)(2 * j) / 64.0f); const float ang = (float)s * invf;
            rope[i] = (f32x2){cosf(ang), sinf(ang)}; }
    }
    SEAM(0);

    if (IN(1)) { PHASE_BEGIN();
        { Gemm g = mkgemm(XB, Win_t, MT, NU, 1024, 1024, 1024); StaticOrder S; S.init(MT, NU, G, bx);
          EpiU E{{rstd0, XGG, CQ, CKV, KR, SIGA, SIGB, args.in[I_B_GATE]}}; pg8::gemm_phase(lds, g, S, E, tid); }
        { Gemm g = mkgemm(memb, Wmkv_t, NB * MEM_LEN, 2048, 1024, 1024, 1024); StaticOrder S; S.init(NB * MEM_LEN, 2048, G, (bx + G / 2) % G);
          pg8::EpiChunk<FMemKV> E{{rstdm, MKV}}; pg8::gemm_phase(lds, g, S, E, tid); }
    }
    SEAM(1);

    if (IN(2)) { PHASE_BEGIN();
        const float* cw = args.in[I_CONV_W]; const float* cb = args.in[I_CONV_B];
        for (int blk = gw; blk < MT / 4; blk += NGW) { const int r0 = blk * 4, s0 = r0 & (SEQ - 1);
            u32x4 pxr[6][2], gbr[4][2]; u32x2 cqr[4]; unsigned ckr[4]; bf16_t k1[4], k2[4];
            const u32x4 z = {0u, 0u, 0u, 0u};
#pragma unroll
            for (int i = 0; i < 6; ++i) { const int rr = r0 - 1 + i; const bool ok = (i > 0 || s0 > 0) && (i < 5 || s0 + 4 < SEQ);
#pragma unroll
                for (int j = 0; j < 2; ++j) pxr[i][j] = ok ? *(const u32x4*)(XGG + (size_t)rr * 2048 + lane * 8 + 512 * j) : z; }
#pragma unroll
            for (int i = 0; i < 4; ++i) { const int rr = r0 + i;
#pragma unroll
                for (int j = 0; j < 2; ++j) gbr[i][j] = *(const u32x4*)(XGG + (size_t)rr * 2048 + 1024 + lane * 8 + 512 * j);
                cqr[i] = *(const u32x2*)(CQ + (size_t)rr * 256 + lane * 4); ckr[i] = *(const unsigned*)(CKV + (size_t)rr * 128 + lane * 2);
                { const int j_ = (lane >> 3) * 4 + (lane & 3); k1[i] = KR[(size_t)rr * 64 + j_]; k2[i] = KR[(size_t)rr * 64 + j_ + 32]; } }
#pragma unroll
            for (int j = 0; j < 2; ++j) { const int c0 = lane * 8 + 512 * j;
                float w0[8], w1[8], w2[8], bb[8];
                { const f32x4 a = *(const f32x4*)(cw + c0), b = *(const f32x4*)(cw + c0 + 4); w0[0] = a[0]; w0[1] = a[1]; w0[2] = a[2]; w0[3] = a[3]; w0[4] = b[0]; w0[5] = b[1]; w0[6] = b[2]; w0[7] = b[3]; }
                { const f32x4 a = *(const f32x4*)(cw + 1024 + c0), b = *(const f32x4*)(cw + 1024 + c0 + 4); w1[0] = a[0]; w1[1] = a[1]; w1[2] = a[2]; w1[3] = a[3]; w1[4] = b[0]; w1[5] = b[1]; w1[6] = b[2]; w1[7] = b[3]; }
                { const f32x4 a = *(const f32x4*)(cw + 2048 + c0), b = *(const f32x4*)(cw + 2048 + c0 + 4); w2[0] = a[0]; w2[1] = a[1]; w2[2] = a[2]; w2[3] = a[3]; w2[4] = b[0]; w2[5] = b[1]; w2[6] = b[2]; w2[7] = b[3]; }
                { const f32x4 a = *(const f32x4*)(cb + c0), b = *(const f32x4*)(cb + c0 + 4); bb[0] = a[0]; bb[1] = a[1]; bb[2] = a[2]; bb[3] = a[3]; bb[4] = b[0]; bb[5] = b[1]; bb[6] = b[2]; bb[7] = b[3]; }
                float p[6][8];
#pragma unroll
                for (int i = 0; i < 6; ++i) unpack8(pxr[i][j], p[i]);
#pragma unroll
                for (int i = 0; i < 4; ++i) { float gb[8], o[8]; unpack8(gbr[i][j], gb);
#pragma unroll
                    for (int e = 0; e < 8; ++e) o[e] = gb[e] * (w0[e] * p[i][e] + w1[e] * p[i + 1][e] + w2[e] * p[i + 2][e] + bb[e]);
                    *(u32x4*)(ACONV + (size_t)(r0 + i) * 1024 + c0) = pack8(o); } }
#pragma unroll
            for (int i = 0; i < 4; ++i) { const int r = r0 + i, s = r & (SEQ - 1);
                { const u32x2 w = cqr[i]; const float a = bflo(w.x), b = bfhi(w.x), c = bflo(w.y), d = bfhi(w.y);
                  const float sq = wave_sum((a * a + b * b) + (c * c + d * d)); if (lane == 0) rstdq[r] = 1.f / sqrtf(sq * (1.f / 256.f) + EPS); }
                { const unsigned w = ckr[i]; const float a = bflo(w), b = bfhi(w);
                  const float sq = wave_sum(a * a + b * b); if (lane == 0) rstdkv[r] = 1.f / sqrtf(sq * (1.f / 128.f) + EPS); }
                { const int pp = lane, j = (pp >> 3) * 4 + (pp & 3), half = (pp >> 2) & 1; const float v1 = bf2f(k1[i]), v2 = bf2f(k2[i]); const f32x2 cs = rope[s * 32 + j];
                  const float kv_ = half ? v1 * cs.y + v2 * cs.x : v1 * cs.x - v2 * cs.y;
#if ATT_FP8
                  KR8[(size_t)r * 64 + pp] = (unsigned char)(__builtin_amdgcn_cvt_pk_fp8_f32(kv_, kv_, 0u, false) & 0xffu);
#else
                  KROPE[(size_t)r * 64 + pp] = f2bf(kv_);
#endif
                } }
        }
    }
    SEAM(2);

    if (IN(3)) { PHASE_BEGIN();
        { Gemm g = mkgemm(ACONV, Wco_t, MT, 1024, 1024, 1024, 1024); StaticOrder S; S.init(MT, 1024, G, bx);
          pg8::EpiChunk<FGateMul> E{{SIGA, MIXA}}; pg8::gemm_phase(lds, g, S, E, tid); }
        { Gemm g = mkgemm(CQ, Wuq_t, MT, 1536, 256, 256, 256); StaticOrder S; S.init(MT, 1536, G, (bx + G / 2) % G);
          pg8::EpiChunk<FQ> E{{rstdq, rope, QB, ATT_FP8 ? Q8 : nullptr}}; pg8::gemm_phase(lds, g, S, E, tid); }
        { Gemm g = mkgemm(CKV, Wukv_t, MT, 2048, 128, 128, 128); StaticOrder S; S.init(MT, 2048, G, bx);
#if ATT_FP8
          (void)g; (void)S; }
        { Gemm g = mkgemm(CKV, Wukv_t, MT, 1024, 128, 128, 128); StaticOrder S; S.init(MT, 1024, G, bx);
          pg8::EpiChunk<FK8> E{{rstdkv, KN8}}; pg8::gemm_phase(lds, g, S, E, tid); }
        { Gemm g = mkgemm(Wukv_t + (size_t)1024 * 128, CKV, 1024, MT, 128, 128, 128); StaticOrder S; S.init(1024, MT, G, bx);
          pg8::EpiChunk<FVT8> E{{rstdkv, VT8}}; pg8::gemm_phase(lds, g, S, E, tid); }
#else
          pg8::EpiChunk<FScaleRow> E{{rstdkv, KVB, 2048}}; pg8::gemm_phase(lds, g, S, E, tid); }
#endif
        { Gemm g = mkgemm(MKV, Wmqh, 2048, 1024, 256, 256, 256, 1, 4, (size_t)1024 * 256); StaticOrder S; S.init(2048, 1024, G, bx);
          pg8::EpiChunk<FPlain> E{{QKT, 1024}}; pg8::gemm_phase(lds, g, S, E, tid); }
        for (int b = 0; b < NB; ++b) { Gemm g = mkgemm(Woht, MKV + (size_t)(8 + b * 4) * 65536, 4096, 256, 256, 256, 256, 4, 4, (size_t)65536); StaticOrder S; S.init(4096, 256, G, (bx + G - 64 - 16 * b) % G);
          pg8::EpiChunk<FVW> E{{VWT + (size_t)b * 1024 * 1024}}; pg8::gemm_phase(lds, g, S, E, tid); }
    }
    SEAM(3);

    if (IN(4)) { PHASE_BEGIN();
        for (int u = vcu; u < NB * NHEAD * (SEQ / 256); u += G) { const int bh = u >> 5, qb = u & 31, b = bh >> 3, h = bh & 7; const size_t row0 = (size_t)b * SEQ + qb * 256;
#if ATT_FP8
            att::attn_unit9(Q8 + row0 * 1536 + h * 128, Q8 + row0 * 1536 + 1024 + h * 64, KN8 + (size_t)b * SEQ * 1024 + h * 128, KR8 + (size_t)b * SEQ * 64,
                            VT8 + (size_t)(b * NHEAD + h) * 128 * SEQ, OB + row0 * 1024 + h * 128, SEQ, (char*)lds_raw, tid);
#else
            att::attn_unit(QB + row0 * 1536 + h * 128, QB + row0 * 1536 + 1024 + h * 64, KVB + (size_t)b * SEQ * 2048 + h * 128,
                           KROPE + (size_t)b * SEQ * 64, OB + row0 * 1024 + h * 128, SEQ, (char*)lds_raw, tid);
#endif
        }
    }
    SEAM(4);

    if (IN(5)) { PHASE_BEGIN(); Gemm g = mkgemm(OB, Wmo_t, MT, 1024, 1024, 1024, 1024); StaticOrder S; S.init(MT, 1024, G, bx);
        pg8::EpiChunk<FGateMulAdd> E{{SIGB, MIXA, MIXED}}; pg8::gemm_phase(lds, g, S, E, tid); }
    SEAM(5);

    if (IN(6)) { PHASE_BEGIN(); Gemm g = mkgemm(MIXED, Wmix_t, MT, 1024, 1024, 1024, 1024); StaticOrder S; S.init(MT, 1024, G, bx);
        EpiX1 E{x, RESID_BF16 ? nullptr : out, X1B, ssq}; pg8::gemm_phase(lds, g, S, E, tid); }
    SEAM(6);

    if (IN(7)) { PHASE_BEGIN(); Gemm g = mkgemm(X1B, QKT, MT, 1024, 1024, 1024, 1024, 32, 2, (size_t)1024 * 1024); StaticOrder S; S.init(MT, 1024, G, bx);
        EpiSoftmax E{ssq, PM}; pg8::gemm_phase(lds, g, S, E, tid); }
    SEAM(7);

    if (IN(8)) { PHASE_BEGIN(); Gemm g = mkgemm(PM, VWT, MT, 1024, 1024, 1024, 1024, 32, 2, (size_t)1024 * 1024); StaticOrder S; S.init(MT, 1024, G, bx);
#if RESID_BF16
        pg8::EpiChunk<FResidBf16> E{{X1B, X2B}}; pg8::gemm_phase(lds, g, S, E, tid); }
#else
        pg8::EpiChunk<FResidF32> E{{out, out}}; pg8::gemm_phase(lds, g, S, E, tid); }
#endif
    SEAM(8);

#if RESID_BF16
#define LDROW4(r_, j_) ([&]() -> f32x4 { const u32x2 w_ = *(const u32x2*)(X2B + (size_t)(r_) * 1024 + (lane + 64 * (j_)) * 4); return (f32x4){bflo(w_.x), bfhi(w_.x), bflo(w_.y), bfhi(w_.y)}; }())
#else
#define LDROW4(r_, j_) (*(const f32x4*)(out + (size_t)(r_) * 1024 + (lane + 64 * (j_)) * 4))
#endif
    if (IN(9)) { PHASE_BEGIN();
        constexpr int RP = 1028;
        LAS float* wt = (LAS float*)lds;
        LAS float* hb = (LAS float*)(lds + 16 * RP * 4);
        LAS float* part = (LAS float*)(lds + 2 * 16 * RP * 4);
        const float* wr_ = args.in[I_W_ROUTER]; const float* gn = args.in[I_NORM_MOE_G];
        for (int i = tid; i < 1024 * 16; i += NWAVES * 64) wt[(i & 15) * RP + (i >> 4)] = wr_[i];
        f32x4 gv[4];
#pragma unroll
        for (int j = 0; j < 4; ++j) gv[j] = *(const f32x4*)(gn + (lane + 64 * j) * 4);
        f32x4 v[2][4], vn[2][4];
        const int ngroups = MT / 16;
        if (vcu < ngroups) {
#pragma unroll
            for (int t = 0; t < 2; ++t)
#pragma unroll
                for (int j = 0; j < 4; ++j) v[t][j] = LDROW4(vcu * 16 + wave * 2 + t, j); }
        __syncthreads();
        for (int g = vcu; g < ngroups; g += G) { const int r0 = g * 16;
            if (g + G < ngroups) {
#pragma unroll
                for (int t = 0; t < 2; ++t)
#pragma unroll
                    for (int j = 0; j < 4; ++j) vn[t][j] = LDROW4((g + G) * 16 + wave * 2 + t, j); }
#pragma unroll
            for (int t = 0; t < 2; ++t) { const int tk = wave * 2 + t, r = r0 + tk; float s = 0.f;
#pragma unroll
                for (int j = 0; j < 4; ++j) s += (v[t][j][0] * v[t][j][0] + v[t][j][1] * v[t][j][1]) + (v[t][j][2] * v[t][j][2] + v[t][j][3] * v[t][j][3]);
                const float rs = 1.f / sqrtf(wave_sum(s) * (1.f / 1024.f) + EPS);
#pragma unroll
                for (int j = 0; j < 4; ++j) { const f32x4 hh = v[t][j] * rs * gv[j]; *(LAS f32x4*)(hb + tk * RP + (lane + 64 * j) * 4) = hh;
                    u32x2 w; w.x = cvtpk(hh[0], hh[1]); w.y = cvtpk(hh[2], hh[3]); *(u32x2*)(H3 + (size_t)r * 1024 + (lane + 64 * j) * 4) = w; } }
            __syncthreads();
            { f32x4 acc = {0.f, 0.f, 0.f, 0.f}; const LAS float* ap = wt + (lane & 15) * RP + wave * 128 + (lane >> 4); const LAS float* bp = hb + (lane & 15) * RP + wave * 128 + (lane >> 4);
#pragma unroll 8
                for (int st = 0; st < 32; ++st) acc = __builtin_amdgcn_mfma_f32_16x16x4f32(ap[4 * st], bp[4 * st], acc, 0, 0, 0);
                *(LAS f32x4*)(part + (wave * 16 + (lane & 15)) * 16 + 4 * (lane >> 4)) = acc; }
            __syncthreads();
            if (tid < 256) { const int tk = tid >> 4, e = tid & 15; float lg = 0.f;
#pragma unroll
                for (int w = 0; w < 8; ++w) lg += part[(w * 16 + tk) * 16 + e];
                float mx = lg;
#pragma unroll
                for (int o = 1; o < 16; o <<= 1) mx = fmaxf(mx, __shfl_xor(mx, o));
                const float p = __expf(lg - mx); float sm = p;
#pragma unroll
                for (int o = 1; o < 16; o <<= 1) sm += __shfl_xor(sm, o);
                const int r = r0 + tk, b = r >> 13, sidx = r & (SEQ - 1); aff[((size_t)b * NEXP + e) * SEQ + sidx] = p / sm; inv[(size_t)r * 16 + e] = -1; }
            __syncthreads();
#pragma unroll
            for (int t = 0; t < 2; ++t)
#pragma unroll
                for (int j = 0; j < 4; ++j) v[t][j] = vn[t][j];
        }
    }
    SEAM(9);

    if (IN(10)) { PHASE_BEGIN();
        if (vcu < NB * NEXP) {
            LAS unsigned* keys = (LAS unsigned*)lds; LAS unsigned* hist = (LAS unsigned*)(lds + 32768); LAS unsigned* misc = (LAS unsigned*)(lds + 32768 + 1024);
            for (int be = vcu; be < NB * NEXP; be += G) { const int b = be >> 4, e = be & 15; const float* a = aff + (size_t)be * SEQ;
#pragma unroll 1
                for (int i = tid; i < SEQ; i += NWAVES * 64) keys[i] = __float_as_uint(a[i]);
                unsigned prefix = 0u, kth = CAP;
#pragma unroll 1
                for (int pass = 0; pass < 4; ++pass) { const int shift = 24 - 8 * pass;
                    if (tid < 256) hist[tid] = 0u;
                    __syncthreads();
#pragma unroll 1
                    for (int i = tid; i < SEQ; i += NWAVES * 64) { const unsigned k = keys[i]; const bool match = (pass == 0) || ((k >> (shift + 8)) == (prefix >> (shift + 8)));
                        if (match) atomicAdd((unsigned*)(hist + ((k >> shift) & 255u)), 1u); }
                    __syncthreads();
                    if (wave == 0) { unsigned c[4]; unsigned tot = 0u;
#pragma unroll
                        for (int i = 0; i < 4; ++i) { c[i] = hist[255 - (4 * lane + i)]; tot += c[i]; }
                        unsigned incl = tot;
#pragma unroll
                        for (int o = 1; o < 64; o <<= 1) { const unsigned t = __shfl_up(incl, o); if (lane >= o) incl += t; }
                        unsigned run = incl - tot;
#pragma unroll
                        for (int i = 0; i < 4; ++i) { if (run < kth && run + c[i] >= kth) { misc[0] = 255u - (unsigned)(4 * lane + i); misc[1] = kth - run; } run += c[i]; } }
                    __syncthreads();
                    prefix |= misc[0] << shift; kth = misc[1];
                    __syncthreads();
                }
                const unsigned T = prefix; unsigned base_g = 0u, base_e = 0u;
#pragma unroll 1
                for (int it = 0; it < SEQ / (NWAVES * 64); ++it) { const int t = it * (NWAVES * 64) + tid; const unsigned k = keys[t]; const bool gt = k > T, eq = k == T;
                    const unsigned long long bg = __ballot(gt), bq = __ballot(eq); const unsigned long long lt = (1ull << lane) - 1ull;
                    if (lane == 0) { misc[8 + wave] = (unsigned)__popcll(bg); misc[16 + wave] = (unsigned)__popcll(bq); }
                    __syncthreads();
                    unsigned pg = base_g, pq = base_e, tg = 0u, tq = 0u;
#pragma unroll
                    for (int w = 0; w < NWAVES; ++w) { const unsigned cg = misc[8 + w], cq = misc[16 + w]; if (w < wave) { pg += cg; pq += cq; } tg += cg; tq += cq; }
                    pg += (unsigned)__popcll(bg & lt); pq += (unsigned)__popcll(bq & lt);
                    const bool sel = gt || (eq && pq < kth);
                    if (sel) { const unsigned pos = pg + (pq < kth ? pq : kth); idx[(size_t)be * CAP + pos] = t; gate[(size_t)be * CAP + pos] = __uint_as_float(k); inv[((size_t)b * SEQ + t) * 16 + e] = (int)pos; }
                    base_g += tg; base_e += tq;
                    __syncthreads();
                }
            }
        } else {
            const int cw_ = vcu - NB * NEXP, ncw = G - NB * NEXP; const int gw2 = cw_ * NWAVES + wave, NGW2 = ncw * NWAVES;
#pragma unroll 1
            for (int it = gw2; it < NEXP * 768; it += NGW2) { const int e = it / 768, r = it % 768;
                if (r < 512) { const int nb = r >> 4, kb = r & 15, n0 = nb * 64; const int f0 = (n0 >> 8) * 128 + (n0 & 127);
                    const float* W = (((n0 >> 7) & 1) ? args.in[I_W_EXP_UP] : args.in[I_W_EXP_GATE]) + (size_t)e * 1024 * 1024 + f0; bf16_t* D = Wgu_t + (size_t)e * 2048 * 1024 + (size_t)n0 * 1024;
                    transpose_item([&](int n) { return W + n; }, [&](int n) { return D + (size_t)n * 1024; }, 1024, nullptr, kb * 64, scr, lane); }
                else { const int r2 = r - 512, nb = r2 >> 4, kb = r2 & 15, n0 = nb * 64;
                    const float* W = args.in[I_W_EXP_DOWN] + (size_t)e * 1024 * 1024 + n0; bf16_t* D = Wd_t + (size_t)e * 1024 * 1024 + (size_t)n0 * 1024;
                    transpose_item([&](int n) { return W + n; }, [&](int n) { return D + (size_t)n * 1024; }, 1024, nullptr, kb * 64, scr, lane); } }
        }
    }
    if (IN(10) && IN(12)) GRID_BAR();

    if (IN(12)) { PHASE_BEGIN(); Gemm g = mkgemm(H3, Wgu_t, MOE_ROWS, 2048, 1024, 1024, 1024, 4, 16, (size_t)2048 * 1024); g.gidx = idx; StaticOrder S; S.init(MOE_ROWS, 2048, G, bx);
        EpiSwiglu E{HB}; pg8::gemm_phase<EpiSwiglu, StaticOrder, true>(lds, g, S, E, tid); }
    SEAM(12);

    if (IN(13)) { PHASE_BEGIN(); Gemm g = mkgemm(HB, Wd_t, MOE_ROWS, 1024, 1024, 1024, 1024, 4, 16, (size_t)1024 * 1024); StaticOrder S; S.init(MOE_ROWS, 1024, G, bx);
        pg8::EpiChunk<FGateRow> E{{gate, Y}}; pg8::gemm_phase(lds, g, S, E, tid); }
    SEAM(13);

    if (IN(14)) { PHASE_BEGIN();
        const float* gn = args.in[I_NORM_FINAL_G]; f32x4 gv[4];
#pragma unroll
        for (int j = 0; j < 4; ++j) gv[j] = *(const f32x4*)(gn + (lane + 64 * j) * 4);
        f32x4 v[4], vn[4]; int myslot = -1, nslot = -1;
        if (gw < MT) { myslot = inv[(size_t)gw * 16 + (lane & 15)];
#pragma unroll
            for (int j = 0; j < 4; ++j) v[j] = LDROW4(gw, j); }
        for (int r = gw; r < MT; r += NGW) { float* row = out + (size_t)r * 1024; const int b = r >> 13;
            if (r + NGW < MT) { nslot = inv[(size_t)(r + NGW) * 16 + (lane & 15)];
#pragma unroll
                for (int j = 0; j < 4; ++j) vn[j] = LDROW4(r + NGW, j); }
            unsigned long long em = __ballot(lane < 16 && myslot >= 0) & 0xffffull;
            while (em) { u32x2 w[4][4]; int ne = 0;
#pragma unroll
                for (int q = 0; q < 4; ++q) { if (em) { const int e = __builtin_ctzll(em); em &= em - 1; const int slot = __builtin_amdgcn_readlane(myslot, e);
                        const bf16_t* yr = Y + ((size_t)(b * NEXP + e) * CAP + slot) * 1024;
#pragma unroll
                        for (int j = 0; j < 4; ++j) w[q][j] = *(const u32x2*)(yr + (lane + 64 * j) * 4);
                        ne = q + 1; } }
#pragma unroll
                for (int q = 0; q < 4; ++q) { if (q < ne) {
#pragma unroll
                        for (int j = 0; j < 4; ++j) { v[j][0] += bflo(w[q][j].x); v[j][1] += bfhi(w[q][j].x); v[j][2] += bflo(w[q][j].y); v[j][3] += bfhi(w[q][j].y); } } } }
            float s = 0.f;
#pragma unroll
            for (int j = 0; j < 4; ++j) s += (v[j][0] * v[j][0] + v[j][1] * v[j][1]) + (v[j][2] * v[j][2] + v[j][3] * v[j][3]);
            const float rs = 1.f / sqrtf(wave_sum(s) * (1.f / 1024.f) + EPS);
#pragma unroll
            for (int j = 0; j < 4; ++j) *(f32x4*)(row + (lane + 64 * j) * 4) = v[j] * rs * gv[j];
#pragma unroll
            for (int j = 0; j < 4; ++j) v[j] = vn[j];
            myslot = nslot;
        }
    }
#undef IN
#undef SEAM
#undef GRID_BAR
}

#ifndef PH_MASK
#define PH_MASK 0x7fff
#endif
static const void* phase_fn(int k) {
#if MK_N_LAUNCHES == 1
    (void)k; return (const void*)fwd_kernel<PH_MASK>;
#else
    switch (k) {
    case 0: return (const void*)fwd_kernel<1 << 0>;   case 1: return (const void*)fwd_kernel<1 << 1>;   case 2: return (const void*)fwd_kernel<1 << 2>;   case 3: return (const void*)fwd_kernel<1 << 3>;
    case 4: return (const void*)fwd_kernel<1 << 4>;   case 5: return (const void*)fwd_kernel<1 << 5>;   case 6: return (const void*)fwd_kernel<1 << 6>;   case 7: return (const void*)fwd_kernel<1 << 7>;
    case 8: return (const void*)fwd_kernel<1 << 8>;   case 9: return (const void*)fwd_kernel<1 << 9>;   case 10: return (const void*)fwd_kernel<1 << 10>; case 11: return (const void*)fwd_kernel<1 << 11>;
    case 12: return (const void*)fwd_kernel<1 << 12>; case 13: return (const void*)fwd_kernel<1 << 13>; default: return (const void*)fwd_kernel<1 << 14>;
    }
#endif
}
extern "C" void kernel_launch(void* const* d_in, const int* in_sizes, int n_in, void* d_out, int out_size, void* d_ws, size_t ws_size, hipStream_t stream) {
    static int grid = 0;
    if (grid == 0) {
        if (n_in != 25 || in_sizes[0] != MT * DM || out_size != MT * DM || ws_size < WS_END) {
            fprintf(stderr, "kernel_launch: built for 25 inputs, x/out of %d floats, >= %zu bytes of workspace; got n_in %d, in0 %d, out %d, ws %zu; nothing launched\n", MT * DM, (size_t)WS_END, n_in, n_in > 0 ? in_sizes[0] : -1, out_size, ws_size);
            grid = -1; return; }
        int dev = 0, cus = 0;
        if (hipGetDevice(&dev) != hipSuccess || hipDeviceGetAttribute(&cus, hipDeviceAttributeMultiprocessorCount, dev) != hipSuccess) { fprintf(stderr, "kernel_launch: device query failed\n"); grid = -1; return; }
        for (int k = 0; k < (N_LAUNCHES == 1 ? 1 : N_PHASES); ++k)
            if (hipFuncSetAttribute(phase_fn(N_LAUNCHES == 1 ? -1 : k), hipFuncAttributeMaxDynamicSharedMemorySize, LDS_BYTES) != hipSuccess) { fprintf(stderr, "kernel_launch: hipFuncSetAttribute failed\n"); grid = -1; return; }
        (void)hipGetLastError();
        grid = cus;
    }
    if (grid < 0) return;
    if (hipMemsetAsync((char*)d_ws + WS_CTL, 0, CTL_ZERO_BYTES, stream) != hipSuccess) { fprintf(stderr, "kernel_launch: memset failed\n"); return; }
    Args a{};
    for (int i = 0; i < 25; ++i) a.in[i] = (const float*)d_in[i];
    a.out = (float*)d_out; a.ws = (unsigned char*)d_ws;
    for (int li = 0; li < N_LAUNCHES; ++li) {
        a.ph_lo = (N_LAUNCHES == 1) ? 0 : li; a.ph_hi = (N_LAUNCHES == 1) ? N_PHASES : li + 1;
        void* kargs[] = {&a};
        for (int rep = 0; rep < ((N_LAUNCHES != 1 && li == REP_PHASE) ? 2 : 1); ++rep)
            (void)hipLaunchKernel(phase_fn(N_LAUNCHES == 1 ? -1 : li), dim3(grid), dim3(NWAVES * 64), kargs, LDS_BYTES, stream);
        const hipError_t le = hipPeekAtLastError();
        if (le != hipSuccess) { fprintf(stderr, "kernel_launch: launch %d failed: %s\n", li, hipGetErrorName(le)); break; }
    }
}
```

```cpp
#include <hip/hip_runtime.h>
#include <cstdio>
#include <cstdint>

#ifndef MK_N_LAUNCHES
#define MK_N_LAUNCHES 1
#endif
#ifndef REP_PHASE
#define REP_PHASE -1
#endif
#ifndef RESID_BF16
#define RESID_BF16 1
#endif
#ifndef ATT_FP8
#define ATT_FP8 1
#endif
#ifndef GEMM_SIMPLE
#define GEMM_SIMPLE 0
#endif

#define LAS __attribute__((address_space(3)))
#define GAS __attribute__((address_space(1)))
typedef unsigned short bf16_t;
typedef short bf16x8 __attribute__((ext_vector_type(8)));
typedef short s16x4 __attribute__((ext_vector_type(4)));
typedef float f32x2 __attribute__((ext_vector_type(2)));
typedef float f32x4 __attribute__((ext_vector_type(4)));
typedef float f32x16 __attribute__((ext_vector_type(16)));
typedef unsigned u32x2 __attribute__((ext_vector_type(2)));
typedef unsigned u32x4 __attribute__((ext_vector_type(4)));
typedef __bf16 bf16x2_t __attribute__((ext_vector_type(2)));

constexpr int DM = 1024, NB = 2, SEQ = 8192, MT = NB * SEQ;
constexpr int NU = 5632;
constexpr int NHEAD = 8, QK_NOPE = 128, QK_ROPE = 64, V_HEAD = 128, Q_LORA = 256, KV_LORA = 128;
constexpr int MEM_LEN = 256, MEM_HEADS = 4, MEM_HD = 256;
constexpr int NEXP = 16, EFF = 1024, CAP = 1024;
constexpr int MOE_ROWS = NB * NEXP * CAP;
constexpr float EPS = 1e-6f;
constexpr float ATT_SCALE = 0.07216878364870322f;

__device__ __forceinline__ unsigned cvtpk(float lo, float hi) { f32x2 v = {lo, hi}; bf16x2_t b = __builtin_convertvector(v, bf16x2_t); return __builtin_bit_cast(unsigned, b); }
__device__ __forceinline__ float bflo(unsigned w) { return __builtin_bit_cast(float, w << 16); }
__device__ __forceinline__ float bfhi(unsigned w) { return __builtin_bit_cast(float, w & 0xffff0000u); }
__device__ __forceinline__ float bf2f(bf16_t h) { return __builtin_bit_cast(float, (unsigned)h << 16); }
__device__ __forceinline__ bf16_t f2bf(float f) { return (bf16_t)(cvtpk(f, 0.f) & 0xffffu); }
__device__ __forceinline__ void unpack8(const u32x4 w, float (&v)[8]) { v[0] = bflo(w.x); v[1] = bfhi(w.x); v[2] = bflo(w.y); v[3] = bfhi(w.y); v[4] = bflo(w.z); v[5] = bfhi(w.z); v[6] = bflo(w.w); v[7] = bfhi(w.w); }
__device__ __forceinline__ u32x4 pack8(const float (&v)[8]) { u32x4 w; w.x = cvtpk(v[0], v[1]); w.y = cvtpk(v[2], v[3]); w.z = cvtpk(v[4], v[5]); w.w = cvtpk(v[6], v[7]); return w; }
typedef int v8i __attribute__((ext_vector_type(8)));
__device__ __forceinline__ unsigned pk4_fp8(float a, float b, float c, float d) { unsigned w = 0; w = __builtin_amdgcn_cvt_pk_fp8_f32(a, b, w, false); w = __builtin_amdgcn_cvt_pk_fp8_f32(c, d, w, true); return w; }
__device__ __forceinline__ u32x2 pack8_fp8(const float (&v)[8]) { u32x2 w; w.x = pk4_fp8(v[0], v[1], v[2], v[3]); w.y = pk4_fp8(v[4], v[5], v[6], v[7]); return w; }
__device__ __forceinline__ float wave_sum(float v) {
#pragma unroll
    for (int o = 1; o < 64; o <<= 1) v += __shfl_xor(v, o);
    return v;
}

namespace pg8 {
constexpr int BM = 256, BK = 64, HALF = 128, HTB = HALF * BK * 2, STAGE_BYTES = 8 * HTB, NXCD = 8, WGM = 8;
__host__ __device__ __forceinline__ int lds_byte(int r, int c) { const int st = (r >> 4) * 2 + (c >> 5), rr = r & 15, cc = c & 31, ob = rr * 64 + cc * 2; return st * 1024 + (ob ^ (((ob >> 9) & 1) << 5)); }
__host__ __device__ __forceinline__ void stage_rc(int b, int& R, int& C) { const int st = b / 1024, sb = b % 1024, swz = sb ^ (((sb >> 9) & 1) << 5); R = (st >> 1) * 16 + swz / 64; C = (st & 1) * 32 + (swz % 64) / 2; }
__host__ __device__ __forceinline__ int perm32(int rho) { const int n = rho >> 4, i = rho & 15; return 8 * (i >> 2) + 4 * n + (i & 3); }

struct Unit { int pm, pn; };
struct Gemm { const bf16_t* A; const bf16_t* Bt; int M, N, K, lda, ldb, bdiv, bmod; size_t bstride; const int* gidx; };
__device__ __forceinline__ Gemm mkgemm(const bf16_t* A, const bf16_t* Bt, int M, int N, int K, int lda, int ldb, int bdiv = 1, int bmod = 1, size_t bstride = 0) {
    Gemm g; g.A = A; g.Bt = Bt; g.M = M; g.N = N; g.K = K; g.lda = lda; g.ldb = ldb; g.bdiv = bdiv; g.bmod = bmod; g.bstride = bstride; g.gidx = nullptr; return g; }

struct StaticOrder {
    int nM, nN, nwg, G, c;
    __host__ __device__ void init(int M, int N, int G_, int c_) { nM = M / BM; nN = N / BM; nwg = nM * nN; G = G_; c = c_; }
    __host__ __device__ bool next(int i, Unit& u) const {
        const long L = (long)i * G + c; if (L >= nwg) return false;
        int wgid = (int)L; { const int q = nwg / NXCD, r = nwg % NXCD, xcd = wgid % NXCD, off = wgid / NXCD; wgid = (xcd < r ? xcd * (q + 1) : r * (q + 1) + (xcd - r) * q) + off; }
        const int nig = WGM * nN, gid = wgid / nig, fm = gid * WGM, gsz = (nM - fm) < WGM ? (nM - fm) : WGM;
        u.pm = fm + ((wgid % nig) % gsz); u.pn = (wgid % nig) / gsz; return true;
    }
};

typedef f32x4 Acc[2][2][4][2];

template <class Epi, class Sched>
__device__ __forceinline__ void gemm_simple(LAS unsigned char* lds, const Gemm g, const Sched& S, const Epi& E, const int tid) {
    const int wid = __builtin_amdgcn_readfirstlane(tid >> 6), lane = tid & 63, wr = wid >> 2, wc = wid & 3, fr = lane & 15, fq = lane >> 4;
    Unit u;
    for (int i = 0; S.next(i, u); ++i) {
        Acc acc;
#pragma unroll
        for (int a = 0; a < 2; ++a)
#pragma unroll
            for (int b = 0; b < 2; ++b)
#pragma unroll
                for (int m = 0; m < 4; ++m)
#pragma unroll
                    for (int n = 0; n < 2; ++n) acc[a][b][m][n] = (f32x4){0.f, 0.f, 0.f, 0.f};
        const bf16_t* Ab = g.A + (size_t)u.pm * BM * g.lda + (size_t)(wr * 64 + fr) * g.lda + fq * 8;
        const bf16_t* Bb = g.Bt + (size_t)((u.pm / g.bdiv) % g.bmod) * g.bstride + (size_t)u.pn * BM * g.ldb + fq * 8;
        int brow[2][2];
#pragma unroll
        for (int bj = 0; bj < 2; ++bj)
#pragma unroll
            for (int n = 0; n < 2; ++n) brow[bj][n] = bj * HALF + wc * 32 + perm32(n * 16 + fr);
#pragma unroll 1
        for (int k0 = 0; k0 < g.K; k0 += 32) {
            bf16x8 b[2][2];
#pragma unroll
            for (int bj = 0; bj < 2; ++bj)
#pragma unroll
                for (int n = 0; n < 2; ++n) b[bj][n] = *(const bf16x8*)(Bb + (size_t)brow[bj][n] * g.ldb + k0);
#pragma unroll
            for (int ai = 0; ai < 2; ++ai) { bf16x8 a[4];
#pragma unroll
                for (int m = 0; m < 4; ++m) a[m] = *(const bf16x8*)(Ab + (size_t)(ai * HALF + m * 16) * g.lda + k0);
#pragma unroll
                for (int bj = 0; bj < 2; ++bj)
#pragma unroll
                    for (int m = 0; m < 4; ++m)
#pragma unroll
                        for (int n = 0; n < 2; ++n) acc[ai][bj][m][n] = __builtin_amdgcn_mfma_f32_16x16x32_bf16(b[bj][n], a[m], acc[ai][bj][m][n], 0, 0, 0); }
        }
        E.run(acc, u, wr, wc, fr, fq, lds, wid, lane);
        if (Epi::USES_LDS) __syncthreads();
    }
}

template <class Epi, class Sched, bool GATHER>
__device__ __forceinline__ void gemm_fast(LAS unsigned char* lds, const Gemm g, const Sched& S, const Epi& E, const int tid) {
    const int wid = __builtin_amdgcn_readfirstlane(tid >> 6), lane = tid & 63, wr = wid >> 2, wc = wid & 3, fr = lane & 15, fq = lane >> 4;
    int Kop = g.K; asm volatile("" : "+s"(Kop));
    const int K = Kop, nt = K / BK;
    int Rr[2], Cc[2]; unsigned voffB[2];
    unsigned cvA0[2], cvA1[2], nvA0[2], nvA1[2];
    const size_t kstep = (size_t)(BK * 2);
    const size_t hstepA = (size_t)HALF * g.lda * 2, hstepB = (size_t)HALF * g.ldb * 2;
    const size_t tstepA = 2 * hstepA, tstepB = 2 * hstepB;
#pragma unroll
    for (int i = 0; i < 2; ++i) { stage_rc(tid * 16 + i * 8192, Rr[i], Cc[i]); const int Rb = (Rr[i] & ~31) + perm32(Rr[i] & 31);
        voffB[i] = (unsigned)(Rb * g.ldb + Cc[i]) * 2u;
        cvA0[i] = (unsigned)(Rr[i] * g.lda + Cc[i]) * 2u; cvA1[i] = cvA0[i] + (unsigned)hstepA; nvA0[i] = cvA0[i]; nvA1[i] = cvA1[i]; }
    const unsigned ldsw = (unsigned)wid * 1024u;
    const int aoff = lds_byte(wr * 64 + fr, fq * 8), boff = lds_byte(wc * 32 + fr, fq * 8);
#define PG8_SA(b, h) (((b) * 2 + (h)) * HTB)
#define PG8_SB(b, h) ((4 + (b) * 2 + (h)) * HTB)
#define PG8_STAGE(bufoff, gbase, voff) do { _Pragma("unroll") for (int _i = 0; _i < 2; ++_i) \
        __builtin_amdgcn_global_load_lds((const unsigned*)((const char*)(gbase) + (voff)[_i]), (LAS unsigned*)(lds + (bufoff) + ldsw + _i * 8192), 16, 0, 0); } while (0)
#define PG8_LDA(dst, b, h) do { _Pragma("unroll") for (int m = 0; m < 4; ++m) _Pragma("unroll") for (int k = 0; k < 2; ++k) dst[m][k] = *(const LAS bf16x8*)(lds + PG8_SA(b, h) + aoff + m * 2048 + k * 1024); } while (0)
#define PG8_LDB(dst, b, h) do { _Pragma("unroll") for (int n = 0; n < 2; ++n) _Pragma("unroll") for (int k = 0; k < 2; ++k) dst[n][k] = *(const LAS bf16x8*)(lds + PG8_SB(b, h) + boff + n * 2048 + k * 1024); } while (0)
#define PG8_MMA(ai, bj, At, Bt) do { __builtin_amdgcn_s_setprio(1); _Pragma("unroll") for (int m = 0; m < 4; ++m) _Pragma("unroll") for (int n = 0; n < 2; ++n) _Pragma("unroll") for (int k = 0; k < 2; ++k) \
        acc[ai][bj][m][n] = __builtin_amdgcn_mfma_f32_16x16x32_bf16(Bt[n][k], At[m][k], acc[ai][bj][m][n], 0, 0, 0); __builtin_amdgcn_s_setprio(0); } while (0)
#define PG8_WAIT_V(n) asm volatile("s_waitcnt vmcnt(" #n ")" ::: "memory")
#define PG8_WAIT_L(n) asm volatile("s_waitcnt lgkmcnt(" #n ")" ::: "memory")
#define PG8_BAR __builtin_amdgcn_s_barrier()
#define PG8_SCHED __builtin_amdgcn_sched_barrier(0)
#define PG8_GIDX(u, raw) do { const int* ip_ = g.gidx + (size_t)(u).pm * BM; raw[0] = ip_[Rr[0]]; raw[1] = ip_[Rr[1]]; raw[2] = ip_[HALF + Rr[0]]; raw[3] = ip_[HALF + Rr[1]]; } while (0)
#define PG8_GOFF(u, raw, v0, v1) do { const unsigned bb_ = (unsigned)((u).pm >> 6) * (unsigned)SEQ; _Pragma("unroll") for (int _i = 0; _i < 2; ++_i) { \
        v0[_i] = ((bb_ + (unsigned)raw[_i]) * (unsigned)g.lda + (unsigned)Cc[_i]) * 2u; v1[_i] = ((bb_ + (unsigned)raw[2 + _i]) * (unsigned)g.lda + (unsigned)Cc[_i]) * 2u; } } while (0)
    Unit cur, nxt; int ui = 0;
    if (!S.next(0, cur)) return;
    Acc acc;
#pragma unroll
    for (int a = 0; a < 2; ++a)
#pragma unroll
        for (int b = 0; b < 2; ++b)
#pragma unroll
            for (int m = 0; m < 4; ++m)
#pragma unroll
                for (int n = 0; n < 2; ++n) acc[a][b][m][n] = (f32x4){0.f, 0.f, 0.f, 0.f};
    bf16x8 At[4][2], B0[2][2], B1[2][2];
    int nraw[4] = {0, 0, 0, 0};
    const char* cA = GATHER ? (const char*)g.A : (const char*)g.A + (size_t)cur.pm * tstepA;
    const char* cB = (const char*)g.Bt + (size_t)((cur.pm / g.bdiv) % g.bmod) * g.bstride * 2 + (size_t)cur.pn * tstepB;
    if constexpr (GATHER) { int craw[4]; PG8_GIDX(cur, craw); PG8_GOFF(cur, craw, cvA0, cvA1); }
    PG8_STAGE(PG8_SB(0, 0), cB, voffB); PG8_STAGE(PG8_SB(0, 1), cB + hstepB, voffB); PG8_STAGE(PG8_SA(0, 0), cA, cvA0); PG8_STAGE(PG8_SA(0, 1), cA, cvA1);
    if (wr == 1) PG8_BAR;
    PG8_WAIT_V(2); PG8_BAR;
    PG8_STAGE(PG8_SB(1, 0), cB + kstep, voffB); PG8_STAGE(PG8_SA(1, 0), cA + kstep, cvA0); PG8_STAGE(PG8_SB(1, 1), cB + hstepB + kstep, voffB);
    PG8_WAIT_V(6); PG8_BAR;
    for (;;) {
        const bool has_next = S.next(ui + 1, nxt);
        const char* nA = GATHER ? (const char*)g.A : (has_next ? (const char*)g.A + (size_t)nxt.pm * tstepA : cA);
        const char* nB = has_next ? (const char*)g.Bt + (size_t)((nxt.pm / g.bdiv) % g.bmod) * g.bstride * 2 + (size_t)nxt.pn * tstepB : cB;
        if constexpr (GATHER) { if (has_next) PG8_GIDX(nxt, nraw); }
        for (int t = 0; t < nt; t += 2) {
            const bool last = (t == nt - 2);
            const char* a1 = cA + (size_t)(t + 1) * kstep;
            const char* a2 = last ? nA : cA + (size_t)(t + 2) * kstep; const char* b2 = last ? nB : cB + (size_t)(t + 2) * kstep;
            const char* a3 = a2 + kstep; const char* b3 = b2 + kstep;
            unsigned sA0[2] = {cvA0[0], cvA0[1]}, sA1[2] = {cvA1[0], cvA1[1]};
            if constexpr (GATHER) { if (last) { if (has_next) PG8_GOFF(nxt, nraw, nvA0, nvA1); else { nvA0[0] = cvA0[0]; nvA0[1] = cvA0[1]; nvA1[0] = cvA1[0]; nvA1[1] = cvA1[1]; }
                                                 sA0[0] = nvA0[0]; sA0[1] = nvA0[1]; sA1[0] = nvA1[0]; sA1[1] = nvA1[1]; } }
            PG8_LDB(B0, 0, 0); PG8_LDB(B1, 0, 1); PG8_SCHED; PG8_LDA(At, 0, 0); PG8_STAGE(PG8_SA(1, 1), a1, cvA1);
            PG8_WAIT_V(8); PG8_WAIT_L(0); PG8_BAR; PG8_MMA(0, 0, At, B0); PG8_MMA(0, 1, At, B1); PG8_BAR; PG8_SCHED;
            PG8_LDA(At, 0, 1); PG8_STAGE(PG8_SB(0, 0), b2, voffB); PG8_STAGE(PG8_SB(0, 1), b2 + hstepB, voffB); PG8_STAGE(PG8_SA(0, 0), a2, sA0);
            PG8_WAIT_V(8); PG8_WAIT_L(0); PG8_BAR; PG8_MMA(1, 0, At, B0); PG8_MMA(1, 1, At, B1); PG8_BAR; PG8_SCHED;
            PG8_LDB(B0, 1, 0); PG8_LDB(B1, 1, 1); PG8_SCHED; PG8_LDA(At, 1, 0); PG8_STAGE(PG8_SA(0, 1), a2, sA1);
            PG8_WAIT_V(8); PG8_WAIT_L(0); PG8_BAR; PG8_MMA(0, 0, At, B0); PG8_MMA(0, 1, At, B1); PG8_BAR; PG8_SCHED;
            PG8_LDA(At, 1, 1); PG8_STAGE(PG8_SB(1, 0), b3, voffB); PG8_STAGE(PG8_SB(1, 1), b3 + hstepB, voffB); PG8_STAGE(PG8_SA(1, 0), a3, sA0);
            PG8_WAIT_V(8); PG8_WAIT_L(0); PG8_BAR; PG8_MMA(1, 0, At, B0); PG8_MMA(1, 1, At, B1); PG8_BAR; PG8_SCHED;
        }
        if (wr == 0) PG8_BAR;
        E.run(acc, cur, wr, wc, fr, fq, lds + STAGE_BYTES, wid, lane);
        if (!has_next) break;
#pragma unroll
        for (int a = 0; a < 2; ++a)
#pragma unroll
            for (int b = 0; b < 2; ++b)
#pragma unroll
                for (int m = 0; m < 4; ++m)
#pragma unroll
                    for (int n = 0; n < 2; ++n) acc[a][b][m][n] = (f32x4){0.f, 0.f, 0.f, 0.f};
        cur = nxt; cA = nA; cB = nB; ++ui;
        if constexpr (GATHER) { cvA0[0] = nvA0[0]; cvA0[1] = nvA0[1]; cvA1[0] = nvA1[0]; cvA1[1] = nvA1[1]; }
        if (wr == 1) PG8_BAR;
    }
    PG8_WAIT_V(0);
    PG8_BAR;
#undef PG8_SA
#undef PG8_SB
#undef PG8_STAGE
#undef PG8_LDA
#undef PG8_LDB
#undef PG8_MMA
#undef PG8_WAIT_V
#undef PG8_WAIT_L
#undef PG8_BAR
#undef PG8_SCHED
#undef PG8_GIDX
#undef PG8_GOFF
}

template <class Epi, class Sched, bool GATHER = false>
__device__ __forceinline__ void gemm_phase(LAS unsigned char* lds, const Gemm g, const Sched& S, const Epi& E, const int tid) {
#if GEMM_SIMPLE
    static_assert(!GATHER, "the simple body has no gather path");
    gemm_simple<Epi, Sched>(lds + STAGE_BYTES, g, S, E, tid);
#else
    gemm_fast<Epi, Sched, GATHER>(lds, g, S, E, tid);
#endif
}

template <class F> struct EpiChunk {
    static constexpr bool USES_LDS = false;
    F f;
    __device__ __forceinline__ void run(Acc& acc, const Unit& u, int wr, int wc, int fr, int fq, LAS unsigned char*, int, int) const {
        constexpr int NBT = F::NBATCH, GPB = 8 / NBT;
#pragma unroll
        for (int bt = 0; bt < NBT; ++bt) {
            typename F::Pre pre[GPB][2];
#pragma unroll
            for (int g = 0; g < GPB; ++g) { const int rg = bt * GPB + g, ai = rg >> 2, m = rg & 3; const int row = u.pm * BM + ai * HALF + wr * 64 + m * 16 + fr;
#pragma unroll
                for (int bj = 0; bj < 2; ++bj) { const int col = u.pn * BM + bj * HALF + wc * 32 + 8 * fq; pre[g][bj] = f.load(row, col); } }
            asm volatile("" ::: "memory");
#pragma unroll
            for (int g = 0; g < GPB; ++g) { const int rg = bt * GPB + g, ai = rg >> 2, m = rg & 3; const int row = u.pm * BM + ai * HALF + wr * 64 + m * 16 + fr;
#pragma unroll
                for (int bj = 0; bj < 2; ++bj) { const int col = u.pn * BM + bj * HALF + wc * 32 + 8 * fq;
                    const f32x4 a = acc[ai][bj][m][0], b = acc[ai][bj][m][1];
                    const float v[8] = {a[0], a[1], a[2], a[3], b[0], b[1], b[2], b[3]};
                    f.chunk(row, col, v, pre[g][bj]); } }
            asm volatile("" ::: "memory");
        }
    }
};
}
using pg8::Gemm; using pg8::Unit; using pg8::StaticOrder; using pg8::mkgemm;

struct PreNone {};
struct PreF { float r; };
struct FU { const float* rstd0; bf16_t *XGG, *CQ, *CKV, *KR, *SIGA, *SIGB; const float* bgate;
    static constexpr int NBATCH = 4;
    struct Pre { float rs; f32x4 b0, b1; };
    __device__ __forceinline__ Pre load(int row, int col) const { Pre p; p.rs = rstd0[row];
        if (col >= 3584) { p.b0 = *(const f32x4*)(bgate + (col - 3584)); p.b1 = *(const f32x4*)(bgate + (col - 3584) + 4); } else { p.b0 = (f32x4){0.f, 0.f, 0.f, 0.f}; p.b1 = p.b0; }
        return p; }
    __device__ __forceinline__ void chunk(int row, int col, const float (&v)[8], const Pre& p) const {
        const float rs = p.rs; float o[8];
#pragma unroll
        for (int i = 0; i < 8; ++i) o[i] = v[i] * rs;
        if (col < 3072) { *(u32x4*)(XGG + (size_t)row * 2048 + 1024 + (col - 2048)) = pack8(o); }
        else if (col < 3328) { *(u32x4*)(CQ + (size_t)row * 256 + (col - 3072)) = pack8(o); }
        else if (col < 3456) { *(u32x4*)(CKV + (size_t)row * 128 + (col - 3328)) = pack8(o); }
        else if (col < 3520) { *(u32x4*)(KR + (size_t)row * 64 + (col - 3456)) = pack8(o); }
        else if (col >= 3584) { const int c = col - 3584;
            const float bb[8] = {p.b0[0], p.b0[1], p.b0[2], p.b0[3], p.b1[0], p.b1[1], p.b1[2], p.b1[3]};
#pragma unroll
            for (int i = 0; i < 8; ++i) o[i] = 1.f / (1.f + __expf(-(o[i] + bb[i])));
            bf16_t* dst = c < 1024 ? SIGA + (size_t)row * 1024 + c : SIGB + (size_t)row * 1024 + (c - 1024);
            *(u32x4*)dst = pack8(o); }
    } };
struct EpiU {
    static constexpr bool USES_LDS = false;
    FU f;
    __device__ __forceinline__ void run(pg8::Acc& acc, const Unit& u, int wr, int wc, int fr, int fq, LAS unsigned char* scr, int wid, int lane) const {
        if (u.pn < 8) {
#pragma unroll
            for (int ai = 0; ai < 2; ++ai)
#pragma unroll
                for (int m = 0; m < 4; ++m) { const int row = u.pm * 256 + ai * 128 + wr * 64 + m * 16 + fr; const int col = u.pn * 128 + wc * 32 + 8 * fq; const float rs = f.rstd0[row]; const float r2 = rs * rs; float o[8];
#pragma unroll
                    for (int n = 0; n < 2; ++n)
#pragma unroll
                        for (int i = 0; i < 4; ++i) o[n * 4 + i] = acc[ai][0][m][n][i] * acc[ai][1][m][n][i] * r2;
                    *(u32x4*)(f.XGG + (size_t)row * 2048 + col) = pack8(o); }
        } else { pg8::EpiChunk<FU> E{f}; E.run(acc, u, wr, wc, fr, fq, scr, wid, lane); }
    }
};
struct FMemKV { const float* rstdm; bf16_t* MKV;
    static constexpr int NBATCH = 1; typedef PreF Pre;
    __device__ __forceinline__ Pre load(int row, int) const { Pre p; p.r = rstdm[row]; return p; }
    __device__ __forceinline__ void chunk(int row, int col, const float (&v)[8], const Pre& p) const {
        const float rs = p.r * (col < 1024 ? 0.0625f : 1.f); float o[8];
#pragma unroll
        for (int i = 0; i < 8; ++i) o[i] = v[i] * rs;
        const int kv = col >> 10, h = (col >> 8) & 3, j = col & 255, b = row >> 8, key = row & 255;
        *(u32x4*)(MKV + ((size_t)((kv * 2 + b) * 4 + h) * 256 + key) * 256 + j) = pack8(o);
    } };
struct FQ { const float* rstdq; const f32x2* rope; bf16_t* Q; unsigned char* Q8;
    static constexpr int NBATCH = 4;
    struct Pre { float rs; f32x2 cs[4]; };
    __device__ __forceinline__ Pre load(int row, int col) const { Pre p; p.rs = rstdq[row];
        if (col >= 1024) { const int pp = (col - 1024) & 63, j0 = (pp >> 3) * 4, s = row & (SEQ - 1);
#pragma unroll
            for (int i = 0; i < 4; ++i) p.cs[i] = rope[s * 32 + j0 + i]; }
        else {
#pragma unroll
            for (int i = 0; i < 4; ++i) p.cs[i] = (f32x2){1.f, 0.f}; }
        return p; }
    __device__ __forceinline__ void chunk(int row, int col, const float (&v)[8], const Pre& p) const {
        const float rs = p.rs; float o[8];
#pragma unroll
        for (int i = 0; i < 8; ++i) o[i] = v[i] * rs;
        if (col >= 1024) {
#pragma unroll
            for (int i = 0; i < 4; ++i) { const f32x2 cs = p.cs[i]; const float a = o[i], b = o[4 + i]; o[i] = a * cs.x - b * cs.y; o[4 + i] = a * cs.y + b * cs.x; } }
        if (Q8) { float q[8];
#pragma unroll
            for (int i = 0; i < 8; ++i) q[i] = o[i] * (16.f * ATT_SCALE * 1.4426950408889634f);
            *(u32x2*)(Q8 + (size_t)row * 1536 + col) = pack8_fp8(q); }
        else *(u32x4*)(Q + (size_t)row * 1536 + col) = pack8(o);
    } };
struct FScaleRow { const float* rs; bf16_t* O; int ldo;
    static constexpr int NBATCH = 1; typedef PreF Pre;
    __device__ __forceinline__ Pre load(int row, int) const { Pre p; p.r = rs[row]; return p; }
    __device__ __forceinline__ void chunk(int row, int col, const float (&v)[8], const Pre& p) const {
        const float r = p.r; float o[8];
#pragma unroll
        for (int i = 0; i < 8; ++i) o[i] = v[i] * r;
        *(u32x4*)(O + (size_t)row * ldo + col) = pack8(o);
    } };
struct FK8 { const float* rs; unsigned char* K8;
    static constexpr int NBATCH = 1; typedef PreF Pre;
    __device__ __forceinline__ Pre load(int row, int) const { Pre p; p.r = rs[row]; return p; }
    __device__ __forceinline__ void chunk(int row, int col, const float (&v)[8], const Pre& p) const {
        const float r = p.r; float o[8];
#pragma unroll
        for (int i = 0; i < 8; ++i) o[i] = v[i] * r;
        *(u32x2*)(K8 + (size_t)row * 1024 + col) = pack8_fp8(o);
    } };
struct FVT8 { const float* rs; unsigned char* VT;
    static constexpr int NBATCH = 2;
    struct Pre { f32x4 a, b; };
    __device__ __forceinline__ Pre load(int, int col) const { Pre p; p.a = *(const f32x4*)(rs + col); p.b = *(const f32x4*)(rs + col + 4); return p; }
    __device__ __forceinline__ void chunk(int row, int col, const float (&v)[8], const Pre& p) const {
        const float o[8] = {v[0] * p.a[0], v[1] * p.a[1], v[2] * p.a[2], v[3] * p.a[3], v[4] * p.b[0], v[5] * p.b[1], v[6] * p.b[2], v[7] * p.b[3]};
        *(u32x2*)(VT + (size_t)(col >> 13) * ((size_t)1024 * SEQ) + (size_t)row * SEQ + (col & (SEQ - 1))) = pack8_fp8(o);
    } };
struct FPlain { bf16_t* O; int ldo;
    static constexpr int NBATCH = 1; typedef PreNone Pre;
    __device__ __forceinline__ Pre load(int, int) const { return Pre{}; }
    __device__ __forceinline__ void chunk(int row, int col, const float (&v)[8], const Pre&) const { *(u32x4*)(O + (size_t)row * ldo + col) = pack8(v); } };
struct FVW { bf16_t* O;
    static constexpr int NBATCH = 1; typedef PreNone Pre;
    __device__ __forceinline__ Pre load(int, int) const { return Pre{}; }
    __device__ __forceinline__ void chunk(int row, int col, const float (&v)[8], const Pre&) const { const int h = row >> 10, n = row & 1023; *(u32x4*)(O + (size_t)n * 1024 + h * 256 + col) = pack8(v); } };
struct FGateMul { const bf16_t* G; bf16_t* O;
    static constexpr int NBATCH = 2;
    struct Pre { u32x4 g; };
    __device__ __forceinline__ Pre load(int row, int col) const { Pre p; p.g = *(const u32x4*)(G + (size_t)row * 1024 + col); return p; }
    __device__ __forceinline__ void chunk(int row, int col, const float (&v)[8], const Pre& p) const {
        float g[8], o[8]; unpack8(p.g, g);
#pragma unroll
        for (int i = 0; i < 8; ++i) o[i] = g[i] * v[i];
        *(u32x4*)(O + (size_t)row * 1024 + col) = pack8(o);
    } };
struct FGateMulAdd { const bf16_t* G; const bf16_t* Pv; bf16_t* O;
    static constexpr int NBATCH = 2;
    struct Pre { u32x4 g, p; };
    __device__ __forceinline__ Pre load(int row, int col) const { Pre p; p.g = *(const u32x4*)(G + (size_t)row * 1024 + col); p.p = *(const u32x4*)(Pv + (size_t)row * 1024 + col); return p; }
    __device__ __forceinline__ void chunk(int row, int col, const float (&v)[8], const Pre& pr) const {
        float g[8], p[8], o[8]; unpack8(pr.g, g); unpack8(pr.p, p);
#pragma unroll
        for (int i = 0; i < 8; ++i) o[i] = p[i] + g[i] * v[i];
        *(u32x4*)(O + (size_t)row * 1024 + col) = pack8(o);
    } };
struct FResidF32 { const float* base; float* out;
    static constexpr int NBATCH = 2;
    struct Pre { f32x4 a, b; };
    __device__ __forceinline__ Pre load(int row, int col) const { const size_t off = (size_t)row * 1024 + col; Pre p; p.a = *(const f32x4*)(base + off); p.b = *(const f32x4*)(base + off + 4); return p; }
    __device__ __forceinline__ void chunk(int row, int col, const float (&v)[8], const Pre& p) const {
        const size_t off = (size_t)row * 1024 + col; const f32x4 a = p.a, b = p.b;
        *(f32x4*)(out + off) = (f32x4){a[0] + v[0], a[1] + v[1], a[2] + v[2], a[3] + v[3]}; *(f32x4*)(out + off + 4) = (f32x4){b[0] + v[4], b[1] + v[5], b[2] + v[6], b[3] + v[7]};
    } };
struct FResidBf16 { const bf16_t* base; bf16_t* out;
    static constexpr int NBATCH = 1;
    struct Pre { u32x4 a; };
    __device__ __forceinline__ Pre load(int row, int col) const { Pre p; p.a = *(const u32x4*)(base + (size_t)row * 1024 + col); return p; }
    __device__ __forceinline__ void chunk(int row, int col, const float (&v)[8], const Pre& p) const {
        float a[8], o[8]; unpack8(p.a, a);
#pragma unroll
        for (int i = 0; i < 8; ++i) o[i] = a[i] + v[i];
        *(u32x4*)(out + (size_t)row * 1024 + col) = pack8(o);
    } };
struct FGateRow { const float* gate; bf16_t* O;
    static constexpr int NBATCH = 1; typedef PreF Pre;
    __device__ __forceinline__ Pre load(int row, int) const { Pre p; p.r = gate[row]; return p; }
    __device__ __forceinline__ void chunk(int row, int col, const float (&v)[8], const Pre& p) const {
        const float r = p.r; float o[8];
#pragma unroll
        for (int i = 0; i < 8; ++i) o[i] = v[i] * r;
        *(u32x4*)(O + (size_t)row * 1024 + col) = pack8(o);
    } };

struct EpiX1 {
    static constexpr bool USES_LDS = false;
    const float* base; float* out; bf16_t* xb; float* ssq;
    __device__ __forceinline__ void run(pg8::Acc& acc, const Unit& u, int wr, int wc, int fr, int fq, LAS unsigned char*, int, int) const {
#pragma unroll
        for (int bt = 0; bt < 4; ++bt) { f32x4 pa[2][2], pb[2][2];
#pragma unroll
            for (int g = 0; g < 2; ++g) { const int rg = bt * 2 + g, ai = rg >> 2, m = rg & 3; const int row = u.pm * 256 + ai * 128 + wr * 64 + m * 16 + fr;
#pragma unroll
                for (int bj = 0; bj < 2; ++bj) { const size_t off = (size_t)row * 1024 + u.pn * 256 + bj * 128 + wc * 32 + 8 * fq; pa[g][bj] = *(const f32x4*)(base + off); pb[g][bj] = *(const f32x4*)(base + off + 4); } }
            asm volatile("" ::: "memory");
#pragma unroll
            for (int g = 0; g < 2; ++g) { const int rg = bt * 2 + g, ai = rg >> 2, m = rg & 3; const int row = u.pm * 256 + ai * 128 + wr * 64 + m * 16 + fr; float s = 0.f;
#pragma unroll
                for (int bj = 0; bj < 2; ++bj) { const int col = u.pn * 256 + bj * 128 + wc * 32 + 8 * fq; const size_t off = (size_t)row * 1024 + col;
                    const f32x4 a = pa[g][bj], b = pb[g][bj]; const f32x4 c0 = acc[ai][bj][m][0], c1 = acc[ai][bj][m][1];
                    const float o[8] = {a[0] + c0[0], a[1] + c0[1], a[2] + c0[2], a[3] + c0[3], b[0] + c1[0], b[1] + c1[1], b[2] + c1[2], b[3] + c1[3]};
                    if (out) { *(f32x4*)(out + off) = (f32x4){o[0], o[1], o[2], o[3]}; *(f32x4*)(out + off + 4) = (f32x4){o[4], o[5], o[6], o[7]}; }
                    *(u32x4*)(xb + off) = pack8(o);
#pragma unroll
                    for (int i = 0; i < 8; ++i) s += o[i] * o[i]; }
                s += __shfl_xor(s, 16); s += __shfl_xor(s, 32);
                if (fq == 0) ssq[(size_t)row * 16 + u.pn * 4 + wc] = s; }
            asm volatile("" ::: "memory"); }
    }
};
struct EpiSoftmax {
    static constexpr bool USES_LDS = true;
    const float* ssq; bf16_t* P;
    __device__ __forceinline__ void run(pg8::Acc& acc, const Unit& u, int wr, int wc, int fr, int fq, LAS unsigned char* scr, int wid_, int lane_) const {
        LAS float* PM = (LAS float*)scr;
        LAS float* PS = (LAS float*)(scr + 4096);
        LAS float* RS = (LAS float*)(scr + 4096);
        { const int t = wid_ * 64 + lane_; if (t < 256) { const f32x4* sp = (const f32x4*)((const char*)ssq + (unsigned)(u.pm * 256 + t) * 64u); const f32x4 q0 = sp[0], q1 = sp[1], q2 = sp[2], q3 = sp[3];
            float tt = ((q0[0] + q0[1]) + (q0[2] + q0[3])) + ((q1[0] + q1[1]) + (q1[2] + q1[3])); tt += ((q2[0] + q2[1]) + (q2[2] + q2[3])) + ((q3[0] + q3[1]) + (q3[2] + q3[3]));
            RS[t] = 1.f / sqrtf(tt * (1.f / 1024.f) + EPS); } }
        __syncthreads();
#pragma unroll
        for (int ai = 0; ai < 2; ++ai)
#pragma unroll
            for (int m = 0; m < 4; ++m) { const int rl = ai * 128 + wr * 64 + m * 16 + fr;
                const float rs = RS[rl];
                float mx = -3.0e38f;
#pragma unroll
                for (int bj = 0; bj < 2; ++bj)
#pragma unroll
                    for (int n = 0; n < 2; ++n)
#pragma unroll
                        for (int i = 0; i < 4; ++i) { const float s = acc[ai][bj][m][n][i] * rs; acc[ai][bj][m][n][i] = s; mx = fmaxf(mx, s); }
                mx = fmaxf(mx, __shfl_xor(mx, 16)); mx = fmaxf(mx, __shfl_xor(mx, 32));
                if (fq == 0) PM[rl * 4 + wc] = mx;
                asm volatile("" ::: "memory"); }
        __syncthreads();
#pragma unroll
        for (int ai = 0; ai < 2; ++ai)
#pragma unroll
            for (int m = 0; m < 4; ++m) { const int rl = ai * 128 + wr * 64 + m * 16 + fr;
                const f32x4 pm4 = *(const LAS f32x4*)(PM + rl * 4); const float mx = fmaxf(fmaxf(pm4[0], pm4[1]), fmaxf(pm4[2], pm4[3]));
                float s = 0.f;
#pragma unroll
                for (int bj = 0; bj < 2; ++bj)
#pragma unroll
                    for (int n = 0; n < 2; ++n)
#pragma unroll
                        for (int i = 0; i < 4; ++i) { const float e = __expf(acc[ai][bj][m][n][i] - mx); acc[ai][bj][m][n][i] = e; s += e; }
                s += __shfl_xor(s, 16); s += __shfl_xor(s, 32);
                if (fq == 0) PS[rl * 4 + wc] = s;
                asm volatile("" ::: "memory"); }
        __syncthreads();
#pragma unroll
        for (int ai = 0; ai < 2; ++ai)
#pragma unroll
            for (int m = 0; m < 4; ++m) { const int rl = ai * 128 + wr * 64 + m * 16 + fr; const int row = u.pm * 256 + rl;
                const f32x4 ps4 = *(const LAS f32x4*)(PS + rl * 4); const float inv = 1.f / ((ps4[0] + ps4[1]) + (ps4[2] + ps4[3]));
#pragma unroll
                for (int bj = 0; bj < 2; ++bj) { const int col = u.pn * 256 + bj * 128 + wc * 32 + 8 * fq; float o[8];
#pragma unroll
                    for (int n = 0; n < 2; ++n)
#pragma unroll
                        for (int i = 0; i < 4; ++i) o[n * 4 + i] = acc[ai][bj][m][n][i] * inv;
                    *(u32x4*)((char*)P + ((unsigned)row * 1024u + (unsigned)col) * 2u) = pack8(o); }
                asm volatile("" ::: "memory"); }
    }
};
struct EpiSwiglu {
    static constexpr bool USES_LDS = false;
    bf16_t* H;
    __device__ __forceinline__ void run(pg8::Acc& acc, const Unit& u, int wr, int wc, int fr, int fq, LAS unsigned char*, int, int) const {
#pragma unroll
        for (int ai = 0; ai < 2; ++ai)
#pragma unroll
            for (int m = 0; m < 4; ++m) { const int row = u.pm * 256 + ai * 128 + wr * 64 + m * 16 + fr; const int col = u.pn * 128 + wc * 32 + 8 * fq; float o[8];
#pragma unroll
                for (int n = 0; n < 2; ++n)
#pragma unroll
                    for (int i = 0; i < 4; ++i) { const float g = acc[ai][0][m][n][i], up = acc[ai][1][m][n][i]; o[n * 4 + i] = g / (1.f + __expf(-g)) * up; }
                *(u32x4*)(H + (size_t)row * 1024 + col) = pack8(o); }
    }
};

namespace att {
constexpr int QBLK = 32, KVBLK = 64, NW = 8;
constexpr int LDQ = 1536, LDKV = 2048, LDKR = 64, LDO = 1024;
constexpr int KPITCH = 272, KRPITCH = 144;
constexpr int SHM_V = KVBLK * 128 * 2, SHM_K = KVBLK * KPITCH, SHM_KR = KVBLK * KRPITCH;
constexpr int OFF_V = 0, OFF_K = 2 * SHM_V, OFF_KR = OFF_K + 2 * SHM_K, OFF_WS = OFF_KR + 2 * SHM_KR, OFF_QR = OFF_WS + NW * 64 * 4, SHM_ATTN = OFF_QR + NW * 4096;
constexpr float THR = 8.f;
#define KSWZ(row, colB) ((row) * KPITCH + (colB))
#define KRSWZ(row, colB) ((row) * KRPITCH + (colB))
#define SBAR() __builtin_amdgcn_sched_barrier(0)
#ifndef PROBE_SEG
#define PROBE_SEG 0
#endif
#ifndef PROBE_WAVE
#define PROBE_WAVE 0
#endif
__device__ __forceinline__ unsigned tstamp() { unsigned long long t; asm volatile("s_memtime %0\n\ts_waitcnt lgkmcnt(0)" : "=s"(t)); return (unsigned)t; }
#ifndef PIPE9
#define PIPE9() do { } while (0)
#endif
__device__ __forceinline__ int crow(int r, int hi) { return (r & 3) + 8 * (r >> 2) + 4 * hi; }
__device__ __forceinline__ unsigned cvtpk_a(float lo, float hi) { unsigned r; asm volatile("v_cvt_pk_bf16_f32 %0, %1, %2" : "=v"(r) : "v"(lo), "v"(hi)); return r; }

__device__ __forceinline__ void partialSM(f32x16& p0, f32x16& p1, float& m_reg, float& mn, float& alpha) {
  constexpr float C = ATT_SCALE * 1.4426950408889634f;
  float pmax = p0[0];
#pragma unroll
  for (int r = 1; r < 16; ++r) pmax = fmaxf(pmax, p0[r]);
#pragma unroll
  for (int r = 0; r < 16; ++r) pmax = fmaxf(pmax, p1[r]);
  { auto rr = __builtin_amdgcn_permlane32_swap(__float_as_uint(pmax), __float_as_uint(pmax), false, false);
    pmax = fmaxf(__uint_as_float(rr[0]), __uint_as_float(rr[1])); }
  if (__builtin_expect(__all(pmax - m_reg <= THR / ATT_SCALE), 1)) { mn = m_reg; alpha = 1.f; }
  else { mn = fmaxf(m_reg, pmax); alpha = __builtin_amdgcn_exp2f((m_reg - mn) * C); m_reg = mn; }
  float mnC = -mn * C;
#pragma unroll
  for (int r = 0; r < 16; ++r) p0[r] = fmaf(p0[r], C, mnC);
#pragma unroll
  for (int r = 0; r < 16; ++r) p1[r] = fmaf(p1[r], C, mnC);
#pragma unroll
  for (int r = 0; r < 16; ++r) p0[r] = __builtin_amdgcn_exp2f(p0[r]);
}
__device__ __forceinline__ void finishSM(f32x16& p0, f32x16& p1, float alpha, float& l_reg, bf16x8& pa0, bf16x8& pa1, bf16x8& pa2, bf16x8& pa3) {
#pragma unroll
  for (int r = 0; r < 16; ++r) p1[r] = __builtin_amdgcn_exp2f(p1[r]);
  float ps = 0;
#pragma unroll
  for (int r = 0; r < 16; ++r) ps += p0[r];
#pragma unroll
  for (int r = 0; r < 16; ++r) ps += p1[r];
  { auto rr = __builtin_amdgcn_permlane32_swap(__float_as_uint(ps), __float_as_uint(ps), false, false);
    ps = __uint_as_float(rr[0]) + __uint_as_float(rr[1]); }
  l_reg = l_reg * alpha + ps;
#define PK4(P, BASE, OUT) do { unsigned a0 = cvtpk_a(P[BASE + 0], P[BASE + 1]), a1 = cvtpk_a(P[BASE + 2], P[BASE + 3]);   \
    unsigned b0 = cvtpk_a(P[BASE + 4], P[BASE + 5]), b1 = cvtpk_a(P[BASE + 6], P[BASE + 7]);                              \
    auto r0 = __builtin_amdgcn_permlane32_swap(a0, b0, false, false); auto r1 = __builtin_amdgcn_permlane32_swap(a1, b1, false, false); \
    u32x4 w = {r0[0], r1[0], r0[1], r1[1]}; OUT = *reinterpret_cast<bf16x8*>(&w); } while (0)
  PK4(p0, 0, pa0); PK4(p0, 8, pa1); PK4(p1, 0, pa2); PK4(p1, 8, pa3);
#undef PK4
}
__device__ __forceinline__ void qkt(f32x16& p0, f32x16& p1, const char* Ks, const char* Krs, const bf16x8* qr, const char* qpark, int r32, int hi) {
  p0 = f32x16{}; p1 = f32x16{};
  const char* kb = Ks + r32 * KPITCH + hi * 16; const char* rb = Krs + r32 * KRPITCH + hi * 16;
#pragma unroll
  for (int d0 = 0; d0 < 8; ++d0) {
    bf16x8 b0 = *reinterpret_cast<const bf16x8*>(kb + d0 * 32);
    bf16x8 b1 = *reinterpret_cast<const bf16x8*>(kb + 32 * KPITCH + d0 * 32);
    p0 = __builtin_amdgcn_mfma_f32_32x32x16_bf16(b0, qr[d0], p0, 0, 0, 0);
    p1 = __builtin_amdgcn_mfma_f32_32x32x16_bf16(b1, qr[d0], p1, 0, 0, 0); }
#pragma unroll
  for (int d0 = 0; d0 < 4; ++d0) {
    bf16x8 b0 = *reinterpret_cast<const bf16x8*>(rb + d0 * 32);
    bf16x8 b1 = *reinterpret_cast<const bf16x8*>(rb + 32 * KRPITCH + d0 * 32);
    const bf16x8 qf = qr[8 + d0];
    p0 = __builtin_amdgcn_mfma_f32_32x32x16_bf16(b0, qf, p0, 0, 0, 0);
    p1 = __builtin_amdgcn_mfma_f32_32x32x16_bf16(b1, qf, p1, 0, 0, 0); }
}
__device__ __forceinline__ int v_st(int k, int c) { const int kk = (k & ~0xC) | ((k & 4) << 1) | ((k & 8) >> 1); return ((kk >> 3) * 4 + (c >> 5)) * 512 + ((kk & 7) * 32 + (c & 31)) * 2; }
__device__ __forceinline__ int v_rd_base(int lane) { return ((lane & 3) << 3) | (((lane >> 2) & 3) << 6) | (((lane >> 4) & 1) << 5) | (((lane >> 5) & 1) << 8); }
constexpr int v_rd_off(int d0, int ks, int half) { return d0 * 512 + ks * 4096 + half * 2048; }
template <int OFF> __device__ __forceinline__ s16x4 tr_read(int vb) {
  s16x4 r; asm volatile("ds_read_b64_tr_b16 %0, %1 offset:%2" : "=&v"(r) : "v"(vb), "i"(OFF) : "memory"); return r;
}
template <int D0> __device__ __forceinline__ void pv_one(f32x16& od, int vb, bf16x8 pa0, bf16x8 pa1, bf16x8 pa2, bf16x8 pa3) {
  const s16x4 l0 = tr_read<v_rd_off(D0, 0, 0)>(vb), h0 = tr_read<v_rd_off(D0, 0, 1)>(vb), l1 = tr_read<v_rd_off(D0, 1, 0)>(vb), h1 = tr_read<v_rd_off(D0, 1, 1)>(vb);
  const s16x4 l2 = tr_read<v_rd_off(D0, 2, 0)>(vb), h2 = tr_read<v_rd_off(D0, 2, 1)>(vb), l3 = tr_read<v_rd_off(D0, 3, 0)>(vb), h3 = tr_read<v_rd_off(D0, 3, 1)>(vb);
  asm volatile("s_waitcnt lgkmcnt(0)" ::: "memory"); SBAR();
#define PK(L, H) (bf16x8){L[0], L[1], L[2], L[3], H[0], H[1], H[2], H[3]}
  od = __builtin_amdgcn_mfma_f32_32x32x16_bf16(pa0, PK(l0, h0), od, 0, 0, 0);
  od = __builtin_amdgcn_mfma_f32_32x32x16_bf16(pa1, PK(l1, h1), od, 0, 0, 0);
  od = __builtin_amdgcn_mfma_f32_32x32x16_bf16(pa2, PK(l2, h2), od, 0, 0, 0);
  od = __builtin_amdgcn_mfma_f32_32x32x16_bf16(pa3, PK(l3, h3), od, 0, 0, 0);
#undef PK
}
__device__ __forceinline__ void pv_d0(f32x16* o, int vb, bf16x8 pa0, bf16x8 pa1, bf16x8 pa2, bf16x8 pa3) {
  pv_one<0>(o[0], vb, pa0, pa1, pa2, pa3); pv_one<1>(o[1], vb, pa0, pa1, pa2, pa3); pv_one<2>(o[2], vb, pa0, pa1, pa2, pa3); pv_one<3>(o[3], vb, pa0, pa1, pa2, pa3);
}

__device__ __forceinline__ void attn_unit(const bf16_t* __restrict__ Qn, const bf16_t* __restrict__ Qr, const bf16_t* __restrict__ Kh,
                                          const bf16_t* __restrict__ Krh, bf16_t* __restrict__ Ob, int seq, char* lds, const int tid) {
  const int wid = tid >> 6, lane = tid & 63, r32 = lane & 31, hi = lane >> 5;
  char* V_lds = lds + OFF_V; char* K_lds = lds + OFF_K; char* Kr_lds = lds + OFF_KR;
  float* ws = (float*)(lds + OFF_WS) + wid * 64; float* li_l = ws; float* al_l = ws + 32;
  float m_reg = -1e30f, l_reg = 0; f32x16 o[4] = {}; bf16x8 qr[12];
  char* qpark = nullptr;
  { const bf16_t* qn = Qn + (long)(wid * QBLK + r32) * LDQ + hi * 8; const bf16_t* qq = Qr + (long)(wid * QBLK + r32) * LDQ + hi * 8;
#pragma unroll
    for (int d0 = 0; d0 < 8; ++d0) qr[d0] = *reinterpret_cast<const bf16x8*>(qn + d0 * 16);
#pragma unroll
    for (int d0 = 0; d0 < 4; ++d0) qr[8 + d0] = *reinterpret_cast<const bf16x8*>(qq + d0 * 16); }
  const int sr = tid >> 4, sc = (tid & 15) * 8, vst0 = v_st(sr, sc), vst1 = v_st(32 + sr, sc);
  const int krr = tid >> 3, krc = (tid & 7) * 8;
  const int vb0 = (int)(uintptr_t)V_lds + v_rd_base(lane);
  bf16x8 vs0, vs1, ks0, ks1, kr0;
  const unsigned offkv = (unsigned)(sr * LDKV + sc) * 2u, offkr = (unsigned)(krr * LDKR + krc) * 2u;
#define SLOAD(k0) do { const char* kb_ = (const char*)Kh + (size_t)(k0) * (LDKV * 2); const char* kb2_ = kb_ + 32 * LDKV * 2; const char* rb_ = (const char*)Krh + (size_t)(k0) * (LDKR * 2); \
    ks0 = *reinterpret_cast<const bf16x8*>(kb_ + offkv); vs0 = *reinterpret_cast<const bf16x8*>(kb_ + offkv + 2048); \
    ks1 = *reinterpret_cast<const bf16x8*>(kb2_ + offkv); vs1 = *reinterpret_cast<const bf16x8*>(kb2_ + offkv + 2048); \
    kr0 = *reinterpret_cast<const bf16x8*>(rb_ + offkr); } while (0)
#define SWRITE(b) do { *(bf16x8*)(V_lds + (b) * SHM_V + vst0) = vs0; *(bf16x8*)(V_lds + (b) * SHM_V + vst1) = vs1; const int kc = sc * 2; \
    *(bf16x8*)(K_lds + (b) * SHM_K + KSWZ(sr, kc)) = ks0; *(bf16x8*)(K_lds + (b) * SHM_K + KSWZ(32 + sr, kc)) = ks1; \
    *(bf16x8*)(Kr_lds + (b) * SHM_KR + KRSWZ(krr, krc * 2)) = kr0; } while (0)
#define SWAIT() asm volatile("s_waitcnt vmcnt(0)" ::: "memory")
#define RESC(a) do { if (__any((a) < 1.f)) { if (hi == 0) al_l[r32] = (a); asm volatile("s_waitcnt lgkmcnt(0)" ::: "memory"); \
    _Pragma("unroll") for (int d = 0; d < 4; ++d) _Pragma("unroll") for (int r = 0; r < 16; ++r) o[d][r] *= al_l[crow(r, hi)]; } } while (0)
  f32x16 pA0, pA1, pB0, pB1; float mnA, mnB, alA, alB; bf16x8 pa0, pa1, pa2, pa3; const int NT = seq / KVBLK;
  SLOAD(0); SWAIT(); SWRITE(0); __syncthreads();
  qkt(pA0, pA1, K_lds, Kr_lds, qr, qpark, r32, hi); partialSM(pA0, pA1, m_reg, mnA, alA);
  SLOAD(KVBLK);
  SWAIT(); SWRITE(1); __syncthreads();
  for (int j = 1; j + 1 < NT; j += 2) {
    SBAR(); qkt(pB0, pB1, K_lds + SHM_K, Kr_lds + SHM_KR, qr, qpark, r32, hi);
    finishSM(pA0, pA1, alA, l_reg, pa0, pa1, pa2, pa3); SBAR();
    SLOAD((j + 1) * KVBLK); SBAR();
    pv_d0(o, vb0, pa0, pa1, pa2, pa3); partialSM(pB0, pB1, m_reg, mnB, alB);
    __syncthreads(); SWAIT(); SWRITE(0);
    RESC(alB); __syncthreads();
    SBAR(); qkt(pA0, pA1, K_lds, Kr_lds, qr, qpark, r32, hi);
    finishSM(pB0, pB1, alB, l_reg, pa0, pa1, pa2, pa3); SBAR();
    SLOAD((j + 2) * KVBLK); SBAR();
    pv_d0(o, vb0 + SHM_V, pa0, pa1, pa2, pa3); partialSM(pA0, pA1, m_reg, mnA, alA);
    __syncthreads(); SWAIT(); SWRITE(1);
    RESC(alA); __syncthreads();
  }
  SBAR(); qkt(pB0, pB1, K_lds + SHM_K, Kr_lds + SHM_KR, qr, qpark, r32, hi);
  finishSM(pA0, pA1, alA, l_reg, pa0, pa1, pa2, pa3); SBAR();
  pv_d0(o, vb0, pa0, pa1, pa2, pa3); partialSM(pB0, pB1, m_reg, mnB, alB);
  __syncthreads(); RESC(alB);
  finishSM(pB0, pB1, alB, l_reg, pa0, pa1, pa2, pa3); SBAR();
  pv_d0(o, vb0 + SHM_V, pa0, pa1, pa2, pa3);
  if (hi == 0) li_l[r32] = l_reg; asm volatile("s_waitcnt lgkmcnt(0)" ::: "memory");
  float rli[16];
#pragma unroll
  for (int r = 0; r < 16; ++r) rli[r] = __builtin_amdgcn_rcpf(li_l[crow(r, hi)]);
  bf16_t* Ow = Ob + (long)(wid * QBLK) * LDO;
#pragma unroll
  for (int r = 0; r < 16; ++r) { const int orow = crow(r, hi);
#pragma unroll
    for (int d0 = 0; d0 < 4; ++d0) Ow[(long)orow * LDO + d0 * 32 + r32] = f2bf(o[d0][r] * rli[r]); }
  __syncthreads();
#undef SLOAD
#undef SWRITE
#undef SWAIT
#undef RESC
}

constexpr int K8P = 144, KR8P = 80, SHM_K8 = KVBLK * K8P, SHM_KR8 = KVBLK * KR8P;
__device__ __forceinline__ v8i ld32(const char* p) { const u32x4 a = *reinterpret_cast<const u32x4*>(p), b = *reinterpret_cast<const u32x4*>(p + 16); return (v8i){(int)a.x, (int)a.y, (int)a.z, (int)a.w, (int)b.x, (int)b.y, (int)b.z, (int)b.w}; }
constexpr int V8P = 80, SHM_V8 = 128 * V8P;
constexpr int O9_V = 0, O9_K = 2 * SHM_V8, O9_KR = O9_K + 2 * SHM_K8, O9_WS = O9_KR + 2 * SHM_KR8, SHM_ATTN9 = 3 * (SHM_V8 + SHM_K8 + SHM_KR8) + NW * 64 * 4;
constexpr float THR9 = 2.f, THRL9 = THR9 * 1.4426950408889634f;
__device__ __forceinline__ void qkt9(f32x16& p0, f32x16& p1, const char* Ks, const char* Krs, const v8i* qf, const f32x16& negm, int r32, int hi) {
  const char* kb = Ks + r32 * K8P + hi * 32; const char* rb = Krs + r32 * KR8P + hi * 32;
  { const v8i a0 = ld32(kb), a1 = ld32(kb + 32 * K8P);
    p0 = __builtin_amdgcn_mfma_scale_f32_32x32x64_f8f6f4(a0, qf[0], negm, 0, 0, 0, 0x7f7f7f7f, 0, 0x7b7b7b7b);
    p1 = __builtin_amdgcn_mfma_scale_f32_32x32x64_f8f6f4(a1, qf[0], negm, 0, 0, 0, 0x7f7f7f7f, 0, 0x7b7b7b7b); }
  { const v8i a0 = ld32(kb + 64), a1 = ld32(kb + 32 * K8P + 64);
    p0 = __builtin_amdgcn_mfma_scale_f32_32x32x64_f8f6f4(a0, qf[1], p0, 0, 0, 0, 0x7f7f7f7f, 0, 0x7b7b7b7b);
    p1 = __builtin_amdgcn_mfma_scale_f32_32x32x64_f8f6f4(a1, qf[1], p1, 0, 0, 0, 0x7f7f7f7f, 0, 0x7b7b7b7b); }
  { const v8i a0 = ld32(rb), a1 = ld32(rb + 32 * KR8P);
    p0 = __builtin_amdgcn_mfma_scale_f32_32x32x64_f8f6f4(a0, qf[2], p0, 0, 0, 0, 0x7f7f7f7f, 0, 0x7b7b7b7b);
    p1 = __builtin_amdgcn_mfma_scale_f32_32x32x64_f8f6f4(a1, qf[2], p1, 0, 0, 0, 0x7f7f7f7f, 0, 0x7b7b7b7b); }
}
template <bool FIRST> __device__ __forceinline__ void partialSM9n(f32x16& p0, f32x16& p1, f32x16& negm, float& alpha) {
  float pmax = p0[0];
#pragma unroll
  for (int r = 1; r < 16; ++r) pmax = fmaxf(pmax, p0[r]);
#pragma unroll
  for (int r = 0; r < 16; ++r) pmax = fmaxf(pmax, p1[r]);
  { auto rr = __builtin_amdgcn_permlane32_swap(__float_as_uint(pmax), __float_as_uint(pmax), false, false);
    pmax = fmaxf(__uint_as_float(rr[0]), __uint_as_float(rr[1])); }
  const float ex = pmax - 4.f;
  if (!FIRST && __builtin_expect(__all(ex <= THRL9), 1)) { alpha = 1.f; }
  else { const float d = FIRST ? ex : fmaxf(ex, 0.f); alpha = FIRST ? 1.f : __builtin_amdgcn_exp2f(-d);
#pragma unroll
    for (int r = 0; r < 16; ++r) { p0[r] -= d; p1[r] -= d; }
#pragma unroll
    for (int r = 0; r < 16; ++r) negm[r] -= d;
    asm volatile("" : "+v"(negm)); }
#pragma unroll
  for (int r = 0; r < 16; ++r) p0[r] = __builtin_amdgcn_exp2f(p0[r]);
}
__device__ __forceinline__ void partialSM9(f32x16& p0, f32x16& p1, float& m_reg, float& mn, float& alpha) {
  constexpr float C = ATT_SCALE * 1.4426950408889634f;
  float pmax = p0[0];
#pragma unroll
  for (int r = 1; r < 16; ++r) pmax = fmaxf(pmax, p0[r]);
#pragma unroll
  for (int r = 0; r < 16; ++r) pmax = fmaxf(pmax, p1[r]);
  { auto rr = __builtin_amdgcn_permlane32_swap(__float_as_uint(pmax), __float_as_uint(pmax), false, false);
    pmax = fmaxf(__uint_as_float(rr[0]), __uint_as_float(rr[1])); }
  if (__builtin_expect(__all(pmax - m_reg <= THR9 / ATT_SCALE), 1)) { mn = m_reg; alpha = 1.f; }
  else { mn = fmaxf(m_reg, pmax); alpha = __builtin_amdgcn_exp2f((m_reg - mn) * C); m_reg = mn; }
  float mnC = 4.f - mn * C;
#pragma unroll
  for (int r = 0; r < 16; ++r) p0[r] = fmaf(p0[r], C, mnC);
#pragma unroll
  for (int r = 0; r < 16; ++r) p1[r] = fmaf(p1[r], C, mnC);
#pragma unroll
  for (int r = 0; r < 16; ++r) p0[r] = __builtin_amdgcn_exp2f(p0[r]);
}
__device__ __forceinline__ void finishSM9(f32x16& p0, f32x16& p1, float alpha, float& l_reg, v8i& pf) {
#pragma unroll
  for (int r = 0; r < 16; ++r) p1[r] = __builtin_amdgcn_exp2f(p1[r]);
  float ps = 0;
#pragma unroll
  for (int r = 0; r < 16; ++r) ps += p0[r];
#pragma unroll
  for (int r = 0; r < 16; ++r) ps += p1[r];
  { auto rr = __builtin_amdgcn_permlane32_swap(__float_as_uint(ps), __float_as_uint(ps), false, false);
    ps = __uint_as_float(rr[0]) + __uint_as_float(rr[1]); }
  l_reg = l_reg * alpha + ps;
  unsigned a[4], b[4];
#pragma unroll
  for (int i = 0; i < 4; ++i) { a[i] = pk4_fp8(p0[4 * i], p0[4 * i + 1], p0[4 * i + 2], p0[4 * i + 3]); b[i] = pk4_fp8(p1[4 * i], p1[4 * i + 1], p1[4 * i + 2], p1[4 * i + 3]); }
#pragma unroll
  for (int i = 0; i < 4; ++i) { auto r = __builtin_amdgcn_permlane32_swap(a[i], b[i], false, false); pf[i] = (int)r[0]; pf[4 + i] = (int)r[1]; }
}
__device__ __forceinline__ void pv9(f32x16* o, const char* Vs, const v8i pf, int r32, int hi) {
  const char* vb = Vs + r32 * V8P + hi * 32;
#pragma unroll
  for (int d0 = 0; d0 < 4; ++d0) { const v8i vf = ld32(vb + d0 * 32 * V8P);
    o[d0] = __builtin_amdgcn_mfma_scale_f32_32x32x64_f8f6f4(pf, vf, o[d0], 0, 0, 0, 0x7f7f7f7f, 0, 0x7f7f7f7f); }
}
__device__ __forceinline__ float pmax9(const f32x16& p0, const f32x16& p1) {
  float m0 = fmaxf(p0[0], p0[1]), m1 = fmaxf(p1[0], p1[1]);
#pragma unroll
  for (int r = 2; r < 16; r += 2) { m0 = fmaxf(fmaxf(m0, p0[r]), p0[r + 1]); m1 = fmaxf(fmaxf(m1, p1[r]), p1[r + 1]); }
  float pmax = fmaxf(m0, m1);
  { auto rr = __builtin_amdgcn_permlane32_swap(__float_as_uint(pmax), __float_as_uint(pmax), false, false);
    pmax = fmaxf(__uint_as_float(rr[0]), __uint_as_float(rr[1])); }
  return pmax - 4.f;
}
__device__ __forceinline__ void prest9(f32x16& p0, f32x16& p1, f32x16& negm, float& alpha, const float ex) {
  if (__builtin_expect(__all(ex <= THRL9), 1)) { alpha = 1.f; }
  else { const float d = fmaxf(ex, 0.f); alpha = __builtin_amdgcn_exp2f(-d);
#pragma unroll
    for (int r = 0; r < 16; ++r) { p0[r] -= d; p1[r] -= d; }
#pragma unroll
    for (int r = 0; r < 16; ++r) negm[r] -= d;
    asm volatile("" : "+v"(negm)); }
#pragma unroll
  for (int r = 0; r < 16; ++r) p0[r] = __builtin_amdgcn_exp2f(p0[r]);
}
__device__ __forceinline__ void attn_unit9(const unsigned char* __restrict__ Q8n, const unsigned char* __restrict__ Q8r, const unsigned char* __restrict__ K8h,
                                           const unsigned char* __restrict__ Kr8, const unsigned char* __restrict__ VTh, bf16_t* __restrict__ Ob, int seq, char* lds, const int tid, unsigned& tacc) {
  const int wid = tid >> 6, lane = tid & 63, r32 = lane & 31, hi = lane >> 5;
  const bool pw_ = __builtin_amdgcn_readfirstlane(wid) == PROBE_WAVE; unsigned tprev_ = 0; (void)pw_; (void)tprev_;
  constexpr int SL = SHM_V8 + SHM_K8 + SHM_KR8, SK = SHM_V8, SR = SHM_V8 + SHM_K8;
  float* ws = (float*)(lds + 3 * SL) + wid * 64; float* li_l = ws; float* al_l = ws + 32;
  float l_reg = 0; f32x16 o[4] = {}; v8i qf[3]; f32x16 negm;
#pragma unroll
  for (int r = 0; r < 16; ++r) negm[r] = 4.f;
  { const unsigned char* qn = Q8n + (long)(wid * QBLK + r32) * LDQ + hi * 32; const unsigned char* qq = Q8r + (long)(wid * QBLK + r32) * LDQ + hi * 32;
    qf[0] = ld32((const char*)qn); qf[1] = ld32((const char*)qn + 64); qf[2] = ld32((const char*)qq); }
  const int k8r = tid >> 3, k8c = (tid & 7) * 16;
  const int r8r = tid >> 3, r8c = (tid & 7) * 8;
  const int v8d = tid >> 2, v8c = tid & 3;
  const int v8w = v8d * V8P + (v8c >> 1) * 32 + (v8c & 1) * 8;
  u32x4 v8v, k8v; u32x2 r8v;
  const unsigned offv8 = (unsigned)(v8d * SEQ + v8c * 16), offk8 = (unsigned)(k8r * 1024 + k8c), offr8 = (unsigned)(r8r * 64 + r8c);
  const __amdgpu_buffer_rsrc_t rsV_ = __builtin_amdgcn_make_buffer_rsrc((void*)VTh, (short)0, 128 * SEQ, 0x00020000);
  const __amdgpu_buffer_rsrc_t rsK_ = __builtin_amdgcn_make_buffer_rsrc((void*)K8h, (short)0, SEQ * 1024 - 896, 0x00020000);
  const __amdgpu_buffer_rsrc_t rsR_ = __builtin_amdgcn_make_buffer_rsrc((void*)Kr8, (short)0, SEQ * 64, 0x00020000);
#define SLOAD(k0) do { v8v = __builtin_bit_cast(u32x4, __builtin_amdgcn_raw_buffer_load_b128(rsV_, offv8, (unsigned)(k0), 0)); \
    k8v = __builtin_bit_cast(u32x4, __builtin_amdgcn_raw_buffer_load_b128(rsK_, offk8, (unsigned)(k0) * 1024u, 0)); \
    r8v = __builtin_bit_cast(u32x2, __builtin_amdgcn_raw_buffer_load_b64(rsR_, offr8, (unsigned)(k0) * 64u, 0)); } while (0)
#define SWRITE(so) do { char* sb_ = lds + (so); char* vp_ = sb_ + v8w; *(unsigned*)(vp_) = v8v.x; *(unsigned*)(vp_ + 16) = v8v.y; *(unsigned*)(vp_ + 4) = v8v.z; *(unsigned*)(vp_ + 20) = v8v.w; \
    *(u32x4*)(sb_ + SK + k8r * K8P + k8c) = k8v; *(u32x2*)(sb_ + SR + r8r * KR8P + r8c) = r8v; } while (0)
#define SWAIT() asm volatile("s_waitcnt vmcnt(0)" ::: "memory")
#define RESC(a) do { if (__any((a) < 1.f)) { if (hi == 0) al_l[r32] = (a); asm volatile("s_waitcnt lgkmcnt(0)" ::: "memory"); \
    _Pragma("unroll") for (int d = 0; d < 4; ++d) _Pragma("unroll") for (int r = 0; r < 16; ++r) o[d][r] *= al_l[crow(r, hi)]; } } while (0)
  f32x16 pA0, pA1, pB0, pB1; float alA, alB; v8i pf; const int NT = seq / KVBLK;
  int sp = 0, scur = SL, sn = 2 * SL;
#define ROT() do { const int t_ = sp; sp = scur; scur = sn; sn = t_; } while (0)
  SLOAD(0); SWAIT(); SWRITE(0); __syncthreads();
  qkt9(pA0, pA1, lds + SK, lds + SR, qf, negm, r32, hi); partialSM9n<true>(pA0, pA1, negm, alA);
  SLOAD(KVBLK);
  SWAIT(); SWRITE(SL); __syncthreads();
#if PROBE_SEG == 1
#define PR_A() do { } while (0)
#define PR_B() do { } while (0)
#define PR_C() const unsigned tc_ = tstamp()
#define PR_D() do { const unsigned td_ = tstamp(); if (pw_) tacc += td_ - tc_; } while (0)
#elif PROBE_SEG == 2
#define PR_A() const unsigned ta_ = tstamp()
#define PR_B() do { const unsigned tb_ = tstamp(); if (pw_) tacc += tb_ - ta_; } while (0)
#define PR_C() do { } while (0)
#define PR_D() do { } while (0)
#elif PROBE_SEG == 3
#define PR_A() do { const unsigned ta_ = tstamp(); if (pw_) tacc += ta_ - tprev_; } while (0)
#define PR_B() do { } while (0)
#define PR_C() do { } while (0)
#define PR_D() tprev_ = tstamp()
#else
#define PR_A() do { } while (0)
#define PR_B() do { } while (0)
#define PR_C() do { } while (0)
#define PR_D() do { } while (0)
#endif
#define HALF(PP0, PP1, ALP, PN0, PN1, ALN, KNEXT) do { \
    SLOAD(KNEXT); \
    qkt9(PN0, PN1, lds + scur + SK, lds + scur + SR, qf, negm, r32, hi); \
    finishSM9(PP0, PP1, ALP, l_reg, pf); \
    pv9(o, lds + sp, pf, r32, hi); \
    const float ex_ = pmax9(PN0, PN1); \
    PIPE9(); \
    prest9(PN0, PN1, negm, ALN, ex_); \
    PR_A(); SWAIT(); PR_B(); SWRITE(sn); RESC(ALN); PR_C(); __syncthreads(); PR_D(); ROT(); } while (0)
#if PROBE_SEG
  tprev_ = tstamp();
#endif
  for (int j = 1; j + 1 < NT; j += 2) {
    HALF(pA0, pA1, alA, pB0, pB1, alB, (j + 1) * KVBLK);
    HALF(pB0, pB1, alB, pA0, pA1, alA, (j + 2) * KVBLK);
  }
#undef HALF
  SBAR(); qkt9(pB0, pB1, lds + scur + SK, lds + scur + SR, qf, negm, r32, hi);
  finishSM9(pA0, pA1, alA, l_reg, pf); SBAR();
  pv9(o, lds + sp, pf, r32, hi); partialSM9n<false>(pB0, pB1, negm, alB);
  RESC(alB);
  finishSM9(pB0, pB1, alB, l_reg, pf); SBAR();
  pv9(o, lds + scur, pf, r32, hi);
#undef ROT
  if (hi == 0) li_l[r32] = l_reg; asm volatile("s_waitcnt lgkmcnt(0)" ::: "memory");
  float rli[16];
#pragma unroll
  for (int r = 0; r < 16; ++r) rli[r] = __builtin_amdgcn_rcpf(li_l[crow(r, hi)]);
  bf16_t* Ow = Ob + (long)(wid * QBLK) * LDO;
#pragma unroll
  for (int r = 0; r < 16; ++r) { const int orow = crow(r, hi);
#pragma unroll
    for (int d0 = 0; d0 < 4; ++d0) Ow[(long)orow * LDO + d0 * 32 + r32] = f2bf(o[d0][r] * rli[r]); }
  __syncthreads();
#undef SLOAD
#undef SWRITE
#undef SWAIT
#undef RESC
}
__device__ __forceinline__ v8i ld32v(const LAS char* p) {
  const u32x4 a = *reinterpret_cast<const volatile LAS u32x4*>(p), b = *reinterpret_cast<const volatile LAS u32x4*>(p + 16);
  return (v8i){(int)a.x, (int)a.y, (int)a.z, (int)a.w, (int)b.x, (int)b.y, (int)b.z, (int)b.w};
}
__device__ __forceinline__ unsigned pk4s_fp8(float a, float b, float c, float d, unsigned seed) { unsigned w = __builtin_amdgcn_cvt_pk_fp8_f32(a, b, seed, false); return __builtin_amdgcn_cvt_pk_fp8_f32(c, d, w, true); }
#define MFQ(A, B, C) __builtin_amdgcn_mfma_scale_f32_32x32x64_f8f6f4(A, B, C, 0, 0, 0, 0x7f7f7f7f, 0, 0x7b7b7b7b)
#define MFP(A, B, C) __builtin_amdgcn_mfma_scale_f32_32x32x64_f8f6f4(A, B, C, 0, 0, 0, 0x7f7f7f7f, 0, 0x7f7f7f7f)
#define PIN(x) asm volatile("" : "+v"(x))
#define GAPE() __builtin_amdgcn_sched_barrier(0)
#define EXP8(P, R0) do { _Pragma("unroll") for (int r_ = (R0); r_ < (R0) + 8; ++r_) P[r_] = __builtin_amdgcn_exp2f(P[r_]); } while (0)
__device__ __forceinline__ void attn_unit10(const unsigned char* __restrict__ Q8n, const unsigned char* __restrict__ Q8r, const unsigned char* __restrict__ K8h,
                                            const unsigned char* __restrict__ Kr8, const unsigned char* __restrict__ VTh, bf16_t* __restrict__ Ob, int seq, char* lds, const int tid, unsigned& tacc) {
  const int wid = tid >> 6, lane = tid & 63, r32 = lane & 31, hi = lane >> 5;
  const bool pw_ = __builtin_amdgcn_readfirstlane(wid) == PROBE_WAVE; unsigned tprev_ = 0; (void)pw_; (void)tprev_;
  constexpr int SL = SHM_V8 + SHM_K8 + SHM_KR8, SK = SHM_V8, SR = SHM_V8 + SHM_K8;
  const LAS char* ldl = (const LAS char*)lds;
  float* ws = (float*)(lds + 4 * SL) + wid * 64; float* li_l = ws; float* al_l = ws + 32;
  float l_reg = 0; f32x16 o[4] = {}; v8i qf[3]; f32x16 negm;
#pragma unroll
  for (int r = 0; r < 16; ++r) negm[r] = 4.f;
  { const unsigned char* qn = Q8n + (long)(wid * QBLK + r32) * LDQ + hi * 32; const unsigned char* qq = Q8r + (long)(wid * QBLK + r32) * LDQ + hi * 32;
    qf[0] = ld32((const char*)qn); qf[1] = ld32((const char*)qn + 64); qf[2] = ld32((const char*)qq); }
  const int k8r = tid >> 3, k8c = (tid & 7) * 16;
  const int r8r = tid >> 3, r8c = (tid & 7) * 8;
  const int v8d = tid >> 2, v8c = tid & 3;
  const int v8w = v8d * V8P + (v8c >> 1) * 32 + (v8c & 1) * 8;
  const int kfb = SK + r32 * K8P + hi * 32, rfb = SR + r32 * KR8P + hi * 32, vfb = r32 * V8P + hi * 32;
  u32x4 v8v, k8v; u32x2 r8v;
  const unsigned offv8 = (unsigned)(v8d * SEQ + v8c * 16), offk8 = (unsigned)(k8r * 1024 + k8c), offr8 = (unsigned)(r8r * 64 + r8c);
  const __amdgpu_buffer_rsrc_t rsV_ = __builtin_amdgcn_make_buffer_rsrc((void*)VTh, (short)0, 128 * SEQ, 0x00020000);
  const __amdgpu_buffer_rsrc_t rsK_ = __builtin_amdgcn_make_buffer_rsrc((void*)K8h, (short)0, SEQ * 1024 - 896, 0x00020000);
  const __amdgpu_buffer_rsrc_t rsR_ = __builtin_amdgcn_make_buffer_rsrc((void*)Kr8, (short)0, SEQ * 64, 0x00020000);
#define SLOADX(k0, V_, K_, R_) do { V_ = __builtin_bit_cast(u32x4, __builtin_amdgcn_raw_buffer_load_b128(rsV_, offv8, (unsigned)(k0), 0)); \
    K_ = __builtin_bit_cast(u32x4, __builtin_amdgcn_raw_buffer_load_b128(rsK_, offk8, (unsigned)(k0) * 1024u, 0)); \
    R_ = __builtin_bit_cast(u32x2, __builtin_amdgcn_raw_buffer_load_b64(rsR_, offr8, (unsigned)(k0) * 64u, 0)); } while (0)
#define SWRITEX(so, V_, K_, R_) do { char* sb_ = lds + (so); char* vp_ = sb_ + v8w; *(unsigned*)(vp_) = V_.x; *(unsigned*)(vp_ + 16) = V_.y; *(unsigned*)(vp_ + 4) = V_.z; *(unsigned*)(vp_ + 20) = V_.w; \
    *(u32x4*)(sb_ + SK + k8r * K8P + k8c) = K_; *(u32x2*)(sb_ + SR + r8r * KR8P + r8c) = R_; } while (0)
#define SWAIT() asm volatile("s_waitcnt vmcnt(0)" ::: "memory")
#define RESC(a) do { if (__any((a) < 1.f)) { if (hi == 0) al_l[r32] = (a); asm volatile("s_waitcnt lgkmcnt(0)" ::: "memory"); \
    _Pragma("unroll") for (int d = 0; d < 4; ++d) _Pragma("unroll") for (int r = 0; r < 16; ++r) o[d][r] *= al_l[crow(r, hi)]; } } while (0)
  f32x16 pA0, pA1, pB0, pB1; float alA, alB; v8i pf, fa, fb, fc, fd; const int NT = seq / KVBLK;
  int so1_ = SL, so2_ = 2 * SL; asm volatile("" : "+s"(so1_), "+s"(so2_));
  { u32x4 va_, ka_; u32x2 ra_;
    SLOADX(0, va_, ka_, ra_); SLOADX(KVBLK, v8v, k8v, r8v);
    SWAIT(); SWRITEX(0, va_, ka_, ra_); SWRITEX(so1_, v8v, k8v, r8v); }
  SLOADX(2 * KVBLK, v8v, k8v, r8v);
  __syncthreads();
  qkt9(pA0, pA1, lds + SK, lds + SR, qf, negm, r32, hi);
  { const float d = pmax9(pA0, pA1);
#pragma unroll
    for (int r = 0; r < 16; ++r) { pA0[r] -= d; pA1[r] -= d; negm[r] -= d; }
    PIN(negm); alA = 1.f; }
  SWAIT(); SWRITEX(so2_, v8v, k8v, r8v); __syncthreads();
  fa = ld32v(ldl + (kfb + so1_)); fb = ld32v(ldl + (kfb + so1_) + 32 * K8P); fc = ld32v(ldl + (kfb + so1_) + 64);
#if PROBE_SEG == 1
#define PR_A() do { } while (0)
#define PR_B() do { } while (0)
#define PR_C() const unsigned tc_ = tstamp()
#define PR_D() do { const unsigned td_ = tstamp(); if (pw_) tacc += td_ - tc_; } while (0)
#elif PROBE_SEG == 2
#define PR_A() const unsigned ta_ = tstamp()
#define PR_B() do { const unsigned tb_ = tstamp(); if (pw_) tacc += tb_ - ta_; } while (0)
#define PR_C() do { } while (0)
#define PR_D() do { } while (0)
#elif PROBE_SEG == 3
#define PR_A() do { const unsigned ta_ = tstamp(); if (pw_) tacc += ta_ - tprev_; } while (0)
#define PR_B() do { } while (0)
#define PR_C() do { } while (0)
#define PR_D() tprev_ = tstamp()
#else
#define PR_A() do { } while (0)
#define PR_B() do { } while (0)
#define PR_C() do { } while (0)
#define PR_D() do { } while (0)
#endif
#define STEP(PP0, PP1, ALP, PN0, PN1, ALN, FA, FB, FC, FD, J) do { \
    const int sj_ = ((J) & 3) * SL, sp_ = (((J) - 1) & 3) * SL, sn_ = (((J) + 1) & 3) * SL, sw_ = (((J) + 2) & 3) * SL; \
    SLOADX(((J) + 2) * KVBLK, v8v, k8v, r8v); \
    const LAS char* kq_ = ldl + (kfb + sj_); const LAS char* rq_ = ldl + (rfb + sj_); const LAS char* vq_ = ldl + (vfb + sp_); const LAS char* nq_ = ldl + (kfb + sn_); \
    unsigned a0_, a1_, a2_, a3_, b0_, b1_, b2_, b3_; float s0_, s1_, s2_, s3_, m0_, m1_; \
      FD = ld32v(kq_ + 32 * K8P + 64); PN0 = MFQ(FA, qf[0], negm); PIN(PN0); EXP8(PP0, 0); PIN(PP0); GAPE(); \
      FA = ld32v(rq_); PN1 = MFQ(FB, qf[0], negm); PIN(PN1); EXP8(PP0, 8); PIN(PP0); GAPE(); \
      FB = ld32v(rq_ + 32 * KR8P); PN0 = MFQ(FC, qf[1], PN0); PIN(PN0); EXP8(PP1, 0); PIN(PP1); GAPE(); \
      FC = ld32v(vq_); PN1 = MFQ(FD, qf[1], PN1); PIN(PN1); EXP8(PP1, 8); PIN(PP1); GAPE(); \
      FD = ld32v(vq_ + 32 * V8P); PN0 = MFQ(FA, qf[2], PN0); PIN(PN0); \
      a0_ = pk4s_fp8(PP0[0], PP0[1], PP0[2], PP0[3], (unsigned)kfb); a1_ = pk4s_fp8(PP0[4], PP0[5], PP0[6], PP0[7], (unsigned)kfb); a2_ = pk4s_fp8(PP0[8], PP0[9], PP0[10], PP0[11], (unsigned)kfb); \
      a3_ = pk4s_fp8(PP0[12], PP0[13], PP0[14], PP0[15], (unsigned)kfb); b0_ = pk4s_fp8(PP1[0], PP1[1], PP1[2], PP1[3], (unsigned)kfb); b1_ = pk4s_fp8(PP1[4], PP1[5], PP1[6], PP1[7], (unsigned)kfb); \
      asm volatile("" : "+v"(a0_), "+v"(a1_), "+v"(a2_), "+v"(a3_), "+v"(b0_), "+v"(b1_)); GAPE(); \
      FA = ld32v(vq_ + 64 * V8P); PN1 = MFQ(FB, qf[2], PN1); PIN(PN1); \
      b2_ = pk4s_fp8(PP1[8], PP1[9], PP1[10], PP1[11], (unsigned)kfb); b3_ = pk4s_fp8(PP1[12], PP1[13], PP1[14], PP1[15], (unsigned)kfb); \
      { auto q0_ = __builtin_amdgcn_permlane32_swap(a0_, b0_, false, false); auto q1_ = __builtin_amdgcn_permlane32_swap(a1_, b1_, false, false); \
        auto q2_ = __builtin_amdgcn_permlane32_swap(a2_, b2_, false, false); auto q3_ = __builtin_amdgcn_permlane32_swap(a3_, b3_, false, false); \
        pf = (v8i){(int)q0_[0], (int)q1_[0], (int)q2_[0], (int)q3_[0], (int)q0_[1], (int)q1_[1], (int)q2_[1], (int)q3_[1]}; } PIN(pf); GAPE(); \
      FB = ld32v(vq_ + 96 * V8P); o[0] = MFP(pf, FC, o[0]); PIN(o[0]); PIN(PP0); \
      s0_ = PP0[0] + PP0[2]; s1_ = PP0[1] + PP0[3]; _Pragma("unroll") for (int r_ = 4; r_ < 16; r_ += 2) { s0_ += PP0[r_]; s1_ += PP0[r_ + 1]; } \
      asm volatile("" : "+v"(s0_), "+v"(s1_)); GAPE(); \
      FC = ld32v(nq_); o[1] = MFP(pf, FD, o[1]); PIN(o[1]); PIN(PP1); \
      s2_ = PP1[0] + PP1[2]; s3_ = PP1[1] + PP1[3]; _Pragma("unroll") for (int r_ = 4; r_ < 16; r_ += 2) { s2_ += PP1[r_]; s3_ += PP1[r_ + 1]; } \
      asm volatile("" : "+v"(s2_), "+v"(s3_)); GAPE(); \
      FD = ld32v(nq_ + 32 * K8P); o[2] = MFP(pf, FA, o[2]); PIN(o[2]); PIN(PN0); \
      { float ps_ = (s0_ + s1_) + (s2_ + s3_); auto rr_ = __builtin_amdgcn_permlane32_swap(__float_as_uint(ps_), __float_as_uint(ps_), false, false); \
        ps_ = __uint_as_float(rr_[0]) + __uint_as_float(rr_[1]); l_reg = l_reg * (ALP) + ps_; } \
      m0_ = fmaxf(PN0[0], PN0[1]); _Pragma("unroll") for (int r_ = 2; r_ < 16; r_ += 2) m0_ = fmaxf(fmaxf(m0_, PN0[r_]), PN0[r_ + 1]); \
      asm volatile("" : "+v"(m0_), "+v"(l_reg)); GAPE(); \
      FA = ld32v(nq_ + 64); o[3] = MFP(pf, FB, o[3]); PIN(o[3]); PIN(PN1); \
      m1_ = fmaxf(PN1[0], PN1[1]); _Pragma("unroll") for (int r_ = 2; r_ < 16; r_ += 2) m1_ = fmaxf(fmaxf(m1_, PN1[r_]), PN1[r_ + 1]); \
      float ex_ = fmaxf(m0_, m1_); { auto rr_ = __builtin_amdgcn_permlane32_swap(__float_as_uint(ex_), __float_as_uint(ex_), false, false); \
        ex_ = fmaxf(__uint_as_float(rr_[0]), __uint_as_float(rr_[1])) - 4.f; } PIN(ex_); GAPE(); \
    if (__builtin_expect(__all(ex_ <= THRL9), 1)) { ALN = 1.f; } \
    else { const float d_ = fmaxf(ex_, 0.f); ALN = __builtin_amdgcn_exp2f(-d_); \
      _Pragma("unroll") for (int r_ = 0; r_ < 16; ++r_) { PN0[r_] -= d_; PN1[r_] -= d_; negm[r_] -= d_; } PIN(negm); } \
    PR_A(); SWAIT(); PR_B(); SWRITEX(sw_, v8v, k8v, r8v); RESC(ALN); PR_C(); __syncthreads(); PR_D(); } while (0)
#if PROBE_SEG
  tprev_ = tstamp();
#endif
  for (int j = 1; j + 1 < NT; j += 2) {
    STEP(pA0, pA1, alA, pB0, pB1, alB, fa, fb, fc, fd, j);
    STEP(pB0, pB1, alB, pA0, pA1, alA, fc, fd, fa, fb, j + 1);
  }
  STEP(pA0, pA1, alA, pB0, pB1, alB, fa, fb, fc, fd, NT - 1);
#undef STEP
  { _Pragma("unroll") for (int r = 0; r < 16; ++r) pB0[r] = __builtin_amdgcn_exp2f(pB0[r]); }
  finishSM9(pB0, pB1, alB, l_reg, pf);
  pv9(o, lds + ((NT - 1) & 3) * SL, pf, r32, hi);
  int le_ = (int)__builtin_amdgcn_mbcnt_hi(~0u, __builtin_amdgcn_mbcnt_lo(~0u, 0u)); asm volatile("" : "+v"(le_));
  const int r32e = le_ & 31, hie = le_ >> 5;
  if (hie == 0) li_l[r32e] = l_reg; asm volatile("s_waitcnt lgkmcnt(0)" ::: "memory");
  float rli[16];
#pragma unroll
  for (int r = 0; r < 16; ++r) rli[r] = __builtin_amdgcn_rcpf(li_l[crow(r, hie)]);
  bf16_t* Ow = Ob + (long)(__builtin_amdgcn_readfirstlane(wid) * QBLK) * LDO; const unsigned oo_ = (unsigned)(hie * 4 * LDO + r32e);
#pragma unroll
  for (int r = 0; r < 16; ++r) { const unsigned orow = (unsigned)((r & 3) + 8 * (r >> 2));
#pragma unroll
    for (int d0 = 0; d0 < 4; ++d0) Ow[oo_ + orow * LDO + d0 * 32] = f2bf(o[d0][r] * rli[r]); }
  __syncthreads();
#undef SLOADX
#undef SWRITEX
#undef SWAIT
#undef RESC
}
#undef SBAR
}

constexpr int NWAVES = 8;
constexpr int N_LAUNCHES = MK_N_LAUNCHES;
constexpr int N_PHASES = 15;
static_assert(N_LAUNCHES == 1 || N_LAUNCHES == N_PHASES, "MK_N_LAUNCHES is 1 or 15");

constexpr size_t MiB = 1u << 20;
constexpr size_t WS_CTL = 0, CTL_ZERO_BYTES = 32768;
constexpr size_t WS_ROPE = 1 * MiB;
constexpr size_t WS_RSTD0 = 3 * MiB, WS_RSTDQ = WS_RSTD0 + 65536, WS_RSTDKV = WS_RSTDQ + 65536, WS_RSTDM = WS_RSTDKV + 65536;
constexpr size_t WS_SSQ = 4 * MiB;
constexpr size_t WS_AFF = 5 * MiB;
constexpr size_t WS_INV = 6 * MiB;
constexpr size_t WS_IDX = 7 * MiB, WS_GATE = WS_IDX + 131072;
constexpr size_t WS_MEMB = 8 * MiB;
constexpr size_t WS_MKV = 9 * MiB;
constexpr size_t WS_QKT = 11 * MiB, WS_VWT = 15 * MiB;
constexpr size_t WS_WIN = 19 * MiB;
constexpr size_t WS_WCO = 30 * MiB, WS_WMO = 32 * MiB, WS_WMIX = 34 * MiB, WS_WUQ = 36 * MiB, WS_WUKV = 37 * MiB, WS_WMQH = 38 * MiB, WS_WOHT = 40 * MiB, WS_WMKV = 42 * MiB;
constexpr size_t WS_XGG = 48 * MiB, WS_QB = 48 * MiB, WS_MIXA = 96 * MiB, WS_WGU = 48 * MiB, WS_WD = 112 * MiB, WS_Y = 48 * MiB;
constexpr size_t WS_XB = 144 * MiB, WS_ACONV = 144 * MiB, WS_OB = 144 * MiB, WS_X1B = 144 * MiB, WS_XG = 144 * MiB;
constexpr size_t WS_SIGA = 176 * MiB, WS_MIXED = 176 * MiB, WS_PM = 176 * MiB;
constexpr size_t WS_SIGB = 208 * MiB, WS_H3 = 208 * MiB, WS_H = 144 * MiB;
constexpr size_t WS_CQ = 240 * MiB, WS_CKV = 248 * MiB, WS_KR = 252 * MiB, WS_KROPE = 254 * MiB;
constexpr size_t WS_KN8 = 128 * MiB;
constexpr size_t WS_X2B = 256 * MiB;
constexpr size_t WS_END = RESID_BF16 ? 288 * MiB : 256 * MiB;
constexpr int CW_TMO = 0, CW_BAR = 4096;

constexpr int RING_BYTES = 131072, EPI_OFF = 131072, EPI_BYTES = 8192, LDSCTL_OFF = 140288, MISC_OFF = LDSCTL_OFF + 320;
constexpr int LDS_BYTES = 148480;
static_assert(2 * 16 * 1028 * 4 + 8192 <= LDSCTL_OFF && EPI_OFF + EPI_BYTES <= LDSCTL_OFF, "LDS map (router, epilogue scratch)");
static_assert(MISC_OFF + 128 <= LDS_BYTES && att::SHM_ATTN <= RING_BYTES, "LDS map");

typedef GAS unsigned gu32;
#define RLX_AGENT __ATOMIC_RELAXED, __HIP_MEMORY_SCOPE_AGENT

#define XB_TMO      128
#define XB_XCNT(j)  (256  + 64 * (j))
#define XB_XSUB(j)  (1280 + 64 * (j))
#define XB_XGEN(j)  (2304 + 64 * (j))
#define XB_TOP      3328
#define XB_TOPGEN   3392
#define XCD_BAR_WORDS 3456
#define XB_SPIN_CAP (1u << 18)
__device__ __forceinline__ unsigned xb_ld(unsigned* p)              { return __hip_atomic_load(p, __ATOMIC_RELAXED, __HIP_MEMORY_SCOPE_AGENT); }
__device__ __forceinline__ unsigned xb_add(unsigned* p, unsigned v) { return __hip_atomic_fetch_add(p, v, __ATOMIC_RELAXED, __HIP_MEMORY_SCOPE_AGENT); }
__device__ __forceinline__ unsigned xb_xcc_id() { return (unsigned)__builtin_amdgcn_s_getreg((3 << 11) | 20) & 0xFu; }
#define XB_SPIN(cond, bar) do { unsigned _sp = 0; while (cond) { __builtin_amdgcn_s_sleep(1); \
    if ((++_sp & 255u) == 0u) { if (xb_ld(&(bar)[XB_TMO])) break; if (_sp > XB_SPIN_CAP) { atomicAdd(&(bar)[XB_TMO], 1u); break; } } } } while (0)
struct XcdBarrier { unsigned* bar; unsigned x; volatile LAS unsigned* st; };
__device__ __forceinline__ XcdBarrier xcd_barrier_post(unsigned* bar, volatile LAS unsigned* st, const bool t0) {
    XcdBarrier b; b.bar = bar; b.x = xb_xcc_id(); b.st = st;
    if (t0) (void)xb_add(&bar[XB_XCNT(b.x)], 1u);
    return b;
}
__device__ __forceinline__ void xcd_barrier_complete(unsigned* bar, unsigned x, unsigned& nloc, unsigned& nx) {
    const unsigned G = gridDim.x * gridDim.y * gridDim.z;
    unsigned sum, cnt, mine, sp = 0u;
    for (;;) {
        sum = 0u; cnt = 0u; mine = 0u;
#pragma unroll
        for (unsigned j = 0; j < 16; ++j) { const unsigned c = xb_ld(&bar[XB_XCNT(j)]); sum += c; cnt += (c > 0u) ? 1u : 0u; mine = (j == x) ? c : mine; }
        if (sum == G) break;
        __builtin_amdgcn_s_sleep(1);
        if ((++sp & 255u) == 0u) { if (xb_ld(&bar[XB_TMO])) break; if (sp > XB_SPIN_CAP) { atomicAdd(&bar[XB_TMO], 1u); break; } }
    }
    nloc = mine > 0u ? mine : 1u; nx = cnt > 0u ? cnt : 1u;
}
__device__ __forceinline__ void xcd_barrier(const XcdBarrier& b, const bool t0) {
    asm volatile("s_waitcnt vmcnt(0)" ::: "memory");
    __syncthreads();
    if (t0) {
        unsigned* bar = b.bar;
        __builtin_amdgcn_s_waitcnt(0);
        unsigned nloc = b.st[0], nx = b.st[1];
        if (nloc == 0u) { xcd_barrier_complete(bar, b.x, nloc, nx); b.st[0] = nloc; b.st[1] = nx; }
        const unsigned old = xb_add(&bar[XB_XSUB(b.x)], 1u);
        const unsigned gen = old / nloc;
        if (old + 1u == (gen + 1u) * nloc) {
            __builtin_amdgcn_fence(__ATOMIC_RELEASE, "agent");
            asm volatile("s_waitcnt vmcnt(0)" ::: "memory");
            const unsigned og = xb_add(&bar[XB_TOP], 1u);
            const unsigned tg = og / nx;
            __builtin_amdgcn_fence(__ATOMIC_ACQUIRE, "agent");
            if (og + 1u == (tg + 1u) * nx) (void)__hip_atomic_fetch_add(&bar[XB_TOPGEN], 1u, __ATOMIC_RELAXED, __HIP_MEMORY_SCOPE_AGENT);
            else XB_SPIN(xb_ld(&bar[XB_TOPGEN]) == tg, bar);
            (void)__hip_atomic_fetch_add(&bar[XB_XGEN(b.x)], 1u, __ATOMIC_RELAXED, __HIP_MEMORY_SCOPE_AGENT);
            asm volatile("s_waitcnt vmcnt(0)" ::: "memory");
        } else {
            __builtin_amdgcn_fence(__ATOMIC_ACQUIRE, "agent");
            XB_SPIN(xb_ld(&bar[XB_XGEN(b.x)]) == gen, bar);
            asm volatile("s_waitcnt vmcnt(0)" ::: "memory");
        }
    }
    __syncthreads();
}

struct Args {
    const float* in[25];
    float* out; unsigned char* ws;
    int ph_lo, ph_hi;
};
enum { I_X = 0, I_MEM, I_NORM_MIX_G, I_W_IN, I_CONV_W, I_CONV_B, I_W_CONV_OUT, I_Q_NORM_G, I_W_UQ, I_KV_NORM_G, I_W_UKV, I_W_MLA_OUT, I_B_GATE, I_W_MIX_OUT,
       I_NORM_MEM_G, I_NORM_MEMKV_G, I_W_MEM_Q, I_W_MEM_KV, I_W_MEM_OUT, I_NORM_MOE_G, I_W_ROUTER, I_W_EXP_GATE, I_W_EXP_UP, I_W_EXP_DOWN, I_NORM_FINAL_G };

constexpr int TP_PITCH = 65, TP_BYTES = 64 * TP_PITCH * 4;
template <class SrcF, class DstF>
__device__ __forceinline__ void transpose_item(SrcF srcp, DstF dstp, int ld, const float* gain, int k0, LAS float* scr, int lane) {
    const int n4 = (lane & 15) * 4, kr = lane >> 4;
    const float* sp = srcp(n4);
    f32x4 v[16];
#pragma unroll
    for (int i = 0; i < 16; ++i) v[i] = sp ? *(const f32x4*)(sp + (size_t)(k0 + 4 * i + kr) * ld) : (f32x4){0.f, 0.f, 0.f, 0.f};
    if (gain) {
#pragma unroll
        for (int i = 0; i < 16; ++i) v[i] = v[i] * gain[k0 + 4 * i + kr]; }
#pragma unroll
    for (int i = 0; i < 16; ++i)
#pragma unroll
        for (int e = 0; e < 4; ++e) scr[(n4 + e) * TP_PITCH + 4 * i + kr] = v[i][e];
    asm volatile("s_waitcnt lgkmcnt(0)" ::: "memory");
    const int c = lane & 7;
#pragma unroll
    for (int j = 0; j < 8; ++j) { const int n = (lane >> 3) + 8 * j; const LAS float* s = scr + n * TP_PITCH + 8 * c;
        u32x4 o; o.x = cvtpk(s[0], s[1]); o.y = cvtpk(s[2], s[3]); o.z = cvtpk(s[4], s[5]); o.w = cvtpk(s[6], s[7]);
        *(u32x4*)(dstp(n) + k0 + 8 * c) = o; }
    asm volatile("s_waitcnt lgkmcnt(0)" ::: "memory");
}
template <class MapF>
__device__ __forceinline__ void transpose_matrix(MapF map, bf16_t* dst, int NDST, int K, int ld, const float* gain, LAS float* scr, int lane, int gw, int NGW, int& itbase) {
    const int nkb = K / 64, nitems = (NDST / 64) * nkb;
    int first = (gw - (itbase % NGW) + NGW) % NGW;
    for (int it = first; it < nitems; it += NGW) { const int nb = it / nkb, kb = it % nkb, n0 = nb * 64;
        transpose_item([&](int n) { return map(n0 + n); }, [&](int n) { return dst + (size_t)(n0 + n) * K; }, ld, gain, kb * 64, scr, lane); }
    itbase += nitems;
}

__device__ __forceinline__ int rope_dim(int p) { return (p >> 3) * 4 + (p & 3) + 32 * ((p >> 2) & 1); }

template <int PHM> __global__ void __launch_bounds__(NWAVES * 64, 2) fwd_kernel(Args args) {
    extern __shared__ __attribute__((aligned(16))) unsigned char lds_raw[];
    LAS unsigned char* lds = (LAS unsigned char*)lds_raw;
    volatile LAS unsigned* MISC = (volatile LAS unsigned*)(lds + MISC_OFF);
    int tid = threadIdx.x, lane = tid & 63; const int wave = __builtin_amdgcn_readfirstlane(tid >> 6);
#define PHASE_BEGIN() do { lane = (int)__builtin_amdgcn_mbcnt_hi(~0u, __builtin_amdgcn_mbcnt_lo(~0u, 0u)); asm volatile("" : "+v"(lane)); tid = wave * 64 + lane; } while (0)
    const int G = gridDim.x; const int bx = blockIdx.x; const int vcu = (G % 8 == 0) ? (bx % 8) * (G / 8) + bx / 8 : bx;
    const int gw = vcu * NWAVES + wave, NGW = G * NWAVES;
    unsigned char* ws = args.ws;
    gu32* ctl = (gu32*)(ws + WS_CTL);
    for (int u = tid; u < (LDS_BYTES - LDSCTL_OFF) / 4; u += NWAVES * 64) ((LAS unsigned*)(lds + LDSCTL_OFF))[u] = 0u;
    __syncthreads();
    XcdBarrier bar; bar.bar = (unsigned*)(ctl + CW_BAR); bar.x = 0; bar.st = nullptr;
    if (N_LAUNCHES == 1) bar = xcd_barrier_post((unsigned*)(ctl + CW_BAR), MISC + 8, tid == 0);
#define GRID_BAR() do { if (N_LAUNCHES == 1) xcd_barrier(bar, wave == 0 && __builtin_amdgcn_mbcnt_hi(~0u, __builtin_amdgcn_mbcnt_lo(~0u, 0u)) == 0u); } while (0)
    const int lo = args.ph_lo, hi = args.ph_hi;
#define IN(k) (((PHM >> (k)) & 1) && lo <= (k) && (k) < hi)
#define SEAM(k) do { if (IN(k) && IN((k) + 1)) GRID_BAR(); } while (0)

    const float* x = args.in[I_X]; float* out = args.out;
#define rope ((f32x2*)(ws + WS_ROPE))
#define rstd0 ((float*)(ws + WS_RSTD0))
#define rstdq ((float*)(ws + WS_RSTDQ))
#define rstdkv ((float*)(ws + WS_RSTDKV))
#define rstdm ((float*)(ws + WS_RSTDM))
#define ssq ((float*)(ws + WS_SSQ))
#define aff ((float*)(ws + WS_AFF))
#define inv ((int*)(ws + WS_INV))
#define idx ((int*)(ws + WS_IDX))
#define gate ((float*)(ws + WS_GATE))
#define memb ((bf16_t*)(ws + WS_MEMB))
#define MKV ((bf16_t*)(ws + WS_MKV))
#define QKT ((bf16_t*)(ws + WS_QKT))
#define VWT ((bf16_t*)(ws + WS_VWT))
#define Win_t ((bf16_t*)(ws + WS_WIN))
#define Wco_t ((bf16_t*)(ws + WS_WCO))
#define Wmo_t ((bf16_t*)(ws + WS_WMO))
#define Wmix_t ((bf16_t*)(ws + WS_WMIX))
#define Wuq_t ((bf16_t*)(ws + WS_WUQ))
#define Wukv_t ((bf16_t*)(ws + WS_WUKV))
#define Wmqh ((bf16_t*)(ws + WS_WMQH))
#define Woht ((bf16_t*)(ws + WS_WOHT))
#define Wmkv_t ((bf16_t*)(ws + WS_WMKV))
#define XGG ((bf16_t*)(ws + WS_XGG))
#define QB ((bf16_t*)(ws + WS_QB))
#define MIXA ((bf16_t*)(ws + WS_MIXA))
#define Wgu_t ((bf16_t*)(ws + WS_WGU))
#define Wd_t ((bf16_t*)(ws + WS_WD))
#define Y ((bf16_t*)(ws + WS_Y))
#define XB ((bf16_t*)(ws + WS_XB))
#define KN8 ((unsigned char*)(ws + WS_KN8))
#define VT8 ((unsigned char*)out)
#define Q8 ((unsigned char*)(ws + WS_QB))
#define KR8 ((unsigned char*)(ws + WS_KROPE))
#define X2B ((bf16_t*)(ws + WS_X2B))
#define ACONV ((bf16_t*)(ws + WS_ACONV))
#define OB ((bf16_t*)(ws + WS_OB))
#define X1B ((bf16_t*)(ws + WS_X1B))
#define XG ((bf16_t*)(ws + WS_XG))
#define SIGA ((bf16_t*)(ws + WS_SIGA))
#define MIXED ((bf16_t*)(ws + WS_MIXED))
#define PM ((bf16_t*)(ws + WS_PM))
#define SIGB ((bf16_t*)(ws + WS_SIGB))
#define H3 ((bf16_t*)(ws + WS_H3))
#define HB ((bf16_t*)(ws + WS_H))
#define CQ ((bf16_t*)(ws + WS_CQ))
#define CKV ((bf16_t*)(ws + WS_CKV))
#define KR ((bf16_t*)(ws + WS_KR))
#define KROPE ((bf16_t*)(ws + WS_KROPE))
#define KVB ((bf16_t*)out)
    LAS float* scr = (LAS float*)(lds + wave * TP_BYTES);

    if (IN(0)) { PHASE_BEGIN();
        int itb = 0;
        { const float* W = args.in[I_W_IN]; const float* gn = args.in[I_NORM_MIX_G];
          transpose_matrix([&](int n) -> const float* { if (n < 2048) { const int t = n >> 8, half = (n >> 7) & 1, c = n & 127; return W + (half ? 2048 : 0) + 128 * t + c; }
                                                         if (n < 3072) return W + 1024 + (n - 2048); if (n < 3520) return W + n; if (n < 3584) return nullptr; return W + (n - 64); },
                           Win_t, NU, 1024, 5568, gn, scr, lane, gw, NGW, itb); }
        { const float* W = args.in[I_W_CONV_OUT]; transpose_matrix([&](int n) -> const float* { return W + n; }, Wco_t, 1024, 1024, 1024, nullptr, scr, lane, gw, NGW, itb); }
        { const float* W = args.in[I_W_MLA_OUT]; transpose_matrix([&](int n) -> const float* { return W + n; }, Wmo_t, 1024, 1024, 1024, nullptr, scr, lane, gw, NGW, itb); }
        { const float* W = args.in[I_W_MIX_OUT]; transpose_matrix([&](int n) -> const float* { return W + n; }, Wmix_t, 1024, 1024, 1024, nullptr, scr, lane, gw, NGW, itb); }
        { const float* W = args.in[I_W_UQ]; const float* gn = args.in[I_Q_NORM_G];
          transpose_matrix([&](int n) -> const float* { if (n < 1024) return W + (n >> 7) * 192 + (n & 127); const int r = n - 1024; return W + (r >> 6) * 192 + 128 + rope_dim(r & 63); },
                           Wuq_t, 1536, 256, 1536, gn, scr, lane, gw, NGW, itb); }
        { const float* W = args.in[I_W_UKV]; const float* gn = args.in[I_KV_NORM_G];
          transpose_matrix([&](int n) -> const float* { if (n < 1024) return W + (n >> 7) * 256 + (n & 127); const int r = n - 1024; return W + (r >> 7) * 256 + 128 + (r & 127); },
                           Wukv_t, 2048, 128, 2048, gn, scr, lane, gw, NGW, itb); }
        { const float* W = args.in[I_W_MEM_KV]; const float* gn = args.in[I_NORM_MEMKV_G];
          transpose_matrix([&](int n) -> const float* { return W + n; }, Wmkv_t, 2048, 1024, 2048, gn, scr, lane, gw, NGW, itb); }
        for (int h = 0; h < 4; ++h) { const float* W = args.in[I_W_MEM_OUT] + (size_t)h * 256 * 1024;
          transpose_matrix([&](int n) -> const float* { return W + n; }, Woht + (size_t)h * 1024 * 256, 1024, 256, 1024, nullptr, scr, lane, gw, NGW, itb); }
        { const float* W = args.in[I_W_MEM_Q]; const float* gn = args.in[I_NORM_MEM_G];
          for (int c = gw * 64 + lane; c < 1024 * 1024 / 8; c += NGW * 64) { const int e0 = c * 8, h = e0 >> 18, d = (e0 >> 8) & 1023, j = e0 & 255; const float g = gn[d];
              const float* s = W + (size_t)d * 1024 + h * 256 + j; const f32x4 a = *(const f32x4*)s, b = *(const f32x4*)(s + 4);
              const float o[8] = {a[0] * g, a[1] * g, a[2] * g, a[3] * g, b[0] * g, b[1] * g, b[2] * g, b[3] * g}; *(u32x4*)(Wmqh + e0) = pack8(o); } }
        for (int r = gw; r < MT + NB * MEM_LEN; r += NGW) { const bool isx = r < MT; const int rr = isx ? r : r - MT;
            const float* src = (isx ? x : args.in[I_MEM]) + (size_t)rr * 1024; bf16_t* dst = (isx ? XB : memb) + (size_t)rr * 1024; float s = 0.f;
#pragma unroll
            for (int j = 0; j < 4; ++j) { const f32x4 v = *(const f32x4*)(src + (lane + 64 * j) * 4); s += (v[0] * v[0] + v[1] * v[1]) + (v[2] * v[2] + v[3] * v[3]);
                u32x2 w; w.x = cvtpk(v[0], v[1]); w.y = cvtpk(v[2], v[3]); *(u32x2*)(dst + (lane + 64 * j) * 4) = w; }
            s = wave_sum(s); if (lane == 0) (isx ? rstd0 : rstdm)[rr] = 1.f / sqrtf(s * (1.f / 1024.f) + EPS); }
        for (int i = gw * 64 + lane; i < SEQ * 32; i += NGW * 64) { const int s = i >> 5, j = i & 31; const float invf = 1.0f / powf(10000.0f, (float)(2 * j) / 64.0f); const float ang = (float)s * invf;
            rope[i] = (f32x2){cosf(ang), sinf(ang)}; }
    }
    SEAM(0);

    if (IN(1)) { PHASE_BEGIN();
        { Gemm g = mkgemm(XB, Win_t, MT, NU, 1024, 1024, 1024); StaticOrder S; S.init(MT, NU, G, bx);
          EpiU E{{rstd0, XGG, CQ, CKV, KR, SIGA, SIGB, args.in[I_B_GATE]}}; pg8::gemm_phase(lds, g, S, E, tid); }
        { Gemm g = mkgemm(memb, Wmkv_t, NB * MEM_LEN, 2048, 1024, 1024, 1024); StaticOrder S; S.init(NB * MEM_LEN, 2048, G, (bx + G / 2) % G);
          pg8::EpiChunk<FMemKV> E{{rstdm, MKV}}; pg8::gemm_phase(lds, g, S, E, tid); }
    }
    SEAM(1);

    if (IN(2)) { PHASE_BEGIN();
        const float* cw = args.in[I_CONV_W]; const float* cb = args.in[I_CONV_B];
        for (int blk = gw; blk < MT / 4; blk += NGW) { const int r0 = blk * 4, s0 = r0 & (SEQ - 1);
            u32x4 pxr[6][2], gbr[4][2]; u32x2 cqr[4]; unsigned ckr[4]; bf16_t k1[4], k2[4];
            const u32x4 z = {0u, 0u, 0u, 0u};
#pragma unroll
            for (int i = 0; i < 6; ++i) { const int rr = r0 - 1 + i; const bool ok = (i > 0 || s0 > 0) && (i < 5 || s0 + 4 < SEQ);
#pragma unroll
                for (int j = 0; j < 2; ++j) pxr[i][j] = ok ? *(const u32x4*)(XGG + (size_t)rr * 2048 + lane * 8 + 512 * j) : z; }
#pragma unroll
            for (int i = 0; i < 4; ++i) { const int rr = r0 + i;
#pragma unroll
                for (int j = 0; j < 2; ++j) gbr[i][j] = *(const u32x4*)(XGG + (size_t)rr * 2048 + 1024 + lane * 8 + 512 * j);
                cqr[i] = *(const u32x2*)(CQ + (size_t)rr * 256 + lane * 4); ckr[i] = *(const unsigned*)(CKV + (size_t)rr * 128 + lane * 2);
                { const int j_ = (lane >> 3) * 4 + (lane & 3); k1[i] = KR[(size_t)rr * 64 + j_]; k2[i] = KR[(size_t)rr * 64 + j_ + 32]; } }
#pragma unroll
            for (int j = 0; j < 2; ++j) { const int c0 = lane * 8 + 512 * j;
                float w0[8], w1[8], w2[8], bb[8];
                { const f32x4 a = *(const f32x4*)(cw + c0), b = *(const f32x4*)(cw + c0 + 4); w0[0] = a[0]; w0[1] = a[1]; w0[2] = a[2]; w0[3] = a[3]; w0[4] = b[0]; w0[5] = b[1]; w0[6] = b[2]; w0[7] = b[3]; }
                { const f32x4 a = *(const f32x4*)(cw + 1024 + c0), b = *(const f32x4*)(cw + 1024 + c0 + 4); w1[0] = a[0]; w1[1] = a[1]; w1[2] = a[2]; w1[3] = a[3]; w1[4] = b[0]; w1[5] = b[1]; w1[6] = b[2]; w1[7] = b[3]; }
                { const f32x4 a = *(const f32x4*)(cw + 2048 + c0), b = *(const f32x4*)(cw + 2048 + c0 + 4); w2[0] = a[0]; w2[1] = a[1]; w2[2] = a[2]; w2[3] = a[3]; w2[4] = b[0]; w2[5] = b[1]; w2[6] = b[2]; w2[7] = b[3]; }
                { const f32x4 a = *(const f32x4*)(cb + c0), b = *(const f32x4*)(cb + c0 + 4); bb[0] = a[0]; bb[1] = a[1]; bb[2] = a[2]; bb[3] = a[3]; bb[4] = b[0]; bb[5] = b[1]; bb[6] = b[2]; bb[7] = b[3]; }
                float p[6][8];
#pragma unroll
                for (int i = 0; i < 6; ++i) unpack8(pxr[i][j], p[i]);
#pragma unroll
                for (int i = 0; i < 4; ++i) { float gb[8], o[8]; unpack8(gbr[i][j], gb);
#pragma unroll
                    for (int e = 0; e < 8; ++e) o[e] = gb[e] * (w0[e] * p[i][e] + w1[e] * p[i + 1][e] + w2[e] * p[i + 2][e] + bb[e]);
                    *(u32x4*)(ACONV + (size_t)(r0 + i) * 1024 + c0) = pack8(o); } }
#pragma unroll
            for (int i = 0; i < 4; ++i) { const int r = r0 + i, s = r & (SEQ - 1);
                { const u32x2 w = cqr[i]; const float a = bflo(w.x), b = bfhi(w.x), c = bflo(w.y), d = bfhi(w.y);
                  const float sq = wave_sum((a * a + b * b) + (c * c + d * d)); if (lane == 0) rstdq[r] = 1.f / sqrtf(sq * (1.f / 256.f) + EPS); }
                { const unsigned w = ckr[i]; const float a = bflo(w), b = bfhi(w);
                  const float sq = wave_sum(a * a + b * b); if (lane == 0) rstdkv[r] = 1.f / sqrtf(sq * (1.f / 128.f) + EPS); }
                { const int pp = lane, j = (pp >> 3) * 4 + (pp & 3), half = (pp >> 2) & 1; const float v1 = bf2f(k1[i]), v2 = bf2f(k2[i]); const f32x2 cs = rope[s * 32 + j];
                  const float kv_ = half ? v1 * cs.y + v2 * cs.x : v1 * cs.x - v2 * cs.y;
#if ATT_FP8
                  KR8[(size_t)r * 64 + pp] = (unsigned char)(__builtin_amdgcn_cvt_pk_fp8_f32(kv_, kv_, 0u, false) & 0xffu);
#else
                  KROPE[(size_t)r * 64 + pp] = f2bf(kv_);
#endif
                } }
        }
    }
    SEAM(2);

    if (IN(3)) { PHASE_BEGIN();
        { Gemm g = mkgemm(ACONV, Wco_t, MT, 1024, 1024, 1024, 1024); StaticOrder S; S.init(MT, 1024, G, bx);
          pg8::EpiChunk<FGateMul> E{{SIGA, MIXA}}; pg8::gemm_phase(lds, g, S, E, tid); }
        { Gemm g = mkgemm(CQ, Wuq_t, MT, 1536, 256, 256, 256); StaticOrder S; S.init(MT, 1536, G, (bx + G / 2) % G);
          pg8::EpiChunk<FQ> E{{rstdq, rope, QB, ATT_FP8 ? Q8 : nullptr}}; pg8::gemm_phase(lds, g, S, E, tid); }
        { Gemm g = mkgemm(CKV, Wukv_t, MT, 2048, 128, 128, 128); StaticOrder S; S.init(MT, 2048, G, bx);
#if ATT_FP8
          (void)g; (void)S; }
        { Gemm g = mkgemm(CKV, Wukv_t, MT, 1024, 128, 128, 128); StaticOrder S; S.init(MT, 1024, G, bx);
          pg8::EpiChunk<FK8> E{{rstdkv, KN8}}; pg8::gemm_phase(lds, g, S, E, tid); }
        { Gemm g = mkgemm(Wukv_t + (size_t)1024 * 128, CKV, 1024, MT, 128, 128, 128); StaticOrder S; S.init(1024, MT, G, bx);
          pg8::EpiChunk<FVT8> E{{rstdkv, VT8}}; pg8::gemm_phase(lds, g, S, E, tid); }
#else
          pg8::EpiChunk<FScaleRow> E{{rstdkv, KVB, 2048}}; pg8::gemm_phase(lds, g, S, E, tid); }
#endif
        { Gemm g = mkgemm(MKV, Wmqh, 2048, 1024, 256, 256, 256, 1, 4, (size_t)1024 * 256); StaticOrder S; S.init(2048, 1024, G, bx);
          pg8::EpiChunk<FPlain> E{{QKT, 1024}}; pg8::gemm_phase(lds, g, S, E, tid); }
        for (int b = 0; b < NB; ++b) { Gemm g = mkgemm(Woht, MKV + (size_t)(8 + b * 4) * 65536, 4096, 256, 256, 256, 256, 4, 4, (size_t)65536); StaticOrder S; S.init(4096, 256, G, (bx + G - 64 - 16 * b) % G);
          pg8::EpiChunk<FVW> E{{VWT + (size_t)b * 1024 * 1024}}; pg8::gemm_phase(lds, g, S, E, tid); }
    }
    SEAM(3);

    if (IN(4)) { PHASE_BEGIN(); unsigned tacc_ = 0;
        for (int u = vcu; u < NB * NHEAD * (SEQ / 256); u += G) { const int bh = u >> 5, qb = u & 31, b = bh >> 3, h = bh & 7; const size_t row0 = (size_t)b * SEQ + qb * 256;
#if ATT_FP8
            att::attn_unit10(Q8 + row0 * 1536 + h * 128, Q8 + row0 * 1536 + 1024 + h * 64, KN8 + (size_t)b * SEQ * 1024 + h * 128, KR8 + (size_t)b * SEQ * 64,
                            VT8 + (size_t)(b * NHEAD + h) * 128 * SEQ, OB + row0 * 1024 + h * 128, SEQ, (char*)lds_raw, tid, tacc_);
#else
            att::attn_unit(QB + row0 * 1536 + h * 128, QB + row0 * 1536 + 1024 + h * 64, KVB + (size_t)b * SEQ * 2048 + h * 128,
                           KROPE + (size_t)b * SEQ * 64, OB + row0 * 1024 + h * 128, SEQ, (char*)lds_raw, tid);
#endif
        }
#if PROBE_SEG
        if (bx == 0 && wave == PROBE_WAVE) { const unsigned t0_ = att::tstamp(); while (att::tstamp() - t0_ < tacc_) { } }
#endif
    }
    SEAM(4);

    if (IN(5)) { PHASE_BEGIN(); Gemm g = mkgemm(OB, Wmo_t, MT, 1024, 1024, 1024, 1024); StaticOrder S; S.init(MT, 1024, G, bx);
        pg8::EpiChunk<FGateMulAdd> E{{SIGB, MIXA, MIXED}}; pg8::gemm_phase(lds, g, S, E, tid); }
    SEAM(5);

    if (IN(6)) { PHASE_BEGIN(); Gemm g = mkgemm(MIXED, Wmix_t, MT, 1024, 1024, 1024, 1024); StaticOrder S; S.init(MT, 1024, G, bx);
        EpiX1 E{x, RESID_BF16 ? nullptr : out, X1B, ssq}; pg8::gemm_phase(lds, g, S, E, tid); }
    SEAM(6);

    if (IN(7)) { PHASE_BEGIN(); Gemm g = mkgemm(X1B, QKT, MT, 1024, 1024, 1024, 1024, 32, 2, (size_t)1024 * 1024); StaticOrder S; S.init(MT, 1024, G, bx);
        EpiSoftmax E{ssq, PM}; pg8::gemm_phase(lds, g, S, E, tid); }
    SEAM(7);

    if (IN(8)) { PHASE_BEGIN(); Gemm g = mkgemm(PM, VWT, MT, 1024, 1024, 1024, 1024, 32, 2, (size_t)1024 * 1024); StaticOrder S; S.init(MT, 1024, G, bx);
#if RESID_BF16
        pg8::EpiChunk<FResidBf16> E{{X1B, X2B}}; pg8::gemm_phase(lds, g, S, E, tid); }
#else
        pg8::EpiChunk<FResidF32> E{{out, out}}; pg8::gemm_phase(lds, g, S, E, tid); }
#endif
    SEAM(8);

#if RESID_BF16
#define LDROW4(r_, j_) ([&]() -> f32x4 { const u32x2 w_ = *(const u32x2*)(X2B + (size_t)(r_) * 1024 + (lane + 64 * (j_)) * 4); return (f32x4){bflo(w_.x), bfhi(w_.x), bflo(w_.y), bfhi(w_.y)}; }())
#else
#define LDROW4(r_, j_) (*(const f32x4*)(out + (size_t)(r_) * 1024 + (lane + 64 * (j_)) * 4))
#endif
    if (IN(9)) { PHASE_BEGIN();
        constexpr int RP = 1028;
        LAS float* wt = (LAS float*)lds;
        LAS float* hb = (LAS float*)(lds + 16 * RP * 4);
        LAS float* part = (LAS float*)(lds + 2 * 16 * RP * 4);
        const float* wr_ = args.in[I_W_ROUTER]; const float* gn = args.in[I_NORM_MOE_G];
        for (int i = tid; i < 1024 * 16; i += NWAVES * 64) wt[(i & 15) * RP + (i >> 4)] = wr_[i];
        f32x4 gv[4];
#pragma unroll
        for (int j = 0; j < 4; ++j) gv[j] = *(const f32x4*)(gn + (lane + 64 * j) * 4);
        f32x4 v[2][4], vn[2][4];
        const int ngroups = MT / 16;
        if (vcu < ngroups) {
#pragma unroll
            for (int t = 0; t < 2; ++t)
#pragma unroll
                for (int j = 0; j < 4; ++j) v[t][j] = LDROW4(vcu * 16 + wave * 2 + t, j); }
        __syncthreads();
        for (int g = vcu; g < ngroups; g += G) { const int r0 = g * 16;
            if (g + G < ngroups) {
#pragma unroll
                for (int t = 0; t < 2; ++t)
#pragma unroll
                    for (int j = 0; j < 4; ++j) vn[t][j] = LDROW4((g + G) * 16 + wave * 2 + t, j); }
#pragma unroll
            for (int t = 0; t < 2; ++t) { const int tk = wave * 2 + t, r = r0 + tk; float s = 0.f;
#pragma unroll
                for (int j = 0; j < 4; ++j) s += (v[t][j][0] * v[t][j][0] + v[t][j][1] * v[t][j][1]) + (v[t][j][2] * v[t][j][2] + v[t][j][3] * v[t][j][3]);
                const float rs = 1.f / sqrtf(wave_sum(s) * (1.f / 1024.f) + EPS);
#pragma unroll
                for (int j = 0; j < 4; ++j) { const f32x4 hh = v[t][j] * rs * gv[j]; *(LAS f32x4*)(hb + tk * RP + (lane + 64 * j) * 4) = hh;
                    u32x2 w; w.x = cvtpk(hh[0], hh[1]); w.y = cvtpk(hh[2], hh[3]); *(u32x2*)(H3 + (size_t)r * 1024 + (lane + 64 * j) * 4) = w; } }
            __syncthreads();
            { f32x4 acc = {0.f, 0.f, 0.f, 0.f}; const LAS float* ap = wt + (lane & 15) * RP + wave * 128 + (lane >> 4); const LAS float* bp = hb + (lane & 15) * RP + wave * 128 + (lane >> 4);
#pragma unroll 8
                for (int st = 0; st < 32; ++st) acc = __builtin_amdgcn_mfma_f32_16x16x4f32(ap[4 * st], bp[4 * st], acc, 0, 0, 0);
                *(LAS f32x4*)(part + (wave * 16 + (lane & 15)) * 16 + 4 * (lane >> 4)) = acc; }
            __syncthreads();
            if (tid < 256) { const int tk = tid >> 4, e = tid & 15; float lg = 0.f;
#pragma unroll
                for (int w = 0; w < 8; ++w) lg += part[(w * 16 + tk) * 16 + e];
                float mx = lg;
#pragma unroll
                for (int o = 1; o < 16; o <<= 1) mx = fmaxf(mx, __shfl_xor(mx, o));
                const float p = __expf(lg - mx); float sm = p;
#pragma unroll
                for (int o = 1; o < 16; o <<= 1) sm += __shfl_xor(sm, o);
                const int r = r0 + tk, b = r >> 13, sidx = r & (SEQ - 1); aff[((size_t)b * NEXP + e) * SEQ + sidx] = p / sm; inv[(size_t)r * 16 + e] = -1; }
            __syncthreads();
#pragma unroll
            for (int t = 0; t < 2; ++t)
#pragma unroll
                for (int j = 0; j < 4; ++j) v[t][j] = vn[t][j];
        }
    }
    SEAM(9);

    if (IN(10)) { PHASE_BEGIN();
        if (vcu < NB * NEXP) {
            LAS unsigned* keys = (LAS unsigned*)lds; LAS unsigned* hist = (LAS unsigned*)(lds + 32768); LAS unsigned* misc = (LAS unsigned*)(lds + 32768 + 1024);
            for (int be = vcu; be < NB * NEXP; be += G) { const int b = be >> 4, e = be & 15; const float* a = aff + (size_t)be * SEQ;
#pragma unroll 1
                for (int i = tid; i < SEQ; i += NWAVES * 64) keys[i] = __float_as_uint(a[i]);
                unsigned prefix = 0u, kth = CAP;
#pragma unroll 1
                for (int pass = 0; pass < 4; ++pass) { const int shift = 24 - 8 * pass;
                    if (tid < 256) hist[tid] = 0u;
                    __syncthreads();
#pragma unroll 1
                    for (int i = tid; i < SEQ; i += NWAVES * 64) { const unsigned k = keys[i]; const bool match = (pass == 0) || ((k >> (shift + 8)) == (prefix >> (shift + 8)));
                        if (match) atomicAdd((unsigned*)(hist + ((k >> shift) & 255u)), 1u); }
                    __syncthreads();
                    if (wave == 0) { unsigned c[4]; unsigned tot = 0u;
#pragma unroll
                        for (int i = 0; i < 4; ++i) { c[i] = hist[255 - (4 * lane + i)]; tot += c[i]; }
                        unsigned incl = tot;
#pragma unroll
                        for (int o = 1; o < 64; o <<= 1) { const unsigned t = __shfl_up(incl, o); if (lane >= o) incl += t; }
                        unsigned run = incl - tot;
#pragma unroll
                        for (int i = 0; i < 4; ++i) { if (run < kth && run + c[i] >= kth) { misc[0] = 255u - (unsigned)(4 * lane + i); misc[1] = kth - run; } run += c[i]; } }
                    __syncthreads();
                    prefix |= misc[0] << shift; kth = misc[1];
                    __syncthreads();
                }
                const unsigned T = prefix; unsigned base_g = 0u, base_e = 0u;
#pragma unroll 1
                for (int it = 0; it < SEQ / (NWAVES * 64); ++it) { const int t = it * (NWAVES * 64) + tid; const unsigned k = keys[t]; const bool gt = k > T, eq = k == T;
                    const unsigned long long bg = __ballot(gt), bq = __ballot(eq); const unsigned long long lt = (1ull << lane) - 1ull;
                    if (lane == 0) { misc[8 + wave] = (unsigned)__popcll(bg); misc[16 + wave] = (unsigned)__popcll(bq); }
                    __syncthreads();
                    unsigned pg = base_g, pq = base_e, tg = 0u, tq = 0u;
#pragma unroll
                    for (int w = 0; w < NWAVES; ++w) { const unsigned cg = misc[8 + w], cq = misc[16 + w]; if (w < wave) { pg += cg; pq += cq; } tg += cg; tq += cq; }
                    pg += (unsigned)__popcll(bg & lt); pq += (unsigned)__popcll(bq & lt);
                    const bool sel = gt || (eq && pq < kth);
                    if (sel) { const unsigned pos = pg + (pq < kth ? pq : kth); idx[(size_t)be * CAP + pos] = t; gate[(size_t)be * CAP + pos] = __uint_as_float(k); inv[((size_t)b * SEQ + t) * 16 + e] = (int)pos; }
                    base_g += tg; base_e += tq;
                    __syncthreads();
                }
            }
        } else {
            const int cw_ = vcu - NB * NEXP, ncw = G - NB * NEXP; const int gw2 = cw_ * NWAVES + wave, NGW2 = ncw * NWAVES;
#pragma unroll 1
            for (int it = gw2; it < NEXP * 768; it += NGW2) { const int e = it / 768, r = it % 768;
                if (r < 512) { const int nb = r >> 4, kb = r & 15, n0 = nb * 64; const int f0 = (n0 >> 8) * 128 + (n0 & 127);
                    const float* W = (((n0 >> 7) & 1) ? args.in[I_W_EXP_UP] : args.in[I_W_EXP_GATE]) + (size_t)e * 1024 * 1024 + f0; bf16_t* D = Wgu_t + (size_t)e * 2048 * 1024 + (size_t)n0 * 1024;
                    transpose_item([&](int n) { return W + n; }, [&](int n) { return D + (size_t)n * 1024; }, 1024, nullptr, kb * 64, scr, lane); }
                else { const int r2 = r - 512, nb = r2 >> 4, kb = r2 & 15, n0 = nb * 64;
                    const float* W = args.in[I_W_EXP_DOWN] + (size_t)e * 1024 * 1024 + n0; bf16_t* D = Wd_t + (size_t)e * 1024 * 1024 + (size_t)n0 * 1024;
                    transpose_item([&](int n) { return W + n; }, [&](int n) { return D + (size_t)n * 1024; }, 1024, nullptr, kb * 64, scr, lane); } }
        }
    }
    if (IN(10) && IN(12)) GRID_BAR();

    if (IN(12)) { PHASE_BEGIN(); Gemm g = mkgemm(H3, Wgu_t, MOE_ROWS, 2048, 1024, 1024, 1024, 4, 16, (size_t)2048 * 1024); g.gidx = idx; StaticOrder S; S.init(MOE_ROWS, 2048, G, bx);
        EpiSwiglu E{HB}; pg8::gemm_phase<EpiSwiglu, StaticOrder, true>(lds, g, S, E, tid); }
    SEAM(12);

    if (IN(13)) { PHASE_BEGIN(); Gemm g = mkgemm(HB, Wd_t, MOE_ROWS, 1024, 1024, 1024, 1024, 4, 16, (size_t)1024 * 1024); StaticOrder S; S.init(MOE_ROWS, 1024, G, bx);
        pg8::EpiChunk<FGateRow> E{{gate, Y}}; pg8::gemm_phase(lds, g, S, E, tid); }
    SEAM(13);

    if (IN(14)) { PHASE_BEGIN();
        const float* gn = args.in[I_NORM_FINAL_G]; f32x4 gv[4];
#pragma unroll
        for (int j = 0; j < 4; ++j) gv[j] = *(const f32x4*)(gn + (lane + 64 * j) * 4);
        f32x4 v[4], vn[4]; int myslot = -1, nslot = -1;
        if (gw < MT) { myslot = inv[(size_t)gw * 16 + (lane & 15)];
#pragma unroll
            for (int j = 0; j < 4; ++j) v[j] = LDROW4(gw, j); }
        for (int r = gw; r < MT; r += NGW) { float* row = out + (size_t)r * 1024; const int b = r >> 13;
            if (r + NGW < MT) { nslot = inv[(size_t)(r + NGW) * 16 + (lane & 15)];
#pragma unroll
                for (int j = 0; j < 4; ++j) vn[j] = LDROW4(r + NGW, j); }
            unsigned long long em = __ballot(lane < 16 && myslot >= 0) & 0xffffull;
            while (em) { u32x2 w[4][4]; int ne = 0;
#pragma unroll
                for (int q = 0; q < 4; ++q) { if (em) { const int e = __builtin_ctzll(em); em &= em - 1; const int slot = __builtin_amdgcn_readlane(myslot, e);
                        const bf16_t* yr = Y + ((size_t)(b * NEXP + e) * CAP + slot) * 1024;
#pragma unroll
                        for (int j = 0; j < 4; ++j) w[q][j] = *(const u32x2*)(yr + (lane + 64 * j) * 4);
                        ne = q + 1; } }
#pragma unroll
                for (int q = 0; q < 4; ++q) { if (q < ne) {
#pragma unroll
                        for (int j = 0; j < 4; ++j) { v[j][0] += bflo(w[q][j].x); v[j][1] += bfhi(w[q][j].x); v[j][2] += bflo(w[q][j].y); v[j][3] += bfhi(w[q][j].y); } } } }
            float s = 0.f;
#pragma unroll
            for (int j = 0; j < 4; ++j) s += (v[j][0] * v[j][0] + v[j][1] * v[j][1]) + (v[j][2] * v[j][2] + v[j][3] * v[j][3]);
            const float rs = 1.f / sqrtf(wave_sum(s) * (1.f / 1024.f) + EPS);
#pragma unroll
            for (int j = 0; j < 4; ++j) *(f32x4*)(row + (lane + 64 * j) * 4) = v[j] * rs * gv[j];
#pragma unroll
            for (int j = 0; j < 4; ++j) v[j] = vn[j];
            myslot = nslot;
        }
    }
#undef IN
#undef SEAM
#undef GRID_BAR
}

#ifndef PH_MASK
#define PH_MASK 0x7fff
#endif
static const void* phase_fn(int k) {
#if MK_N_LAUNCHES == 1
    (void)k; return (const void*)fwd_kernel<PH_MASK>;
#else
    switch (k) {
    case 0: return (const void*)fwd_kernel<1 << 0>;   case 1: return (const void*)fwd_kernel<1 << 1>;   case 2: return (const void*)fwd_kernel<1 << 2>;   case 3: return (const void*)fwd_kernel<1 << 3>;
    case 4: return (const void*)fwd_kernel<1 << 4>;   case 5: return (const void*)fwd_kernel<1 << 5>;   case 6: return (const void*)fwd_kernel<1 << 6>;   case 7: return (const void*)fwd_kernel<1 << 7>;
    case 8: return (const void*)fwd_kernel<1 << 8>;   case 9: return (const void*)fwd_kernel<1 << 9>;   case 10: return (const void*)fwd_kernel<1 << 10>; case 11: return (const void*)fwd_kernel<1 << 11>;
    case 12: return (const void*)fwd_kernel<1 << 12>; case 13: return (const void*)fwd_kernel<1 << 13>; default: return (const void*)fwd_kernel<1 << 14>;
    }
#endif
}
extern "C" void kernel_launch(void* const* d_in, const int* in_sizes, int n_in, void* d_out, int out_size, void* d_ws, size_t ws_size, hipStream_t stream) {
    static int grid = 0;
    if (grid == 0) {
        if (n_in != 25 || in_sizes[0] != MT * DM || out_size != MT * DM || ws_size < WS_END) {
            fprintf(stderr, "kernel_launch: built for 25 inputs, x/out of %d floats, >= %zu bytes of workspace; got n_in %d, in0 %d, out %d, ws %zu; nothing launched\n", MT * DM, (size_t)WS_END, n_in, n_in > 0 ? in_sizes[0] : -1, out_size, ws_size);
            grid = -1; return; }
        int dev = 0, cus = 0;
        if (hipGetDevice(&dev) != hipSuccess || hipDeviceGetAttribute(&cus, hipDeviceAttributeMultiprocessorCount, dev) != hipSuccess) { fprintf(stderr, "kernel_launch: device query failed\n"); grid = -1; return; }
        for (int k = 0; k < (N_LAUNCHES == 1 ? 1 : N_PHASES); ++k)
            if (hipFuncSetAttribute(phase_fn(N_LAUNCHES == 1 ? -1 : k), hipFuncAttributeMaxDynamicSharedMemorySize, LDS_BYTES) != hipSuccess) { fprintf(stderr, "kernel_launch: hipFuncSetAttribute failed\n"); grid = -1; return; }
        (void)hipGetLastError();
        grid = cus;
    }
    if (grid < 0) return;
    if (hipMemsetAsync((char*)d_ws + WS_CTL, 0, CTL_ZERO_BYTES, stream) != hipSuccess) { fprintf(stderr, "kernel_launch: memset failed\n"); return; }
    Args a{};
    for (int i = 0; i < 25; ++i) a.in[i] = (const float*)d_in[i];
    a.out = (float*)d_out; a.ws = (unsigned char*)d_ws;
    for (int li = 0; li < N_LAUNCHES; ++li) {
        a.ph_lo = (N_LAUNCHES == 1) ? 0 : li; a.ph_hi = (N_LAUNCHES == 1) ? N_PHASES : li + 1;
        void* kargs[] = {&a};
        for (int rep = 0; rep < ((N_LAUNCHES != 1 && li == REP_PHASE) ? 2 : 1); ++rep)
            (void)hipLaunchKernel(phase_fn(N_LAUNCHES == 1 ? -1 : li), dim3(grid), dim3(NWAVES * 64), kargs, LDS_BYTES, stream);
        const hipError_t le = hipPeekAtLastError();
        if (le != hipSuccess) { fprintf(stderr, "kernel_launch: launch %d failed: %s\n", li, hipGetErrorName(le)); break; }
    }
}
```
